# Optimizing an MI355X kernel written in HIP

```python
import jax, jax.numpy as jnp
from jax import lax
import numpy as np

D_MODEL = 1024
BATCH = 2
SEQ = 8192
DEPTH = 1

CHUNK = 64
PLE_DIM = 256
HEAD_DIM = 64
SWA_HEADS = 8
SWA_KV_HEADS = 2
SWA_GROUP = SWA_HEADS // SWA_KV_HEADS
WINDOW = 128
SWA_BLOCK = WINDOW
FOX_HEADS = 8
FOX_BLOCK = 128
D_FF = 4 * D_MODEL
N_BRANCH = 2
RMS_EPS = 1e-6

SWA_Q = SWA_HEADS * HEAD_DIM
SWA_KV = SWA_KV_HEADS * HEAD_DIM
FOX_W = FOX_HEADS * HEAD_DIM
GATE_W = N_BRANCH * D_MODEL
SPLIT_POINTS = tuple(np.cumsum([SWA_Q, SWA_KV, SWA_KV, FOX_W, FOX_W, FOX_W, FOX_HEADS]).tolist())
D_IN = SPLIT_POINTS[-1] + GATE_W

kernel_name = "hybrid_swa_sink_fox_gated_block"


def alibi_slopes(n_heads):
    return jnp.asarray(np.array([2.0 ** (-8.0 * (h + 1) / n_heads) for h in range(n_heads)], dtype=np.float32))


def rms_norm(x, g):
    x32 = x.astype(jnp.float32)
    y = x32 * lax.rsqrt(jnp.mean(jnp.square(x32), axis=-1, keepdims=True) + RMS_EPS)
    return (y * g.astype(jnp.float32)).astype(x.dtype)


def sliding_window_attention(q, k, v, sinks):
    B, S = q.shape[0], q.shape[1]
    nb = S // SWA_BLOCK
    SB = SWA_BLOCK
    qb = q.reshape(B, nb, SB, SWA_KV_HEADS, SWA_GROUP, HEAD_DIM)
    kb = k.reshape(B, nb, SB, SWA_KV_HEADS, HEAD_DIM)
    vb = v.reshape(B, nb, SB, SWA_KV_HEADS, HEAD_DIM)

    def band(t):
        prev = jnp.pad(t[:, :-1], ((0, 0), (1, 0), (0, 0), (0, 0), (0, 0)))
        return jnp.concatenate([prev, t], axis=2)

    k_band, v_band = band(kb), band(vb)
    s = jnp.einsum('bnqkgd,bnskd->bnkgqs', qb, k_band).astype(jnp.float32) * (HEAD_DIM ** -0.5)

    qi = jnp.arange(SB)[:, None] + SB
    si = jnp.arange(2 * SB)[None, :]
    chunk_diff = qi // CHUNK - si // CHUNK
    band_ok = (chunk_diff >= 0) & (chunk_diff <= WINDOW // CHUNK)
    real_key = (jnp.arange(nb)[:, None, None] > 0) | (si >= SB)[None]
    mask = band_ok[None] & real_key

    slopes = alibi_slopes(SWA_HEADS).reshape(SWA_KV_HEADS, SWA_GROUP)
    alibi = -slopes[:, :, None, None] * jnp.abs(qi - si).astype(jnp.float32)
    s = jnp.where(mask[None, :, None, None], s + alibi[None, None], -jnp.inf)

    sink = jnp.broadcast_to(sinks.astype(jnp.float32).reshape(SWA_KV_HEADS, SWA_GROUP)[None, None, :, :, None, None],
                            s.shape[:-1] + (1,))
    probs = jax.nn.softmax(jnp.concatenate([s, sink], axis=-1), axis=-1)[..., :-1]
    out = jnp.einsum('bnkgqs,bnskd->bnqkgd', probs.astype(v.dtype), v_band)
    return out.reshape(B, S, SWA_Q)


def forgetting_attention(q, k, v, f_logit):
    B, S = q.shape[0], q.shape[1]
    nb = S // FOX_BLOCK
    log_f = jax.nn.log_sigmoid(f_logit.astype(jnp.float32))
    c = jnp.cumsum(log_f, axis=1)
    c_k = c.transpose(0, 2, 1)
    kh = k.transpose(0, 2, 1, 3)
    vh = v.transpose(0, 2, 1, 3)
    q_blocks = q.reshape(B, nb, FOX_BLOCK, FOX_HEADS, HEAD_DIM).transpose(1, 0, 3, 2, 4)
    c_blocks = c.reshape(B, nb, FOX_BLOCK, FOX_HEADS).transpose(1, 0, 3, 2)
    k_pos = jnp.arange(S)
    scale = HEAD_DIM ** -0.5

    def one_block(args):
        qb, cq, n = args
        s = jnp.einsum('bhqd,bhsd->bhqs', qb, kh).astype(jnp.float32) * scale
        s = s + cq[..., None] - c_k[:, :, None, :]
        q_pos = n * FOX_BLOCK + jnp.arange(FOX_BLOCK)
        s = jnp.where((k_pos[None, :] <= q_pos[:, None])[None, None], s, -jnp.inf)
        probs = jax.nn.softmax(s, axis=-1)
        return jnp.einsum('bhqs,bhsd->bhqd', probs.astype(vh.dtype), vh)

    out = lax.map(one_block, (q_blocks, c_blocks, jnp.arange(nb, dtype=jnp.int32)))
    return out.transpose(1, 0, 3, 2, 4).reshape(B, S, FOX_W)


def setup_inputs(seed: int = 0) -> dict:
    key = jax.random.key(seed)
    ks = jax.random.split(key, 18)

    def dense(k, fan_in, fan_out):
        return jax.random.normal(k, (DEPTH, fan_in, fan_out), jnp.float32) * fan_in ** -0.5

    def gain(k, shape):
        return 1.0 + 0.02 * jax.random.normal(k, shape, jnp.float32)

    return {
        "x": jax.random.normal(ks[0], (BATCH, SEQ, D_MODEL), jnp.float32),
        "p": jax.random.normal(ks[1], (DEPTH, BATCH, SEQ, PLE_DIM), jnp.float32),
        "g_mix": gain(ks[2], (DEPTH, D_MODEL)),
        "w_in": dense(ks[3], D_MODEL, D_IN),
        "b_forget": 3.0 + 0.5 * jax.random.normal(ks[4], (DEPTH, FOX_HEADS), jnp.float32),
        "swa_sinks": 0.5 * jax.random.normal(ks[5], (DEPTH, SWA_HEADS), jnp.float32),
        "w_br_swa": dense(ks[6], SWA_Q, D_MODEL),
        "w_br_fox": dense(ks[7], FOX_W, D_MODEL),
        "w_mix_out": dense(ks[8], D_MODEL, D_MODEL),
        "g_mlp": gain(ks[9], (DEPTH, D_MODEL)),
        "w_ff1": dense(ks[10], D_MODEL, D_FF),
        "w_ff2": dense(ks[11], D_FF, D_MODEL),
        "g_ple": gain(ks[12], (DEPTH, D_MODEL)),
        "w_ple_gate": dense(ks[13], D_MODEL, D_MODEL),
        "w_ple_proj": dense(ks[14], PLE_DIM, D_MODEL),
        "g_final": gain(ks[15], (D_MODEL,)),
    }


def reference(x, p, g_mix, w_in, b_forget, swa_sinks, w_br_swa, w_br_fox, w_mix_out,
              g_mlp, w_ff1, w_ff2, g_ple, w_ple_gate, w_ple_proj, g_final):
    B, S = x.shape[0], x.shape[1]
    h = x
    for i in range(DEPTH):
        u = rms_norm(h, g_mix[i])
        z = u @ w_in[i]
        q_a, k_a, v_a, q_b, k_b, v_b, f_b, gate_logits = jnp.split(z, SPLIT_POINTS, axis=-1)
        y_a = sliding_window_attention(
            q_a.reshape(B, S, SWA_HEADS, HEAD_DIM),
            k_a.reshape(B, S, SWA_KV_HEADS, HEAD_DIM),
            v_a.reshape(B, S, SWA_KV_HEADS, HEAD_DIM),
            swa_sinks[i]) @ w_br_swa[i]
        y_b = forgetting_attention(
            q_b.reshape(B, S, FOX_HEADS, HEAD_DIM),
            k_b.reshape(B, S, FOX_HEADS, HEAD_DIM),
            v_b.reshape(B, S, FOX_HEADS, HEAD_DIM),
            f_b + b_forget[i]) @ w_br_fox[i]
        gates = jax.nn.sigmoid(gate_logits).reshape(B, S, N_BRANCH, D_MODEL)
        mixed = gates[:, :, 0] * y_a + gates[:, :, 1] * y_b
        h = h + mixed @ w_mix_out[i]
        u = rms_norm(h, g_mlp[i])
        h = h + jnp.square(jax.nn.relu(u @ w_ff1[i])) @ w_ff2[i]
        ple_gate = jax.nn.sigmoid(rms_norm(h, g_ple[i]) @ w_ple_gate[i])
        h = h + ple_gate * (p[i] @ w_ple_proj[i])
    return rms_norm(h, g_final)
```

```cpp
#include <hip/hip_runtime.h>
#include <hip/hip_cooperative_groups.h>
#include <cstdio>
#include <cstdint>
__device__ __forceinline__ int fresh_lane() { int l; asm volatile("v_mbcnt_lo_u32_b32 %0, -1, 0\n\tv_mbcnt_hi_u32_b32 %0, -1, %0" : "=v"(l)); return l; }

namespace pg8 {

#define PG8_LAS __attribute__((address_space(3)))
typedef unsigned short bf16_t;
typedef short bf16x8 __attribute__((ext_vector_type(8)));
typedef float f32x4 __attribute__((ext_vector_type(4)));
typedef unsigned u32x4 __attribute__((ext_vector_type(4)));
constexpr int BM = 256, BK = 64, HALF = 128, HTB = HALF * BK * 2  , STAGE_BYTES = 8 * HTB, NXCD = 8, WGM = 8;

__host__ __device__ __forceinline__ int lds_byte(int r, int c) { const int st = (r >> 4) * 2 + (c >> 5), rr = r & 15, cc = c & 31, ob = rr * 64 + cc * 2; return st * 1024 + (ob ^ (((ob >> 9) & 1) << 5)); }
__host__ __device__ __forceinline__ void stage_rc(int b, int& R, int& C) { const int st = b / 1024, sb = b % 1024, swz = sb ^ (((sb >> 9) & 1) << 5); R = (st >> 1) * 16 + swz / 64; C = (st & 1) * 32 + (swz % 64) / 2; }
__host__ __device__ __forceinline__ int perm32(int rho) { const int n = rho >> 4, i = rho & 15; return 8 * (i >> 2) + 4 * n + (i & 3); }

struct Unit { int pm, pn; };
struct Gemm { const bf16_t* A; const bf16_t* Bt; int M, N, K, lda; };

struct StaticOrder {
    int nM, nN, nwg, G, c;
    __host__ __device__ void init(int M, int N, int G_, int c_) { nM = M / BM; nN = N / BM; nwg = nM * nN; G = G_; c = c_; }
    __host__ __device__ bool next(int i, Unit& u) const {
        const long L = (long)i * G + c; if (L >= nwg) return false;
        int wgid = (int)L; { const int q = nwg / NXCD, r = nwg % NXCD, xcd = wgid % NXCD, off = wgid / NXCD; wgid = (xcd < r ? xcd * (q + 1) : r * (q + 1) + (xcd - r) * q) + off; }
        const int nig = WGM * nN, gid = wgid / nig, fm = gid * WGM, gsz = (nM - fm) < WGM ? (nM - fm) : WGM;
        u.pm = fm + ((wgid % nig) % gsz); u.pn = (wgid % nig) / gsz; return true;
    }
    __device__ __forceinline__ void a_ready(const Unit&) const {}
    __device__ __forceinline__ void done(const Unit&) const {}
};

__device__ __forceinline__ unsigned cvt_pk_bf16(float lo, float hi) { unsigned r; asm volatile("v_cvt_pk_bf16_f32 %0, %1, %2" : "=v"(r) : "v"(lo), "v"(hi)); return r; }
typedef float f32x2 __attribute__((ext_vector_type(2)));
constexpr int ZP = 4352;
constexpr float C2F = 0.125f * 1.4426950408889634f;
__device__ __forceinline__ float sigmoidf_fast(float x) { return __builtin_amdgcn_rcpf(1.0f + __builtin_amdgcn_exp2f(-1.4426950408889634f * x)); }
__device__ __forceinline__ f32x4 bf4_lo(unsigned a, unsigned b) { return (f32x4){__uint_as_float(a << 16), __uint_as_float(a & 0xffff0000u), __uint_as_float(b << 16), __uint_as_float(b & 0xffff0000u)}; }
__device__ __forceinline__ u32x4 pack8(f32x4 v0, f32x4 v1) { u32x4 w; w.x = cvt_pk_bf16(v0[0], v0[1]); w.y = cvt_pk_bf16(v0[2], v0[3]); w.z = cvt_pk_bf16(v1[0], v1[1]); w.w = cvt_pk_bf16(v1[2], v1[3]); return w; }
__device__ __forceinline__ float rstd_from_stats(const float* st, int row) { const f32x4* s = (const f32x4*)(st + (size_t)row * 16); const f32x4 a = s[0], b = s[1], c = s[2], d = s[3];
    const float t = ((a[0] + a[1]) + (a[2] + a[3])) + ((b[0] + b[1]) + (b[2] + b[3])) + ((c[0] + c[1]) + (c[2] + c[3])) + ((d[0] + d[1]) + (d[2] + d[3])); return 1.0f / sqrtf(t * (1.0f / 1024.0f) + 1e-6f); }
#define EPI_ROWS(...) _Pragma("unroll") for (int ai = 0; ai < 2; ++ai) _Pragma("unroll") for (int m = 0; m < 4; ++m) { const int row = u.pm * BM + ai * HALF + wr * 64 + m * 16 + fr; __VA_ARGS__ asm volatile("" ::: "memory"); }
#define EPI_COLS(...) _Pragma("unroll") for (int bj = 0; bj < 2; ++bj) { const int col = u.pn * BM + bj * HALF + wc * 32 + 8 * fq; const f32x4 a0 = acc[ai][bj][m][0], a1 = acc[ai][bj][m][1]; __VA_ARGS__ }
struct EpiZ { static constexpr bool PERM = true, AFTER_DRAIN = false; bf16_t* Z;
    __device__ __forceinline__ void operator()(const f32x4 (&acc)[2][2][4][2], const Unit& u, int wr, int wc, int fr, int fq) const {
        const int pn = u.pn; const int mode = (pn >= 9) ? 2 : ((pn == 0 || pn == 1 || pn == 3 || pn == 4) ? 1 : 0);
        EPI_ROWS( bf16_t* rowp = Z + (size_t)row * ZP; EPI_COLS( f32x4 v0 = a0, v1 = a1;
            if (mode == 1) { v0 = v0 * C2F; v1 = v1 * C2F; }
            else if (mode == 2) { _Pragma("unroll") for (int e = 0; e < 4; ++e) { v0[e] = sigmoidf_fast(v0[e]); v1[e] = sigmoidf_fast(v1[e]); } }
            *(u32x4*)(rowp + col) = pack8(v0, v1); ) )
    } };
struct EpiT1 { static constexpr bool PERM = true, AFTER_DRAIN = false; const bf16_t* G; float* T;
    __device__ __forceinline__ void operator()(const f32x4 (&acc)[2][2][4][2], const Unit& u, int wr, int wc, int fr, int fq) const {
        EPI_ROWS( EPI_COLS( const u32x4 g = *(const u32x4*)(G + (size_t)row * ZP + col); float* tp = T + (size_t)row * 1024 + col;
            *(f32x4*)tp = a0 * bf4_lo(g.x, g.y); *(f32x4*)(tp + 4) = a1 * bf4_lo(g.z, g.w); ) )
    } };
struct EpiMix { static constexpr bool PERM = true, AFTER_DRAIN = false; const bf16_t* G; const float* T; bf16_t* O;
    __device__ __forceinline__ void operator()(const f32x4 (&acc)[2][2][4][2], const Unit& u, int wr, int wc, int fr, int fq) const {
        EPI_ROWS( EPI_COLS( const u32x4 g = *(const u32x4*)(G + (size_t)row * ZP + col); const float* tp = T + (size_t)row * 1024 + col;
            const f32x4 v0 = *(const f32x4*)tp + a0 * bf4_lo(g.x, g.y), v1 = *(const f32x4*)(tp + 4) + a1 * bf4_lo(g.z, g.w);
            *(u32x4*)(O + (size_t)row * 1024 + col) = pack8(v0, v1); ) )
    } };
struct EpiRes { static constexpr bool PERM = true, AFTER_DRAIN = false; const float* base; float* out; bf16_t* hb; float* st;
    __device__ __forceinline__ void operator()(const f32x4 (&acc)[2][2][4][2], const Unit& u, int wr, int wc, int fr, int fq) const {
        EPI_ROWS( float ss = 0.f; EPI_COLS( const size_t off = (size_t)row * 1024 + col; const f32x4 h0 = *(const f32x4*)(base + off) + a0, h1 = *(const f32x4*)(base + off + 4) + a1;
            *(f32x4*)(out + off) = h0; *(f32x4*)(out + off + 4) = h1; *(u32x4*)(hb + off) = pack8(h0, h1);
            ss += ((h0[0] * h0[0] + h0[1] * h0[1]) + (h0[2] * h0[2] + h0[3] * h0[3])) + ((h1[0] * h1[0] + h1[1] * h1[1]) + (h1[2] * h1[2] + h1[3] * h1[3])); )
            ss += __shfl_xor(ss, 16); ss += __shfl_xor(ss, 32); if (fq == 0) st[(size_t)row * 16 + u.pn * 4 + wc] = ss; )
    } };
struct EpiRelu2 { static constexpr bool PERM = true, AFTER_DRAIN = false; const float* st; bf16_t* O;
    __device__ __forceinline__ void operator()(const f32x4 (&acc)[2][2][4][2], const Unit& u, int wr, int wc, int fr, int fq) const {
        EPI_ROWS( const float rs = rstd_from_stats(st, row); EPI_COLS( f32x4 v0 = a0 * rs, v1 = a1 * rs;
            _Pragma("unroll") for (int e = 0; e < 4; ++e) { const float x0 = fmaxf(v0[e], 0.f), x1 = fmaxf(v1[e], 0.f); v0[e] = x0 * x0; v1[e] = x1 * x1; }
            *(u32x4*)(O + (size_t)row * 4096 + col) = pack8(v0, v1); ) )
    } };
struct EpiPP { static constexpr bool PERM = true, AFTER_DRAIN = false; float* T;
    __device__ __forceinline__ void operator()(const f32x4 (&acc)[2][2][4][2], const Unit& u, int wr, int wc, int fr, int fq) const {
        EPI_ROWS( EPI_COLS( float* tp = T + (size_t)row * 1024 + col; *(f32x4*)tp = a0; *(f32x4*)(tp + 4) = a1; ) )
    } };
struct EpiPle { static constexpr bool PERM = true, AFTER_DRAIN = false; const float* st_in; const float* T; float* h; float* st;
    __device__ __forceinline__ void operator()(const f32x4 (&acc)[2][2][4][2], const Unit& u, int wr, int wc, int fr, int fq) const {
        EPI_ROWS( const float rs = rstd_from_stats(st_in, row); float ss = 0.f; EPI_COLS( const size_t off = (size_t)row * 1024 + col;
            f32x4 g0 = a0 * rs, g1 = a1 * rs; _Pragma("unroll") for (int e = 0; e < 4; ++e) { g0[e] = sigmoidf_fast(g0[e]); g1[e] = sigmoidf_fast(g1[e]); }
            const f32x4 h0 = *(const f32x4*)(h + off) + g0 * *(const f32x4*)(T + off), h1 = *(const f32x4*)(h + off + 4) + g1 * *(const f32x4*)(T + off + 4);
            *(f32x4*)(h + off) = h0; *(f32x4*)(h + off + 4) = h1;
            ss += ((h0[0] * h0[0] + h0[1] * h0[1]) + (h0[2] * h0[2] + h0[3] * h0[3])) + ((h1[0] * h1[0] + h1[1] * h1[1]) + (h1[2] * h1[2] + h1[3] * h1[3])); )
            ss += __shfl_xor(ss, 16); ss += __shfl_xor(ss, 32); if (fq == 0) st[(size_t)row * 16 + u.pn * 4 + wc] = ss; )
    } };

template <class Epi, class Sched, bool ALIGN_EPI = false, bool SP2 = false>
__device__ __forceinline__ void gemm_phase(PG8_LAS unsigned char* lds, const Gemm g, const Sched& S, const Epi& E, const int wave_s) {
    const int tid = wave_s * 64 + fresh_lane(), wid = wave_s, lane = tid & 63, wr = wid >> 2, wc = wid & 3, fr = lane & 15, fq = lane >> 4;
    const int K = g.K, nt = K / BK;
    unsigned voffA[2], voffB[2];
#pragma unroll
    for (int i = 0; i < 2; ++i) { int R, C; stage_rc(tid * 16 + i * 8192, R, C); const int Rb = Epi::PERM ? ((R & ~31) + perm32(R & 31)) : R;
        voffA[i] = (unsigned)(R * g.lda + C) * 2u; voffB[i] = (unsigned)(Rb * K + C) * 2u; }
    const size_t kstep = (size_t)(BK * 2);
    const size_t hstepA = (size_t)HALF * g.lda * 2, hstepB = (size_t)HALF * K * 2;
    const size_t tstepA = 2 * hstepA, tstepB = 2 * hstepB;
    const unsigned ldsw = (unsigned)wid * 1024u;
    const int aoff = lds_byte(wr * 64 + fr, fq * 8), boff = lds_byte(wc * 32 + fr, fq * 8);
#define PG8_SA(b, h) (((b) * 2 + (h)) * HTB)
#define PG8_SB(b, h) ((4 + (b) * 2 + (h)) * HTB)
#define PG8_STAGE(bufoff, gbase, voff) do { _Pragma("unroll") for (int _i = 0; _i < 2; ++_i) \
        __builtin_amdgcn_global_load_lds((const unsigned*)((const char*)(gbase) + (voff)[_i]), (PG8_LAS unsigned*)(lds + (bufoff) + ldsw + _i * 8192), 16, 0, 0); } while (0)
#define PG8_LDA(dst, b, h) do { _Pragma("unroll") for (int m = 0; m < 4; ++m) _Pragma("unroll") for (int k = 0; k < 2; ++k) dst[m][k] = *(const PG8_LAS bf16x8*)(lds + PG8_SA(b, h) + aoff + m * 2048 + k * 1024); } while (0)
#define PG8_LDB(dst, b, h) do { _Pragma("unroll") for (int n = 0; n < 2; ++n) _Pragma("unroll") for (int k = 0; k < 2; ++k) dst[n][k] = *(const PG8_LAS bf16x8*)(lds + PG8_SB(b, h) + boff + n * 2048 + k * 1024); } while (0)
#define PG8_MMA(ai, bj, At, Bt) do { __builtin_amdgcn_s_setprio(1); _Pragma("unroll") for (int m = 0; m < 4; ++m) _Pragma("unroll") for (int n = 0; n < 2; ++n) _Pragma("unroll") for (int k = 0; k < 2; ++k) \
        acc[ai][bj][m][n] = __builtin_amdgcn_mfma_f32_16x16x32_bf16(Bt[n][k], At[m][k], acc[ai][bj][m][n], 0, 0, 0); __builtin_amdgcn_s_setprio(0); } while (0)
#define PG8_WAIT_V(n) asm volatile("s_waitcnt vmcnt(" #n ")" ::: "memory")
#define PG8_WAIT_L(n) asm volatile("s_waitcnt lgkmcnt(" #n ")" ::: "memory")
#define PG8_BAR __builtin_amdgcn_s_barrier()
#define PG8_SCHED __builtin_amdgcn_sched_barrier(0)
    Unit cur, nxt; int ui = 0;
    if (!S.next(0, cur)) return;
    f32x4 acc[2][2][4][2];
#pragma unroll
    for (int a = 0; a < 2; ++a)
#pragma unroll
        for (int b = 0; b < 2; ++b)
#pragma unroll
            for (int m = 0; m < 4; ++m)
#pragma unroll
                for (int n = 0; n < 2; ++n) acc[a][b][m][n] = (f32x4){0.f, 0.f, 0.f, 0.f};
    bf16x8 At[4][2], B0[2][2], B1[2][2];
    const char* cA = (const char*)g.A + (size_t)cur.pm * tstepA; const char* cB = (const char*)g.Bt + (size_t)cur.pn * tstepB;
    S.a_ready(cur);
    if constexpr (SP2) {
        PG8_STAGE(PG8_SB(0, 0), cB, voffB); PG8_STAGE(PG8_SB(0, 1), cB + hstepB, voffB); PG8_STAGE(PG8_SA(0, 0), cA, voffA); PG8_STAGE(PG8_SA(0, 1), cA + hstepA, voffA);
        if (wr == 1) PG8_BAR;
        PG8_WAIT_V(2); PG8_BAR;
        PG8_STAGE(PG8_SB(1, 0), cB + kstep, voffB); PG8_STAGE(PG8_SA(1, 0), cA + kstep, voffA); PG8_STAGE(PG8_SB(1, 1), cB + hstepB + kstep, voffB);
        PG8_WAIT_V(6); PG8_BAR;
    } else {
        PG8_STAGE(PG8_SB(0, 0), cB, voffB); PG8_STAGE(PG8_SA(0, 0), cA, voffA); PG8_STAGE(PG8_SB(0, 1), cB + hstepB, voffB); PG8_STAGE(PG8_SA(0, 1), cA + hstepA, voffA);
        if (wr == 1) PG8_BAR;
        PG8_WAIT_V(4); PG8_BAR;
        PG8_STAGE(PG8_SB(1, 0), cB + kstep, voffB); PG8_STAGE(PG8_SA(1, 0), cA + kstep, voffA); PG8_STAGE(PG8_SB(1, 1), cB + hstepB + kstep, voffB);
        PG8_WAIT_V(6); PG8_BAR;
    }
    for (;;) {
        const bool has_next = S.next(ui + 1, nxt);
        const char* nA = has_next ? (const char*)g.A + (size_t)nxt.pm * tstepA : cA; const char* nB = has_next ? (const char*)g.Bt + (size_t)nxt.pn * tstepB : cB;
        for (int t = 0; t < nt; t += 2) {
            const bool last = (t == nt - 2);
            const char* a1 = cA + (size_t)(t + 1) * kstep;
            const char* a2 = last ? nA : cA + (size_t)(t + 2) * kstep; const char* b2 = last ? nB : cB + (size_t)(t + 2) * kstep;
            const char* a3 = a2 + kstep; const char* b3 = b2 + kstep;
            if (last && has_next) S.a_ready(nxt);
            if constexpr (SP2) {
            PG8_LDB(B0, 0, 0); PG8_LDB(B1, 0, 1); PG8_SCHED; PG8_LDA(At, 0, 0); PG8_STAGE(PG8_SA(1, 1), a1 + hstepA, voffA);
            PG8_WAIT_V(8); PG8_WAIT_L(0); PG8_BAR; PG8_MMA(0, 0, At, B0); PG8_MMA(0, 1, At, B1); PG8_BAR; PG8_SCHED;
            PG8_LDA(At, 0, 1); PG8_STAGE(PG8_SB(0, 0), b2, voffB); PG8_STAGE(PG8_SB(0, 1), b2 + hstepB, voffB); PG8_STAGE(PG8_SA(0, 0), a2, voffA);
            PG8_WAIT_V(8); PG8_WAIT_L(0); PG8_BAR; PG8_MMA(1, 0, At, B0); PG8_MMA(1, 1, At, B1); PG8_BAR; PG8_SCHED;
            PG8_LDB(B0, 1, 0); PG8_LDB(B1, 1, 1); PG8_SCHED; PG8_LDA(At, 1, 0); PG8_STAGE(PG8_SA(0, 1), a2 + hstepA, voffA);
            PG8_WAIT_V(8); PG8_WAIT_L(0); PG8_BAR; PG8_MMA(0, 0, At, B0); PG8_MMA(0, 1, At, B1); PG8_BAR; PG8_SCHED;
            PG8_LDA(At, 1, 1); PG8_STAGE(PG8_SB(1, 0), b3, voffB); PG8_STAGE(PG8_SB(1, 1), b3 + hstepB, voffB); PG8_STAGE(PG8_SA(1, 0), a3, voffA);
            PG8_WAIT_V(8); PG8_WAIT_L(0); PG8_BAR; PG8_MMA(1, 0, At, B0); PG8_MMA(1, 1, At, B1); PG8_BAR; PG8_SCHED;
            } else {
            PG8_LDB(B0, 0, 0); PG8_SCHED; PG8_LDA(At, 0, 0); PG8_STAGE(PG8_SA(1, 1), a1 + hstepA, voffA);
            PG8_WAIT_L(8); PG8_BAR; PG8_WAIT_L(0); PG8_MMA(0, 0, At, B0); PG8_BAR; PG8_SCHED;
            PG8_LDB(B1, 0, 1); PG8_STAGE(PG8_SB(0, 0), b2, voffB);
            PG8_BAR; PG8_WAIT_L(0); PG8_MMA(0, 1, At, B1); PG8_BAR;
            PG8_LDA(At, 0, 1); PG8_STAGE(PG8_SA(0, 0), a2, voffA);
            PG8_BAR; PG8_WAIT_L(0); PG8_MMA(1, 0, At, B0); PG8_BAR; PG8_SCHED;
            PG8_STAGE(PG8_SB(0, 1), b2 + hstepB, voffB);
            PG8_WAIT_V(6); PG8_BAR; PG8_MMA(1, 1, At, B1); PG8_BAR;
            PG8_LDB(B0, 1, 0); PG8_SCHED; PG8_LDA(At, 1, 0); PG8_STAGE(PG8_SA(0, 1), a2 + hstepA, voffA);
            PG8_WAIT_L(8); PG8_BAR; PG8_WAIT_L(0); PG8_MMA(0, 0, At, B0); PG8_BAR; PG8_SCHED;
            PG8_LDB(B1, 1, 1); PG8_STAGE(PG8_SB(1, 0), b3, voffB);
            PG8_BAR; PG8_WAIT_L(0); PG8_MMA(0, 1, At, B1); PG8_BAR;
            PG8_LDA(At, 1, 1); PG8_STAGE(PG8_SA(1, 0), a3, voffA);
            PG8_BAR; PG8_WAIT_L(0); PG8_MMA(1, 0, At, B0); PG8_BAR; PG8_SCHED;
            PG8_STAGE(PG8_SB(1, 1), b3 + hstepB, voffB);
            PG8_WAIT_V(6); PG8_BAR; PG8_MMA(1, 1, At, B1); PG8_BAR;
            }
        }
        if constexpr (ALIGN_EPI) { if (wr == 0) PG8_BAR; }
        if constexpr (!Epi::AFTER_DRAIN) { E(acc, cur, wr, wc, fr, fq); S.done(cur); }
        if (!has_next) break;
#pragma unroll
        for (int a = 0; a < 2; ++a)
#pragma unroll
            for (int b = 0; b < 2; ++b)
#pragma unroll
                for (int m = 0; m < 4; ++m)
#pragma unroll
                    for (int n = 0; n < 2; ++n) acc[a][b][m][n] = (f32x4){0.f, 0.f, 0.f, 0.f};
        cur = nxt; cA = nA; cB = nB; ++ui;
        if constexpr (ALIGN_EPI) { if (wr == 1) PG8_BAR; }
    }
    PG8_WAIT_V(0);
    if constexpr (!ALIGN_EPI) { if (wr == 0) PG8_BAR; }
    PG8_BAR;
    if constexpr (Epi::AFTER_DRAIN) { E.fused(acc, cur, wr, wc, fr, fq, lds, wid, lane); S.done(cur); }
#undef PG8_SA
#undef PG8_SB
#undef PG8_STAGE
#undef PG8_LDA
#undef PG8_LDB
#undef PG8_MMA
#undef PG8_WAIT_V
#undef PG8_WAIT_L
#undef PG8_BAR
#undef PG8_SCHED
}
}
#ifndef PG8_SP2
#define PG8_SP2 true
#endif
#ifndef PG8_ALIGN
#define PG8_ALIGN true
#endif
#include <hip/hip_bf16.h>
#include <cmath>
namespace attn_body {
using bf16=__hip_bfloat16;
using bf16x8=__attribute__((ext_vector_type(8)))short;
using s16x4=__attribute__((ext_vector_type(4)))short;
using f32x16=__attribute__((ext_vector_type(16)))float;
using u32x4=__attribute__((ext_vector_type(4)))unsigned;
constexpr int BATCH=2,SEQ=8192,D=64,DM=4352;
constexpr int NW=8,QBLK=32,QB=QBLK*NW,KVBLK=64,NQB=SEQ/QB;
constexpr int ATTN_PITCH=DM, ATTN_UNIT_ROWS=QB;
__device__ __forceinline__ int crow(int r,int hi){return (r&3)+8*(r>>2)+4*hi;}
#define SBAR() __builtin_amdgcn_sched_barrier(0)
__device__ __forceinline__ void cmask(f32x16&p0,f32x16&p1,int jb,int qrel,int hi){
  const float NEG=-INFINITY; int kb=64*jb+4*hi;
  #pragma unroll
  for(int r=0;r<16;++r){int kv=kb+(r&3)+8*(r>>2); if(kv>qrel)p0[r]=NEG; if(kv+32>qrel)p1[r]=NEG;}
}

constexpr int NSLOT=3, SLOTB=8192; typedef float f32x4v __attribute__((ext_vector_type(4))); constexpr int LDS_BIAS=86016;
constexpr int LDS_K=0, LDS_V=NSLOT*SLOTB, LDS_WS=2*NSLOT*SLOTB, LDS_OST=LDS_WS+NW*64*4, LDS_BYTES=LDS_OST+NW*4096;
constexpr float C2=0.125f*1.4426950408889634f;
__device__ __forceinline__ void glds16(const void*gsrc,unsigned lds_dst){unsigned keep;
  asm volatile("s_mov_b32 %0, m0\n\ts_mov_b32 m0, %2\n\ts_nop 0\n\tglobal_load_lds_dwordx4 %1, off\n\ts_mov_b32 m0, %0":"=&s"(keep):"v"(gsrc),"s"(lds_dst):"memory");}
__device__ __forceinline__ float max3f(float a,float b,float c){float r;asm("v_max3_f32 %0, %1, %2, %3":"=v"(r):"v"(a),"v"(b),"v"(c));return r;}
__device__ __forceinline__ float max2f(float a,float b){float r;asm("v_max_f32_e32 %0, %1, %2":"=v"(r):"v"(a),"v"(b));return r;}
__device__ __forceinline__ float fadd_s(float a,float b){float r;asm("v_add_f32_e32 %0, %1, %2":"=v"(r):"v"(a),"v"(b));return r;}
__device__ __forceinline__ float fsub_s(float a,float b){float r;asm("v_sub_f32_e32 %0, %1, %2":"=v"(r):"v"(a),"v"(b));return r;}
typedef float f32x2_t __attribute__((ext_vector_type(2))); typedef __bf16 bf16x2_t __attribute__((ext_vector_type(2)));
__device__ __forceinline__ unsigned cvtpk_s(float lo,float hi){f32x2_t v={lo,hi};bf16x2_t b=__builtin_convertvector(v,bf16x2_t);return __builtin_bit_cast(unsigned,b);}
#define WAIT_BAR(N) asm volatile("s_waitcnt vmcnt(" #N ") lgkmcnt(0)\n\ts_barrier":::"memory")

__device__ __forceinline__ void qkt(f32x16&p0,f32x16&p1,const char*Kslot,const bf16x8*qr,const f32x16&negm,int r32,int hi){
  const char*kb=Kslot+hi*1024+r32*16;
  #pragma unroll
  for(int d0=0;d0<4;++d0){
    const bf16x8 b0=*reinterpret_cast<const bf16x8*>(kb+d0*2048);
    const bf16x8 b1=*reinterpret_cast<const bf16x8*>(kb+d0*2048+512);
    if(d0==0){p0=__builtin_amdgcn_mfma_f32_32x32x16_bf16(b0,qr[0],negm,0,0,0);p1=__builtin_amdgcn_mfma_f32_32x32x16_bf16(b1,qr[0],negm,0,0,0);}
    else{p0=__builtin_amdgcn_mfma_f32_32x32x16_bf16(b0,qr[d0],p0,0,0,0);p1=__builtin_amdgcn_mfma_f32_32x32x16_bf16(b1,qr[d0],p1,0,0,0);}}
}
typedef __attribute__((address_space(3))) const char* lds_cptr;
typedef short v4i16_t __attribute__((ext_vector_type(4)));
__device__ __forceinline__ void kload8(bf16x8*kf,lds_cptr kp){
  kf[0]=*(const __attribute__((address_space(3))) bf16x8*)(kp);      kf[1]=*(const __attribute__((address_space(3))) bf16x8*)(kp+512);
  kf[2]=*(const __attribute__((address_space(3))) bf16x8*)(kp+2048); kf[3]=*(const __attribute__((address_space(3))) bf16x8*)(kp+2560);
  kf[4]=*(const __attribute__((address_space(3))) bf16x8*)(kp+4096); kf[5]=*(const __attribute__((address_space(3))) bf16x8*)(kp+4608);
  kf[6]=*(const __attribute__((address_space(3))) bf16x8*)(kp+6144); kf[7]=*(const __attribute__((address_space(3))) bf16x8*)(kp+6656);
}
__device__ __forceinline__ void kload2(bf16x8*kf,lds_cptr kp,int j){ kf[2*j]=*(const __attribute__((address_space(3))) bf16x8*)(kp+j*2048); kf[2*j+1]=*(const __attribute__((address_space(3))) bf16x8*)(kp+j*2048+512); }
__device__ __forceinline__ s16x4 vtr(lds_cptr p){ return __builtin_bit_cast(s16x4,__builtin_amdgcn_ds_read_tr16_b64_v4i16((__attribute__((address_space(3))) v4i16_t*)p)); }
__device__ __forceinline__ float rowmax(const f32x16&p0,const f32x16&p1){
  float a=max3f(p0[0],p0[1],p1[0]),b=max3f(p0[2],p0[3],p1[1]);a=max3f(a,p1[2],p1[3]);
  #pragma unroll
  for(int r=4;r<16;r+=4){a=max3f(a,p0[r],p0[r+1]);b=max3f(b,p0[r+2],p0[r+3]);a=max3f(a,p1[r],p1[r+1]);b=max3f(b,p1[r+2],p1[r+3]);}
  const float m=max2f(a,b);
  auto rr=__builtin_amdgcn_permlane32_swap(__float_as_uint(m),__float_as_uint(m),false,false);
  return max2f(__uint_as_float(rr[0]),__uint_as_float(rr[1]));
}
__device__ __forceinline__ void pv(f32x16*o,int vb,bf16x8 pa0,bf16x8 pa1,bf16x8 pa2,bf16x8 pa3){
  #pragma unroll
  for(int d0=0;d0<2;++d0){s16x4 lo[4],hi[4];
    #pragma unroll
    for(int ks=0;ks<4;++ks){
      asm volatile("ds_read_b64_tr_b16 %0,%1 offset:%c2":"=&v"(lo[ks]):"v"(vb),"i"(d0*4096+ks*1024):"memory");
      asm volatile("ds_read_b64_tr_b16 %0,%1 offset:%c2":"=&v"(hi[ks]):"v"(vb),"i"(d0*4096+ks*1024+512):"memory");}
    asm volatile("s_waitcnt lgkmcnt(0)":::"memory");SBAR();
    #define PK(k) (bf16x8){lo[k][0],lo[k][1],lo[k][2],lo[k][3],hi[k][0],hi[k][1],hi[k][2],hi[k][3]}
    o[d0]=__builtin_amdgcn_mfma_f32_32x32x16_bf16(pa0,PK(0),o[d0],0,0,0);
    o[d0]=__builtin_amdgcn_mfma_f32_32x32x16_bf16(pa1,PK(1),o[d0],0,0,0);
    o[d0]=__builtin_amdgcn_mfma_f32_32x32x16_bf16(pa2,PK(2),o[d0],0,0,0);
    o[d0]=__builtin_amdgcn_mfma_f32_32x32x16_bf16(pa3,PK(3),o[d0],0,0,0);
    #undef PK
  }
}

#ifndef ATTN_STORE16
#define ATTN_STORE16(p,v) (*(u32x4*)(p)=(v))
#endif
template<int THRL> __device__ __forceinline__ void attn_unit(const int wave_s,int qb,const bf16*Qh,const bf16*__restrict__ Kh,const bf16*__restrict__ Vh,bf16*Oh,const float*__restrict__ cbias,char*shm){
  const int wid=wave_s; const int tid=wave_s*64+fresh_lane(),lane=tid&63,r32=lane&31,hi=lane>>5;
  const int q0=qb*QB;
  const bf16*Qw=Qh+(long)(q0+wid*QBLK)*DM;
  const unsigned lds0=(unsigned)(uintptr_t)shm;
  float*wsf=(float*)(shm+LDS_WS)+wid*64;
  const bf16*ksrc=Kh+(long)lane*DM+wid*8;
  const bf16*vsrc=Vh+(long)(16*(wid&3)+(lane>>2))*DM+(wid>>2)*32+(lane&3)*8;
  const unsigned kdst=lds0+LDS_K+wid*1024, vdst=lds0+LDS_V+wid*1024;
  #define DMA_K(t,slot) glds16(ksrc+(long)(t)*KVBLK*DM,(unsigned)__builtin_amdgcn_readfirstlane(kdst+(slot)))
  #define DMA_V(t,slot) glds16(vsrc+(long)(t)*KVBLK*DM,(unsigned)__builtin_amdgcn_readfirstlane(vdst+(slot)))
  const int vb0=(int)(lds0+LDS_V)+((lane>>4)&1)*32+(lane&3)*8+(4*hi+((lane&15)>>2))*64;
  const char*Kbase=shm+LDS_K; bf16x8 kf[8];
  const lds_cptr shm3=(lds_cptr)shm; const lds_cptr kp0=shm3+LDS_K+hi*1024+r32*16; const lds_cptr vp0=shm3+LDS_V+((lane>>4)&1)*32+(lane&3)*8+(4*hi+((lane&15)>>2))*64;
  { const int nk4=(q0+QB)>>2; __attribute__((address_space(3))) f32x4v* bt=(__attribute__((address_space(3))) f32x4v*)((lds_cptr)shm+LDS_BIAS); for(int i=tid;i<nk4;i+=NW*64) bt[i]=((const f32x4v*)cbias)[i]; }
  const int NT=(q0+QB)/KVBLK;
  DMA_K(0,0);DMA_V(0,0);DMA_K(1,SLOTB);
  bf16x8 qr[4];
  #pragma unroll
  for(int d0=0;d0<4;++d0)qr[d0]=*reinterpret_cast<const bf16x8*>(&Qw[(long)r32*DM+d0*16+hi*8]);
  float mhat=0.f,l_reg=0.f;float zf_=0.f;asm volatile("":"+v"(zf_));f32x16 o[2];f32x16 negm;
  _Pragma("unroll") for(int r=0;r<16;++r){o[0][r]=zf_;o[1][r]=zf_;negm[r]=zf_;} asm volatile("":"+v"(negm));
  const int qrel=wid*QBLK+r32;
  #define CMASK(P0,P1,t) do{int jb_=(t)-(NT-4); if(jb_>=0)cmask(P0,P1,jb_,qrel,hi);}while(0)
  #define BIAS(P0,P1,t) do{ const __attribute__((address_space(3))) f32x4v* bt_=(const __attribute__((address_space(3))) f32x4v*)(shm3+LDS_BIAS)+(t)*16+hi; \
    _Pragma("unroll") for(int i_=0;i_<4;++i_){ const f32x4v b0_=bt_[2*i_], b1_=bt_[8+2*i_]; \
      P0[4*i_]+=b0_[0];P0[4*i_+1]+=b0_[1];P0[4*i_+2]+=b0_[2];P0[4*i_+3]+=b0_[3]; P1[4*i_]+=b1_[0];P1[4*i_+1]+=b1_[1];P1[4*i_+2]+=b1_[2];P1[4*i_+3]+=b1_[3]; } }while(0)
  bool resc=false;
  #define START(P0,P1) do{ const float rm=rowmax(P0,P1); resc=false; \
    { const float dl=rm; mhat=fadd_s(mhat,dl); \
      _Pragma("unroll") for(int r=0;r<16;++r){P0[r]=fsub_s(P0[r],dl);P1[r]=fsub_s(P1[r],dl);} \
      _Pragma("unroll") for(int r=0;r<16;++r)negm[r]=-mhat; asm volatile("":"+v"(negm)); } \
    _Pragma("unroll") for(int r=0;r<16;++r)P0[r]=__builtin_amdgcn_exp2f(P0[r]); }while(0)
  #define RESC() do{ if(resc){ asm volatile("s_waitcnt lgkmcnt(0)":::"memory"); \
      _Pragma("unroll") for(int d_=0;d_<2;++d_) _Pragma("unroll") for(int r=0;r<16;++r)o[d_][r]*=wsf[crow(r,hi)]; } }while(0)
  f32x16 pA0,pA1,pB0,pB1;
  int sl_prev=0,sl_cur=0,sl_next=SLOTB;
  #define ROT() do{sl_prev=sl_cur;sl_cur=sl_next;sl_next=(sl_next==(NSLOT-1)*SLOTB)?0:sl_next+SLOTB;}while(0)
  DMA_K(2,2*SLOTB);
  WAIT_BAR(3);
  qkt(pA0,pA1,Kbase,qr,negm,r32,hi);asm volatile("s_nop 15\n\ts_nop 7":"+v"(pA0),"+v"(pA1));BIAS(pA0,pA1,0);CMASK(pA0,pA1,0);
  START(pA0,pA1);
  _Pragma("unroll") for(int r=0;r<16;++r)pA1[r]=__builtin_amdgcn_exp2f(pA1[r]);
  WAIT_BAR(0);
  DMA_K(3,0);DMA_V(1,SLOTB);
  ROT();
  kload8(kf,kp0+sl_cur);
  WAIT_BAR(2);
  s16x4 vlo[8],vhi[8]; u32x4 pw0,pw1,pw2,pw3;
  #define PKW(P,B) cvtpk_s(P[B],P[B+1])
  #define PAF(k) __builtin_bit_cast(bf16x8,pw##k)
  #define VFR(i) (bf16x8){vlo[i][0],vlo[i][1],vlo[i][2],vlo[i][3],vhi[i][0],vhi[i][1],vhi[i][2],vhi[i][3]}
  #define PIN(x) asm volatile("":"+v"(x))
  #define MX3(a,b,c) __builtin_fmaxf(__builtin_fmaxf((a),(b)),(c))
  #define GAPA(MF,A0,A1,A2,A3,W0,W1,PW) do{ MF; sacc+=A0; sacc+=A1; sacc+=A2; sacc+=A3; PIN(sacc); W0; W1; PIN(PW); SBAR(); }while(0)
  #define EX(v) __builtin_amdgcn_exp2f(v)
  #define GAPB(MF,X,B) do{ MF; X[B]=EX(X[B]); X[B+1]=EX(X[B+1]); X[B+2]=EX(X[B+2]); X[B+3]=EX(X[B+3]); PIN(X); SBAR(); }while(0)
  #define VRD(i) do{ vlo[i]=vtr(vp_+(((i)>>2)*4096+((i)&3)*1024)); vhi[i]=vtr(vp_+(((i)>>2)*4096+((i)&3)*1024+512)); }while(0)
  #define KRD(G,j) do{ if(G){ kload2(kf,kp0+sl_next,j); SBAR(); } }while(0)
  #define STEP(C0,C1,P0,P1,t,GK,GV,GL) do{ SBAR(); \
    const lds_cptr vp_=vp0+sl_prev; \
    VRD(0); SBAR(); float sacc=(P0[0]+P0[1]); \
    GAPA(C0=__builtin_amdgcn_mfma_f32_32x32x16_bf16(kf[0],qr[0],negm,0,0,0), P0[2],P0[3],P0[4],P0[5],     pw0[0]=PKW(P0,0), pw0[1]=PKW(P0,2), pw0); \
    VRD(4); SBAR(); GAPA(C1=__builtin_amdgcn_mfma_f32_32x32x16_bf16(kf[1],qr[0],negm,0,0,0), P0[6],P0[7],P0[8],P0[9],     pw0[2]=PKW(P0,4), pw0[3]=PKW(P0,6), pw0); \
    VRD(1); SBAR(); GAPA(C0=__builtin_amdgcn_mfma_f32_32x32x16_bf16(kf[2],qr[1],C0,0,0,0),   P0[10],P0[11],P0[12],P0[13], pw1[0]=PKW(P0,8), pw1[1]=PKW(P0,10), pw1); \
    VRD(5); SBAR(); GAPA(C1=__builtin_amdgcn_mfma_f32_32x32x16_bf16(kf[3],qr[1],C1,0,0,0),   P0[14],P0[15],P1[0],P1[1],   pw1[2]=PKW(P0,12),pw1[3]=PKW(P0,14), pw1); \
    VRD(2); SBAR(); GAPA(C0=__builtin_amdgcn_mfma_f32_32x32x16_bf16(kf[4],qr[2],C0,0,0,0),   P1[2],P1[3],P1[4],P1[5],     pw2[0]=PKW(P1,0), pw2[1]=PKW(P1,2), pw2); \
    VRD(6); SBAR(); GAPA(C1=__builtin_amdgcn_mfma_f32_32x32x16_bf16(kf[5],qr[2],C1,0,0,0),   P1[6],P1[7],P1[8],P1[9],     pw2[2]=PKW(P1,4), pw2[3]=PKW(P1,6), pw2); \
    VRD(3); SBAR(); GAPA(C0=__builtin_amdgcn_mfma_f32_32x32x16_bf16(kf[6],qr[3],C0,0,0,0),   P1[10],P1[11],P1[12],P1[13], pw3[0]=PKW(P1,8), pw3[1]=PKW(P1,10), pw3); \
    VRD(7); SBAR(); GAPA(C1=__builtin_amdgcn_mfma_f32_32x32x16_bf16(kf[7],qr[3],C1,0,0,0),   P1[14],P1[15],0.f,0.f,       pw3[2]=PKW(P1,12),pw3[3]=PKW(P1,14), pw3); \
    l_reg+=sacc; \
    if(GK){DMA_K((t)+3,sl_cur);} if(GV){DMA_V((t)+1,sl_next);} \
    BIAS(C0,C1,t); CMASK(C0,C1,t); \
    { float a=MX3(C0[0],C0[1],C1[0]),b=MX3(C0[2],C0[3],C1[1]); a=MX3(a,C1[2],C1[3]); \
      _Pragma("unroll") for(int r=4;r<16;r+=4){a=MX3(a,C0[r],C0[r+1]);b=MX3(b,C0[r+2],C0[r+3]);a=MX3(a,C1[r],C1[r+1]);b=MX3(b,C1[r+2],C1[r+3]);} \
      float rm=__builtin_fmaxf(a,b); { auto rr=__builtin_amdgcn_permlane32_swap(__float_as_uint(rm),__float_as_uint(rm),false,false); rm=__builtin_fmaxf(__uint_as_float(rr[0]),__uint_as_float(rr[1])); } \
      resc=false; \
      if(__builtin_expect(__any(rm>(float)THRL),0)){ const float dl=__builtin_fmaxf(rm,0.f); mhat+=dl; \
        _Pragma("unroll") for(int r=0;r<16;++r){C0[r]-=dl;C1[r]-=dl;} \
        _Pragma("unroll") for(int r=0;r<16;++r)negm[r]=-mhat; asm volatile("":"+v"(negm)); \
        const float f=__builtin_amdgcn_exp2f(-dl); l_reg*=f; if(hi==0)wsf[r32]=f; resc=true; } } \
    SBAR(); \
    GAPB(o[0]=__builtin_amdgcn_mfma_f32_32x32x16_bf16(PAF(0),VFR(0),o[0],0,0,0), C0,0); \
    GAPB(o[1]=__builtin_amdgcn_mfma_f32_32x32x16_bf16(PAF(0),VFR(4),o[1],0,0,0), C0,4); \
    KRD(GL,0); GAPB(o[0]=__builtin_amdgcn_mfma_f32_32x32x16_bf16(PAF(1),VFR(1),o[0],0,0,0), C0,8); \
    KRD(GL,1); GAPB(o[1]=__builtin_amdgcn_mfma_f32_32x32x16_bf16(PAF(1),VFR(5),o[1],0,0,0), C0,12); \
    KRD(GL,2); GAPB(o[0]=__builtin_amdgcn_mfma_f32_32x32x16_bf16(PAF(2),VFR(2),o[0],0,0,0), C1,0); \
    KRD(GL,3); GAPB(o[1]=__builtin_amdgcn_mfma_f32_32x32x16_bf16(PAF(2),VFR(6),o[1],0,0,0), C1,4); \
    GAPB(o[0]=__builtin_amdgcn_mfma_f32_32x32x16_bf16(PAF(3),VFR(3),o[0],0,0,0), C1,8); \
    GAPB(o[1]=__builtin_amdgcn_mfma_f32_32x32x16_bf16(PAF(3),VFR(7),o[1],0,0,0), C1,12); \
    }while(0)
  int t=1;
  #undef CMASK
  #define CMASK(P0,P1,t) do{}while(0)
  for(;t+5<NT;t+=2){
    STEP(pB0,pB1,pA0,pA1,t,true,true,true);     WAIT_BAR(2); RESC(); ROT();
    STEP(pA0,pA1,pB0,pB1,t+1,true,true,true);   WAIT_BAR(2); RESC(); ROT();
  }
  #undef CMASK
  #define CMASK(P0,P1,t) do{int jb_=(t)-(NT-4); if(jb_>=0)cmask(P0,P1,jb_,qrel,hi);}while(0)
  #define ENDW(tt) do{ if((tt)+3<NT){WAIT_BAR(2);} else if((tt)+2<NT){WAIT_BAR(1);} else {WAIT_BAR(0);} }while(0)
  for(;t+1<NT;t+=2){
    STEP(pB0,pB1,pA0,pA1,t,(t+3<NT),(t+1<NT),(t+1<NT));       ENDW(t);   RESC(); ROT();
    STEP(pA0,pA1,pB0,pB1,t+1,(t+4<NT),(t+2<NT),(t+2<NT));     ENDW(t+1); RESC(); ROT();
  }
  STEP(pB0,pB1,pA0,pA1,NT-1,false,false,false); RESC();
  { float sacc=pB0[0]+pB0[1]; _Pragma("unroll") for(int r=2;r<16;++r)sacc+=pB0[r]; _Pragma("unroll") for(int r=0;r<16;++r)sacc+=pB1[r]; l_reg+=sacc;
    pw0=(u32x4){PKW(pB0,0),PKW(pB0,2),PKW(pB0,4),PKW(pB0,6)};pw1=(u32x4){PKW(pB0,8),PKW(pB0,10),PKW(pB0,12),PKW(pB0,14)};pw2=(u32x4){PKW(pB1,0),PKW(pB1,2),PKW(pB1,4),PKW(pB1,6)};pw3=(u32x4){PKW(pB1,8),PKW(pB1,10),PKW(pB1,12),PKW(pB1,14)};
    SBAR(); pv(o,vb0+sl_cur,PAF(0),PAF(1),PAF(2),PAF(3)); }
  #undef PKW
  #undef PAF
  #undef VFR
  #undef PIN
  #undef MX3
  #undef GAPA
  #undef GAPB
  #undef EX
  #undef VRD
  #undef KRD
  #undef STEP
  #undef ENDW
  {auto rr=__builtin_amdgcn_permlane32_swap(__float_as_uint(l_reg),__float_as_uint(l_reg),false,false);l_reg=__uint_as_float(rr[0])+__uint_as_float(rr[1]);}
  if(hi==0)wsf[32+r32]=l_reg;asm volatile("s_waitcnt lgkmcnt(0)":::"memory");
  float rli[16];
  #pragma unroll
  for(int r=0;r<16;++r)rli[r]=__builtin_amdgcn_rcpf(wsf[32+crow(r,hi)]);
  bf16*Ow=Oh+(long)(q0+wid*QBLK)*DM;
  { bf16*stg=(bf16*)(shm+LDS_OST)+wid*2048;
    #pragma unroll
    for(int r=0;r<16;++r){const int orow=crow(r,hi);
      #pragma unroll
      for(int d0=0;d0<2;++d0)stg[orow*64+d0*32+r32]=__float2bfloat16(o[d0][r]*rli[r]);}
    asm volatile("s_waitcnt lgkmcnt(0)":::"memory");
    #pragma unroll
    for(int i=0;i<4;++i){const int row=i*8+(lane>>3),ch=lane&7; const u32x4 v=*(const u32x4*)(stg+row*64+ch*8); ATTN_STORE16(Ow+(long)row*DM+ch*8,v);} }
  asm volatile("s_waitcnt lgkmcnt(0)\n\ts_barrier":::"memory");
  #undef DMA_K
  #undef DMA_V
  #undef CMASK
  #undef START
  #undef RESC
  #undef ROT
  #undef BIAS
}
constexpr int ATTN_LDS_BYTES=LDS_BYTES;
constexpr int SWA_K=0, SWA_V=6*SLOTB, SWA_OST=12*SLOTB, SWA_WS=133120;
__device__ __forceinline__ void swa_unit(const int wave_s,int qb,const bf16*Qh,const bf16*__restrict__ Kh,const bf16*__restrict__ Vh,bf16*Oh,float slope2,float sink2,char*shm){
  const int wid=wave_s; const int tid=wave_s*64+fresh_lane(),lane=tid&63,r32=lane&31,hi=lane>>5;
  const int q0=qb*QB, c0=4*qb-2;
  const bf16*Qw=Qh+(long)(q0+wid*QBLK)*DM;
  const unsigned lds0=(unsigned)(uintptr_t)shm;
  float*wsf=(float*)(shm+SWA_WS)+wid*64;
  const bf16*ksrc=Kh+(long)lane*DM+wid*8;
  const bf16*vsrc=Vh+(long)(16*(wid&3)+(lane>>2))*DM+(wid>>2)*32+(lane&3)*8;
  const unsigned kdst=lds0+SWA_K+wid*1024, vdst=lds0+SWA_V+wid*1024;
  #pragma unroll
  for(int s=0;s<6;++s){ const int ch=c0+s; if(ch>=0){ glds16(ksrc+(long)ch*KVBLK*DM,(unsigned)__builtin_amdgcn_readfirstlane(kdst+s*SLOTB)); glds16(vsrc+(long)ch*KVBLK*DM,(unsigned)__builtin_amdgcn_readfirstlane(vdst+s*SLOTB)); } }
  bf16x8 qr[4];
  #pragma unroll
  for(int d0=0;d0<4;++d0)qr[d0]=*reinterpret_cast<const bf16x8*>(&Qw[(long)r32*DM+d0*16+hi*8]);
  WAIT_BAR(0);
  const int wc=wid>>1, qrel=(wid&1)*32+r32;
  f32x16 zero=f32x16{}; asm volatile("":"+v"(zero));
  f32x16 S[3][2];
  #pragma unroll
  for(int t=0;t<3;++t){
    if(c0+wc+t>=0){
      qkt(S[t][0],S[t][1],shm+SWA_K+(wc+t)*SLOTB,qr,zero,r32,hi);
      const float qf=(float)(64*(2-t)+qrel-4*hi);
      #pragma unroll
      for(int r=0;r<16;++r){ const float dd=qf-(float)((r&3)+8*(r>>2)); S[t][0][r]=__builtin_fmaf(-slope2,__builtin_fabsf(dd),S[t][0][r]); S[t][1][r]=__builtin_fmaf(-slope2,__builtin_fabsf(dd-32.f),S[t][1][r]); }
    } else {
      #pragma unroll
      for(int r=0;r<16;++r){ S[t][0][r]=-INFINITY; S[t][1][r]=-INFINITY; }
    }
  }
  float m=sink2;
  #pragma unroll
  for(int t=0;t<3;++t) m=__builtin_fmaxf(m,rowmax(S[t][0],S[t][1]));
  float l=0.f;
  #pragma unroll
  for(int t=0;t<3;++t){
    #pragma unroll
    for(int r=0;r<16;++r){ S[t][0][r]=__builtin_amdgcn_exp2f(S[t][0][r]-m); S[t][1][r]=__builtin_amdgcn_exp2f(S[t][1][r]-m); l+=S[t][0][r]+S[t][1][r]; }
  }
  {auto rr=__builtin_amdgcn_permlane32_swap(__float_as_uint(l),__float_as_uint(l),false,false);l=__uint_as_float(rr[0])+__uint_as_float(rr[1]);}
  l+=__builtin_amdgcn_exp2f(sink2-m);
  f32x16 o[2];o[0]=f32x16{};o[1]=f32x16{};
  const int vb0=(int)(lds0+SWA_V)+((lane>>4)&1)*32+(lane&3)*8+(4*hi+((lane&15)>>2))*64;
  #pragma unroll
  for(int t=0;t<3;++t){
    if(c0+wc+t>=0){
      #define PKW(P,B) cvtpk_s(P[B],P[B+1])
      const u32x4 pw0=(u32x4){PKW(S[t][0],0),PKW(S[t][0],2),PKW(S[t][0],4),PKW(S[t][0],6)},pw1=(u32x4){PKW(S[t][0],8),PKW(S[t][0],10),PKW(S[t][0],12),PKW(S[t][0],14)};
      const u32x4 pw2=(u32x4){PKW(S[t][1],0),PKW(S[t][1],2),PKW(S[t][1],4),PKW(S[t][1],6)},pw3=(u32x4){PKW(S[t][1],8),PKW(S[t][1],10),PKW(S[t][1],12),PKW(S[t][1],14)};
      #undef PKW
      SBAR(); pv(o,vb0+(wc+t)*SLOTB,__builtin_bit_cast(bf16x8,pw0),__builtin_bit_cast(bf16x8,pw1),__builtin_bit_cast(bf16x8,pw2),__builtin_bit_cast(bf16x8,pw3));
    }
  }
  if(hi==0)wsf[32+r32]=l;asm volatile("s_waitcnt lgkmcnt(0)":::"memory");
  float rli[16];
  #pragma unroll
  for(int r=0;r<16;++r)rli[r]=__builtin_amdgcn_rcpf(wsf[32+crow(r,hi)]);
  bf16*Ow=Oh+(long)(q0+wid*QBLK)*DM;
  { bf16*stg=(bf16*)(shm+SWA_OST)+wid*2048;
    #pragma unroll
    for(int r=0;r<16;++r){const int orow=crow(r,hi);
      #pragma unroll
      for(int d0=0;d0<2;++d0)stg[orow*64+d0*32+r32]=__float2bfloat16(o[d0][r]*rli[r]);}
    asm volatile("s_waitcnt lgkmcnt(0)":::"memory");
    #pragma unroll
    for(int i=0;i<4;++i){const int row=i*8+(lane>>3),ch=lane&7; const u32x4 v=*(const u32x4*)(stg+row*64+ch*8); ATTN_STORE16(Ow+(long)row*DM+ch*8,v);} }
  asm volatile("s_waitcnt lgkmcnt(0)\n\ts_barrier":::"memory");
}

#undef SBAR
#undef WAIT_BAR
}

namespace cg = cooperative_groups;
constexpr int NWAVES = 8;
constexpr int BATCH = 2, T = 8192, D = 1024, FF = 4096, PLE = 256, DIN_SRC = 4360, NZ = 4352, M = BATCH * T;
constexpr float RMS_EPS = 1e-6f, LOG2E = 1.4426950408889634f;
constexpr size_t MiB = 1u << 20;
constexpr size_t WS_WIN = 0, WS_WA = 9 * MiB, WS_WB = 10 * MiB, WS_WMIX = 11 * MiB, WS_W1 = 13 * MiB, WS_W2 = 21 * MiB, WS_WG = 29 * MiB, WS_WP = 31 * MiB;
constexpr size_t WS_LF = 31 * MiB + 512 * 1024, WS_CB = 32 * MiB;
constexpr size_t WS_ST1 = 33 * MiB, WS_ST2 = 34 * MiB, WS_ST3 = 35 * MiB;
constexpr size_t WS_PB = 36 * MiB;
constexpr size_t WS_XN = 44 * MiB;
constexpr size_t WS_HN = 76 * MiB;
constexpr size_t WS_Z = 108 * MiB;
constexpr size_t WS_CTL = 244 * MiB, CTL_ZERO_BYTES = 16384;
constexpr size_t WS_END = 245 * MiB;
constexpr int RING_BYTES = 131072, LDS_BYTES = 147456, MISC_OFF = RING_BYTES + 320;
#define GAS __attribute__((address_space(1)))
#define LAS __attribute__((address_space(3)))
typedef unsigned short bf16;
typedef unsigned v4u __attribute__((ext_vector_type(4)));
typedef unsigned v2u __attribute__((ext_vector_type(2)));
typedef float f32x4 __attribute__((ext_vector_type(4)));
#define LDS_WAIT() asm volatile("s_waitcnt lgkmcnt(0)" ::: "memory")
__device__ __forceinline__ unsigned f2bf(float f) { unsigned u = __builtin_bit_cast(unsigned, f); return (u + 0x7fffu + ((u >> 16) & 1u)) >> 16; }
__device__ __forceinline__ unsigned pk2(float lo, float hi) { return f2bf(lo) | (f2bf(hi) << 16); }
__device__ __forceinline__ float wave_sum(float v) {
#pragma unroll
    for (int o = 1; o < 64; o <<= 1) v += __shfl_xor(v, o);
    return v;
}
#define RLX_AGENT __ATOMIC_RELAXED, __HIP_MEMORY_SCOPE_AGENT
#define XB_TMO      128
#define XB_XCNT(j)  (256  + 64 * (j))
#define XB_XSUB(j)  (1280 + 64 * (j))
#define XB_XGEN(j)  (2304 + 64 * (j))
#define XB_TOP      3328
#define XB_TOPGEN   3392
#define XCD_BAR_WORDS 3456
#define XB_SPIN_CAP (1u << 18)

__device__ __forceinline__ unsigned xb_ld(unsigned* p)              { return __hip_atomic_load(p, __ATOMIC_RELAXED, __HIP_MEMORY_SCOPE_AGENT); }
__device__ __forceinline__ unsigned xb_add(unsigned* p, unsigned v) { return __hip_atomic_fetch_add(p, v, __ATOMIC_RELAXED, __HIP_MEMORY_SCOPE_AGENT); }
__device__ __forceinline__ unsigned xb_xcc_id() { return (unsigned)__builtin_amdgcn_s_getreg((3 << 11) | 20) & 0xFu; }
#define XB_SPIN(cond, bar) do { unsigned _sp = 0; while (cond) { __builtin_amdgcn_s_sleep(1); \
    if ((++_sp & 255u) == 0u) { if (xb_ld(&(bar)[XB_TMO])) break; if (_sp > XB_SPIN_CAP) { atomicAdd(&(bar)[XB_TMO], 1u); break; } } } } while (0)

struct XcdBarrier {
    unsigned* bar; unsigned x;
    volatile LAS unsigned* st;
};

__device__ __forceinline__ XcdBarrier xcd_barrier_post(unsigned* bar, volatile LAS unsigned* st) {
    XcdBarrier b; b.bar = bar; b.x = xb_xcc_id(); b.st = st;
    if (threadIdx.x == 0) (void)xb_add(&bar[XB_XCNT(b.x)], 1u);
    return b;
}
__device__ __forceinline__ void xcd_barrier_complete(unsigned* bar, unsigned x, unsigned& nloc, unsigned& nx) {
    const unsigned G = gridDim.x * gridDim.y * gridDim.z;
    unsigned sum, cnt, mine, sp = 0u;
    for (;;) {
        sum = 0u; cnt = 0u; mine = 0u;
#pragma unroll
        for (unsigned j = 0; j < 16; ++j) { const unsigned c = xb_ld(&bar[XB_XCNT(j)]); sum += c; cnt += (c > 0u) ? 1u : 0u; mine = (j == x) ? c : mine; }
        if (sum == G) break;
        __builtin_amdgcn_s_sleep(1);
        if ((++sp & 255u) == 0u) { if (xb_ld(&bar[XB_TMO])) break; if (sp > XB_SPIN_CAP) { atomicAdd(&bar[XB_TMO], 1u); break; } }
    }
    nloc = mine > 0u ? mine : 1u; nx = cnt > 0u ? cnt : 1u;
}

__device__ __forceinline__ void xcd_barrier(const XcdBarrier& b, const bool t0) {
    asm volatile("s_waitcnt vmcnt(0)" ::: "memory");
    __syncthreads();
    if (t0) {
        unsigned* bar = b.bar;
        __builtin_amdgcn_s_waitcnt(0);
        unsigned nloc = b.st[0], nx = b.st[1];
        if (nloc == 0u) { xcd_barrier_complete(bar, b.x, nloc, nx); b.st[0] = nloc; b.st[1] = nx; }
        const unsigned old = xb_add(&bar[XB_XSUB(b.x)], 1u);
        const unsigned gen = old / nloc;
        if (old + 1u == (gen + 1u) * nloc) {
            __builtin_amdgcn_fence(__ATOMIC_RELEASE, "agent");
            asm volatile("s_waitcnt vmcnt(0)" ::: "memory");
            const unsigned og = xb_add(&bar[XB_TOP], 1u);
            const unsigned tg = og / nx;
            if (og + 1u == (tg + 1u) * nx) xb_add(&bar[XB_TOPGEN], 1u);
            else XB_SPIN(xb_ld(&bar[XB_TOPGEN]) == tg, bar);
            __builtin_amdgcn_fence(__ATOMIC_ACQUIRE, "agent");
            xb_add(&bar[XB_XGEN(b.x)], 1u);
            asm volatile("s_waitcnt vmcnt(0)" ::: "memory");
        } else {
            XB_SPIN(xb_ld(&bar[XB_XGEN(b.x)]) == gen, bar);
            __builtin_amdgcn_fence(__ATOMIC_ACQUIRE, "agent");
            asm volatile("s_waitcnt vmcnt(0)" ::: "memory");
        }
    }
    __syncthreads();
}
struct Frame {
    LAS unsigned char* lds; int wave, vcu, G;
};
__device__ __forceinline__ void p0_transpose_item(const float* W, int ldw, int K, int N, int split, int extra, const float* gs, bf16* WT, LAS float* scr, int item, int lane) {
    const int nblk = N / 32, kb = item / nblk, nb = item % nblk, k0 = 64 * kb, n0 = 32 * nb, s0 = n0 + (n0 >= split ? extra : 0);
#pragma unroll 8
    for (int i = 0; i < 32; ++i) { const int kk = 2 * i + (lane >> 5); float w = W[(size_t)(k0 + kk) * ldw + s0 + (lane & 31)]; if (gs) w *= gs[k0 + kk]; scr[kk * 33 + (lane & 31)] = w; }
    LDS_WAIT(); asm volatile("" ::: "memory");
    const int c = lane & 7;
#pragma unroll
    for (int j = 0; j < 4; ++j) { const int n = (lane >> 3) + 8 * j; const LAS float* s = scr + (8 * c) * 33 + n;
        v4u o; o.x = pk2(s[0 * 33], s[1 * 33]); o.y = pk2(s[2 * 33], s[3 * 33]); o.z = pk2(s[4 * 33], s[5 * 33]); o.w = pk2(s[6 * 33], s[7 * 33]);
        *(GAS v4u*)(WT + (size_t)(n0 + n) * K + k0 + 8 * c) = o; }
    LDS_WAIT(); asm volatile("" ::: "memory");
}
struct Args { const float* in[16]; float* out; unsigned char* ws; };
constexpr int WF_OFF = 8 * 8704;

__global__ void __launch_bounds__(NWAVES * 64, 2) mk_fwd(Args args) {
    extern __shared__ __attribute__((aligned(16))) unsigned char lds[];
    cg::grid_group grid = cg::this_grid();
    Frame F;
    F.lds = (LAS unsigned char*)lds;
    F.wave = __builtin_amdgcn_readfirstlane((int)threadIdx.x >> 6);
    F.G = gridDim.x; { const int bx = blockIdx.x; F.vcu = (F.G % 8 == 0) ? (bx % 8) * (F.G / 8) + bx / 8 : bx; }
    unsigned char* ws = args.ws;
    const float* x = args.in[0]; const float* p_in = args.in[1]; const float* g_mix = args.in[2]; const float* w_in = args.in[3]; const float* b_forget = args.in[4];
    const float* sinks = args.in[5]; const float* w_br_swa = args.in[6]; const float* w_br_fox = args.in[7]; const float* w_mix = args.in[8]; const float* g_mlp = args.in[9];
    const float* w_ff1 = args.in[10]; const float* w_ff2 = args.in[11]; const float* g_ple = args.in[12]; const float* w_pg = args.in[13]; const float* w_pp = args.in[14]; const float* g_final = args.in[15];
    float* out = args.out;
    bf16 *WIN_t = (bf16*)(ws + WS_WIN), *WA_t = (bf16*)(ws + WS_WA), *WB_t = (bf16*)(ws + WS_WB), *WMIX_t = (bf16*)(ws + WS_WMIX), *W1_t = (bf16*)(ws + WS_W1), *W2_t = (bf16*)(ws + WS_W2), *WG_t = (bf16*)(ws + WS_WG), *WP_t = (bf16*)(ws + WS_WP);
    float *LF = (float*)(ws + WS_LF), *CB = (float*)(ws + WS_CB), *ST1 = (float*)(ws + WS_ST1), *ST2 = (float*)(ws + WS_ST2), *ST3 = (float*)(ws + WS_ST3);
    bf16 *PB = (bf16*)(ws + WS_PB), *XN = (bf16*)(ws + WS_XN), *HN = (bf16*)(ws + WS_HN), *Z = (bf16*)(ws + WS_Z), *HB = (bf16*)(ws + WS_Z); float* PP = (float*)(ws + WS_Z);
    const int gw = F.vcu * NWAVES + F.wave, NGW = F.G * NWAVES;

    for (int u = threadIdx.x; u < 128; u += NWAVES * 64) ((LAS unsigned*)(F.lds + RING_BYTES))[u] = 0u;
    __syncthreads();
    XcdBarrier bar = xcd_barrier_post((unsigned*)(ws + WS_CTL), (volatile LAS unsigned*)(F.lds + MISC_OFF) + 8);
#define GRID_BAR() do { const int l_ = fresh_lane(); xcd_barrier(bar, (F.wave == 0) && (l_ == 0)); } while (0)
    {
        const int p0_tid = threadIdx.x, p0_lane = p0_tid & 63;
        LAS float* wfT = (LAS float*)(F.lds + WF_OFF);
        for (int i = p0_tid; i < 8 * D; i += NWAVES * 64) { const int h = i >> 10, k = i & 1023; wfT[i] = g_mix[k] * w_in[(size_t)k * DIN_SRC + 2304 + h]; }
        __syncthreads();
        for (int m = gw; m < M; m += NGW) {
            const GAS f32x4* xr = (const GAS f32x4*)(x + (size_t)m * D) + p0_lane;
            f32x4 v[4]; float ss = 0.f;
#pragma unroll
            for (int j = 0; j < 4; ++j) { v[j] = xr[64 * j]; ss += (v[j].x * v[j].x + v[j].y * v[j].y) + (v[j].z * v[j].z + v[j].w * v[j].w); }
            const float rstd = 1.f / sqrtf(wave_sum(ss) * (1.f / D) + RMS_EPS);
            float fsel = 0.f;
#pragma unroll
            for (int h = 0; h < 8; ++h) { float a = 0.f;
#pragma unroll
                for (int j = 0; j < 4; ++j) { const f32x4 w = ((const LAS f32x4*)wfT)[h * 256 + 64 * j + p0_lane]; a += (v[j].x * w.x + v[j].y * w.y) + (v[j].z * w.z + v[j].w * w.w); }
                a = wave_sum(a); if (p0_lane == h) fsel = a; }
            if (p0_lane < 8) { const float xf = fsel * rstd + b_forget[p0_lane]; const float ls = fminf(xf, 0.f) - log1pf(expf(-fabsf(xf)));
                LF[(size_t)((m >> 13) * 8 + p0_lane) * T + (m & (T - 1))] = ls; }
            GAS unsigned long long* o8 = (GAS unsigned long long*)(XN + (size_t)m * D) + p0_lane;
#pragma unroll
            for (int j = 0; j < 4; ++j) { const f32x4 gm = ((const GAS f32x4*)g_mix)[64 * j + p0_lane]; const f32x4 y = v[j] * rstd * gm;
                o8[64 * j] = (unsigned long long)pk2(y.x, y.y) | ((unsigned long long)pk2(y.z, y.w) << 32); }
        }
        for (int i = gw * 64 + p0_lane; i < M * PLE / 8; i += NGW * 64) { const f32x4 a = ((const GAS f32x4*)p_in)[2 * i], b = ((const GAS f32x4*)p_in)[2 * i + 1];
            v4u o; o.x = pk2(a.x, a.y); o.y = pk2(a.z, a.w); o.z = pk2(b.x, b.y); o.w = pk2(b.z, b.w); ((GAS v4u*)PB)[i] = o; }
        LAS float* scr = (LAS float*)(F.lds + F.wave * 8704);
        constexpr int I_IN = (D / 64) * (NZ / 32), I_A = (512 / 64) * (D / 32), I_MIX = (D / 64) * (D / 32), I_1 = (D / 64) * (FF / 32), I_2 = (FF / 64) * (D / 32), I_P = (PLE / 64) * (D / 32);
        constexpr int NITEMS = I_IN + 2 * I_A + I_MIX + I_1 + I_2 + I_MIX + I_P;
        for (int it = gw; it < NITEMS; it += NGW) {
            int r = it;
            if (r < I_IN) { p0_transpose_item(w_in, DIN_SRC, D, NZ, 2304, 8, nullptr, WIN_t, scr, r, p0_lane); continue; } r -= I_IN;
            if (r < I_A) { p0_transpose_item(w_br_swa, D, 512, D, 1 << 30, 0, nullptr, WA_t, scr, r, p0_lane); continue; } r -= I_A;
            if (r < I_A) { p0_transpose_item(w_br_fox, D, 512, D, 1 << 30, 0, nullptr, WB_t, scr, r, p0_lane); continue; } r -= I_A;
            if (r < I_MIX) { p0_transpose_item(w_mix, D, D, D, 1 << 30, 0, nullptr, WMIX_t, scr, r, p0_lane); continue; } r -= I_MIX;
            if (r < I_1) { p0_transpose_item(w_ff1, FF, D, FF, 1 << 30, 0, g_mlp, W1_t, scr, r, p0_lane); continue; } r -= I_1;
            if (r < I_2) { p0_transpose_item(w_ff2, D, FF, D, 1 << 30, 0, nullptr, W2_t, scr, r, p0_lane); continue; } r -= I_2;
            if (r < I_MIX) { p0_transpose_item(w_pg, D, D, D, 1 << 30, 0, g_ple, WG_t, scr, r, p0_lane); continue; } r -= I_MIX;
            p0_transpose_item(w_pp, D, PLE, D, 1 << 30, 0, nullptr, WP_t, scr, r, p0_lane);
        }
    }
    grid.sync();

    for (int bh = blockIdx.x; bh < 16; bh += gridDim.x) {
        const int c_lane = fresh_lane(), c_tid = F.wave * 64 + c_lane;
        const GAS f32x4* src = (const GAS f32x4*)(LF + (size_t)bh * T) + c_tid * 4;
        f32x4 v[4]; float run = 0.f;
#pragma unroll
        for (int j = 0; j < 4; ++j) { v[j] = src[j];
#pragma unroll
            for (int e = 0; e < 4; ++e) { run += v[j][e]; v[j][e] = run; } }
        float sc = run;
#pragma unroll
        for (int o = 1; o < 64; o <<= 1) { const float n = __shfl_up(sc, o); if (c_lane >= o) sc += n; }
        LAS float* wt = (LAS float*)F.lds;
        if (c_lane == 63) wt[F.wave] = sc;
        __syncthreads();
        float woff = 0.f;
        for (int w = 0; w < F.wave; ++w) woff += wt[w];
        const float off = woff + sc - run;
        GAS f32x4* dst = (GAS f32x4*)(CB + (size_t)bh * T) + c_tid * 4;
#pragma unroll
        for (int j = 0; j < 4; ++j) dst[j] = (v[j] + off) * (-LOG2E);
        __syncthreads();
    }
    {
        pg8::Gemm g{XN, WIN_t, M, NZ, D, D}; pg8::StaticOrder S; S.init(M, NZ, F.G, (int)blockIdx.x);
        pg8::EpiZ E{Z};
        pg8::gemm_phase<pg8::EpiZ, pg8::StaticOrder, PG8_ALIGN, PG8_SP2>(F.lds, g, S, E, F.wave);
    }
    GRID_BAR();

    for (int id = F.vcu; id < 256; id += F.G) {
        const int bh = id >> 4, s = id & 15, b = bh >> 3, h = bh & 7;
        const attn_body::bf16* Zb = (const attn_body::bf16*)Z + (size_t)b * T * NZ;
        const attn_body::bf16* Qh = Zb + 768 + h * 64; const attn_body::bf16* Kh = Zb + 1280 + h * 64; const attn_body::bf16* Vh = Zb + 1792 + h * 64;
        const float* cb = CB + (size_t)bh * T;
        attn_body::attn_unit<24>(F.wave, 31 - s, Qh, Kh, Vh, (attn_body::bf16*)Qh, cb, (char*)lds);
        attn_body::attn_unit<24>(F.wave, s, Qh, Kh, Vh, (attn_body::bf16*)Qh, cb, (char*)lds);
    }
    for (int id = F.vcu; id < 512; id += F.G) {
        const int bh = id >> 5, qb = id & 31, b = bh >> 3, h = bh & 7;
        const attn_body::bf16* Zb = (const attn_body::bf16*)Z + (size_t)b * T * NZ;
        const attn_body::bf16* Qh = Zb + h * 64; const attn_body::bf16* Kh = Zb + 512 + (h >> 2) * 64; const attn_body::bf16* Vh = Zb + 640 + (h >> 2) * 64;
        const float slope2 = exp2f(-(float)(h + 1)) * LOG2E, sink2 = sinks[h] * LOG2E;
        attn_body::swa_unit(F.wave, qb, Qh, Kh, Vh, (attn_body::bf16*)Qh, slope2, sink2, (char*)lds);
    }
    GRID_BAR();

    {
        pg8::StaticOrder S; S.init(M, D, F.G, (int)blockIdx.x);
        { pg8::Gemm g{Z, WA_t, M, D, 512, NZ}; pg8::EpiT1 E{Z + 2304, out}; pg8::gemm_phase<pg8::EpiT1, pg8::StaticOrder, PG8_ALIGN, PG8_SP2>(F.lds, g, S, E, F.wave); }
        { pg8::Gemm g{Z + 768, WB_t, M, D, 512, NZ}; pg8::EpiMix E{Z + 3328, out, XN}; pg8::gemm_phase<pg8::EpiMix, pg8::StaticOrder, PG8_ALIGN, PG8_SP2>(F.lds, g, S, E, F.wave); }
    }
    GRID_BAR();

    {
        pg8::Gemm g{XN, WMIX_t, M, D, D, D}; pg8::StaticOrder S; S.init(M, D, F.G, (int)blockIdx.x);
        pg8::EpiRes E{x, out, HN, ST1};
        pg8::gemm_phase<pg8::EpiRes, pg8::StaticOrder, PG8_ALIGN, PG8_SP2>(F.lds, g, S, E, F.wave);
    }
    GRID_BAR();

    {
        pg8::Gemm g{HN, W1_t, M, FF, D, D}; pg8::StaticOrder S; S.init(M, FF, F.G, (int)blockIdx.x);
        pg8::EpiRelu2 E{ST1, HB};
        pg8::gemm_phase<pg8::EpiRelu2, pg8::StaticOrder, PG8_ALIGN, PG8_SP2>(F.lds, g, S, E, F.wave);
    }
    GRID_BAR();

    {
        pg8::Gemm g{HB, W2_t, M, D, FF, FF}; pg8::StaticOrder S; S.init(M, D, F.G, (int)blockIdx.x);
        pg8::EpiRes E{out, out, XN, ST2};
        pg8::gemm_phase<pg8::EpiRes, pg8::StaticOrder, PG8_ALIGN, PG8_SP2>(F.lds, g, S, E, F.wave);
    }
    GRID_BAR();

    {
        pg8::StaticOrder S; S.init(M, D, F.G, (int)blockIdx.x);
        { pg8::Gemm g{PB, WP_t, M, D, PLE, PLE}; pg8::EpiPP E{PP}; pg8::gemm_phase<pg8::EpiPP, pg8::StaticOrder, PG8_ALIGN, PG8_SP2>(F.lds, g, S, E, F.wave); }
        { pg8::Gemm g{XN, WG_t, M, D, D, D}; pg8::EpiPle E{ST2, PP, out, ST3}; pg8::gemm_phase<pg8::EpiPle, pg8::StaticOrder, PG8_ALIGN, PG8_SP2>(F.lds, g, S, E, F.wave); }
    }
    GRID_BAR();

    const int f_lane = fresh_lane();
    for (int m = gw; m < M; m += NGW) {
        float t = (f_lane < 16) ? ST3[(size_t)m * 16 + f_lane] : 0.f;
        const float rstd = 1.f / sqrtf(wave_sum(t) * (1.f / D) + RMS_EPS);
        GAS f32x4* xr = (GAS f32x4*)(out + (size_t)m * D) + f_lane;
#pragma unroll
        for (int j = 0; j < 4; ++j) { const f32x4 gm = ((const GAS f32x4*)g_final)[64 * j + f_lane]; xr[64 * j] = xr[64 * j] * rstd * gm; }
    }
}

extern "C" void kernel_launch(void* const* d_in, const int* in_sizes, int n_in, void* d_out, int out_size, void* d_ws, size_t ws_size, hipStream_t stream) {
    static int grid = 0;
    if (grid == 0) {
        if (n_in != 16 || in_sizes[0] != M * D || out_size != M * D || ws_size < WS_END) { fprintf(stderr, "kernel_launch: unexpected shapes (n_in %d, in0 %d, out %d, ws %zu); nothing launched\n", n_in, n_in > 0 ? in_sizes[0] : -1, out_size, ws_size); grid = -1; return; }
        int dev = 0, cus = 0, per_cu = 0;
        if (hipGetDevice(&dev) != hipSuccess || hipDeviceGetAttribute(&cus, hipDeviceAttributeMultiprocessorCount, dev) != hipSuccess) { grid = -1; return; }
        if (hipFuncSetAttribute((const void*)mk_fwd, hipFuncAttributeMaxDynamicSharedMemorySize, LDS_BYTES) != hipSuccess) { fprintf(stderr, "kernel_launch: hipFuncSetAttribute failed\n"); grid = -1; return; }
        if (hipOccupancyMaxActiveBlocksPerMultiprocessor(&per_cu, (const void*)mk_fwd, NWAVES * 64, LDS_BYTES) != hipSuccess || per_cu < 1) { fprintf(stderr, "kernel_launch: occupancy query failed (%d)\n", per_cu); (void)hipGetLastError(); per_cu = 1; }
        if (per_cu > 1) per_cu = 1;
        grid = cus * per_cu;
    }
    if (grid < 0) return;
    if (hipMemsetAsync((char*)d_ws + WS_CTL, 0, CTL_ZERO_BYTES, stream) != hipSuccess) { fprintf(stderr, "kernel_launch: memset failed\n"); return; }
    Args a{};
    for (int i = 0; i < 16; ++i) a.in[i] = (const float*)d_in[i];
    a.out = (float*)d_out; a.ws = (unsigned char*)d_ws;
    void* kargs[] = {&a};
    hipError_t e = hipLaunchCooperativeKernel((const void*)mk_fwd, dim3(grid), dim3(NWAVES * 64), kargs, LDS_BYTES, stream);
    if (e != hipSuccess) fprintf(stderr, "kernel_launch: cooperative launch failed: %s (grid %d)\n", hipGetErrorString(e), grid);
}
```

```cpp
#include <hip/hip_runtime.h>
#include <hip/hip_cooperative_groups.h>
#include <cstdio>
#include <cstdint>
__device__ __forceinline__ int fresh_lane() { int l; asm volatile("v_mbcnt_lo_u32_b32 %0, -1, 0\n\tv_mbcnt_hi_u32_b32 %0, -1, %0" : "=v"(l)); return l; }

namespace pg8 {

#define PG8_LAS __attribute__((address_space(3)))
typedef unsigned short bf16_t;
typedef short bf16x8 __attribute__((ext_vector_type(8)));
typedef float f32x4 __attribute__((ext_vector_type(4)));
typedef unsigned u32x4 __attribute__((ext_vector_type(4)));
constexpr int BM = 256, BK = 64, HALF = 128, HTB = HALF * BK * 2  , STAGE_BYTES = 8 * HTB, NXCD = 8, WGM = 8;

__host__ __device__ __forceinline__ int lds_byte(int r, int c) { const int st = (r >> 4) * 2 + (c >> 5), rr = r & 15, cc = c & 31, ob = rr * 64 + cc * 2; return st * 1024 + (ob ^ (((ob >> 9) & 1) << 5)); }
__host__ __device__ __forceinline__ void stage_rc(int b, int& R, int& C) { const int st = b / 1024, sb = b % 1024, swz = sb ^ (((sb >> 9) & 1) << 5); R = (st >> 1) * 16 + swz / 64; C = (st & 1) * 32 + (swz % 64) / 2; }
__host__ __device__ __forceinline__ int perm32(int rho) { const int n = rho >> 4, i = rho & 15; return 8 * (i >> 2) + 4 * n + (i & 3); }

struct Unit { int pm, pn; };
struct Gemm { const bf16_t* A; const bf16_t* Bt; int M, N, K, lda; };

struct StaticOrder {
    int nM, nN, nwg, G, c;
    __host__ __device__ void init(int M, int N, int G_, int c_) { nM = M / BM; nN = N / BM; nwg = nM * nN; G = G_; c = c_; }
    __host__ __device__ bool next(int i, Unit& u) const {
        const long L = (long)i * G + c; if (L >= nwg) return false;
        int wgid = (int)L; { const int q = nwg / NXCD, r = nwg % NXCD, xcd = wgid % NXCD, off = wgid / NXCD; wgid = (xcd < r ? xcd * (q + 1) : r * (q + 1) + (xcd - r) * q) + off; }
        const int nig = WGM * nN, gid = wgid / nig, fm = gid * WGM, gsz = (nM - fm) < WGM ? (nM - fm) : WGM;
        u.pm = fm + ((wgid % nig) % gsz); u.pn = (wgid % nig) / gsz; return true;
    }
    __device__ __forceinline__ void a_ready(const Unit&) const {}
    __device__ __forceinline__ void done(const Unit&) const {}
};

__device__ __forceinline__ unsigned cvt_pk_bf16(float lo, float hi) { unsigned r; asm volatile("v_cvt_pk_bf16_f32 %0, %1, %2" : "=v"(r) : "v"(lo), "v"(hi)); return r; }
typedef float f32x2 __attribute__((ext_vector_type(2)));
constexpr int ZP = 4352;
constexpr float C2F = 0.125f * 1.4426950408889634f;
__device__ __forceinline__ float sigmoidf_fast(float x) { return __builtin_amdgcn_rcpf(1.0f + __builtin_amdgcn_exp2f(-1.4426950408889634f * x)); }
__device__ __forceinline__ f32x4 bf4_lo(unsigned a, unsigned b) { return (f32x4){__uint_as_float(a << 16), __uint_as_float(a & 0xffff0000u), __uint_as_float(b << 16), __uint_as_float(b & 0xffff0000u)}; }
__device__ __forceinline__ u32x4 pack8(f32x4 v0, f32x4 v1) { u32x4 w; w.x = cvt_pk_bf16(v0[0], v0[1]); w.y = cvt_pk_bf16(v0[2], v0[3]); w.z = cvt_pk_bf16(v1[0], v1[1]); w.w = cvt_pk_bf16(v1[2], v1[3]); return w; }
__device__ __forceinline__ float rstd_from_stats(const float* st, int row) { const f32x4* s = (const f32x4*)(st + (size_t)row * 16); const f32x4 a = s[0], b = s[1], c = s[2], d = s[3];
    const float t = ((a[0] + a[1]) + (a[2] + a[3])) + ((b[0] + b[1]) + (b[2] + b[3])) + ((c[0] + c[1]) + (c[2] + c[3])) + ((d[0] + d[1]) + (d[2] + d[3])); return 1.0f / sqrtf(t * (1.0f / 1024.0f) + 1e-6f); }
#define EPI_ROWS(...) _Pragma("unroll") for (int ai = 0; ai < 2; ++ai) _Pragma("unroll") for (int m = 0; m < 4; ++m) { const int row = u.pm * BM + ai * HALF + wr * 64 + m * 16 + fr; __VA_ARGS__ asm volatile("" ::: "memory"); }
#define EPI_COLS(...) _Pragma("unroll") for (int bj = 0; bj < 2; ++bj) { const int col = u.pn * BM + bj * HALF + wc * 32 + 8 * fq; const f32x4 a0 = acc[ai][bj][m][0], a1 = acc[ai][bj][m][1]; __VA_ARGS__ }
struct EpiZ { static constexpr bool PERM = true, AFTER_DRAIN = false; bf16_t* Z;
    __device__ __forceinline__ void operator()(const f32x4 (&acc)[2][2][4][2], const Unit& u, int wr, int wc, int fr, int fq) const {
        const int pn = u.pn; const int mode = (pn >= 9) ? 2 : ((pn == 0 || pn == 1 || pn == 3 || pn == 4) ? 1 : 0);
        EPI_ROWS( bf16_t* rowp = Z + (size_t)row * ZP; EPI_COLS( f32x4 v0 = a0, v1 = a1;
            if (mode == 1) { v0 = v0 * C2F; v1 = v1 * C2F; }
            else if (mode == 2) { _Pragma("unroll") for (int e = 0; e < 4; ++e) { v0[e] = sigmoidf_fast(v0[e]); v1[e] = sigmoidf_fast(v1[e]); } }
            *(u32x4*)(rowp + col) = pack8(v0, v1); ) )
    } };
#define EPI_GROUP(NR, ...) _Pragma("unroll") for (int ai = 0; ai < 2; ++ai) _Pragma("unroll") for (int mg = 0; mg < 4; mg += NR) { __VA_ARGS__ asm volatile("" ::: "memory"); }
#define EPI_ROWOF(mm) (u.pm * BM + ai * HALF + wr * 64 + (mm) * 16 + fr)
#define EPI_COLOF(bj) (u.pn * BM + (bj) * HALF + wc * 32 + 8 * fq)
struct EpiT1 { static constexpr bool PERM = true, AFTER_DRAIN = false; const bf16_t* G; float* T;
    __device__ __forceinline__ void operator()(const f32x4 (&acc)[2][2][4][2], const Unit& u, int wr, int wc, int fr, int fq) const {
        EPI_GROUP(4, u32x4 g[4][2];
            _Pragma("unroll") for (int i = 0; i < 4; ++i) _Pragma("unroll") for (int bj = 0; bj < 2; ++bj) g[i][bj] = *(const u32x4*)(G + (size_t)EPI_ROWOF(mg + i) * ZP + EPI_COLOF(bj));
            _Pragma("unroll") for (int i = 0; i < 4; ++i) _Pragma("unroll") for (int bj = 0; bj < 2; ++bj) { float* tp = T + (size_t)EPI_ROWOF(mg + i) * 1024 + EPI_COLOF(bj);
                *(f32x4*)tp = acc[ai][bj][mg + i][0] * bf4_lo(g[i][bj].x, g[i][bj].y); *(f32x4*)(tp + 4) = acc[ai][bj][mg + i][1] * bf4_lo(g[i][bj].z, g[i][bj].w); } )
    } };
struct EpiMix { static constexpr bool PERM = true, AFTER_DRAIN = false; const bf16_t* G; const float* T; bf16_t* O;
    __device__ __forceinline__ void operator()(const f32x4 (&acc)[2][2][4][2], const Unit& u, int wr, int wc, int fr, int fq) const {
        EPI_GROUP(2, u32x4 g[2][2]; f32x4 t[2][2][2];
            _Pragma("unroll") for (int i = 0; i < 2; ++i) _Pragma("unroll") for (int bj = 0; bj < 2; ++bj) { g[i][bj] = *(const u32x4*)(G + (size_t)EPI_ROWOF(mg + i) * ZP + EPI_COLOF(bj));
                const float* tp = T + (size_t)EPI_ROWOF(mg + i) * 1024 + EPI_COLOF(bj); t[i][bj][0] = *(const f32x4*)tp; t[i][bj][1] = *(const f32x4*)(tp + 4); }
            _Pragma("unroll") for (int i = 0; i < 2; ++i) _Pragma("unroll") for (int bj = 0; bj < 2; ++bj) {
                const f32x4 v0 = t[i][bj][0] + acc[ai][bj][mg + i][0] * bf4_lo(g[i][bj].x, g[i][bj].y), v1 = t[i][bj][1] + acc[ai][bj][mg + i][1] * bf4_lo(g[i][bj].z, g[i][bj].w);
                *(u32x4*)(O + (size_t)EPI_ROWOF(mg + i) * 1024 + EPI_COLOF(bj)) = pack8(v0, v1); } )
    } };
struct EpiRes { static constexpr bool PERM = true, AFTER_DRAIN = false; const float* base; float* out; bf16_t* hb; float* st;
    __device__ __forceinline__ void operator()(const f32x4 (&acc)[2][2][4][2], const Unit& u, int wr, int wc, int fr, int fq) const {
        EPI_GROUP(4, f32x4 b[4][2][2];
            _Pragma("unroll") for (int i = 0; i < 4; ++i) _Pragma("unroll") for (int bj = 0; bj < 2; ++bj) { const float* bp = base + (size_t)EPI_ROWOF(mg + i) * 1024 + EPI_COLOF(bj); b[i][bj][0] = *(const f32x4*)bp; b[i][bj][1] = *(const f32x4*)(bp + 4); }
            _Pragma("unroll") for (int i = 0; i < 4; ++i) { float ss = 0.f; const int row = EPI_ROWOF(mg + i);
                _Pragma("unroll") for (int bj = 0; bj < 2; ++bj) { const size_t off = (size_t)row * 1024 + EPI_COLOF(bj); const f32x4 h0 = b[i][bj][0] + acc[ai][bj][mg + i][0], h1 = b[i][bj][1] + acc[ai][bj][mg + i][1];
                    *(f32x4*)(out + off) = h0; *(f32x4*)(out + off + 4) = h1; *(u32x4*)(hb + off) = pack8(h0, h1);
                    ss += ((h0[0] * h0[0] + h0[1] * h0[1]) + (h0[2] * h0[2] + h0[3] * h0[3])) + ((h1[0] * h1[0] + h1[1] * h1[1]) + (h1[2] * h1[2] + h1[3] * h1[3])); }
                ss += __shfl_xor(ss, 16); ss += __shfl_xor(ss, 32); if (fq == 0) st[(size_t)row * 16 + u.pn * 4 + wc] = ss; } )
    } };
struct EpiRelu2 { static constexpr bool PERM = true, AFTER_DRAIN = false; const float* st; bf16_t* O;
    __device__ __forceinline__ void operator()(const f32x4 (&acc)[2][2][4][2], const Unit& u, int wr, int wc, int fr, int fq) const {
        float rsv[2][4];
        _Pragma("unroll") for (int ai = 0; ai < 2; ++ai) _Pragma("unroll") for (int m = 0; m < 4; ++m) rsv[ai][m] = rstd_from_stats(st, u.pm * BM + ai * HALF + wr * 64 + m * 16 + fr);
        EPI_ROWS( const float rs = rsv[ai][m]; EPI_COLS( f32x4 v0 = a0 * rs, v1 = a1 * rs;
            _Pragma("unroll") for (int e = 0; e < 4; ++e) { const float x0 = fmaxf(v0[e], 0.f), x1 = fmaxf(v1[e], 0.f); v0[e] = x0 * x0; v1[e] = x1 * x1; }
            *(u32x4*)(O + (size_t)row * 4096 + col) = pack8(v0, v1); ) )
    } };
struct EpiPP { static constexpr bool PERM = true, AFTER_DRAIN = false; float* T;
    __device__ __forceinline__ void operator()(const f32x4 (&acc)[2][2][4][2], const Unit& u, int wr, int wc, int fr, int fq) const {
        EPI_ROWS( EPI_COLS( float* tp = T + (size_t)row * 1024 + col; *(f32x4*)tp = a0; *(f32x4*)(tp + 4) = a1; ) )
    } };
struct EpiPle { static constexpr bool PERM = true, AFTER_DRAIN = false; const float* st_in; const float* T; float* h; float* st;
    __device__ __forceinline__ void operator()(const f32x4 (&acc)[2][2][4][2], const Unit& u, int wr, int wc, int fr, int fq) const {
        EPI_GROUP(2, f32x4 hv[2][2][2]; f32x4 tv[2][2][2]; float rs[2];
            _Pragma("unroll") for (int i = 0; i < 2; ++i) { rs[i] = rstd_from_stats(st_in, EPI_ROWOF(mg + i));
                _Pragma("unroll") for (int bj = 0; bj < 2; ++bj) { const size_t off = (size_t)EPI_ROWOF(mg + i) * 1024 + EPI_COLOF(bj);
                    hv[i][bj][0] = *(const f32x4*)(h + off); hv[i][bj][1] = *(const f32x4*)(h + off + 4); tv[i][bj][0] = *(const f32x4*)(T + off); tv[i][bj][1] = *(const f32x4*)(T + off + 4); } }
            _Pragma("unroll") for (int i = 0; i < 2; ++i) { float ss = 0.f; const int row = EPI_ROWOF(mg + i);
                _Pragma("unroll") for (int bj = 0; bj < 2; ++bj) { const size_t off = (size_t)row * 1024 + EPI_COLOF(bj);
                    f32x4 g0 = acc[ai][bj][mg + i][0] * rs[i], g1 = acc[ai][bj][mg + i][1] * rs[i]; _Pragma("unroll") for (int e = 0; e < 4; ++e) { g0[e] = sigmoidf_fast(g0[e]); g1[e] = sigmoidf_fast(g1[e]); }
                    const f32x4 h0 = hv[i][bj][0] + g0 * tv[i][bj][0], h1 = hv[i][bj][1] + g1 * tv[i][bj][1];
                    *(f32x4*)(h + off) = h0; *(f32x4*)(h + off + 4) = h1;
                    ss += ((h0[0] * h0[0] + h0[1] * h0[1]) + (h0[2] * h0[2] + h0[3] * h0[3])) + ((h1[0] * h1[0] + h1[1] * h1[1]) + (h1[2] * h1[2] + h1[3] * h1[3])); }
                ss += __shfl_xor(ss, 16); ss += __shfl_xor(ss, 32); if (fq == 0) st[(size_t)row * 16 + u.pn * 4 + wc] = ss; } )
    } };

template <class Epi, class Sched, bool ALIGN_EPI = false, bool SP2 = false>
__device__ __forceinline__ void gemm_phase(PG8_LAS unsigned char* lds, const Gemm g, const Sched& S, const Epi& E, const int wave_s) {
    const int tid = wave_s * 64 + fresh_lane(), wid = wave_s, lane = tid & 63, wr = wid >> 2, wc = wid & 3, fr = lane & 15, fq = lane >> 4;
    const int K = g.K, nt = K / BK;
    unsigned voffA[2], voffB[2];
#pragma unroll
    for (int i = 0; i < 2; ++i) { int R, C; stage_rc(tid * 16 + i * 8192, R, C); const int Rb = Epi::PERM ? ((R & ~31) + perm32(R & 31)) : R;
        voffA[i] = (unsigned)(R * g.lda + C) * 2u; voffB[i] = (unsigned)(Rb * K + C) * 2u; }
    const size_t kstep = (size_t)(BK * 2);
    const size_t hstepA = (size_t)HALF * g.lda * 2, hstepB = (size_t)HALF * K * 2;
    const size_t tstepA = 2 * hstepA, tstepB = 2 * hstepB;
    const unsigned ldsw = (unsigned)wid * 1024u;
    const int aoff = lds_byte(wr * 64 + fr, fq * 8), boff = lds_byte(wc * 32 + fr, fq * 8);
#define PG8_SA(b, h) (((b) * 2 + (h)) * HTB)
#define PG8_SB(b, h) ((4 + (b) * 2 + (h)) * HTB)
#define PG8_STAGE(bufoff, gbase, voff) do { _Pragma("unroll") for (int _i = 0; _i < 2; ++_i) \
        __builtin_amdgcn_global_load_lds((const unsigned*)((const char*)(gbase) + (voff)[_i]), (PG8_LAS unsigned*)(lds + (bufoff) + ldsw + _i * 8192), 16, 0, 0); } while (0)
#define PG8_LDA(dst, b, h) do { _Pragma("unroll") for (int m = 0; m < 4; ++m) _Pragma("unroll") for (int k = 0; k < 2; ++k) dst[m][k] = *(const PG8_LAS bf16x8*)(lds + PG8_SA(b, h) + aoff + m * 2048 + k * 1024); } while (0)
#define PG8_LDB(dst, b, h) do { _Pragma("unroll") for (int n = 0; n < 2; ++n) _Pragma("unroll") for (int k = 0; k < 2; ++k) dst[n][k] = *(const PG8_LAS bf16x8*)(lds + PG8_SB(b, h) + boff + n * 2048 + k * 1024); } while (0)
#define PG8_MMA(ai, bj, At, Bt) do { __builtin_amdgcn_s_setprio(1); _Pragma("unroll") for (int m = 0; m < 4; ++m) _Pragma("unroll") for (int n = 0; n < 2; ++n) _Pragma("unroll") for (int k = 0; k < 2; ++k) \
        acc[ai][bj][m][n] = __builtin_amdgcn_mfma_f32_16x16x32_bf16(Bt[n][k], At[m][k], acc[ai][bj][m][n], 0, 0, 0); __builtin_amdgcn_s_setprio(0); } while (0)
#define PG8_WAIT_V(n) asm volatile("s_waitcnt vmcnt(" #n ")" ::: "memory")
#define PG8_WAIT_L(n) asm volatile("s_waitcnt lgkmcnt(" #n ")" ::: "memory")
#define PG8_BAR __builtin_amdgcn_s_barrier()
#define PG8_SCHED __builtin_amdgcn_sched_barrier(0)
    Unit cur, nxt; int ui = 0;
    if (!S.next(0, cur)) return;
    f32x4 acc[2][2][4][2];
#pragma unroll
    for (int a = 0; a < 2; ++a)
#pragma unroll
        for (int b = 0; b < 2; ++b)
#pragma unroll
            for (int m = 0; m < 4; ++m)
#pragma unroll
                for (int n = 0; n < 2; ++n) acc[a][b][m][n] = (f32x4){0.f, 0.f, 0.f, 0.f};
    bf16x8 At[4][2], B0[2][2], B1[2][2];
    const char* cA = (const char*)g.A + (size_t)cur.pm * tstepA; const char* cB = (const char*)g.Bt + (size_t)cur.pn * tstepB;
    S.a_ready(cur);
    if constexpr (SP2) {
        PG8_STAGE(PG8_SB(0, 0), cB, voffB); PG8_STAGE(PG8_SB(0, 1), cB + hstepB, voffB); PG8_STAGE(PG8_SA(0, 0), cA, voffA); PG8_STAGE(PG8_SA(0, 1), cA + hstepA, voffA);
        if (wr == 1) PG8_BAR;
        PG8_WAIT_V(2); PG8_BAR;
        PG8_STAGE(PG8_SB(1, 0), cB + kstep, voffB); PG8_STAGE(PG8_SA(1, 0), cA + kstep, voffA); PG8_STAGE(PG8_SB(1, 1), cB + hstepB + kstep, voffB);
        PG8_WAIT_V(6); PG8_BAR;
    } else {
        PG8_STAGE(PG8_SB(0, 0), cB, voffB); PG8_STAGE(PG8_SA(0, 0), cA, voffA); PG8_STAGE(PG8_SB(0, 1), cB + hstepB, voffB); PG8_STAGE(PG8_SA(0, 1), cA + hstepA, voffA);
        if (wr == 1) PG8_BAR;
        PG8_WAIT_V(4); PG8_BAR;
        PG8_STAGE(PG8_SB(1, 0), cB + kstep, voffB); PG8_STAGE(PG8_SA(1, 0), cA + kstep, voffA); PG8_STAGE(PG8_SB(1, 1), cB + hstepB + kstep, voffB);
        PG8_WAIT_V(6); PG8_BAR;
    }
    for (;;) {
        const bool has_next = S.next(ui + 1, nxt);
        const char* nA = has_next ? (const char*)g.A + (size_t)nxt.pm * tstepA : cA; const char* nB = has_next ? (const char*)g.Bt + (size_t)nxt.pn * tstepB : cB;
        for (int t = 0; t < nt; t += 2) {
            const bool last = (t == nt - 2);
            const char* a1 = cA + (size_t)(t + 1) * kstep;
            const char* a2 = last ? nA : cA + (size_t)(t + 2) * kstep; const char* b2 = last ? nB : cB + (size_t)(t + 2) * kstep;
            const char* a3 = a2 + kstep; const char* b3 = b2 + kstep;
            if (last && has_next) S.a_ready(nxt);
            if constexpr (SP2) {
            PG8_LDB(B0, 0, 0); PG8_LDB(B1, 0, 1); PG8_SCHED; PG8_LDA(At, 0, 0); PG8_STAGE(PG8_SA(1, 1), a1 + hstepA, voffA);
            PG8_WAIT_V(8); PG8_WAIT_L(0); PG8_BAR; PG8_MMA(0, 0, At, B0); PG8_MMA(0, 1, At, B1); PG8_BAR; PG8_SCHED;
            PG8_LDA(At, 0, 1); PG8_STAGE(PG8_SB(0, 0), b2, voffB); PG8_STAGE(PG8_SB(0, 1), b2 + hstepB, voffB); PG8_STAGE(PG8_SA(0, 0), a2, voffA);
            PG8_WAIT_V(8); PG8_WAIT_L(0); PG8_BAR; PG8_MMA(1, 0, At, B0); PG8_MMA(1, 1, At, B1); PG8_BAR; PG8_SCHED;
            PG8_LDB(B0, 1, 0); PG8_LDB(B1, 1, 1); PG8_SCHED; PG8_LDA(At, 1, 0); PG8_STAGE(PG8_SA(0, 1), a2 + hstepA, voffA);
            PG8_WAIT_V(8); PG8_WAIT_L(0); PG8_BAR; PG8_MMA(0, 0, At, B0); PG8_MMA(0, 1, At, B1); PG8_BAR; PG8_SCHED;
            PG8_LDA(At, 1, 1); PG8_STAGE(PG8_SB(1, 0), b3, voffB); PG8_STAGE(PG8_SB(1, 1), b3 + hstepB, voffB); PG8_STAGE(PG8_SA(1, 0), a3, voffA);
            PG8_WAIT_V(8); PG8_WAIT_L(0); PG8_BAR; PG8_MMA(1, 0, At, B0); PG8_MMA(1, 1, At, B1); PG8_BAR; PG8_SCHED;
            } else {
            PG8_LDB(B0, 0, 0); PG8_SCHED; PG8_LDA(At, 0, 0); PG8_STAGE(PG8_SA(1, 1), a1 + hstepA, voffA);
            PG8_WAIT_L(8); PG8_BAR; PG8_WAIT_L(0); PG8_MMA(0, 0, At, B0); PG8_BAR; PG8_SCHED;
            PG8_LDB(B1, 0, 1); PG8_STAGE(PG8_SB(0, 0), b2, voffB);
            PG8_BAR; PG8_WAIT_L(0); PG8_MMA(0, 1, At, B1); PG8_BAR;
            PG8_LDA(At, 0, 1); PG8_STAGE(PG8_SA(0, 0), a2, voffA);
            PG8_BAR; PG8_WAIT_L(0); PG8_MMA(1, 0, At, B0); PG8_BAR; PG8_SCHED;
            PG8_STAGE(PG8_SB(0, 1), b2 + hstepB, voffB);
            PG8_WAIT_V(6); PG8_BAR; PG8_MMA(1, 1, At, B1); PG8_BAR;
            PG8_LDB(B0, 1, 0); PG8_SCHED; PG8_LDA(At, 1, 0); PG8_STAGE(PG8_SA(0, 1), a2 + hstepA, voffA);
            PG8_WAIT_L(8); PG8_BAR; PG8_WAIT_L(0); PG8_MMA(0, 0, At, B0); PG8_BAR; PG8_SCHED;
            PG8_LDB(B1, 1, 1); PG8_STAGE(PG8_SB(1, 0), b3, voffB);
            PG8_BAR; PG8_WAIT_L(0); PG8_MMA(0, 1, At, B1); PG8_BAR;
            PG8_LDA(At, 1, 1); PG8_STAGE(PG8_SA(1, 0), a3, voffA);
            PG8_BAR; PG8_WAIT_L(0); PG8_MMA(1, 0, At, B0); PG8_BAR; PG8_SCHED;
            PG8_STAGE(PG8_SB(1, 1), b3 + hstepB, voffB);
            PG8_WAIT_V(6); PG8_BAR; PG8_MMA(1, 1, At, B1); PG8_BAR;
            }
        }
        if constexpr (ALIGN_EPI) { if (wr == 0) PG8_BAR; }
        if constexpr (!Epi::AFTER_DRAIN) { E(acc, cur, wr, wc, fr, fq); S.done(cur); }
        if (!has_next) break;
#pragma unroll
        for (int a = 0; a < 2; ++a)
#pragma unroll
            for (int b = 0; b < 2; ++b)
#pragma unroll
                for (int m = 0; m < 4; ++m)
#pragma unroll
                    for (int n = 0; n < 2; ++n) acc[a][b][m][n] = (f32x4){0.f, 0.f, 0.f, 0.f};
        cur = nxt; cA = nA; cB = nB; ++ui;
        if constexpr (ALIGN_EPI) { if (wr == 1) PG8_BAR; }
    }
    PG8_WAIT_V(0);
    if constexpr (!ALIGN_EPI) { if (wr == 0) PG8_BAR; }
    PG8_BAR;
    if constexpr (Epi::AFTER_DRAIN) { E.fused(acc, cur, wr, wc, fr, fq, lds, wid, lane); S.done(cur); }
#undef PG8_SA
#undef PG8_SB
#undef PG8_STAGE
#undef PG8_LDA
#undef PG8_LDB
#undef PG8_MMA
#undef PG8_WAIT_V
#undef PG8_WAIT_L
#undef PG8_BAR
#undef PG8_SCHED
}
}
#ifndef PG8_SP2
#define PG8_SP2 true
#endif
#ifndef PG8_ALIGN
#define PG8_ALIGN true
#endif
#include <hip/hip_bf16.h>
#include <cmath>
namespace attn_body {
using bf16=__hip_bfloat16;
using bf16x8=__attribute__((ext_vector_type(8)))short;
using s16x4=__attribute__((ext_vector_type(4)))short;
using f32x16=__attribute__((ext_vector_type(16)))float;
using u32x4=__attribute__((ext_vector_type(4)))unsigned;
constexpr int BATCH=2,SEQ=8192,D=64,DM=4352;
constexpr int NW=8,QBLK=32,QB=QBLK*NW,KVBLK=64,NQB=SEQ/QB;
constexpr int ATTN_PITCH=DM, ATTN_UNIT_ROWS=QB;
__device__ __forceinline__ int crow(int r,int hi){return (r&3)+8*(r>>2)+4*hi;}
#define SBAR() __builtin_amdgcn_sched_barrier(0)
__device__ __forceinline__ void cmask(f32x16&p0,f32x16&p1,int jb,int qrel,int hi){
  const float NEG=-INFINITY; int kb=64*jb+4*hi;
  #pragma unroll
  for(int r=0;r<16;++r){int kv=kb+(r&3)+8*(r>>2); if(kv>qrel)p0[r]=NEG; if(kv+32>qrel)p1[r]=NEG;}
}

constexpr int NSLOT=3, SLOTB=8192; typedef float f32x4v __attribute__((ext_vector_type(4))); constexpr int LDS_BIAS=86016;
constexpr int LDS_K=0, LDS_V=NSLOT*SLOTB, LDS_WS=2*NSLOT*SLOTB, LDS_OST=LDS_WS+NW*64*4, LDS_BYTES=LDS_OST+NW*4096;
constexpr float C2=0.125f*1.4426950408889634f;
__device__ __forceinline__ void glds16(const void*gsrc,unsigned lds_dst){unsigned keep;
  asm volatile("s_mov_b32 %0, m0\n\ts_mov_b32 m0, %2\n\ts_nop 0\n\tglobal_load_lds_dwordx4 %1, off\n\ts_mov_b32 m0, %0":"=&s"(keep):"v"(gsrc),"s"(lds_dst):"memory");}
__device__ __forceinline__ float max3f(float a,float b,float c){float r;asm("v_max3_f32 %0, %1, %2, %3":"=v"(r):"v"(a),"v"(b),"v"(c));return r;}
__device__ __forceinline__ float max2f(float a,float b){float r;asm("v_max_f32_e32 %0, %1, %2":"=v"(r):"v"(a),"v"(b));return r;}
__device__ __forceinline__ float fadd_s(float a,float b){float r;asm("v_add_f32_e32 %0, %1, %2":"=v"(r):"v"(a),"v"(b));return r;}
__device__ __forceinline__ float fsub_s(float a,float b){float r;asm("v_sub_f32_e32 %0, %1, %2":"=v"(r):"v"(a),"v"(b));return r;}
typedef float f32x2_t __attribute__((ext_vector_type(2))); typedef __bf16 bf16x2_t __attribute__((ext_vector_type(2)));
__device__ __forceinline__ unsigned cvtpk_s(float lo,float hi){f32x2_t v={lo,hi};bf16x2_t b=__builtin_convertvector(v,bf16x2_t);return __builtin_bit_cast(unsigned,b);}
#define WAIT_BAR(N) asm volatile("s_waitcnt vmcnt(" #N ") lgkmcnt(0)\n\ts_barrier":::"memory")

__device__ __forceinline__ void qkt(f32x16&p0,f32x16&p1,const char*Kslot,const bf16x8*qr,const f32x16&negm,int r32,int hi){
  const char*kb=Kslot+hi*1024+r32*16;
  #pragma unroll
  for(int d0=0;d0<4;++d0){
    const bf16x8 b0=*reinterpret_cast<const bf16x8*>(kb+d0*2048);
    const bf16x8 b1=*reinterpret_cast<const bf16x8*>(kb+d0*2048+512);
    if(d0==0){p0=__builtin_amdgcn_mfma_f32_32x32x16_bf16(b0,qr[0],negm,0,0,0);p1=__builtin_amdgcn_mfma_f32_32x32x16_bf16(b1,qr[0],negm,0,0,0);}
    else{p0=__builtin_amdgcn_mfma_f32_32x32x16_bf16(b0,qr[d0],p0,0,0,0);p1=__builtin_amdgcn_mfma_f32_32x32x16_bf16(b1,qr[d0],p1,0,0,0);}}
}
typedef __attribute__((address_space(3))) const char* lds_cptr;
typedef short v4i16_t __attribute__((ext_vector_type(4)));
__device__ __forceinline__ void kload8(bf16x8*kf,lds_cptr kp){
  kf[0]=*(const __attribute__((address_space(3))) bf16x8*)(kp);      kf[1]=*(const __attribute__((address_space(3))) bf16x8*)(kp+512);
  kf[2]=*(const __attribute__((address_space(3))) bf16x8*)(kp+2048); kf[3]=*(const __attribute__((address_space(3))) bf16x8*)(kp+2560);
  kf[4]=*(const __attribute__((address_space(3))) bf16x8*)(kp+4096); kf[5]=*(const __attribute__((address_space(3))) bf16x8*)(kp+4608);
  kf[6]=*(const __attribute__((address_space(3))) bf16x8*)(kp+6144); kf[7]=*(const __attribute__((address_space(3))) bf16x8*)(kp+6656);
}
__device__ __forceinline__ void kload2(bf16x8*kf,lds_cptr kp,int j){ kf[2*j]=*(const __attribute__((address_space(3))) bf16x8*)(kp+j*2048); kf[2*j+1]=*(const __attribute__((address_space(3))) bf16x8*)(kp+j*2048+512); }
__device__ __forceinline__ s16x4 vtr(lds_cptr p){ return __builtin_bit_cast(s16x4,__builtin_amdgcn_ds_read_tr16_b64_v4i16((__attribute__((address_space(3))) v4i16_t*)p)); }
__device__ __forceinline__ float rowmax(const f32x16&p0,const f32x16&p1){
  float a=max3f(p0[0],p0[1],p1[0]),b=max3f(p0[2],p0[3],p1[1]);a=max3f(a,p1[2],p1[3]);
  #pragma unroll
  for(int r=4;r<16;r+=4){a=max3f(a,p0[r],p0[r+1]);b=max3f(b,p0[r+2],p0[r+3]);a=max3f(a,p1[r],p1[r+1]);b=max3f(b,p1[r+2],p1[r+3]);}
  const float m=max2f(a,b);
  auto rr=__builtin_amdgcn_permlane32_swap(__float_as_uint(m),__float_as_uint(m),false,false);
  return max2f(__uint_as_float(rr[0]),__uint_as_float(rr[1]));
}
__device__ __forceinline__ void pv(f32x16*o,int vb,bf16x8 pa0,bf16x8 pa1,bf16x8 pa2,bf16x8 pa3){
  #pragma unroll
  for(int d0=0;d0<2;++d0){s16x4 lo[4],hi[4];
    #pragma unroll
    for(int ks=0;ks<4;++ks){
      asm volatile("ds_read_b64_tr_b16 %0,%1 offset:%c2":"=&v"(lo[ks]):"v"(vb),"i"(d0*4096+ks*1024):"memory");
      asm volatile("ds_read_b64_tr_b16 %0,%1 offset:%c2":"=&v"(hi[ks]):"v"(vb),"i"(d0*4096+ks*1024+512):"memory");}
    asm volatile("s_waitcnt lgkmcnt(0)":::"memory");SBAR();
    #define PK(k) (bf16x8){lo[k][0],lo[k][1],lo[k][2],lo[k][3],hi[k][0],hi[k][1],hi[k][2],hi[k][3]}
    o[d0]=__builtin_amdgcn_mfma_f32_32x32x16_bf16(pa0,PK(0),o[d0],0,0,0);
    o[d0]=__builtin_amdgcn_mfma_f32_32x32x16_bf16(pa1,PK(1),o[d0],0,0,0);
    o[d0]=__builtin_amdgcn_mfma_f32_32x32x16_bf16(pa2,PK(2),o[d0],0,0,0);
    o[d0]=__builtin_amdgcn_mfma_f32_32x32x16_bf16(pa3,PK(3),o[d0],0,0,0);
    #undef PK
  }
}

#ifndef ATTN_STORE16
#define ATTN_STORE16(p,v) (*(u32x4*)(p)=(v))
#endif
template<int THRL> __device__ __forceinline__ void attn_unit(const int wave_s,int qb,const bf16*Qh,const bf16*__restrict__ Kh,const bf16*__restrict__ Vh,bf16*Oh,const float*__restrict__ cbias,char*shm){
  const int wid=wave_s; const int tid=wave_s*64+fresh_lane(),lane=tid&63,r32=lane&31,hi=lane>>5;
  const int q0=qb*QB;
  const bf16*Qw=Qh+(long)(q0+wid*QBLK)*DM;
  const unsigned lds0=(unsigned)(uintptr_t)shm;
  float*wsf=(float*)(shm+LDS_WS)+wid*64;
  const bf16*ksrc=Kh+(long)lane*DM+wid*8;
  const bf16*vsrc=Vh+(long)(16*(wid&3)+(lane>>2))*DM+(wid>>2)*32+(lane&3)*8;
  const unsigned kdst=lds0+LDS_K+wid*1024, vdst=lds0+LDS_V+wid*1024;
  #define DMA_K(t,slot) glds16(ksrc+(long)(t)*KVBLK*DM,(unsigned)__builtin_amdgcn_readfirstlane(kdst+(slot)))
  #define DMA_V(t,slot) glds16(vsrc+(long)(t)*KVBLK*DM,(unsigned)__builtin_amdgcn_readfirstlane(vdst+(slot)))
  const int vb0=(int)(lds0+LDS_V)+((lane>>4)&1)*32+(lane&3)*8+(4*hi+((lane&15)>>2))*64;
  const char*Kbase=shm+LDS_K; bf16x8 kf[8];
  const lds_cptr shm3=(lds_cptr)shm; const lds_cptr kp0=shm3+LDS_K+hi*1024+r32*16; const lds_cptr vp0=shm3+LDS_V+((lane>>4)&1)*32+(lane&3)*8+(4*hi+((lane&15)>>2))*64;
  { const int nk4=(q0+QB)>>2; __attribute__((address_space(3))) f32x4v* bt=(__attribute__((address_space(3))) f32x4v*)((lds_cptr)shm+LDS_BIAS); for(int i=tid;i<nk4;i+=NW*64) bt[i]=((const f32x4v*)cbias)[i]; }
  const int NT=(q0+QB)/KVBLK;
  DMA_K(0,0);DMA_V(0,0);DMA_K(1,SLOTB);
  bf16x8 qr[4];
  #pragma unroll
  for(int d0=0;d0<4;++d0)qr[d0]=*reinterpret_cast<const bf16x8*>(&Qw[(long)r32*DM+d0*16+hi*8]);
  float mhat=0.f,l_reg=0.f;float zf_=0.f;asm volatile("":"+v"(zf_));f32x16 o[2];f32x16 negm;
  _Pragma("unroll") for(int r=0;r<16;++r){o[0][r]=zf_;o[1][r]=zf_;negm[r]=zf_;} asm volatile("":"+v"(negm));
  const int qrel=wid*QBLK+r32;
  #define CMASK(P0,P1,t) do{int jb_=(t)-(NT-4); if(jb_>=0)cmask(P0,P1,jb_,qrel,hi);}while(0)
  #define BIAS(P0,P1,t) do{ const __attribute__((address_space(3))) f32x4v* bt_=(const __attribute__((address_space(3))) f32x4v*)(shm3+LDS_BIAS)+(t)*16+hi; \
    _Pragma("unroll") for(int i_=0;i_<4;++i_){ const f32x4v b0_=bt_[2*i_], b1_=bt_[8+2*i_]; \
      P0[4*i_]+=b0_[0];P0[4*i_+1]+=b0_[1];P0[4*i_+2]+=b0_[2];P0[4*i_+3]+=b0_[3]; P1[4*i_]+=b1_[0];P1[4*i_+1]+=b1_[1];P1[4*i_+2]+=b1_[2];P1[4*i_+3]+=b1_[3]; } }while(0)
  bool resc=false;
  #define START(P0,P1) do{ const float rm=rowmax(P0,P1); resc=false; \
    { const float dl=rm; mhat=fadd_s(mhat,dl); \
      _Pragma("unroll") for(int r=0;r<16;++r){P0[r]=fsub_s(P0[r],dl);P1[r]=fsub_s(P1[r],dl);} \
      _Pragma("unroll") for(int r=0;r<16;++r)negm[r]=-mhat; asm volatile("":"+v"(negm)); } \
    _Pragma("unroll") for(int r=0;r<16;++r)P0[r]=__builtin_amdgcn_exp2f(P0[r]); }while(0)
  #define RESC() do{ if(resc){ asm volatile("s_waitcnt lgkmcnt(0)":::"memory"); \
      _Pragma("unroll") for(int d_=0;d_<2;++d_) _Pragma("unroll") for(int r=0;r<16;++r)o[d_][r]*=wsf[crow(r,hi)]; } }while(0)
  f32x16 pA0,pA1,pB0,pB1;
  int sl_prev=0,sl_cur=0,sl_next=SLOTB;
  #define ROT() do{sl_prev=sl_cur;sl_cur=sl_next;sl_next=(sl_next==(NSLOT-1)*SLOTB)?0:sl_next+SLOTB;}while(0)
  DMA_K(2,2*SLOTB);
  WAIT_BAR(3);
  qkt(pA0,pA1,Kbase,qr,negm,r32,hi);asm volatile("s_nop 15\n\ts_nop 7":"+v"(pA0),"+v"(pA1));BIAS(pA0,pA1,0);CMASK(pA0,pA1,0);
  START(pA0,pA1);
  _Pragma("unroll") for(int r=0;r<16;++r)pA1[r]=__builtin_amdgcn_exp2f(pA1[r]);
  WAIT_BAR(0);
  DMA_K(3,0);DMA_V(1,SLOTB);
  ROT();
  kload8(kf,kp0+sl_cur);
  WAIT_BAR(2);
  s16x4 vlo[8],vhi[8]; u32x4 pw0,pw1,pw2,pw3;
  #define PKW(P,B) cvtpk_s(P[B],P[B+1])
  #define PAF(k) __builtin_bit_cast(bf16x8,pw##k)
  #define VFR(i) (bf16x8){vlo[i][0],vlo[i][1],vlo[i][2],vlo[i][3],vhi[i][0],vhi[i][1],vhi[i][2],vhi[i][3]}
  #define PIN(x) asm volatile("":"+v"(x))
  #define MX3(a,b,c) __builtin_fmaxf(__builtin_fmaxf((a),(b)),(c))
  #define GAPA(MF,A0,A1,A2,A3,W0,W1,PW) do{ MF; sacc+=A0; sacc+=A1; sacc+=A2; sacc+=A3; PIN(sacc); W0; W1; PIN(PW); SBAR(); }while(0)
  #define EX(v) __builtin_amdgcn_exp2f(v)
  #define GAPB(MF,X,B) do{ MF; X[B]=EX(X[B]); X[B+1]=EX(X[B+1]); X[B+2]=EX(X[B+2]); X[B+3]=EX(X[B+3]); PIN(X); SBAR(); }while(0)
  #define VRD(i) do{ vlo[i]=vtr(vp_+(((i)>>2)*4096+((i)&3)*1024)); vhi[i]=vtr(vp_+(((i)>>2)*4096+((i)&3)*1024+512)); }while(0)
  #define KRD(G,j) do{ if(G){ kload2(kf,kp0+sl_next,j); SBAR(); } }while(0)
  #define STEP(C0,C1,P0,P1,t,GK,GV,GL) do{ SBAR(); \
    const lds_cptr vp_=vp0+sl_prev; \
    VRD(0); SBAR(); float sacc=(P0[0]+P0[1]); \
    GAPA(C0=__builtin_amdgcn_mfma_f32_32x32x16_bf16(kf[0],qr[0],negm,0,0,0), P0[2],P0[3],P0[4],P0[5],     pw0[0]=PKW(P0,0), pw0[1]=PKW(P0,2), pw0); \
    VRD(4); SBAR(); GAPA(C1=__builtin_amdgcn_mfma_f32_32x32x16_bf16(kf[1],qr[0],negm,0,0,0), P0[6],P0[7],P0[8],P0[9],     pw0[2]=PKW(P0,4), pw0[3]=PKW(P0,6), pw0); \
    VRD(1); SBAR(); GAPA(C0=__builtin_amdgcn_mfma_f32_32x32x16_bf16(kf[2],qr[1],C0,0,0,0),   P0[10],P0[11],P0[12],P0[13], pw1[0]=PKW(P0,8), pw1[1]=PKW(P0,10), pw1); \
    VRD(5); SBAR(); GAPA(C1=__builtin_amdgcn_mfma_f32_32x32x16_bf16(kf[3],qr[1],C1,0,0,0),   P0[14],P0[15],P1[0],P1[1],   pw1[2]=PKW(P0,12),pw1[3]=PKW(P0,14), pw1); \
    VRD(2); SBAR(); GAPA(C0=__builtin_amdgcn_mfma_f32_32x32x16_bf16(kf[4],qr[2],C0,0,0,0),   P1[2],P1[3],P1[4],P1[5],     pw2[0]=PKW(P1,0), pw2[1]=PKW(P1,2), pw2); \
    VRD(6); SBAR(); GAPA(C1=__builtin_amdgcn_mfma_f32_32x32x16_bf16(kf[5],qr[2],C1,0,0,0),   P1[6],P1[7],P1[8],P1[9],     pw2[2]=PKW(P1,4), pw2[3]=PKW(P1,6), pw2); \
    VRD(3); SBAR(); GAPA(C0=__builtin_amdgcn_mfma_f32_32x32x16_bf16(kf[6],qr[3],C0,0,0,0),   P1[10],P1[11],P1[12],P1[13], pw3[0]=PKW(P1,8), pw3[1]=PKW(P1,10), pw3); \
    VRD(7); SBAR(); GAPA(C1=__builtin_amdgcn_mfma_f32_32x32x16_bf16(kf[7],qr[3],C1,0,0,0),   P1[14],P1[15],0.f,0.f,       pw3[2]=PKW(P1,12),pw3[3]=PKW(P1,14), pw3); \
    l_reg+=sacc; \
    if(GK){DMA_K((t)+3,sl_cur);} if(GV){DMA_V((t)+1,sl_next);} \
    BIAS(C0,C1,t); CMASK(C0,C1,t); \
    { float a=MX3(C0[0],C0[1],C1[0]),b=MX3(C0[2],C0[3],C1[1]); a=MX3(a,C1[2],C1[3]); \
      _Pragma("unroll") for(int r=4;r<16;r+=4){a=MX3(a,C0[r],C0[r+1]);b=MX3(b,C0[r+2],C0[r+3]);a=MX3(a,C1[r],C1[r+1]);b=MX3(b,C1[r+2],C1[r+3]);} \
      float rm=__builtin_fmaxf(a,b); { auto rr=__builtin_amdgcn_permlane32_swap(__float_as_uint(rm),__float_as_uint(rm),false,false); rm=__builtin_fmaxf(__uint_as_float(rr[0]),__uint_as_float(rr[1])); } \
      resc=false; \
      if(__builtin_expect(__any(rm>(float)THRL),0)){ const float dl=__builtin_fmaxf(rm,0.f); mhat+=dl; \
        _Pragma("unroll") for(int r=0;r<16;++r){C0[r]-=dl;C1[r]-=dl;} \
        _Pragma("unroll") for(int r=0;r<16;++r)negm[r]=-mhat; asm volatile("":"+v"(negm)); \
        const float f=__builtin_amdgcn_exp2f(-dl); l_reg*=f; if(hi==0)wsf[r32]=f; resc=true; } } \
    SBAR(); \
    GAPB(o[0]=__builtin_amdgcn_mfma_f32_32x32x16_bf16(PAF(0),VFR(0),o[0],0,0,0), C0,0); \
    GAPB(o[1]=__builtin_amdgcn_mfma_f32_32x32x16_bf16(PAF(0),VFR(4),o[1],0,0,0), C0,4); \
    KRD(GL,0); GAPB(o[0]=__builtin_amdgcn_mfma_f32_32x32x16_bf16(PAF(1),VFR(1),o[0],0,0,0), C0,8); \
    KRD(GL,1); GAPB(o[1]=__builtin_amdgcn_mfma_f32_32x32x16_bf16(PAF(1),VFR(5),o[1],0,0,0), C0,12); \
    KRD(GL,2); GAPB(o[0]=__builtin_amdgcn_mfma_f32_32x32x16_bf16(PAF(2),VFR(2),o[0],0,0,0), C1,0); \
    KRD(GL,3); GAPB(o[1]=__builtin_amdgcn_mfma_f32_32x32x16_bf16(PAF(2),VFR(6),o[1],0,0,0), C1,4); \
    GAPB(o[0]=__builtin_amdgcn_mfma_f32_32x32x16_bf16(PAF(3),VFR(3),o[0],0,0,0), C1,8); \
    GAPB(o[1]=__builtin_amdgcn_mfma_f32_32x32x16_bf16(PAF(3),VFR(7),o[1],0,0,0), C1,12); \
    }while(0)
  int t=1;
  #undef CMASK
  #define CMASK(P0,P1,t) do{}while(0)
  for(;t+5<NT;t+=2){
    STEP(pB0,pB1,pA0,pA1,t,true,true,true);     WAIT_BAR(2); RESC(); ROT();
    STEP(pA0,pA1,pB0,pB1,t+1,true,true,true);   WAIT_BAR(2); RESC(); ROT();
  }
  #undef CMASK
  #define CMASK(P0,P1,t) do{int jb_=(t)-(NT-4); if(jb_>=0)cmask(P0,P1,jb_,qrel,hi);}while(0)
  #define ENDW(tt) do{ if((tt)+3<NT){WAIT_BAR(2);} else if((tt)+2<NT){WAIT_BAR(1);} else {WAIT_BAR(0);} }while(0)
  for(;t+1<NT;t+=2){
    STEP(pB0,pB1,pA0,pA1,t,(t+3<NT),(t+1<NT),(t+1<NT));       ENDW(t);   RESC(); ROT();
    STEP(pA0,pA1,pB0,pB1,t+1,(t+4<NT),(t+2<NT),(t+2<NT));     ENDW(t+1); RESC(); ROT();
  }
  STEP(pB0,pB1,pA0,pA1,NT-1,false,false,false); RESC();
  { float sacc=pB0[0]+pB0[1]; _Pragma("unroll") for(int r=2;r<16;++r)sacc+=pB0[r]; _Pragma("unroll") for(int r=0;r<16;++r)sacc+=pB1[r]; l_reg+=sacc;
    pw0=(u32x4){PKW(pB0,0),PKW(pB0,2),PKW(pB0,4),PKW(pB0,6)};pw1=(u32x4){PKW(pB0,8),PKW(pB0,10),PKW(pB0,12),PKW(pB0,14)};pw2=(u32x4){PKW(pB1,0),PKW(pB1,2),PKW(pB1,4),PKW(pB1,6)};pw3=(u32x4){PKW(pB1,8),PKW(pB1,10),PKW(pB1,12),PKW(pB1,14)};
    SBAR(); pv(o,vb0+sl_cur,PAF(0),PAF(1),PAF(2),PAF(3)); }
  #undef PKW
  #undef PAF
  #undef VFR
  #undef PIN
  #undef MX3
  #undef GAPA
  #undef GAPB
  #undef EX
  #undef VRD
  #undef KRD
  #undef STEP
  #undef ENDW
  {auto rr=__builtin_amdgcn_permlane32_swap(__float_as_uint(l_reg),__float_as_uint(l_reg),false,false);l_reg=__uint_as_float(rr[0])+__uint_as_float(rr[1]);}
  if(hi==0)wsf[32+r32]=l_reg;asm volatile("s_waitcnt lgkmcnt(0)":::"memory");
  float rli[16];
  #pragma unroll
  for(int r=0;r<16;++r)rli[r]=__builtin_amdgcn_rcpf(wsf[32+crow(r,hi)]);
  bf16*Ow=Oh+(long)(q0+wid*QBLK)*DM;
  { bf16*stg=(bf16*)(shm+LDS_OST)+wid*2048;
    #pragma unroll
    for(int r=0;r<16;++r){const int orow=crow(r,hi);
      #pragma unroll
      for(int d0=0;d0<2;++d0)stg[orow*64+d0*32+r32]=__float2bfloat16(o[d0][r]*rli[r]);}
    asm volatile("s_waitcnt lgkmcnt(0)":::"memory");
    #pragma unroll
    for(int i=0;i<4;++i){const int row=i*8+(lane>>3),ch=lane&7; const u32x4 v=*(const u32x4*)(stg+row*64+ch*8); ATTN_STORE16(Ow+(long)row*DM+ch*8,v);} }
  asm volatile("s_waitcnt lgkmcnt(0)\n\ts_barrier":::"memory");
  #undef DMA_K
  #undef DMA_V
  #undef CMASK
  #undef START
  #undef RESC
  #undef ROT
  #undef BIAS
}
constexpr int ATTN_LDS_BYTES=LDS_BYTES;
constexpr int SWA_K=0, SWA_V=6*SLOTB, SWA_OST=12*SLOTB, SWA_WS=133120;
__device__ __forceinline__ void swa_unit(const int wave_s,int qb,const bf16*Qh,const bf16*__restrict__ Kh,const bf16*__restrict__ Vh,bf16*Oh,float slope2,float sink2,char*shm){
  const int wid=wave_s; const int tid=wave_s*64+fresh_lane(),lane=tid&63,r32=lane&31,hi=lane>>5;
  const int q0=qb*QB, c0=4*qb-2;
  const bf16*Qw=Qh+(long)(q0+wid*QBLK)*DM;
  const unsigned lds0=(unsigned)(uintptr_t)shm;
  float*wsf=(float*)(shm+SWA_WS)+wid*64;
  const bf16*ksrc=Kh+(long)lane*DM+wid*8;
  const bf16*vsrc=Vh+(long)(16*(wid&3)+(lane>>2))*DM+(wid>>2)*32+(lane&3)*8;
  const unsigned kdst=lds0+SWA_K+wid*1024, vdst=lds0+SWA_V+wid*1024;
  #pragma unroll
  for(int s=0;s<6;++s){ const int ch=c0+s; if(ch>=0){ glds16(ksrc+(long)ch*KVBLK*DM,(unsigned)__builtin_amdgcn_readfirstlane(kdst+s*SLOTB)); glds16(vsrc+(long)ch*KVBLK*DM,(unsigned)__builtin_amdgcn_readfirstlane(vdst+s*SLOTB)); } }
  bf16x8 qr[4];
  #pragma unroll
  for(int d0=0;d0<4;++d0)qr[d0]=*reinterpret_cast<const bf16x8*>(&Qw[(long)r32*DM+d0*16+hi*8]);
  WAIT_BAR(0);
  const int wc=wid>>1, qrel=(wid&1)*32+r32;
  f32x16 zero=f32x16{}; asm volatile("":"+v"(zero));
  f32x16 S[3][2];
  #pragma unroll
  for(int t=0;t<3;++t){
    if(c0+wc+t>=0){
      qkt(S[t][0],S[t][1],shm+SWA_K+(wc+t)*SLOTB,qr,zero,r32,hi);
      const float qf=(float)(64*(2-t)+qrel-4*hi);
      #pragma unroll
      for(int r=0;r<16;++r){ const float dd=qf-(float)((r&3)+8*(r>>2)); S[t][0][r]=__builtin_fmaf(-slope2,__builtin_fabsf(dd),S[t][0][r]); S[t][1][r]=__builtin_fmaf(-slope2,__builtin_fabsf(dd-32.f),S[t][1][r]); }
    } else {
      #pragma unroll
      for(int r=0;r<16;++r){ S[t][0][r]=-INFINITY; S[t][1][r]=-INFINITY; }
    }
  }
  float m=sink2;
  #pragma unroll
  for(int t=0;t<3;++t) m=__builtin_fmaxf(m,rowmax(S[t][0],S[t][1]));
  float l=0.f;
  #pragma unroll
  for(int t=0;t<3;++t){
    #pragma unroll
    for(int r=0;r<16;++r){ S[t][0][r]=__builtin_amdgcn_exp2f(S[t][0][r]-m); S[t][1][r]=__builtin_amdgcn_exp2f(S[t][1][r]-m); l+=S[t][0][r]+S[t][1][r]; }
  }
  {auto rr=__builtin_amdgcn_permlane32_swap(__float_as_uint(l),__float_as_uint(l),false,false);l=__uint_as_float(rr[0])+__uint_as_float(rr[1]);}
  l+=__builtin_amdgcn_exp2f(sink2-m);
  f32x16 o[2];o[0]=f32x16{};o[1]=f32x16{};
  const int vb0=(int)(lds0+SWA_V)+((lane>>4)&1)*32+(lane&3)*8+(4*hi+((lane&15)>>2))*64;
  #pragma unroll
  for(int t=0;t<3;++t){
    if(c0+wc+t>=0){
      #define PKW(P,B) cvtpk_s(P[B],P[B+1])
      const u32x4 pw0=(u32x4){PKW(S[t][0],0),PKW(S[t][0],2),PKW(S[t][0],4),PKW(S[t][0],6)},pw1=(u32x4){PKW(S[t][0],8),PKW(S[t][0],10),PKW(S[t][0],12),PKW(S[t][0],14)};
      const u32x4 pw2=(u32x4){PKW(S[t][1],0),PKW(S[t][1],2),PKW(S[t][1],4),PKW(S[t][1],6)},pw3=(u32x4){PKW(S[t][1],8),PKW(S[t][1],10),PKW(S[t][1],12),PKW(S[t][1],14)};
      #undef PKW
      SBAR(); pv(o,vb0+(wc+t)*SLOTB,__builtin_bit_cast(bf16x8,pw0),__builtin_bit_cast(bf16x8,pw1),__builtin_bit_cast(bf16x8,pw2),__builtin_bit_cast(bf16x8,pw3));
    }
  }
  if(hi==0)wsf[32+r32]=l;asm volatile("s_waitcnt lgkmcnt(0)":::"memory");
  float rli[16];
  #pragma unroll
  for(int r=0;r<16;++r)rli[r]=__builtin_amdgcn_rcpf(wsf[32+crow(r,hi)]);
  bf16*Ow=Oh+(long)(q0+wid*QBLK)*DM;
  { bf16*stg=(bf16*)(shm+SWA_OST)+wid*2048;
    #pragma unroll
    for(int r=0;r<16;++r){const int orow=crow(r,hi);
      #pragma unroll
      for(int d0=0;d0<2;++d0)stg[orow*64+d0*32+r32]=__float2bfloat16(o[d0][r]*rli[r]);}
    asm volatile("s_waitcnt lgkmcnt(0)":::"memory");
    #pragma unroll
    for(int i=0;i<4;++i){const int row=i*8+(lane>>3),ch=lane&7; const u32x4 v=*(const u32x4*)(stg+row*64+ch*8); ATTN_STORE16(Ow+(long)row*DM+ch*8,v);} }
  asm volatile("s_waitcnt lgkmcnt(0)\n\ts_barrier":::"memory");
}

#undef SBAR
#undef WAIT_BAR
}

namespace cg = cooperative_groups;
constexpr int NWAVES = 8;
constexpr int BATCH = 2, T = 8192, D = 1024, FF = 4096, PLE = 256, DIN_SRC = 4360, NZ = 4352, M = BATCH * T;
constexpr float RMS_EPS = 1e-6f, LOG2E = 1.4426950408889634f;
constexpr size_t MiB = 1u << 20;
constexpr size_t WS_WIN = 0, WS_WA = 9 * MiB, WS_WB = 10 * MiB, WS_WMIX = 11 * MiB, WS_W1 = 13 * MiB, WS_W2 = 21 * MiB, WS_WG = 29 * MiB, WS_WP = 31 * MiB;
constexpr size_t WS_LF = 31 * MiB + 512 * 1024, WS_CB = 32 * MiB;
constexpr size_t WS_ST1 = 33 * MiB, WS_ST2 = 34 * MiB, WS_ST3 = 35 * MiB;
constexpr size_t WS_PB = 36 * MiB;
constexpr size_t WS_XN = 44 * MiB;
constexpr size_t WS_HN = 76 * MiB;
constexpr size_t WS_Z = 108 * MiB;
constexpr size_t WS_CTL = 244 * MiB, CTL_ZERO_BYTES = 16384;
constexpr size_t WS_END = 245 * MiB;
constexpr int RING_BYTES = 131072, LDS_BYTES = 147456, MISC_OFF = RING_BYTES + 320;
#define GAS __attribute__((address_space(1)))
#define LAS __attribute__((address_space(3)))
typedef unsigned short bf16;
typedef unsigned v4u __attribute__((ext_vector_type(4)));
typedef unsigned v2u __attribute__((ext_vector_type(2)));
typedef float f32x4 __attribute__((ext_vector_type(4)));
#define LDS_WAIT() asm volatile("s_waitcnt lgkmcnt(0)" ::: "memory")
__device__ __forceinline__ unsigned f2bf(float f) { unsigned u = __builtin_bit_cast(unsigned, f); return (u + 0x7fffu + ((u >> 16) & 1u)) >> 16; }
__device__ __forceinline__ unsigned pk2(float lo, float hi) { return f2bf(lo) | (f2bf(hi) << 16); }
__device__ __forceinline__ float wave_sum(float v) {
#pragma unroll
    for (int o = 1; o < 64; o <<= 1) v += __shfl_xor(v, o);
    return v;
}
#define RLX_AGENT __ATOMIC_RELAXED, __HIP_MEMORY_SCOPE_AGENT
#define XB_TMO      128
#define XB_XCNT(j)  (256  + 64 * (j))
#define XB_XSUB(j)  (1280 + 64 * (j))
#define XB_XGEN(j)  (2304 + 64 * (j))
#define XB_TOP      3328
#define XB_TOPGEN   3392
#define XCD_BAR_WORDS 3456
#define XB_SPIN_CAP (1u << 18)

__device__ __forceinline__ unsigned xb_ld(unsigned* p)              { return __hip_atomic_load(p, __ATOMIC_RELAXED, __HIP_MEMORY_SCOPE_AGENT); }
__device__ __forceinline__ unsigned xb_add(unsigned* p, unsigned v) { return __hip_atomic_fetch_add(p, v, __ATOMIC_RELAXED, __HIP_MEMORY_SCOPE_AGENT); }
__device__ __forceinline__ unsigned xb_xcc_id() { return (unsigned)__builtin_amdgcn_s_getreg((3 << 11) | 20) & 0xFu; }
#define XB_SPIN(cond, bar) do { unsigned _sp = 0; while (cond) { __builtin_amdgcn_s_sleep(1); \
    if ((++_sp & 255u) == 0u) { if (xb_ld(&(bar)[XB_TMO])) break; if (_sp > XB_SPIN_CAP) { atomicAdd(&(bar)[XB_TMO], 1u); break; } } } } while (0)

struct XcdBarrier {
    unsigned* bar; unsigned x;
    volatile LAS unsigned* st;
};

__device__ __forceinline__ XcdBarrier xcd_barrier_post(unsigned* bar, volatile LAS unsigned* st) {
    XcdBarrier b; b.bar = bar; b.x = xb_xcc_id(); b.st = st;
    if (threadIdx.x == 0) (void)xb_add(&bar[XB_XCNT(b.x)], 1u);
    return b;
}
__device__ __forceinline__ void xcd_barrier_complete(unsigned* bar, unsigned x, unsigned& nloc, unsigned& nx) {
    const unsigned G = gridDim.x * gridDim.y * gridDim.z;
    unsigned sum, cnt, mine, sp = 0u;
    for (;;) {
        sum = 0u; cnt = 0u; mine = 0u;
#pragma unroll
        for (unsigned j = 0; j < 16; ++j) { const unsigned c = xb_ld(&bar[XB_XCNT(j)]); sum += c; cnt += (c > 0u) ? 1u : 0u; mine = (j == x) ? c : mine; }
        if (sum == G) break;
        __builtin_amdgcn_s_sleep(1);
        if ((++sp & 255u) == 0u) { if (xb_ld(&bar[XB_TMO])) break; if (sp > XB_SPIN_CAP) { atomicAdd(&bar[XB_TMO], 1u); break; } }
    }
    nloc = mine > 0u ? mine : 1u; nx = cnt > 0u ? cnt : 1u;
}

__device__ __forceinline__ void xcd_barrier(const XcdBarrier& b, const bool t0) {
    asm volatile("s_waitcnt vmcnt(0)" ::: "memory");
    __syncthreads();
    if (t0) {
        unsigned* bar = b.bar;
        __builtin_amdgcn_s_waitcnt(0);
        unsigned nloc = b.st[0], nx = b.st[1];
        if (nloc == 0u) { xcd_barrier_complete(bar, b.x, nloc, nx); b.st[0] = nloc; b.st[1] = nx; }
        const unsigned old = xb_add(&bar[XB_XSUB(b.x)], 1u);
        const unsigned gen = old / nloc;
        if (old + 1u == (gen + 1u) * nloc) {
            __builtin_amdgcn_fence(__ATOMIC_RELEASE, "agent");
            asm volatile("s_waitcnt vmcnt(0)" ::: "memory");
            const unsigned og = xb_add(&bar[XB_TOP], 1u);
            const unsigned tg = og / nx;
            if (og + 1u == (tg + 1u) * nx) xb_add(&bar[XB_TOPGEN], 1u);
            else XB_SPIN(xb_ld(&bar[XB_TOPGEN]) == tg, bar);
            __builtin_amdgcn_fence(__ATOMIC_ACQUIRE, "agent");
            xb_add(&bar[XB_XGEN(b.x)], 1u);
            asm volatile("s_waitcnt vmcnt(0)" ::: "memory");
        } else {
            XB_SPIN(xb_ld(&bar[XB_XGEN(b.x)]) == gen, bar);
            __builtin_amdgcn_fence(__ATOMIC_ACQUIRE, "agent");
            asm volatile("s_waitcnt vmcnt(0)" ::: "memory");
        }
    }
    __syncthreads();
}
struct Frame {
    LAS unsigned char* lds; int wave, vcu, G;
};
__device__ __forceinline__ void p0_transpose_item(const float* W, int ldw, int K, int N, int split, int extra, const float* gs, bf16* WT, LAS float* scr, int item, int lane) {
    const int nblk = N / 32, kb = item / nblk, nb = item % nblk, k0 = 64 * kb, n0 = 32 * nb, s0 = n0 + (n0 >= split ? extra : 0);
    const float* src = W + (size_t)(k0 + (lane >> 5)) * ldw + s0 + (lane & 31);
    float w[32];
#pragma unroll
    for (int i = 0; i < 32; ++i) w[i] = src[(size_t)(2 * i) * ldw];
    const int c = lane & 7;
    f32x4 g0 = (f32x4){1.f, 1.f, 1.f, 1.f}, g1 = g0;
    if (gs) { g0 = *(const f32x4*)(gs + k0 + 8 * c); g1 = *(const f32x4*)(gs + k0 + 8 * c + 4); }
#pragma unroll
    for (int i = 0; i < 32; ++i) scr[(2 * i + (lane >> 5)) * 33 + (lane & 31)] = w[i];
    LDS_WAIT(); asm volatile("" ::: "memory");
#pragma unroll
    for (int j = 0; j < 4; ++j) { const int n = (lane >> 3) + 8 * j; const LAS float* s = scr + (8 * c) * 33 + n;
        v4u o; o.x = pk2(s[0 * 33] * g0.x, s[1 * 33] * g0.y); o.y = pk2(s[2 * 33] * g0.z, s[3 * 33] * g0.w); o.z = pk2(s[4 * 33] * g1.x, s[5 * 33] * g1.y); o.w = pk2(s[6 * 33] * g1.z, s[7 * 33] * g1.w);
        *(GAS v4u*)(WT + (size_t)(n0 + n) * K + k0 + 8 * c) = o; }
    LDS_WAIT(); asm volatile("" ::: "memory");
}
struct Args { const float* in[16]; float* out; unsigned char* ws; };
constexpr int WF_OFF = 8 * 8704;

__global__ void __launch_bounds__(NWAVES * 64, 2) mk_fwd(Args args) {
    extern __shared__ __attribute__((aligned(16))) unsigned char lds[];
    cg::grid_group grid = cg::this_grid();
    Frame F;
    F.lds = (LAS unsigned char*)lds;
    F.wave = __builtin_amdgcn_readfirstlane((int)threadIdx.x >> 6);
    F.G = gridDim.x; { const int bx = blockIdx.x; F.vcu = (F.G % 8 == 0) ? (bx % 8) * (F.G / 8) + bx / 8 : bx; }
    unsigned char* ws = args.ws;
    const float* x = args.in[0]; const float* p_in = args.in[1]; const float* g_mix = args.in[2]; const float* w_in = args.in[3]; const float* b_forget = args.in[4];
    const float* sinks = args.in[5]; const float* w_br_swa = args.in[6]; const float* w_br_fox = args.in[7]; const float* w_mix = args.in[8]; const float* g_mlp = args.in[9];
    const float* w_ff1 = args.in[10]; const float* w_ff2 = args.in[11]; const float* g_ple = args.in[12]; const float* w_pg = args.in[13]; const float* w_pp = args.in[14]; const float* g_final = args.in[15];
    float* out = args.out;
    bf16 *WIN_t = (bf16*)(ws + WS_WIN), *WA_t = (bf16*)(ws + WS_WA), *WB_t = (bf16*)(ws + WS_WB), *WMIX_t = (bf16*)(ws + WS_WMIX), *W1_t = (bf16*)(ws + WS_W1), *W2_t = (bf16*)(ws + WS_W2), *WG_t = (bf16*)(ws + WS_WG), *WP_t = (bf16*)(ws + WS_WP);
    float *LF = (float*)(ws + WS_LF), *CB = (float*)(ws + WS_CB), *ST1 = (float*)(ws + WS_ST1), *ST2 = (float*)(ws + WS_ST2), *ST3 = (float*)(ws + WS_ST3);
    bf16 *PB = (bf16*)(ws + WS_PB), *XN = (bf16*)(ws + WS_XN), *HN = (bf16*)(ws + WS_HN), *Z = (bf16*)(ws + WS_Z), *HB = (bf16*)(ws + WS_Z); float* PP = (float*)(ws + WS_Z);
    const int gw = F.vcu * NWAVES + F.wave, NGW = F.G * NWAVES;

    for (int u = threadIdx.x; u < 128; u += NWAVES * 64) ((LAS unsigned*)(F.lds + RING_BYTES))[u] = 0u;
    __syncthreads();
    XcdBarrier bar = xcd_barrier_post((unsigned*)(ws + WS_CTL), (volatile LAS unsigned*)(F.lds + MISC_OFF) + 8);
#define GRID_BAR() do { const int l_ = fresh_lane(); xcd_barrier(bar, (F.wave == 0) && (l_ == 0)); } while (0)
    {
        const int p0_tid = threadIdx.x, p0_lane = p0_tid & 63;
        LAS float* wfT = (LAS float*)(F.lds + WF_OFF);
        for (int i = p0_tid; i < 8 * D; i += NWAVES * 64) { const int k = i >> 3, h = i & 7; wfT[h * 1024 + k] = g_mix[k] * w_in[(size_t)k * DIN_SRC + 2304 + h]; }
        __syncthreads();
        f32x4 gm4[4];
#pragma unroll
        for (int j = 0; j < 4; ++j) gm4[j] = ((const GAS f32x4*)g_mix)[64 * j + p0_lane];
        const float bfg = b_forget[p0_lane & 7];
        f32x4 v[4];
        if (gw < M) { const GAS f32x4* xr = (const GAS f32x4*)(x + (size_t)gw * D) + p0_lane;
#pragma unroll
            for (int j = 0; j < 4; ++j) v[j] = xr[64 * j]; }
        for (int m = gw; m < M; m += NGW) {
            f32x4 vn[4]; const int mn = (m + NGW < M) ? m + NGW : m;
            { const GAS f32x4* xr = (const GAS f32x4*)(x + (size_t)mn * D) + p0_lane;
#pragma unroll
              for (int j = 0; j < 4; ++j) vn[j] = xr[64 * j]; }
            float ss = 0.f;
#pragma unroll
            for (int j = 0; j < 4; ++j) ss += (v[j].x * v[j].x + v[j].y * v[j].y) + (v[j].z * v[j].z + v[j].w * v[j].w);
            float a8[8];
#pragma unroll
            for (int h = 0; h < 8; ++h) { float a = 0.f;
#pragma unroll
                for (int j = 0; j < 4; ++j) { const f32x4 w = ((const LAS f32x4*)wfT)[h * 256 + 64 * j + p0_lane]; a += (v[j].x * w.x + v[j].y * w.y) + (v[j].z * w.z + v[j].w * w.w); }
                a8[h] = a; }
#pragma unroll
            for (int o = 1; o < 64; o <<= 1) { ss += __shfl_xor(ss, o);
#pragma unroll
                for (int h = 0; h < 8; ++h) a8[h] += __shfl_xor(a8[h], o); }
            const float rstd = 1.f / sqrtf(ss * (1.f / D) + RMS_EPS);
            float fsel = a8[0];
#pragma unroll
            for (int h = 1; h < 8; ++h) fsel = (p0_lane == h) ? a8[h] : fsel;
            if (p0_lane < 8) { const float xf = fsel * rstd + bfg; const float ls = fminf(xf, 0.f) - log1pf(expf(-fabsf(xf)));
                LF[(size_t)((m >> 13) * 8 + p0_lane) * T + (m & (T - 1))] = ls; }
            GAS unsigned long long* o8 = (GAS unsigned long long*)(XN + (size_t)m * D) + p0_lane;
#pragma unroll
            for (int j = 0; j < 4; ++j) { const f32x4 y = v[j] * rstd * gm4[j];
                o8[64 * j] = (unsigned long long)pk2(y.x, y.y) | ((unsigned long long)pk2(y.z, y.w) << 32); }
#pragma unroll
            for (int j = 0; j < 4; ++j) v[j] = vn[j];
        }
        for (int i = gw * 64 + p0_lane; i < M * PLE / 32; i += NGW * 64) { f32x4 a[8];
#pragma unroll
            for (int q = 0; q < 4; ++q) { a[2 * q] = ((const GAS f32x4*)p_in)[2 * (i + q * (M * PLE / 32))]; a[2 * q + 1] = ((const GAS f32x4*)p_in)[2 * (i + q * (M * PLE / 32)) + 1]; }
#pragma unroll
            for (int q = 0; q < 4; ++q) { v4u o; o.x = pk2(a[2 * q].x, a[2 * q].y); o.y = pk2(a[2 * q].z, a[2 * q].w); o.z = pk2(a[2 * q + 1].x, a[2 * q + 1].y); o.w = pk2(a[2 * q + 1].z, a[2 * q + 1].w); ((GAS v4u*)PB)[i + q * (M * PLE / 32)] = o; } }
        LAS float* scr = (LAS float*)(F.lds + F.wave * 8704);
        constexpr int I_IN = (D / 64) * (NZ / 32), I_A = (512 / 64) * (D / 32), I_MIX = (D / 64) * (D / 32), I_1 = (D / 64) * (FF / 32), I_2 = (FF / 64) * (D / 32), I_P = (PLE / 64) * (D / 32);
        constexpr int NITEMS = I_IN + 2 * I_A + I_MIX + I_1 + I_2 + I_MIX + I_P;
        for (int it = gw; it < NITEMS; it += NGW) {
            int r = it;
            if (r < I_IN) { p0_transpose_item(w_in, DIN_SRC, D, NZ, 2304, 8, nullptr, WIN_t, scr, r, p0_lane); continue; } r -= I_IN;
            if (r < I_A) { p0_transpose_item(w_br_swa, D, 512, D, 1 << 30, 0, nullptr, WA_t, scr, r, p0_lane); continue; } r -= I_A;
            if (r < I_A) { p0_transpose_item(w_br_fox, D, 512, D, 1 << 30, 0, nullptr, WB_t, scr, r, p0_lane); continue; } r -= I_A;
            if (r < I_MIX) { p0_transpose_item(w_mix, D, D, D, 1 << 30, 0, nullptr, WMIX_t, scr, r, p0_lane); continue; } r -= I_MIX;
            if (r < I_1) { p0_transpose_item(w_ff1, FF, D, FF, 1 << 30, 0, g_mlp, W1_t, scr, r, p0_lane); continue; } r -= I_1;
            if (r < I_2) { p0_transpose_item(w_ff2, D, FF, D, 1 << 30, 0, nullptr, W2_t, scr, r, p0_lane); continue; } r -= I_2;
            if (r < I_MIX) { p0_transpose_item(w_pg, D, D, D, 1 << 30, 0, g_ple, WG_t, scr, r, p0_lane); continue; } r -= I_MIX;
            p0_transpose_item(w_pp, D, PLE, D, 1 << 30, 0, nullptr, WP_t, scr, r, p0_lane);
        }
    }
    grid.sync();

    for (int bh = blockIdx.x; bh < 16; bh += gridDim.x) {
        const int c_lane = fresh_lane(), c_tid = F.wave * 64 + c_lane;
        const GAS f32x4* src = (const GAS f32x4*)(LF + (size_t)bh * T) + c_tid * 4;
        f32x4 v[4]; float run = 0.f;
#pragma unroll
        for (int j = 0; j < 4; ++j) { v[j] = src[j];
#pragma unroll
            for (int e = 0; e < 4; ++e) { run += v[j][e]; v[j][e] = run; } }
        float sc = run;
#pragma unroll
        for (int o = 1; o < 64; o <<= 1) { const float n = __shfl_up(sc, o); if (c_lane >= o) sc += n; }
        LAS float* wt = (LAS float*)F.lds;
        if (c_lane == 63) wt[F.wave] = sc;
        __syncthreads();
        float woff = 0.f;
        for (int w = 0; w < F.wave; ++w) woff += wt[w];
        const float off = woff + sc - run;
        GAS f32x4* dst = (GAS f32x4*)(CB + (size_t)bh * T) + c_tid * 4;
#pragma unroll
        for (int j = 0; j < 4; ++j) dst[j] = (v[j] + off) * (-LOG2E);
        __syncthreads();
    }
    {
        pg8::Gemm g{XN, WIN_t, M, NZ, D, D}; pg8::StaticOrder S; S.init(M, NZ, F.G, (int)blockIdx.x);
        pg8::EpiZ E{Z};
        pg8::gemm_phase<pg8::EpiZ, pg8::StaticOrder, PG8_ALIGN, PG8_SP2>(F.lds, g, S, E, F.wave);
    }
    GRID_BAR();

    for (int id = F.vcu; id < 256; id += F.G) {
        const int bh = id >> 4, s = id & 15, b = bh >> 3, h = bh & 7;
        const attn_body::bf16* Zb = (const attn_body::bf16*)Z + (size_t)b * T * NZ;
        const attn_body::bf16* Qh = Zb + 768 + h * 64; const attn_body::bf16* Kh = Zb + 1280 + h * 64; const attn_body::bf16* Vh = Zb + 1792 + h * 64;
        const float* cb = CB + (size_t)bh * T;
        attn_body::attn_unit<24>(F.wave, 31 - s, Qh, Kh, Vh, (attn_body::bf16*)Qh, cb, (char*)lds);
        attn_body::attn_unit<24>(F.wave, s, Qh, Kh, Vh, (attn_body::bf16*)Qh, cb, (char*)lds);
    }
    for (int id = F.vcu; id < 512; id += F.G) {
        const int bh = id >> 5, qb = id & 31, b = bh >> 3, h = bh & 7;
        const attn_body::bf16* Zb = (const attn_body::bf16*)Z + (size_t)b * T * NZ;
        const attn_body::bf16* Qh = Zb + h * 64; const attn_body::bf16* Kh = Zb + 512 + (h >> 2) * 64; const attn_body::bf16* Vh = Zb + 640 + (h >> 2) * 64;
        const float slope2 = exp2f(-(float)(h + 1)) * LOG2E, sink2 = sinks[h] * LOG2E;
        attn_body::swa_unit(F.wave, qb, Qh, Kh, Vh, (attn_body::bf16*)Qh, slope2, sink2, (char*)lds);
    }
    GRID_BAR();

    {
        pg8::StaticOrder S; S.init(M, D, F.G, (int)blockIdx.x);
        { pg8::Gemm g{Z, WA_t, M, D, 512, NZ}; pg8::EpiT1 E{Z + 2304, out}; pg8::gemm_phase<pg8::EpiT1, pg8::StaticOrder, PG8_ALIGN, PG8_SP2>(F.lds, g, S, E, F.wave); }
        { pg8::Gemm g{Z + 768, WB_t, M, D, 512, NZ}; pg8::EpiMix E{Z + 3328, out, XN}; pg8::gemm_phase<pg8::EpiMix, pg8::StaticOrder, PG8_ALIGN, PG8_SP2>(F.lds, g, S, E, F.wave); }
    }
    GRID_BAR();

    {
        pg8::Gemm g{XN, WMIX_t, M, D, D, D}; pg8::StaticOrder S; S.init(M, D, F.G, (int)blockIdx.x);
        pg8::EpiRes E{x, out, HN, ST1};
        pg8::gemm_phase<pg8::EpiRes, pg8::StaticOrder, PG8_ALIGN, PG8_SP2>(F.lds, g, S, E, F.wave);
    }
    GRID_BAR();

    {
        pg8::Gemm g{HN, W1_t, M, FF, D, D}; pg8::StaticOrder S; S.init(M, FF, F.G, (int)blockIdx.x);
        pg8::EpiRelu2 E{ST1, HB};
        pg8::gemm_phase<pg8::EpiRelu2, pg8::StaticOrder, PG8_ALIGN, PG8_SP2>(F.lds, g, S, E, F.wave);
    }
    GRID_BAR();

    {
        pg8::Gemm g{HB, W2_t, M, D, FF, FF}; pg8::StaticOrder S; S.init(M, D, F.G, (int)blockIdx.x);
        pg8::EpiRes E{out, out, XN, ST2};
        pg8::gemm_phase<pg8::EpiRes, pg8::StaticOrder, PG8_ALIGN, PG8_SP2>(F.lds, g, S, E, F.wave);
    }
    GRID_BAR();

    {
        pg8::StaticOrder S; S.init(M, D, F.G, (int)blockIdx.x);
        { pg8::Gemm g{PB, WP_t, M, D, PLE, PLE}; pg8::EpiPP E{PP}; pg8::gemm_phase<pg8::EpiPP, pg8::StaticOrder, PG8_ALIGN, PG8_SP2>(F.lds, g, S, E, F.wave); }
        { pg8::Gemm g{XN, WG_t, M, D, D, D}; pg8::EpiPle E{ST2, PP, out, ST3}; pg8::gemm_phase<pg8::EpiPle, pg8::StaticOrder, PG8_ALIGN, PG8_SP2>(F.lds, g, S, E, F.wave); }
    }
    GRID_BAR();

    const int f_lane = fresh_lane();
    for (int m = gw; m < M; m += NGW) {
        float t = (f_lane < 16) ? ST3[(size_t)m * 16 + f_lane] : 0.f;
        const float rstd = 1.f / sqrtf(wave_sum(t) * (1.f / D) + RMS_EPS);
        GAS f32x4* xr = (GAS f32x4*)(out + (size_t)m * D) + f_lane;
#pragma unroll
        for (int j = 0; j < 4; ++j) { const f32x4 gm = ((const GAS f32x4*)g_final)[64 * j + f_lane]; xr[64 * j] = xr[64 * j] * rstd * gm; }
    }
}

extern "C" void kernel_launch(void* const* d_in, const int* in_sizes, int n_in, void* d_out, int out_size, void* d_ws, size_t ws_size, hipStream_t stream) {
    static int grid = 0;
    if (grid == 0) {
        if (n_in != 16 || in_sizes[0] != M * D || out_size != M * D || ws_size < WS_END) { fprintf(stderr, "kernel_launch: unexpected shapes (n_in %d, in0 %d, out %d, ws %zu); nothing launched\n", n_in, n_in > 0 ? in_sizes[0] : -1, out_size, ws_size); grid = -1; return; }
        int dev = 0, cus = 0, per_cu = 0;
        if (hipGetDevice(&dev) != hipSuccess || hipDeviceGetAttribute(&cus, hipDeviceAttributeMultiprocessorCount, dev) != hipSuccess) { grid = -1; return; }
        if (hipFuncSetAttribute((const void*)mk_fwd, hipFuncAttributeMaxDynamicSharedMemorySize, LDS_BYTES) != hipSuccess) { fprintf(stderr, "kernel_launch: hipFuncSetAttribute failed\n"); grid = -1; return; }
        if (hipOccupancyMaxActiveBlocksPerMultiprocessor(&per_cu, (const void*)mk_fwd, NWAVES * 64, LDS_BYTES) != hipSuccess || per_cu < 1) { fprintf(stderr, "kernel_launch: occupancy query failed (%d)\n", per_cu); (void)hipGetLastError(); per_cu = 1; }
        if (per_cu > 1) per_cu = 1;
        grid = cus * per_cu;
    }
    if (grid < 0) return;
    if (hipMemsetAsync((char*)d_ws + WS_CTL, 0, CTL_ZERO_BYTES, stream) != hipSuccess) { fprintf(stderr, "kernel_launch: memset failed\n"); return; }
    Args a{};
    for (int i = 0; i < 16; ++i) a.in[i] = (const float*)d_in[i];
    a.out = (float*)d_out; a.ws = (unsigned char*)d_ws;
    void* kargs[] = {&a};
    hipError_t e = hipLaunchCooperativeKernel((const void*)mk_fwd, dim3(grid), dim3(NWAVES * 64), kargs, LDS_BYTES, stream);
    if (e != hipSuccess) fprintf(stderr, "kernel_launch: cooperative launch failed: %s (grid %d)\n", hipGetErrorString(e), grid);
}
```

```cpp
#include <hip/hip_runtime.h>
#include <hip/hip_cooperative_groups.h>
#include <cstdio>
#include <cstdint>
__device__ __forceinline__ int fresh_lane() { int l; asm volatile("v_mbcnt_lo_u32_b32 %0, -1, 0\n\tv_mbcnt_hi_u32_b32 %0, -1, %0" : "=v"(l)); return l; }

namespace pg8 {

#define PG8_LAS __attribute__((address_space(3)))
typedef unsigned short bf16_t;
typedef short bf16x8 __attribute__((ext_vector_type(8)));
typedef float f32x4 __attribute__((ext_vector_type(4)));
typedef unsigned u32x4 __attribute__((ext_vector_type(4)));
constexpr int BM = 256, BK = 64, HALF = 128, HTB = HALF * BK * 2  , STAGE_BYTES = 8 * HTB, NXCD = 8, WGM = 8;

__host__ __device__ __forceinline__ int lds_byte(int r, int c) { const int st = (r >> 4) * 2 + (c >> 5), rr = r & 15, cc = c & 31, ob = rr * 64 + cc * 2; return st * 1024 + (ob ^ (((ob >> 9) & 1) << 5)); }
__host__ __device__ __forceinline__ void stage_rc(int b, int& R, int& C) { const int st = b / 1024, sb = b % 1024, swz = sb ^ (((sb >> 9) & 1) << 5); R = (st >> 1) * 16 + swz / 64; C = (st & 1) * 32 + (swz % 64) / 2; }
__host__ __device__ __forceinline__ int perm32(int rho) { const int n = rho >> 4, i = rho & 15; return 8 * (i >> 2) + 4 * n + (i & 3); }

struct Unit { int pm, pn; };
struct Gemm { const bf16_t* A; const bf16_t* Bt; int M, N, K, lda; };

struct StaticOrder {
    int nM, nN, nwg, G, c;
    __host__ __device__ void init(int M, int N, int G_, int c_) { nM = M / BM; nN = N / BM; nwg = nM * nN; G = G_; c = c_; }
    __host__ __device__ bool next(int i, Unit& u) const {
        const long L = (long)i * G + c; if (L >= nwg) return false;
        int wgid = (int)L; { const int q = nwg / NXCD, r = nwg % NXCD, xcd = wgid % NXCD, off = wgid / NXCD; wgid = (xcd < r ? xcd * (q + 1) : r * (q + 1) + (xcd - r) * q) + off; }
        const int nig = WGM * nN, gid = wgid / nig, fm = gid * WGM, gsz = (nM - fm) < WGM ? (nM - fm) : WGM;
        u.pm = fm + ((wgid % nig) % gsz); u.pn = (wgid % nig) / gsz; return true;
    }
    __device__ __forceinline__ void a_ready(const Unit&) const {}
    __device__ __forceinline__ void done(const Unit&) const {}
};

__device__ __forceinline__ unsigned cvt_pk_bf16(float lo, float hi) { unsigned r; asm volatile("v_cvt_pk_bf16_f32 %0, %1, %2" : "=v"(r) : "v"(lo), "v"(hi)); return r; }
typedef float f32x2 __attribute__((ext_vector_type(2)));
constexpr int ZP = 4352;
constexpr float C2F = 0.125f * 1.4426950408889634f;
__device__ __forceinline__ float sigmoidf_fast(float x) { return __builtin_amdgcn_rcpf(1.0f + __builtin_amdgcn_exp2f(-1.4426950408889634f * x)); }
__device__ __forceinline__ f32x4 bf4_lo(unsigned a, unsigned b) { return (f32x4){__uint_as_float(a << 16), __uint_as_float(a & 0xffff0000u), __uint_as_float(b << 16), __uint_as_float(b & 0xffff0000u)}; }
__device__ __forceinline__ u32x4 pack8(f32x4 v0, f32x4 v1) { u32x4 w; w.x = cvt_pk_bf16(v0[0], v0[1]); w.y = cvt_pk_bf16(v0[2], v0[3]); w.z = cvt_pk_bf16(v1[0], v1[1]); w.w = cvt_pk_bf16(v1[2], v1[3]); return w; }
__device__ __forceinline__ float rstd_from_stats(const float* st, int row) { const f32x4* s = (const f32x4*)(st + (size_t)row * 16); const f32x4 a = s[0], b = s[1], c = s[2], d = s[3];
    const float t = ((a[0] + a[1]) + (a[2] + a[3])) + ((b[0] + b[1]) + (b[2] + b[3])) + ((c[0] + c[1]) + (c[2] + c[3])) + ((d[0] + d[1]) + (d[2] + d[3])); return 1.0f / sqrtf(t * (1.0f / 1024.0f) + 1e-6f); }
#define EPI_ROWS(...) _Pragma("unroll") for (int ai = 0; ai < 2; ++ai) _Pragma("unroll") for (int m = 0; m < 4; ++m) { const int row = u.pm * BM + ai * HALF + wr * 64 + m * 16 + fr; __VA_ARGS__ asm volatile("" ::: "memory"); }
#define EPI_COLS(...) _Pragma("unroll") for (int bj = 0; bj < 2; ++bj) { const int col = u.pn * BM + bj * HALF + wc * 32 + 8 * fq; const f32x4 a0 = acc[ai][bj][m][0], a1 = acc[ai][bj][m][1]; __VA_ARGS__ }
struct EpiZ { static constexpr bool PERM = true, AFTER_DRAIN = false; bf16_t* Z; unsigned* NM;
    __device__ __forceinline__ void operator()(const f32x4 (&acc)[2][2][4][2], const Unit& u, int wr, int wc, int fr, int fq) const {
        const int pn = u.pn; const int mode = (pn >= 9) ? 2 : ((pn == 0 || pn == 1 || pn == 3 || pn == 4) ? 1 : 0);
        const bool nrm = (pn >= 3 && pn <= 6); float mx0 = 0.f, mx1 = 0.f;
        EPI_ROWS( bf16_t* rowp = Z + (size_t)row * ZP; EPI_COLS( f32x4 v0 = a0, v1 = a1;
            if (mode == 1) { v0 = v0 * C2F; v1 = v1 * C2F; }
            else if (mode == 2) { _Pragma("unroll") for (int e = 0; e < 4; ++e) { v0[e] = sigmoidf_fast(v0[e]); v1[e] = sigmoidf_fast(v1[e]); } }
            if (nrm) { float ss = ((v0[0] * v0[0] + v0[1] * v0[1]) + (v0[2] * v0[2] + v0[3] * v0[3])) + ((v1[0] * v1[0] + v1[1] * v1[1]) + (v1[2] * v1[2] + v1[3] * v1[3]));
                ss += __shfl_xor(ss, 16); ss += __shfl_xor(ss, 32); if (bj == 0) mx0 = fmaxf(mx0, ss); else mx1 = fmaxf(mx1, ss); }
            *(u32x4*)(rowp + col) = pack8(v0, v1); ) )
        if (nrm) {
#pragma unroll
            for (int o = 1; o < 16; o <<= 1) { mx0 = fmaxf(mx0, __shfl_xor(mx0, o)); mx1 = fmaxf(mx1, __shfl_xor(mx1, o)); }
            if (fr == 0 && fq == 0) {
                const int isk = (pn >= 5), cr = (pn - (isk ? 5 : 3)) * 4 + (wc >> 1), half = wc & 1;
                unsigned* b0 = isk ? NM + 1024 + ((u.pm >> 5) * 8 + cr) * 2 + half : NM + (u.pm * 8 + cr) * 2 + half;
                atomicMax(b0, __float_as_uint(mx0 * 1.0001f)); atomicMax(b0 + 4, __float_as_uint(mx1 * 1.0001f));
            } }
    } };
#define EPI_GROUP(NR, ...) _Pragma("unroll") for (int ai = 0; ai < 2; ++ai) _Pragma("unroll") for (int mg = 0; mg < 4; mg += NR) { __VA_ARGS__ asm volatile("" ::: "memory"); }
#define EPI_ROWOF(mm) (u.pm * BM + ai * HALF + wr * 64 + (mm) * 16 + fr)
#define EPI_COLOF(bj) (u.pn * BM + (bj) * HALF + wc * 32 + 8 * fq)
struct EpiT1 { static constexpr bool PERM = true, AFTER_DRAIN = false; const bf16_t* G; bf16_t* T;
    __device__ __forceinline__ void operator()(const f32x4 (&acc)[2][2][4][2], const Unit& u, int wr, int wc, int fr, int fq) const {
        EPI_GROUP(4, u32x4 g[4][2];
            _Pragma("unroll") for (int i = 0; i < 4; ++i) _Pragma("unroll") for (int bj = 0; bj < 2; ++bj) g[i][bj] = *(const u32x4*)(G + (size_t)EPI_ROWOF(mg + i) * ZP + EPI_COLOF(bj));
            _Pragma("unroll") for (int i = 0; i < 4; ++i) _Pragma("unroll") for (int bj = 0; bj < 2; ++bj)
                *(u32x4*)(T + (size_t)EPI_ROWOF(mg + i) * 1024 + EPI_COLOF(bj)) = pack8(acc[ai][bj][mg + i][0] * bf4_lo(g[i][bj].x, g[i][bj].y), acc[ai][bj][mg + i][1] * bf4_lo(g[i][bj].z, g[i][bj].w)); )
    } };
struct EpiMix { static constexpr bool PERM = true, AFTER_DRAIN = false; const bf16_t* G; const bf16_t* T; bf16_t* O;
    __device__ __forceinline__ void operator()(const f32x4 (&acc)[2][2][4][2], const Unit& u, int wr, int wc, int fr, int fq) const {
        EPI_GROUP(4, u32x4 g[4][2]; u32x4 t[4][2];
            _Pragma("unroll") for (int i = 0; i < 4; ++i) _Pragma("unroll") for (int bj = 0; bj < 2; ++bj) { g[i][bj] = *(const u32x4*)(G + (size_t)EPI_ROWOF(mg + i) * ZP + EPI_COLOF(bj));
                t[i][bj] = *(const u32x4*)(T + (size_t)EPI_ROWOF(mg + i) * 1024 + EPI_COLOF(bj)); }
            _Pragma("unroll") for (int i = 0; i < 4; ++i) _Pragma("unroll") for (int bj = 0; bj < 2; ++bj) {
                const f32x4 v0 = bf4_lo(t[i][bj].x, t[i][bj].y) + acc[ai][bj][mg + i][0] * bf4_lo(g[i][bj].x, g[i][bj].y), v1 = bf4_lo(t[i][bj].z, t[i][bj].w) + acc[ai][bj][mg + i][1] * bf4_lo(g[i][bj].z, g[i][bj].w);
                *(u32x4*)(O + (size_t)EPI_ROWOF(mg + i) * 1024 + EPI_COLOF(bj)) = pack8(v0, v1); } )
    } };
struct EpiRes { static constexpr bool PERM = true, AFTER_DRAIN = false; const float* base; float* out; bf16_t* hb; float* st;
    __device__ __forceinline__ void operator()(const f32x4 (&acc)[2][2][4][2], const Unit& u, int wr, int wc, int fr, int fq) const {
        EPI_GROUP(4, f32x4 b[4][2][2];
            _Pragma("unroll") for (int i = 0; i < 4; ++i) _Pragma("unroll") for (int bj = 0; bj < 2; ++bj) { const float* bp = base + (size_t)EPI_ROWOF(mg + i) * 1024 + EPI_COLOF(bj); b[i][bj][0] = *(const f32x4*)bp; b[i][bj][1] = *(const f32x4*)(bp + 4); }
            _Pragma("unroll") for (int i = 0; i < 4; ++i) { float ss = 0.f; const int row = EPI_ROWOF(mg + i);
                _Pragma("unroll") for (int bj = 0; bj < 2; ++bj) { const size_t off = (size_t)row * 1024 + EPI_COLOF(bj); const f32x4 h0 = b[i][bj][0] + acc[ai][bj][mg + i][0], h1 = b[i][bj][1] + acc[ai][bj][mg + i][1];
                    *(f32x4*)(out + off) = h0; *(f32x4*)(out + off + 4) = h1; *(u32x4*)(hb + off) = pack8(h0, h1);
                    ss += ((h0[0] * h0[0] + h0[1] * h0[1]) + (h0[2] * h0[2] + h0[3] * h0[3])) + ((h1[0] * h1[0] + h1[1] * h1[1]) + (h1[2] * h1[2] + h1[3] * h1[3])); }
                ss += __shfl_xor(ss, 16); ss += __shfl_xor(ss, 32); if (fq == 0) st[(size_t)row * 16 + u.pn * 4 + wc] = ss; } )
    } };
struct EpiRelu2 { static constexpr bool PERM = true, AFTER_DRAIN = false; const float* st; bf16_t* O;
    __device__ __forceinline__ void operator()(const f32x4 (&acc)[2][2][4][2], const Unit& u, int wr, int wc, int fr, int fq) const {
        float rsv[2][4];
        _Pragma("unroll") for (int ai = 0; ai < 2; ++ai) { _Pragma("unroll") for (int m = 0; m < 4; ++m) rsv[ai][m] = rstd_from_stats(st, u.pm * BM + ai * HALF + wr * 64 + m * 16 + fr);
            asm volatile("" : "+v"(rsv[ai][0]), "+v"(rsv[ai][1]), "+v"(rsv[ai][2]), "+v"(rsv[ai][3]) :: "memory"); }
        EPI_ROWS( const float rs = rsv[ai][m]; EPI_COLS( f32x4 v0 = a0 * rs, v1 = a1 * rs;
            _Pragma("unroll") for (int e = 0; e < 4; ++e) { const float x0 = fmaxf(v0[e], 0.f), x1 = fmaxf(v1[e], 0.f); v0[e] = x0 * x0; v1[e] = x1 * x1; }
            *(u32x4*)(O + (size_t)row * 4096 + col) = pack8(v0, v1); ) )
    } };
struct EpiPP { static constexpr bool PERM = true, AFTER_DRAIN = false; bf16_t* T;
    __device__ __forceinline__ void operator()(const f32x4 (&acc)[2][2][4][2], const Unit& u, int wr, int wc, int fr, int fq) const {
        EPI_ROWS( EPI_COLS( *(u32x4*)(T + (size_t)row * 1024 + col) = pack8(a0, a1); ) )
    } };
struct EpiPle { static constexpr bool PERM = true, AFTER_DRAIN = false; const float* st_in; const bf16_t* T; float* h; float* st;
    __device__ __forceinline__ void operator()(const f32x4 (&acc)[2][2][4][2], const Unit& u, int wr, int wc, int fr, int fq) const {
        float rsv[2][4];
        _Pragma("unroll") for (int ai = 0; ai < 2; ++ai) { _Pragma("unroll") for (int m = 0; m < 4; ++m) rsv[ai][m] = rstd_from_stats(st_in, u.pm * BM + ai * HALF + wr * 64 + m * 16 + fr);
            asm volatile("" : "+v"(rsv[ai][0]), "+v"(rsv[ai][1]), "+v"(rsv[ai][2]), "+v"(rsv[ai][3]) :: "memory"); }
        EPI_GROUP(2, f32x4 hv[2][2][2]; u32x4 tv[2][2];
            _Pragma("unroll") for (int i = 0; i < 2; ++i) _Pragma("unroll") for (int bj = 0; bj < 2; ++bj) { const size_t off = (size_t)EPI_ROWOF(mg + i) * 1024 + EPI_COLOF(bj);
                    hv[i][bj][0] = *(const f32x4*)(h + off); hv[i][bj][1] = *(const f32x4*)(h + off + 4); tv[i][bj] = *(const u32x4*)(T + off); }
            _Pragma("unroll") for (int i = 0; i < 2; ++i) { float ss = 0.f; const int row = EPI_ROWOF(mg + i); const float rs = rsv[ai][mg + i];
                _Pragma("unroll") for (int bj = 0; bj < 2; ++bj) { const size_t off = (size_t)row * 1024 + EPI_COLOF(bj);
                    f32x4 g0 = acc[ai][bj][mg + i][0] * rs, g1 = acc[ai][bj][mg + i][1] * rs; _Pragma("unroll") for (int e = 0; e < 4; ++e) { g0[e] = sigmoidf_fast(g0[e]); g1[e] = sigmoidf_fast(g1[e]); }
                    const f32x4 h0 = hv[i][bj][0] + g0 * bf4_lo(tv[i][bj].x, tv[i][bj].y), h1 = hv[i][bj][1] + g1 * bf4_lo(tv[i][bj].z, tv[i][bj].w);
                    *(f32x4*)(h + off) = h0; *(f32x4*)(h + off + 4) = h1;
                    ss += ((h0[0] * h0[0] + h0[1] * h0[1]) + (h0[2] * h0[2] + h0[3] * h0[3])) + ((h1[0] * h1[0] + h1[1] * h1[1]) + (h1[2] * h1[2] + h1[3] * h1[3])); }
                ss += __shfl_xor(ss, 16); ss += __shfl_xor(ss, 32); if (fq == 0) st[(size_t)row * 16 + u.pn * 4 + wc] = ss; } )
    } };

template <class Epi, class Sched, bool ALIGN_EPI = false, bool SP2 = false>
__device__ __forceinline__ void gemm_phase(PG8_LAS unsigned char* lds, const Gemm g, const Sched& S, const Epi& E, const int wave_s) {
    const int tid = wave_s * 64 + fresh_lane(), wid = wave_s, lane = tid & 63, wr = wid >> 2, wc = wid & 3, fr = lane & 15, fq = lane >> 4;
    const int K = g.K, nt = K / BK;
    unsigned voffA[2], voffB[2];
#pragma unroll
    for (int i = 0; i < 2; ++i) { int R, C; stage_rc(tid * 16 + i * 8192, R, C); const int Rb = Epi::PERM ? ((R & ~31) + perm32(R & 31)) : R;
        voffA[i] = (unsigned)(R * g.lda + C) * 2u; voffB[i] = (unsigned)(Rb * K + C) * 2u; }
    const size_t kstep = (size_t)(BK * 2);
    const size_t hstepA = (size_t)HALF * g.lda * 2, hstepB = (size_t)HALF * K * 2;
    const size_t tstepA = 2 * hstepA, tstepB = 2 * hstepB;
    const unsigned ldsw = (unsigned)wid * 1024u;
    const int aoff = lds_byte(wr * 64 + fr, fq * 8), boff = lds_byte(wc * 32 + fr, fq * 8);
#define PG8_SA(b, h) (((b) * 2 + (h)) * HTB)
#define PG8_SB(b, h) ((4 + (b) * 2 + (h)) * HTB)
#define PG8_STAGE(bufoff, gbase, voff) do { _Pragma("unroll") for (int _i = 0; _i < 2; ++_i) \
        __builtin_amdgcn_global_load_lds((const unsigned*)((const char*)(gbase) + (voff)[_i]), (PG8_LAS unsigned*)(lds + (bufoff) + ldsw + _i * 8192), 16, 0, 0); } while (0)
#define PG8_LDA(dst, b, h) do { _Pragma("unroll") for (int m = 0; m < 4; ++m) _Pragma("unroll") for (int k = 0; k < 2; ++k) dst[m][k] = *(const PG8_LAS bf16x8*)(lds + PG8_SA(b, h) + aoff + m * 2048 + k * 1024); } while (0)
#define PG8_LDB(dst, b, h) do { _Pragma("unroll") for (int n = 0; n < 2; ++n) _Pragma("unroll") for (int k = 0; k < 2; ++k) dst[n][k] = *(const PG8_LAS bf16x8*)(lds + PG8_SB(b, h) + boff + n * 2048 + k * 1024); } while (0)
#define PG8_MMA(ai, bj, At, Bt) do { __builtin_amdgcn_s_setprio(1); _Pragma("unroll") for (int m = 0; m < 4; ++m) _Pragma("unroll") for (int n = 0; n < 2; ++n) _Pragma("unroll") for (int k = 0; k < 2; ++k) \
        acc[ai][bj][m][n] = __builtin_amdgcn_mfma_f32_16x16x32_bf16(Bt[n][k], At[m][k], acc[ai][bj][m][n], 0, 0, 0); __builtin_amdgcn_s_setprio(0); } while (0)
#define PG8_WAIT_V(n) asm volatile("s_waitcnt vmcnt(" #n ")" ::: "memory")
#define PG8_WAIT_L(n) asm volatile("s_waitcnt lgkmcnt(" #n ")" ::: "memory")
#define PG8_BAR __builtin_amdgcn_s_barrier()
#define PG8_SCHED __builtin_amdgcn_sched_barrier(0)
    Unit cur, nxt; int ui = 0;
    if (!S.next(0, cur)) return;
    f32x4 acc[2][2][4][2];
#pragma unroll
    for (int a = 0; a < 2; ++a)
#pragma unroll
        for (int b = 0; b < 2; ++b)
#pragma unroll
            for (int m = 0; m < 4; ++m)
#pragma unroll
                for (int n = 0; n < 2; ++n) acc[a][b][m][n] = (f32x4){0.f, 0.f, 0.f, 0.f};
    bf16x8 At[4][2], B0[2][2], B1[2][2];
    const char* cA = (const char*)g.A + (size_t)cur.pm * tstepA; const char* cB = (const char*)g.Bt + (size_t)cur.pn * tstepB;
    S.a_ready(cur);
    if constexpr (SP2) {
        PG8_STAGE(PG8_SB(0, 0), cB, voffB); PG8_STAGE(PG8_SB(0, 1), cB + hstepB, voffB); PG8_STAGE(PG8_SA(0, 0), cA, voffA); PG8_STAGE(PG8_SA(0, 1), cA + hstepA, voffA);
        if (wr == 1) PG8_BAR;
        PG8_WAIT_V(2); PG8_BAR;
        PG8_STAGE(PG8_SB(1, 0), cB + kstep, voffB); PG8_STAGE(PG8_SA(1, 0), cA + kstep, voffA); PG8_STAGE(PG8_SB(1, 1), cB + hstepB + kstep, voffB);
        PG8_WAIT_V(6); PG8_BAR;
    } else {
        PG8_STAGE(PG8_SB(0, 0), cB, voffB); PG8_STAGE(PG8_SA(0, 0), cA, voffA); PG8_STAGE(PG8_SB(0, 1), cB + hstepB, voffB); PG8_STAGE(PG8_SA(0, 1), cA + hstepA, voffA);
        if (wr == 1) PG8_BAR;
        PG8_WAIT_V(4); PG8_BAR;
        PG8_STAGE(PG8_SB(1, 0), cB + kstep, voffB); PG8_STAGE(PG8_SA(1, 0), cA + kstep, voffA); PG8_STAGE(PG8_SB(1, 1), cB + hstepB + kstep, voffB);
        PG8_WAIT_V(6); PG8_BAR;
    }
    for (;;) {
        const bool has_next = S.next(ui + 1, nxt);
        const char* nA = has_next ? (const char*)g.A + (size_t)nxt.pm * tstepA : cA; const char* nB = has_next ? (const char*)g.Bt + (size_t)nxt.pn * tstepB : cB;
        for (int t = 0; t < nt; t += 2) {
            const bool last = (t == nt - 2);
            const char* a1 = cA + (size_t)(t + 1) * kstep;
            const char* a2 = last ? nA : cA + (size_t)(t + 2) * kstep; const char* b2 = last ? nB : cB + (size_t)(t + 2) * kstep;
            const char* a3 = a2 + kstep; const char* b3 = b2 + kstep;
            if (last && has_next) S.a_ready(nxt);
            if constexpr (SP2) {
            PG8_LDB(B0, 0, 0); PG8_LDB(B1, 0, 1); PG8_SCHED; PG8_LDA(At, 0, 0); PG8_STAGE(PG8_SA(1, 1), a1 + hstepA, voffA);
            PG8_WAIT_V(8); PG8_WAIT_L(0); PG8_BAR; PG8_MMA(0, 0, At, B0); PG8_MMA(0, 1, At, B1); PG8_BAR; PG8_SCHED;
            PG8_LDA(At, 0, 1); PG8_STAGE(PG8_SB(0, 0), b2, voffB); PG8_STAGE(PG8_SB(0, 1), b2 + hstepB, voffB); PG8_STAGE(PG8_SA(0, 0), a2, voffA);
            PG8_WAIT_V(8); PG8_WAIT_L(0); PG8_BAR; PG8_MMA(1, 0, At, B0); PG8_MMA(1, 1, At, B1); PG8_BAR; PG8_SCHED;
            PG8_LDB(B0, 1, 0); PG8_LDB(B1, 1, 1); PG8_SCHED; PG8_LDA(At, 1, 0); PG8_STAGE(PG8_SA(0, 1), a2 + hstepA, voffA);
            PG8_WAIT_V(8); PG8_WAIT_L(0); PG8_BAR; PG8_MMA(0, 0, At, B0); PG8_MMA(0, 1, At, B1); PG8_BAR; PG8_SCHED;
            PG8_LDA(At, 1, 1); PG8_STAGE(PG8_SB(1, 0), b3, voffB); PG8_STAGE(PG8_SB(1, 1), b3 + hstepB, voffB); PG8_STAGE(PG8_SA(1, 0), a3, voffA);
            PG8_WAIT_V(8); PG8_WAIT_L(0); PG8_BAR; PG8_MMA(1, 0, At, B0); PG8_MMA(1, 1, At, B1); PG8_BAR; PG8_SCHED;
            } else {
            PG8_LDB(B0, 0, 0); PG8_SCHED; PG8_LDA(At, 0, 0); PG8_STAGE(PG8_SA(1, 1), a1 + hstepA, voffA);
            PG8_WAIT_L(8); PG8_BAR; PG8_WAIT_L(0); PG8_MMA(0, 0, At, B0); PG8_BAR; PG8_SCHED;
            PG8_LDB(B1, 0, 1); PG8_STAGE(PG8_SB(0, 0), b2, voffB);
            PG8_BAR; PG8_WAIT_L(0); PG8_MMA(0, 1, At, B1); PG8_BAR;
            PG8_LDA(At, 0, 1); PG8_STAGE(PG8_SA(0, 0), a2, voffA);
            PG8_BAR; PG8_WAIT_L(0); PG8_MMA(1, 0, At, B0); PG8_BAR; PG8_SCHED;
            PG8_STAGE(PG8_SB(0, 1), b2 + hstepB, voffB);
            PG8_WAIT_V(6); PG8_BAR; PG8_MMA(1, 1, At, B1); PG8_BAR;
            PG8_LDB(B0, 1, 0); PG8_SCHED; PG8_LDA(At, 1, 0); PG8_STAGE(PG8_SA(0, 1), a2 + hstepA, voffA);
            PG8_WAIT_L(8); PG8_BAR; PG8_WAIT_L(0); PG8_MMA(0, 0, At, B0); PG8_BAR; PG8_SCHED;
            PG8_LDB(B1, 1, 1); PG8_STAGE(PG8_SB(1, 0), b3, voffB);
            PG8_BAR; PG8_WAIT_L(0); PG8_MMA(0, 1, At, B1); PG8_BAR;
            PG8_LDA(At, 1, 1); PG8_STAGE(PG8_SA(1, 0), a3, voffA);
            PG8_BAR; PG8_WAIT_L(0); PG8_MMA(1, 0, At, B0); PG8_BAR; PG8_SCHED;
            PG8_STAGE(PG8_SB(1, 1), b3 + hstepB, voffB);
            PG8_WAIT_V(6); PG8_BAR; PG8_MMA(1, 1, At, B1); PG8_BAR;
            }
        }
        if constexpr (ALIGN_EPI) { if (wr == 0) PG8_BAR; }
        if constexpr (!Epi::AFTER_DRAIN) { E(acc, cur, wr, wc, fr, fq); S.done(cur); }
        if (!has_next) break;
#pragma unroll
        for (int a = 0; a < 2; ++a)
#pragma unroll
            for (int b = 0; b < 2; ++b)
#pragma unroll
                for (int m = 0; m < 4; ++m)
#pragma unroll
                    for (int n = 0; n < 2; ++n) acc[a][b][m][n] = (f32x4){0.f, 0.f, 0.f, 0.f};
        cur = nxt; cA = nA; cB = nB; ++ui;
        if constexpr (ALIGN_EPI) { if (wr == 1) PG8_BAR; }
    }
    PG8_WAIT_V(0);
    if constexpr (!ALIGN_EPI) { if (wr == 0) PG8_BAR; }
    PG8_BAR;
    if constexpr (Epi::AFTER_DRAIN) { E.fused(acc, cur, wr, wc, fr, fq, lds, wid, lane); S.done(cur); }
#undef PG8_SA
#undef PG8_SB
#undef PG8_STAGE
#undef PG8_LDA
#undef PG8_LDB
#undef PG8_MMA
#undef PG8_WAIT_V
#undef PG8_WAIT_L
#undef PG8_BAR
#undef PG8_SCHED
}
}
#ifndef PG8_SP2
#define PG8_SP2 true
#endif
#ifndef PG8_ALIGN
#define PG8_ALIGN true
#endif
#include <hip/hip_bf16.h>
#include <cmath>
namespace attn_body {
using bf16=__hip_bfloat16;
using bf16x8=__attribute__((ext_vector_type(8)))short;
using s16x4=__attribute__((ext_vector_type(4)))short;
using f32x16=__attribute__((ext_vector_type(16)))float;
using u32x4=__attribute__((ext_vector_type(4)))unsigned;
constexpr int BATCH=2,SEQ=8192,D=64,DM=4352;
constexpr int NW=8,QBLK=32,QB=QBLK*NW,KVBLK=64,NQB=SEQ/QB;
constexpr int ATTN_PITCH=DM, ATTN_UNIT_ROWS=QB;
__device__ __forceinline__ int crow(int r,int hi){return (r&3)+8*(r>>2)+4*hi;}
#define SBAR() __builtin_amdgcn_sched_barrier(0)
__device__ __forceinline__ void cmask(f32x16&p0,f32x16&p1,int jb,int qrel,int hi){
  const float NEG=-INFINITY; int kb=64*jb+4*hi;
  #pragma unroll
  for(int r=0;r<16;++r){int kv=kb+(r&3)+8*(r>>2); if(kv>qrel)p0[r]=NEG; if(kv+32>qrel)p1[r]=NEG;}
}

constexpr int NSLOT=3, SLOTB=8192; typedef float f32x4v __attribute__((ext_vector_type(4))); constexpr int LDS_BIAS=86016;
constexpr int LDS_K=0, LDS_V=NSLOT*SLOTB, LDS_WS=2*NSLOT*SLOTB, LDS_OST=LDS_WS+NW*64*4, LDS_BYTES=LDS_OST+NW*4096;
constexpr float C2=0.125f*1.4426950408889634f;
__device__ __forceinline__ void glds16(const void*gsrc,unsigned lds_dst){unsigned keep;
  asm volatile("s_mov_b32 %0, m0\n\ts_mov_b32 m0, %2\n\ts_nop 0\n\tglobal_load_lds_dwordx4 %1, off\n\ts_mov_b32 m0, %0":"=&s"(keep):"v"(gsrc),"s"(lds_dst):"memory");}
__device__ __forceinline__ float max3f(float a,float b,float c){float r;asm("v_max3_f32 %0, %1, %2, %3":"=v"(r):"v"(a),"v"(b),"v"(c));return r;}
__device__ __forceinline__ float max2f(float a,float b){float r;asm("v_max_f32_e32 %0, %1, %2":"=v"(r):"v"(a),"v"(b));return r;}
__device__ __forceinline__ float fadd_s(float a,float b){float r;asm("v_add_f32_e32 %0, %1, %2":"=v"(r):"v"(a),"v"(b));return r;}
__device__ __forceinline__ float fsub_s(float a,float b){float r;asm("v_sub_f32_e32 %0, %1, %2":"=v"(r):"v"(a),"v"(b));return r;}
typedef float f32x2_t __attribute__((ext_vector_type(2))); typedef __bf16 bf16x2_t __attribute__((ext_vector_type(2)));
__device__ __forceinline__ unsigned cvtpk_s(float lo,float hi){f32x2_t v={lo,hi};bf16x2_t b=__builtin_convertvector(v,bf16x2_t);return __builtin_bit_cast(unsigned,b);}
#define WAIT_BAR(N) asm volatile("s_waitcnt vmcnt(" #N ") lgkmcnt(0)\n\ts_barrier":::"memory")

__device__ __forceinline__ void qkt(f32x16&p0,f32x16&p1,const char*Kslot,const bf16x8*qr,const f32x16&negm,int r32,int hi){
  const char*kb=Kslot+hi*1024+r32*16;
  #pragma unroll
  for(int d0=0;d0<4;++d0){
    const bf16x8 b0=*reinterpret_cast<const bf16x8*>(kb+d0*2048);
    const bf16x8 b1=*reinterpret_cast<const bf16x8*>(kb+d0*2048+512);
    if(d0==0){p0=__builtin_amdgcn_mfma_f32_32x32x16_bf16(b0,qr[0],negm,0,0,0);p1=__builtin_amdgcn_mfma_f32_32x32x16_bf16(b1,qr[0],negm,0,0,0);}
    else{p0=__builtin_amdgcn_mfma_f32_32x32x16_bf16(b0,qr[d0],p0,0,0,0);p1=__builtin_amdgcn_mfma_f32_32x32x16_bf16(b1,qr[d0],p1,0,0,0);}}
}
typedef __attribute__((address_space(3))) const char* lds_cptr;
typedef short v4i16_t __attribute__((ext_vector_type(4)));
__device__ __forceinline__ void kload8(bf16x8*kf,lds_cptr kp){
  kf[0]=*(const __attribute__((address_space(3))) bf16x8*)(kp);      kf[1]=*(const __attribute__((address_space(3))) bf16x8*)(kp+512);
  kf[2]=*(const __attribute__((address_space(3))) bf16x8*)(kp+2048); kf[3]=*(const __attribute__((address_space(3))) bf16x8*)(kp+2560);
  kf[4]=*(const __attribute__((address_space(3))) bf16x8*)(kp+4096); kf[5]=*(const __attribute__((address_space(3))) bf16x8*)(kp+4608);
  kf[6]=*(const __attribute__((address_space(3))) bf16x8*)(kp+6144); kf[7]=*(const __attribute__((address_space(3))) bf16x8*)(kp+6656);
}
__device__ __forceinline__ void kload2(bf16x8*kf,lds_cptr kp,int j){ kf[2*j]=*(const __attribute__((address_space(3))) bf16x8*)(kp+j*2048); kf[2*j+1]=*(const __attribute__((address_space(3))) bf16x8*)(kp+j*2048+512); }
__device__ __forceinline__ s16x4 vtr(lds_cptr p){ return __builtin_bit_cast(s16x4,__builtin_amdgcn_ds_read_tr16_b64_v4i16((__attribute__((address_space(3))) v4i16_t*)p)); }
__device__ __forceinline__ float rowmax(const f32x16&p0,const f32x16&p1){
  float a=max3f(p0[0],p0[1],p1[0]),b=max3f(p0[2],p0[3],p1[1]);a=max3f(a,p1[2],p1[3]);
  #pragma unroll
  for(int r=4;r<16;r+=4){a=max3f(a,p0[r],p0[r+1]);b=max3f(b,p0[r+2],p0[r+3]);a=max3f(a,p1[r],p1[r+1]);b=max3f(b,p1[r+2],p1[r+3]);}
  const float m=max2f(a,b);
  auto rr=__builtin_amdgcn_permlane32_swap(__float_as_uint(m),__float_as_uint(m),false,false);
  return max2f(__uint_as_float(rr[0]),__uint_as_float(rr[1]));
}
__device__ __forceinline__ void pv(f32x16*o,int vb,bf16x8 pa0,bf16x8 pa1,bf16x8 pa2,bf16x8 pa3){
  #pragma unroll
  for(int d0=0;d0<2;++d0){s16x4 lo[4],hi[4];
    #pragma unroll
    for(int ks=0;ks<4;++ks){
      asm volatile("ds_read_b64_tr_b16 %0,%1 offset:%c2":"=&v"(lo[ks]):"v"(vb),"i"(d0*4096+ks*1024):"memory");
      asm volatile("ds_read_b64_tr_b16 %0,%1 offset:%c2":"=&v"(hi[ks]):"v"(vb),"i"(d0*4096+ks*1024+512):"memory");}
    asm volatile("s_waitcnt lgkmcnt(0)":::"memory");SBAR();
    #define PK(k) (bf16x8){lo[k][0],lo[k][1],lo[k][2],lo[k][3],hi[k][0],hi[k][1],hi[k][2],hi[k][3]}
    o[d0]=__builtin_amdgcn_mfma_f32_32x32x16_bf16(pa0,PK(0),o[d0],0,0,0);
    o[d0]=__builtin_amdgcn_mfma_f32_32x32x16_bf16(pa1,PK(1),o[d0],0,0,0);
    o[d0]=__builtin_amdgcn_mfma_f32_32x32x16_bf16(pa2,PK(2),o[d0],0,0,0);
    o[d0]=__builtin_amdgcn_mfma_f32_32x32x16_bf16(pa3,PK(3),o[d0],0,0,0);
    #undef PK
  }
}

#ifndef ATTN_STORE16
#define ATTN_STORE16(p,v) (*(u32x4*)(p)=(v))
#endif
template<int THRL> __device__ __forceinline__ void attn_unit(const int wave_s,int qb,const bf16*Qh,const bf16*__restrict__ Kh,const bf16*__restrict__ Vh,bf16*Oh,const float*__restrict__ cbias,const float qk2,char*shm){
  const int wid=wave_s; const int tid=wave_s*64+fresh_lane(),lane=tid&63,r32=lane&31,hi=lane>>5;
  const int q0=qb*QB;
  const bf16*Qw=Qh+(long)(q0+wid*QBLK)*DM;
  int t0; { const int ntab=(q0+QB)/KVBLK; const float thr=cbias[q0]-(qk2+44.0f); const int l_=tid&63;
    const bool c0_=(l_<ntab-4)&&(cbias[l_*64+63]<thr), c1_=(l_+64<ntab-4)&&(cbias[(l_+64)*64+63]<thr);
    t0=(__builtin_popcountll(__ballot(c0_))+__builtin_popcountll(__ballot(c1_)))&~1; t0=__builtin_amdgcn_readfirstlane(t0); }
  Kh+=(long)t0*KVBLK*DM; Vh+=(long)t0*KVBLK*DM; cbias+=t0*KVBLK;
  const unsigned lds0=(unsigned)(uintptr_t)shm;
  float*wsf=(float*)(shm+LDS_WS)+wid*64;
  const bf16*ksrc=Kh+(long)lane*DM+wid*8;
  const bf16*vsrc=Vh+(long)(16*(wid&3)+(lane>>2))*DM+(wid>>2)*32+(lane&3)*8;
  const unsigned kdst=lds0+LDS_K+wid*1024, vdst=lds0+LDS_V+wid*1024;
  #define DMA_K(t,slot) glds16(ksrc+(long)(t)*KVBLK*DM,(unsigned)__builtin_amdgcn_readfirstlane(kdst+(slot)))
  #define DMA_V(t,slot) glds16(vsrc+(long)(t)*KVBLK*DM,(unsigned)__builtin_amdgcn_readfirstlane(vdst+(slot)))
  const int vb0=(int)(lds0+LDS_V)+((lane>>4)&1)*32+(lane&3)*8+(4*hi+((lane&15)>>2))*64;
  const char*Kbase=shm+LDS_K; bf16x8 kf[8];
  const lds_cptr shm3=(lds_cptr)shm; const lds_cptr kp0=shm3+LDS_K+hi*1024+r32*16; const lds_cptr vp0=shm3+LDS_V+((lane>>4)&1)*32+(lane&3)*8+(4*hi+((lane&15)>>2))*64;
  { const int nk4=((q0+QB)>>2)-t0*16; __attribute__((address_space(3))) f32x4v* bt=(__attribute__((address_space(3))) f32x4v*)((lds_cptr)shm+LDS_BIAS); for(int i=tid;i<nk4;i+=NW*64) bt[i]=((const f32x4v*)cbias)[i]; }
  const int NT=(q0+QB)/KVBLK-t0;
  DMA_K(0,0);DMA_V(0,0);DMA_K(1,SLOTB);
  bf16x8 qr[4];
  #pragma unroll
  for(int d0=0;d0<4;++d0)qr[d0]=*reinterpret_cast<const bf16x8*>(&Qw[(long)r32*DM+d0*16+hi*8]);
  float mhat=0.f,l_reg=0.f;float zf_=0.f;asm volatile("":"+v"(zf_));f32x16 o[2];f32x16 negm;
  _Pragma("unroll") for(int r=0;r<16;++r){o[0][r]=zf_;o[1][r]=zf_;negm[r]=zf_;} asm volatile("":"+v"(negm));
  const int qrel=wid*QBLK+r32;
  #define CMASK(P0,P1,t) do{int jb_=(t)-(NT-4); if(jb_>=0)cmask(P0,P1,jb_,qrel,hi);}while(0)
  #define BIAS(P0,P1,t) do{ const __attribute__((address_space(3))) f32x4v* bt_=(const __attribute__((address_space(3))) f32x4v*)(shm3+LDS_BIAS)+(t)*16+hi; \
    _Pragma("unroll") for(int i_=0;i_<4;++i_){ const f32x4v b0_=bt_[2*i_], b1_=bt_[8+2*i_]; \
      P0[4*i_]+=b0_[0];P0[4*i_+1]+=b0_[1];P0[4*i_+2]+=b0_[2];P0[4*i_+3]+=b0_[3]; P1[4*i_]+=b1_[0];P1[4*i_+1]+=b1_[1];P1[4*i_+2]+=b1_[2];P1[4*i_+3]+=b1_[3]; } }while(0)
  bool resc=false;
  #define START(P0,P1) do{ const float rm=rowmax(P0,P1); resc=false; \
    { const float dl=rm; mhat=fadd_s(mhat,dl); \
      _Pragma("unroll") for(int r=0;r<16;++r){P0[r]=fsub_s(P0[r],dl);P1[r]=fsub_s(P1[r],dl);} \
      _Pragma("unroll") for(int r=0;r<16;++r)negm[r]=-mhat; asm volatile("":"+v"(negm)); } \
    _Pragma("unroll") for(int r=0;r<16;++r)P0[r]=__builtin_amdgcn_exp2f(P0[r]); }while(0)
  #define RESC() do{ if(resc){ asm volatile("s_waitcnt lgkmcnt(0)":::"memory"); \
      _Pragma("unroll") for(int d_=0;d_<2;++d_) _Pragma("unroll") for(int r=0;r<16;++r)o[d_][r]*=wsf[crow(r,hi)]; } }while(0)
  f32x16 pA0,pA1,pB0,pB1;
  int sl_prev=0,sl_cur=0,sl_next=SLOTB;
  #define ROT() do{sl_prev=sl_cur;sl_cur=sl_next;sl_next=(sl_next==(NSLOT-1)*SLOTB)?0:sl_next+SLOTB;}while(0)
  DMA_K(2,2*SLOTB);
  WAIT_BAR(3);
  qkt(pA0,pA1,Kbase,qr,negm,r32,hi);asm volatile("s_nop 15\n\ts_nop 7":"+v"(pA0),"+v"(pA1));BIAS(pA0,pA1,0);CMASK(pA0,pA1,0);
  START(pA0,pA1);
  _Pragma("unroll") for(int r=0;r<16;++r)pA1[r]=__builtin_amdgcn_exp2f(pA1[r]);
  WAIT_BAR(0);
  DMA_K(3,0);DMA_V(1,SLOTB);
  ROT();
  kload8(kf,kp0+sl_cur);
  WAIT_BAR(2);
  s16x4 vlo[8],vhi[8]; u32x4 pw0,pw1,pw2,pw3;
  #define PKW(P,B) cvtpk_s(P[B],P[B+1])
  #define PAF(k) __builtin_bit_cast(bf16x8,pw##k)
  #define VFR(i) (bf16x8){vlo[i][0],vlo[i][1],vlo[i][2],vlo[i][3],vhi[i][0],vhi[i][1],vhi[i][2],vhi[i][3]}
  #define PIN(x) asm volatile("":"+v"(x))
  #define MX3(a,b,c) __builtin_fmaxf(__builtin_fmaxf((a),(b)),(c))
  #define GAPA(MF,A0,A1,A2,A3,W0,W1,PW) do{ MF; sacc+=A0; sacc+=A1; sacc+=A2; sacc+=A3; PIN(sacc); W0; W1; PIN(PW); SBAR(); }while(0)
  #define EX(v) __builtin_amdgcn_exp2f(v)
  #define GAPB(MF,X,B) do{ MF; X[B]=EX(X[B]); X[B+1]=EX(X[B+1]); X[B+2]=EX(X[B+2]); X[B+3]=EX(X[B+3]); PIN(X); SBAR(); }while(0)
  #define VRD(i) do{ vlo[i]=vtr(vp_+(((i)>>2)*4096+((i)&3)*1024)); vhi[i]=vtr(vp_+(((i)>>2)*4096+((i)&3)*1024+512)); }while(0)
  #define KRD(G,j) do{ if(G){ kload2(kf,kp0+sl_next,j); SBAR(); } }while(0)
  #define STEP(C0,C1,P0,P1,t,GK,GV,GL) do{ SBAR(); \
    const lds_cptr vp_=vp0+sl_prev; \
    VRD(0); SBAR(); float sacc=(P0[0]+P0[1]); \
    GAPA(C0=__builtin_amdgcn_mfma_f32_32x32x16_bf16(kf[0],qr[0],negm,0,0,0), P0[2],P0[3],P0[4],P0[5],     pw0[0]=PKW(P0,0), pw0[1]=PKW(P0,2), pw0); \
    VRD(4); SBAR(); GAPA(C1=__builtin_amdgcn_mfma_f32_32x32x16_bf16(kf[1],qr[0],negm,0,0,0), P0[6],P0[7],P0[8],P0[9],     pw0[2]=PKW(P0,4), pw0[3]=PKW(P0,6), pw0); \
    VRD(1); SBAR(); GAPA(C0=__builtin_amdgcn_mfma_f32_32x32x16_bf16(kf[2],qr[1],C0,0,0,0),   P0[10],P0[11],P0[12],P0[13], pw1[0]=PKW(P0,8), pw1[1]=PKW(P0,10), pw1); \
    VRD(5); SBAR(); GAPA(C1=__builtin_amdgcn_mfma_f32_32x32x16_bf16(kf[3],qr[1],C1,0,0,0),   P0[14],P0[15],P1[0],P1[1],   pw1[2]=PKW(P0,12),pw1[3]=PKW(P0,14), pw1); \
    VRD(2); SBAR(); GAPA(C0=__builtin_amdgcn_mfma_f32_32x32x16_bf16(kf[4],qr[2],C0,0,0,0),   P1[2],P1[3],P1[4],P1[5],     pw2[0]=PKW(P1,0), pw2[1]=PKW(P1,2), pw2); \
    VRD(6); SBAR(); GAPA(C1=__builtin_amdgcn_mfma_f32_32x32x16_bf16(kf[5],qr[2],C1,0,0,0),   P1[6],P1[7],P1[8],P1[9],     pw2[2]=PKW(P1,4), pw2[3]=PKW(P1,6), pw2); \
    VRD(3); SBAR(); GAPA(C0=__builtin_amdgcn_mfma_f32_32x32x16_bf16(kf[6],qr[3],C0,0,0,0),   P1[10],P1[11],P1[12],P1[13], pw3[0]=PKW(P1,8), pw3[1]=PKW(P1,10), pw3); \
    VRD(7); SBAR(); GAPA(C1=__builtin_amdgcn_mfma_f32_32x32x16_bf16(kf[7],qr[3],C1,0,0,0),   P1[14],P1[15],0.f,0.f,       pw3[2]=PKW(P1,12),pw3[3]=PKW(P1,14), pw3); \
    l_reg+=sacc; \
    if(GK){DMA_K((t)+3,sl_cur);} if(GV){DMA_V((t)+1,sl_next);} \
    BIAS(C0,C1,t); CMASK(C0,C1,t); \
    { float a=MX3(C0[0],C0[1],C1[0]),b=MX3(C0[2],C0[3],C1[1]); a=MX3(a,C1[2],C1[3]); \
      _Pragma("unroll") for(int r=4;r<16;r+=4){a=MX3(a,C0[r],C0[r+1]);b=MX3(b,C0[r+2],C0[r+3]);a=MX3(a,C1[r],C1[r+1]);b=MX3(b,C1[r+2],C1[r+3]);} \
      float rm=__builtin_fmaxf(a,b); { auto rr=__builtin_amdgcn_permlane32_swap(__float_as_uint(rm),__float_as_uint(rm),false,false); rm=__builtin_fmaxf(__uint_as_float(rr[0]),__uint_as_float(rr[1])); } \
      resc=false; \
      if(__builtin_expect(__any(rm>(float)THRL),0)){ const float dl=__builtin_fmaxf(rm,0.f); mhat+=dl; \
        _Pragma("unroll") for(int r=0;r<16;++r){C0[r]-=dl;C1[r]-=dl;} \
        _Pragma("unroll") for(int r=0;r<16;++r)negm[r]=-mhat; asm volatile("":"+v"(negm)); \
        const float f=__builtin_amdgcn_exp2f(-dl); l_reg*=f; if(hi==0)wsf[r32]=f; resc=true; } } \
    SBAR(); \
    GAPB(o[0]=__builtin_amdgcn_mfma_f32_32x32x16_bf16(PAF(0),VFR(0),o[0],0,0,0), C0,0); \
    GAPB(o[1]=__builtin_amdgcn_mfma_f32_32x32x16_bf16(PAF(0),VFR(4),o[1],0,0,0), C0,4); \
    KRD(GL,0); GAPB(o[0]=__builtin_amdgcn_mfma_f32_32x32x16_bf16(PAF(1),VFR(1),o[0],0,0,0), C0,8); \
    KRD(GL,1); GAPB(o[1]=__builtin_amdgcn_mfma_f32_32x32x16_bf16(PAF(1),VFR(5),o[1],0,0,0), C0,12); \
    KRD(GL,2); GAPB(o[0]=__builtin_amdgcn_mfma_f32_32x32x16_bf16(PAF(2),VFR(2),o[0],0,0,0), C1,0); \
    KRD(GL,3); GAPB(o[1]=__builtin_amdgcn_mfma_f32_32x32x16_bf16(PAF(2),VFR(6),o[1],0,0,0), C1,4); \
    GAPB(o[0]=__builtin_amdgcn_mfma_f32_32x32x16_bf16(PAF(3),VFR(3),o[0],0,0,0), C1,8); \
    GAPB(o[1]=__builtin_amdgcn_mfma_f32_32x32x16_bf16(PAF(3),VFR(7),o[1],0,0,0), C1,12); \
    }while(0)
  int t=1;
  #undef CMASK
  #define CMASK(P0,P1,t) do{}while(0)
  for(;t+5<NT;t+=2){
    STEP(pB0,pB1,pA0,pA1,t,true,true,true);     WAIT_BAR(2); RESC(); ROT();
    STEP(pA0,pA1,pB0,pB1,t+1,true,true,true);   WAIT_BAR(2); RESC(); ROT();
  }
  #undef CMASK
  #define CMASK(P0,P1,t) do{int jb_=(t)-(NT-4); if(jb_>=0)cmask(P0,P1,jb_,qrel,hi);}while(0)
  #define ENDW(tt) do{ if((tt)+3<NT){WAIT_BAR(2);} else if((tt)+2<NT){WAIT_BAR(1);} else {WAIT_BAR(0);} }while(0)
  for(;t+1<NT;t+=2){
    STEP(pB0,pB1,pA0,pA1,t,(t+3<NT),(t+1<NT),(t+1<NT));       ENDW(t);   RESC(); ROT();
    STEP(pA0,pA1,pB0,pB1,t+1,(t+4<NT),(t+2<NT),(t+2<NT));     ENDW(t+1); RESC(); ROT();
  }
  STEP(pB0,pB1,pA0,pA1,NT-1,false,false,false); RESC();
  { float sacc=pB0[0]+pB0[1]; _Pragma("unroll") for(int r=2;r<16;++r)sacc+=pB0[r]; _Pragma("unroll") for(int r=0;r<16;++r)sacc+=pB1[r]; l_reg+=sacc;
    pw0=(u32x4){PKW(pB0,0),PKW(pB0,2),PKW(pB0,4),PKW(pB0,6)};pw1=(u32x4){PKW(pB0,8),PKW(pB0,10),PKW(pB0,12),PKW(pB0,14)};pw2=(u32x4){PKW(pB1,0),PKW(pB1,2),PKW(pB1,4),PKW(pB1,6)};pw3=(u32x4){PKW(pB1,8),PKW(pB1,10),PKW(pB1,12),PKW(pB1,14)};
    SBAR(); pv(o,vb0+sl_cur,PAF(0),PAF(1),PAF(2),PAF(3)); }
  #undef PKW
  #undef PAF
  #undef VFR
  #undef PIN
  #undef MX3
  #undef GAPA
  #undef GAPB
  #undef EX
  #undef VRD
  #undef KRD
  #undef STEP
  #undef ENDW
  {auto rr=__builtin_amdgcn_permlane32_swap(__float_as_uint(l_reg),__float_as_uint(l_reg),false,false);l_reg=__uint_as_float(rr[0])+__uint_as_float(rr[1]);}
  if(hi==0)wsf[32+r32]=l_reg;asm volatile("s_waitcnt lgkmcnt(0)":::"memory");
  float rli[16];
  #pragma unroll
  for(int r=0;r<16;++r)rli[r]=__builtin_amdgcn_rcpf(wsf[32+crow(r,hi)]);
  bf16*Ow=Oh+(long)(q0+wid*QBLK)*DM;
  { bf16*stg=(bf16*)(shm+LDS_OST)+wid*2048;
    #pragma unroll
    for(int r=0;r<16;++r){const int orow=crow(r,hi);
      #pragma unroll
      for(int d0=0;d0<2;++d0)stg[orow*64+d0*32+r32]=__float2bfloat16(o[d0][r]*rli[r]);}
    asm volatile("s_waitcnt lgkmcnt(0)":::"memory");
    #pragma unroll
    for(int i=0;i<4;++i){const int row=i*8+(lane>>3),ch=lane&7; const u32x4 v=*(const u32x4*)(stg+row*64+ch*8); ATTN_STORE16(Ow+(long)row*DM+ch*8,v);} }
  asm volatile("s_waitcnt lgkmcnt(0)\n\ts_barrier":::"memory");
  #undef DMA_K
  #undef DMA_V
  #undef CMASK
  #undef START
  #undef RESC
  #undef ROT
  #undef BIAS
}
constexpr int ATTN_LDS_BYTES=LDS_BYTES;
constexpr int SWA_K=0, SWA_V=6*SLOTB, SWA_OST=12*SLOTB, SWA_WS=133120;
__device__ __forceinline__ void swa_unit(const int wave_s,int qb,const bf16*Qh,const bf16*__restrict__ Kh,const bf16*__restrict__ Vh,bf16*Oh,float slope2,float sink2,char*shm){
  const int wid=wave_s; const int tid=wave_s*64+fresh_lane(),lane=tid&63,r32=lane&31,hi=lane>>5;
  const int q0=qb*QB, c0=4*qb-2;
  const bf16*Qw=Qh+(long)(q0+wid*QBLK)*DM;
  const unsigned lds0=(unsigned)(uintptr_t)shm;
  float*wsf=(float*)(shm+SWA_WS)+wid*64;
  const bf16*ksrc=Kh+(long)lane*DM+wid*8;
  const bf16*vsrc=Vh+(long)(16*(wid&3)+(lane>>2))*DM+(wid>>2)*32+(lane&3)*8;
  const unsigned kdst=lds0+SWA_K+wid*1024, vdst=lds0+SWA_V+wid*1024;
  #pragma unroll
  for(int s=0;s<6;++s){ const int ch=c0+s; if(ch>=0){ glds16(ksrc+(long)ch*KVBLK*DM,(unsigned)__builtin_amdgcn_readfirstlane(kdst+s*SLOTB)); glds16(vsrc+(long)ch*KVBLK*DM,(unsigned)__builtin_amdgcn_readfirstlane(vdst+s*SLOTB)); } }
  bf16x8 qr[4];
  #pragma unroll
  for(int d0=0;d0<4;++d0)qr[d0]=*reinterpret_cast<const bf16x8*>(&Qw[(long)r32*DM+d0*16+hi*8]);
  WAIT_BAR(0);
  const int wc=wid>>1, qrel=(wid&1)*32+r32;
  f32x16 zero=f32x16{}; asm volatile("":"+v"(zero));
  f32x16 S[3][2];
  #pragma unroll
  for(int t=0;t<3;++t){
    if(c0+wc+t>=0){
      qkt(S[t][0],S[t][1],shm+SWA_K+(wc+t)*SLOTB,qr,zero,r32,hi);
      const float qf=(float)(64*(2-t)+qrel-4*hi);
      #pragma unroll
      for(int r=0;r<16;++r){ const float dd=qf-(float)((r&3)+8*(r>>2)); S[t][0][r]=__builtin_fmaf(-slope2,__builtin_fabsf(dd),S[t][0][r]); S[t][1][r]=__builtin_fmaf(-slope2,__builtin_fabsf(dd-32.f),S[t][1][r]); }
    } else {
      #pragma unroll
      for(int r=0;r<16;++r){ S[t][0][r]=-INFINITY; S[t][1][r]=-INFINITY; }
    }
  }
  float m=sink2;
  #pragma unroll
  for(int t=0;t<3;++t) m=__builtin_fmaxf(m,rowmax(S[t][0],S[t][1]));
  float l=0.f;
  #pragma unroll
  for(int t=0;t<3;++t){
    #pragma unroll
    for(int r=0;r<16;++r){ S[t][0][r]=__builtin_amdgcn_exp2f(S[t][0][r]-m); S[t][1][r]=__builtin_amdgcn_exp2f(S[t][1][r]-m); l+=S[t][0][r]+S[t][1][r]; }
  }
  {auto rr=__builtin_amdgcn_permlane32_swap(__float_as_uint(l),__float_as_uint(l),false,false);l=__uint_as_float(rr[0])+__uint_as_float(rr[1]);}
  l+=__builtin_amdgcn_exp2f(sink2-m);
  f32x16 o[2];o[0]=f32x16{};o[1]=f32x16{};
  const int vb0=(int)(lds0+SWA_V)+((lane>>4)&1)*32+(lane&3)*8+(4*hi+((lane&15)>>2))*64;
  #pragma unroll
  for(int t=0;t<3;++t){
    if(c0+wc+t>=0){
      #define PKW(P,B) cvtpk_s(P[B],P[B+1])
      const u32x4 pw0=(u32x4){PKW(S[t][0],0),PKW(S[t][0],2),PKW(S[t][0],4),PKW(S[t][0],6)},pw1=(u32x4){PKW(S[t][0],8),PKW(S[t][0],10),PKW(S[t][0],12),PKW(S[t][0],14)};
      const u32x4 pw2=(u32x4){PKW(S[t][1],0),PKW(S[t][1],2),PKW(S[t][1],4),PKW(S[t][1],6)},pw3=(u32x4){PKW(S[t][1],8),PKW(S[t][1],10),PKW(S[t][1],12),PKW(S[t][1],14)};
      #undef PKW
      SBAR(); pv(o,vb0+(wc+t)*SLOTB,__builtin_bit_cast(bf16x8,pw0),__builtin_bit_cast(bf16x8,pw1),__builtin_bit_cast(bf16x8,pw2),__builtin_bit_cast(bf16x8,pw3));
    }
  }
  if(hi==0)wsf[32+r32]=l;asm volatile("s_waitcnt lgkmcnt(0)":::"memory");
  float rli[16];
  #pragma unroll
  for(int r=0;r<16;++r)rli[r]=__builtin_amdgcn_rcpf(wsf[32+crow(r,hi)]);
  bf16*Ow=Oh+(long)(q0+wid*QBLK)*DM;
  { bf16*stg=(bf16*)(shm+SWA_OST)+wid*2048;
    #pragma unroll
    for(int r=0;r<16;++r){const int orow=crow(r,hi);
      #pragma unroll
      for(int d0=0;d0<2;++d0)stg[orow*64+d0*32+r32]=__float2bfloat16(o[d0][r]*rli[r]);}
    asm volatile("s_waitcnt lgkmcnt(0)":::"memory");
    #pragma unroll
    for(int i=0;i<4;++i){const int row=i*8+(lane>>3),ch=lane&7; const u32x4 v=*(const u32x4*)(stg+row*64+ch*8); ATTN_STORE16(Ow+(long)row*DM+ch*8,v);} }
  asm volatile("s_waitcnt lgkmcnt(0)\n\ts_barrier":::"memory");
}

#undef SBAR
#undef WAIT_BAR
}

namespace cg = cooperative_groups;
constexpr int NWAVES = 8;
constexpr int BATCH = 2, T = 8192, D = 1024, FF = 4096, PLE = 256, DIN_SRC = 4360, NZ = 4352, M = BATCH * T;
constexpr float RMS_EPS = 1e-6f, LOG2E = 1.4426950408889634f;
constexpr size_t MiB = 1u << 20;
constexpr size_t WS_WIN = 0, WS_WA = 9 * MiB, WS_WB = 10 * MiB, WS_WMIX = 11 * MiB, WS_W1 = 13 * MiB, WS_W2 = 21 * MiB, WS_WG = 29 * MiB, WS_WP = 31 * MiB;
constexpr size_t WS_LF = 31 * MiB + 512 * 1024, WS_CB = 32 * MiB;
constexpr size_t WS_NM = 32 * MiB + 512 * 1024;
constexpr size_t WS_ST1 = 33 * MiB, WS_ST2 = 34 * MiB, WS_ST3 = 35 * MiB;
constexpr size_t WS_PB = 36 * MiB;
constexpr size_t WS_XN = 44 * MiB;
constexpr size_t WS_HN = 76 * MiB;
constexpr size_t WS_Z = 108 * MiB;
constexpr size_t WS_CTL = 244 * MiB, CTL_ZERO_BYTES = 16384;
constexpr size_t WS_END = 245 * MiB;
constexpr int RING_BYTES = 131072, LDS_BYTES = 147456, MISC_OFF = RING_BYTES + 320;
#define GAS __attribute__((address_space(1)))
#define LAS __attribute__((address_space(3)))
typedef unsigned short bf16;
typedef unsigned v4u __attribute__((ext_vector_type(4)));
typedef unsigned v2u __attribute__((ext_vector_type(2)));
typedef float f32x4 __attribute__((ext_vector_type(4)));
#define LDS_WAIT() asm volatile("s_waitcnt lgkmcnt(0)" ::: "memory")
__device__ __forceinline__ unsigned f2bf(float f) { unsigned u = __builtin_bit_cast(unsigned, f); return (u + 0x7fffu + ((u >> 16) & 1u)) >> 16; }
__device__ __forceinline__ unsigned pk2(float lo, float hi) { return f2bf(lo) | (f2bf(hi) << 16); }
__device__ __forceinline__ float wave_sum(float v) {
#pragma unroll
    for (int o = 1; o < 64; o <<= 1) v += __shfl_xor(v, o);
    return v;
}
#define RLX_AGENT __ATOMIC_RELAXED, __HIP_MEMORY_SCOPE_AGENT
#define XB_TMO      128
#define XB_XCNT(j)  (256  + 64 * (j))
#define XB_XSUB(j)  (1280 + 64 * (j))
#define XB_XGEN(j)  (2304 + 64 * (j))
#define XB_TOP      3328
#define XB_TOPGEN   3392
#define XCD_BAR_WORDS 3456
#define XB_SPIN_CAP (1u << 18)

__device__ __forceinline__ unsigned xb_ld(unsigned* p)              { return __hip_atomic_load(p, __ATOMIC_RELAXED, __HIP_MEMORY_SCOPE_AGENT); }
__device__ __forceinline__ unsigned xb_add(unsigned* p, unsigned v) { return __hip_atomic_fetch_add(p, v, __ATOMIC_RELAXED, __HIP_MEMORY_SCOPE_AGENT); }
__device__ __forceinline__ unsigned xb_xcc_id() { return (unsigned)__builtin_amdgcn_s_getreg((3 << 11) | 20) & 0xFu; }
#define XB_SPIN(cond, bar) do { unsigned _sp = 0; while (cond) { __builtin_amdgcn_s_sleep(1); \
    if ((++_sp & 255u) == 0u) { if (xb_ld(&(bar)[XB_TMO])) break; if (_sp > XB_SPIN_CAP) { atomicAdd(&(bar)[XB_TMO], 1u); break; } } } } while (0)

struct XcdBarrier {
    unsigned* bar; unsigned x;
    volatile LAS unsigned* st;
};

__device__ __forceinline__ XcdBarrier xcd_barrier_post(unsigned* bar, volatile LAS unsigned* st) {
    XcdBarrier b; b.bar = bar; b.x = xb_xcc_id(); b.st = st;
    if (threadIdx.x == 0) (void)xb_add(&bar[XB_XCNT(b.x)], 1u);
    return b;
}
__device__ __forceinline__ void xcd_barrier_complete(unsigned* bar, unsigned x, unsigned& nloc, unsigned& nx) {
    const unsigned G = gridDim.x * gridDim.y * gridDim.z;
    unsigned sum, cnt, mine, sp = 0u;
    for (;;) {
        sum = 0u; cnt = 0u; mine = 0u;
#pragma unroll
        for (unsigned j = 0; j < 16; ++j) { const unsigned c = xb_ld(&bar[XB_XCNT(j)]); sum += c; cnt += (c > 0u) ? 1u : 0u; mine = (j == x) ? c : mine; }
        if (sum == G) break;
        __builtin_amdgcn_s_sleep(1);
        if ((++sp & 255u) == 0u) { if (xb_ld(&bar[XB_TMO])) break; if (sp > XB_SPIN_CAP) { atomicAdd(&bar[XB_TMO], 1u); break; } }
    }
    nloc = mine > 0u ? mine : 1u; nx = cnt > 0u ? cnt : 1u;
}

__device__ __forceinline__ void xcd_barrier(const XcdBarrier& b, const bool t0) {
    asm volatile("s_waitcnt vmcnt(0)" ::: "memory");
    __syncthreads();
    if (t0) {
        unsigned* bar = b.bar;
        __builtin_amdgcn_s_waitcnt(0);
        unsigned nloc = b.st[0], nx = b.st[1];
        if (nloc == 0u) { xcd_barrier_complete(bar, b.x, nloc, nx); b.st[0] = nloc; b.st[1] = nx; }
        const unsigned old = xb_add(&bar[XB_XSUB(b.x)], 1u);
        const unsigned gen = old / nloc;
        if (old + 1u == (gen + 1u) * nloc) {
            __builtin_amdgcn_fence(__ATOMIC_RELEASE, "agent");
            asm volatile("s_waitcnt vmcnt(0)" ::: "memory");
            const unsigned og = xb_add(&bar[XB_TOP], 1u);
            const unsigned tg = og / nx;
            if (og + 1u == (tg + 1u) * nx) xb_add(&bar[XB_TOPGEN], 1u);
            else XB_SPIN(xb_ld(&bar[XB_TOPGEN]) == tg, bar);
            __builtin_amdgcn_fence(__ATOMIC_ACQUIRE, "agent");
            xb_add(&bar[XB_XGEN(b.x)], 1u);
            asm volatile("s_waitcnt vmcnt(0)" ::: "memory");
        } else {
            XB_SPIN(xb_ld(&bar[XB_XGEN(b.x)]) == gen, bar);
            __builtin_amdgcn_fence(__ATOMIC_ACQUIRE, "agent");
            asm volatile("s_waitcnt vmcnt(0)" ::: "memory");
        }
    }
    __syncthreads();
}
struct Frame {
    LAS unsigned char* lds; int wave, vcu, G;
};
__device__ __forceinline__ void p0_transpose_item(const float* W, int ldw, int K, int N, int split, int extra, const float* gs, bf16* WT, LAS float* scr, int item, int lane) {
    const int nblk = N / 32, kb = item / nblk, nb = item % nblk, k0 = 64 * kb, n0 = 32 * nb, s0 = n0 + (n0 >= split ? extra : 0);
    const float* src = W + (size_t)(k0 + (lane >> 5)) * ldw + s0 + (lane & 31);
    float w[32];
#pragma unroll
    for (int i = 0; i < 32; ++i) w[i] = src[(size_t)(2 * i) * ldw];
    const int c = lane & 7;
    f32x4 g0 = (f32x4){1.f, 1.f, 1.f, 1.f}, g1 = g0;
    if (gs) { g0 = *(const f32x4*)(gs + k0 + 8 * c); g1 = *(const f32x4*)(gs + k0 + 8 * c + 4); }
#pragma unroll
    for (int i = 0; i < 32; ++i) scr[(2 * i + (lane >> 5)) * 33 + (lane & 31)] = w[i];
    LDS_WAIT(); asm volatile("" ::: "memory");
#pragma unroll
    for (int j = 0; j < 4; ++j) { const int n = (lane >> 3) + 8 * j; const LAS float* s = scr + (8 * c) * 33 + n;
        v4u o; o.x = pk2(s[0 * 33] * g0.x, s[1 * 33] * g0.y); o.y = pk2(s[2 * 33] * g0.z, s[3 * 33] * g0.w); o.z = pk2(s[4 * 33] * g1.x, s[5 * 33] * g1.y); o.w = pk2(s[6 * 33] * g1.z, s[7 * 33] * g1.w);
        *(GAS v4u*)(WT + (size_t)(n0 + n) * K + k0 + 8 * c) = o; }
    LDS_WAIT(); asm volatile("" ::: "memory");
}
struct Args { const float* in[16]; float* out; unsigned char* ws; };
constexpr int WF_OFF = 8 * 8704;

__global__ void __launch_bounds__(NWAVES * 64, 2) mk_fwd(Args args) {
    extern __shared__ __attribute__((aligned(16))) unsigned char lds[];
    cg::grid_group grid = cg::this_grid();
    Frame F;
    F.lds = (LAS unsigned char*)lds;
    F.wave = __builtin_amdgcn_readfirstlane((int)threadIdx.x >> 6);
    F.G = gridDim.x; { const int bx = blockIdx.x; F.vcu = (F.G % 8 == 0) ? (bx % 8) * (F.G / 8) + bx / 8 : bx; }
    unsigned char* ws = args.ws;
    const float* x = args.in[0]; const float* p_in = args.in[1]; const float* g_mix = args.in[2]; const float* w_in = args.in[3]; const float* b_forget = args.in[4];
    const float* sinks = args.in[5]; const float* w_br_swa = args.in[6]; const float* w_br_fox = args.in[7]; const float* w_mix = args.in[8]; const float* g_mlp = args.in[9];
    const float* w_ff1 = args.in[10]; const float* w_ff2 = args.in[11]; const float* g_ple = args.in[12]; const float* w_pg = args.in[13]; const float* w_pp = args.in[14]; const float* g_final = args.in[15];
    float* out = args.out;
    bf16 *WIN_t = (bf16*)(ws + WS_WIN), *WA_t = (bf16*)(ws + WS_WA), *WB_t = (bf16*)(ws + WS_WB), *WMIX_t = (bf16*)(ws + WS_WMIX), *W1_t = (bf16*)(ws + WS_W1), *W2_t = (bf16*)(ws + WS_W2), *WG_t = (bf16*)(ws + WS_WG), *WP_t = (bf16*)(ws + WS_WP);
    float *LF = (float*)(ws + WS_LF), *CB = (float*)(ws + WS_CB), *ST1 = (float*)(ws + WS_ST1), *ST2 = (float*)(ws + WS_ST2), *ST3 = (float*)(ws + WS_ST3);
    bf16 *PB = (bf16*)(ws + WS_PB), *XN = (bf16*)(ws + WS_XN), *HN = (bf16*)(ws + WS_HN), *Z = (bf16*)(ws + WS_Z), *HB = (bf16*)(ws + WS_Z); bf16* PP = (bf16*)(ws + WS_Z);
    unsigned* NM = (unsigned*)(ws + WS_NM);
    const int gw = F.vcu * NWAVES + F.wave, NGW = F.G * NWAVES;

    for (int u = threadIdx.x; u < 128; u += NWAVES * 64) ((LAS unsigned*)(F.lds + RING_BYTES))[u] = 0u;
    __syncthreads();
    XcdBarrier bar = xcd_barrier_post((unsigned*)(ws + WS_CTL), (volatile LAS unsigned*)(F.lds + MISC_OFF) + 8);
#define GRID_BAR() do { const int l_ = fresh_lane(); xcd_barrier(bar, (F.wave == 0) && (l_ == 0)); } while (0)
    {
        const int p0_tid = threadIdx.x, p0_lane = p0_tid & 63;
        for (int i = blockIdx.x * (NWAVES * 64) + p0_tid; i < 1024 + 32; i += F.G * NWAVES * 64) NM[i] = 0u;
        LAS float* wfT = (LAS float*)(F.lds + WF_OFF);
        for (int i = p0_tid; i < 8 * D; i += NWAVES * 64) { const int k = i >> 3, h = i & 7; wfT[h * 1024 + k] = g_mix[k] * w_in[(size_t)k * DIN_SRC + 2304 + h]; }
        __syncthreads();
        f32x4 gm4[4];
#pragma unroll
        for (int j = 0; j < 4; ++j) gm4[j] = ((const GAS f32x4*)g_mix)[64 * j + p0_lane];
        const float bfg = b_forget[p0_lane & 7];
        f32x4 v[4];
        if (gw < M) { const GAS f32x4* xr = (const GAS f32x4*)(x + (size_t)gw * D) + p0_lane;
#pragma unroll
            for (int j = 0; j < 4; ++j) v[j] = xr[64 * j]; }
        for (int m = gw; m < M; m += NGW) {
            f32x4 vn[4]; const int mn = (m + NGW < M) ? m + NGW : m;
            { const GAS f32x4* xr = (const GAS f32x4*)(x + (size_t)mn * D) + p0_lane;
#pragma unroll
              for (int j = 0; j < 4; ++j) vn[j] = xr[64 * j]; }
            float ss = 0.f;
#pragma unroll
            for (int j = 0; j < 4; ++j) ss += (v[j].x * v[j].x + v[j].y * v[j].y) + (v[j].z * v[j].z + v[j].w * v[j].w);
            float a8[8];
#pragma unroll
            for (int h = 0; h < 8; ++h) { float a = 0.f;
#pragma unroll
                for (int j = 0; j < 4; ++j) { const f32x4 w = ((const LAS f32x4*)wfT)[h * 256 + 64 * j + p0_lane]; a += (v[j].x * w.x + v[j].y * w.y) + (v[j].z * w.z + v[j].w * w.w); }
                a8[h] = a; }
#pragma unroll
            for (int o = 1; o < 64; o <<= 1) { ss += __shfl_xor(ss, o);
#pragma unroll
                for (int h = 0; h < 8; ++h) a8[h] += __shfl_xor(a8[h], o); }
            const float rstd = 1.f / sqrtf(ss * (1.f / D) + RMS_EPS);
            float fsel = a8[0];
#pragma unroll
            for (int h = 1; h < 8; ++h) fsel = (p0_lane == h) ? a8[h] : fsel;
            if (p0_lane < 8) { const float xf = fsel * rstd + bfg; const float ls = fminf(xf, 0.f) - log1pf(expf(-fabsf(xf)));
                LF[(size_t)((m >> 13) * 8 + p0_lane) * T + (m & (T - 1))] = ls; }
            GAS unsigned long long* o8 = (GAS unsigned long long*)(XN + (size_t)m * D) + p0_lane;
#pragma unroll
            for (int j = 0; j < 4; ++j) { const f32x4 y = v[j] * rstd * gm4[j];
                o8[64 * j] = (unsigned long long)pk2(y.x, y.y) | ((unsigned long long)pk2(y.z, y.w) << 32); }
#pragma unroll
            for (int j = 0; j < 4; ++j) v[j] = vn[j];
        }
        for (int i = gw * 64 + p0_lane; i < M * PLE / 32; i += NGW * 64) { f32x4 a[8];
#pragma unroll
            for (int q = 0; q < 4; ++q) { a[2 * q] = ((const GAS f32x4*)p_in)[2 * (i + q * (M * PLE / 32))]; a[2 * q + 1] = ((const GAS f32x4*)p_in)[2 * (i + q * (M * PLE / 32)) + 1]; }
#pragma unroll
            for (int q = 0; q < 4; ++q) { v4u o; o.x = pk2(a[2 * q].x, a[2 * q].y); o.y = pk2(a[2 * q].z, a[2 * q].w); o.z = pk2(a[2 * q + 1].x, a[2 * q + 1].y); o.w = pk2(a[2 * q + 1].z, a[2 * q + 1].w); ((GAS v4u*)PB)[i + q * (M * PLE / 32)] = o; } }
        LAS float* scr = (LAS float*)(F.lds + F.wave * 8704);
        constexpr int I_IN = (D / 64) * (NZ / 32), I_A = (512 / 64) * (D / 32), I_MIX = (D / 64) * (D / 32), I_1 = (D / 64) * (FF / 32), I_2 = (FF / 64) * (D / 32), I_P = (PLE / 64) * (D / 32);
        constexpr int NITEMS = I_IN + 2 * I_A + I_MIX + I_1 + I_2 + I_MIX + I_P;
        for (int it = gw; it < NITEMS; it += NGW) {
            int r = it;
            if (r < I_IN) { p0_transpose_item(w_in, DIN_SRC, D, NZ, 2304, 8, nullptr, WIN_t, scr, r, p0_lane); continue; } r -= I_IN;
            if (r < I_A) { p0_transpose_item(w_br_swa, D, 512, D, 1 << 30, 0, nullptr, WA_t, scr, r, p0_lane); continue; } r -= I_A;
            if (r < I_A) { p0_transpose_item(w_br_fox, D, 512, D, 1 << 30, 0, nullptr, WB_t, scr, r, p0_lane); continue; } r -= I_A;
            if (r < I_MIX) { p0_transpose_item(w_mix, D, D, D, 1 << 30, 0, nullptr, WMIX_t, scr, r, p0_lane); continue; } r -= I_MIX;
            if (r < I_1) { p0_transpose_item(w_ff1, FF, D, FF, 1 << 30, 0, g_mlp, W1_t, scr, r, p0_lane); continue; } r -= I_1;
            if (r < I_2) { p0_transpose_item(w_ff2, D, FF, D, 1 << 30, 0, nullptr, W2_t, scr, r, p0_lane); continue; } r -= I_2;
            if (r < I_MIX) { p0_transpose_item(w_pg, D, D, D, 1 << 30, 0, g_ple, WG_t, scr, r, p0_lane); continue; } r -= I_MIX;
            p0_transpose_item(w_pp, D, PLE, D, 1 << 30, 0, nullptr, WP_t, scr, r, p0_lane);
        }
    }
    grid.sync();

    for (int bh = blockIdx.x; bh < 16; bh += gridDim.x) {
        const int c_lane = fresh_lane(), c_tid = F.wave * 64 + c_lane;
        const GAS f32x4* src = (const GAS f32x4*)(LF + (size_t)bh * T) + c_tid * 4;
        f32x4 v[4]; float run = 0.f;
#pragma unroll
        for (int j = 0; j < 4; ++j) { v[j] = src[j];
#pragma unroll
            for (int e = 0; e < 4; ++e) { run += v[j][e]; v[j][e] = run; } }
        float sc = run;
#pragma unroll
        for (int o = 1; o < 64; o <<= 1) { const float n = __shfl_up(sc, o); if (c_lane >= o) sc += n; }
        LAS float* wt = (LAS float*)F.lds;
        if (c_lane == 63) wt[F.wave] = sc;
        __syncthreads();
        float woff = 0.f;
        for (int w = 0; w < F.wave; ++w) woff += wt[w];
        const float off = woff + sc - run;
        GAS f32x4* dst = (GAS f32x4*)(CB + (size_t)bh * T) + c_tid * 4;
#pragma unroll
        for (int j = 0; j < 4; ++j) dst[j] = (v[j] + off) * (-LOG2E);
        __syncthreads();
    }
    {
        pg8::Gemm g{XN, WIN_t, M, NZ, D, D}; pg8::StaticOrder S; S.init(M, NZ, F.G, (int)blockIdx.x);
        pg8::EpiZ E{Z, NM};
        pg8::gemm_phase<pg8::EpiZ, pg8::StaticOrder, PG8_ALIGN, PG8_SP2>(F.lds, g, S, E, F.wave);
    }
    GRID_BAR();

    for (int id = F.vcu; id < 256; id += F.G) {
        const int bh = id >> 4, s = id & 15, b = bh >> 3, h = bh & 7;
        const attn_body::bf16* Zb = (const attn_body::bf16*)Z + (size_t)b * T * NZ;
        const attn_body::bf16* Qh = Zb + 768 + h * 64; const attn_body::bf16* Kh = Zb + 1280 + h * 64; const attn_body::bf16* Vh = Zb + 1792 + h * 64;
        const float* cb = CB + (size_t)bh * T;
        const float km = sqrtf(__uint_as_float(NM[1024 + bh * 2]) + __uint_as_float(NM[1024 + bh * 2 + 1]));
        const int pmA = b * 32 + (31 - s), pmB = b * 32 + s;
        const float qkA = 2.04f * km * sqrtf(__uint_as_float(NM[(pmA * 8 + h) * 2]) + __uint_as_float(NM[(pmA * 8 + h) * 2 + 1]));
        const float qkB = 2.04f * km * sqrtf(__uint_as_float(NM[(pmB * 8 + h) * 2]) + __uint_as_float(NM[(pmB * 8 + h) * 2 + 1]));
        attn_body::attn_unit<24>(F.wave, 31 - s, Qh, Kh, Vh, (attn_body::bf16*)Qh, cb, qkA, (char*)lds);
        attn_body::attn_unit<24>(F.wave, s, Qh, Kh, Vh, (attn_body::bf16*)Qh, cb, qkB, (char*)lds);
    }
    for (int id = F.vcu; id < 512; id += F.G) {
        const int bh = id >> 5, qb = id & 31, b = bh >> 3, h = bh & 7;
        const attn_body::bf16* Zb = (const attn_body::bf16*)Z + (size_t)b * T * NZ;
        const attn_body::bf16* Qh = Zb + h * 64; const attn_body::bf16* Kh = Zb + 512 + (h >> 2) * 64; const attn_body::bf16* Vh = Zb + 640 + (h >> 2) * 64;
        const float slope2 = exp2f(-(float)(h + 1)) * LOG2E, sink2 = sinks[h] * LOG2E;
        attn_body::swa_unit(F.wave, qb, Qh, Kh, Vh, (attn_body::bf16*)Qh, slope2, sink2, (char*)lds);
    }
    GRID_BAR();

    {
        pg8::StaticOrder S; S.init(M, D, F.G, (int)blockIdx.x);
        { pg8::Gemm g{Z, WA_t, M, D, 512, NZ}; pg8::EpiT1 E{Z + 2304, (bf16*)out}; pg8::gemm_phase<pg8::EpiT1, pg8::StaticOrder, PG8_ALIGN, PG8_SP2>(F.lds, g, S, E, F.wave); }
        { pg8::Gemm g{Z + 768, WB_t, M, D, 512, NZ}; pg8::EpiMix E{Z + 3328, (const bf16*)out, XN}; pg8::gemm_phase<pg8::EpiMix, pg8::StaticOrder, PG8_ALIGN, PG8_SP2>(F.lds, g, S, E, F.wave); }
    }
    GRID_BAR();

    {
        pg8::Gemm g{XN, WMIX_t, M, D, D, D}; pg8::StaticOrder S; S.init(M, D, F.G, (int)blockIdx.x);
        pg8::EpiRes E{x, out, HN, ST1};
        pg8::gemm_phase<pg8::EpiRes, pg8::StaticOrder, PG8_ALIGN, PG8_SP2>(F.lds, g, S, E, F.wave);
    }
    GRID_BAR();

    {
        pg8::Gemm g{HN, W1_t, M, FF, D, D}; pg8::StaticOrder S; S.init(M, FF, F.G, (int)blockIdx.x);
        pg8::EpiRelu2 E{ST1, HB};
        pg8::gemm_phase<pg8::EpiRelu2, pg8::StaticOrder, PG8_ALIGN, PG8_SP2>(F.lds, g, S, E, F.wave);
    }
    GRID_BAR();

    {
        pg8::Gemm g{HB, W2_t, M, D, FF, FF}; pg8::StaticOrder S; S.init(M, D, F.G, (int)blockIdx.x);
        pg8::EpiRes E{out, out, XN, ST2};
        pg8::gemm_phase<pg8::EpiRes, pg8::StaticOrder, PG8_ALIGN, PG8_SP2>(F.lds, g, S, E, F.wave);
    }
    GRID_BAR();

    {
        pg8::StaticOrder S; S.init(M, D, F.G, (int)blockIdx.x);
        { pg8::Gemm g{PB, WP_t, M, D, PLE, PLE}; pg8::EpiPP E{PP}; pg8::gemm_phase<pg8::EpiPP, pg8::StaticOrder, PG8_ALIGN, PG8_SP2>(F.lds, g, S, E, F.wave); }
        { pg8::Gemm g{XN, WG_t, M, D, D, D}; pg8::EpiPle E{ST2, PP, out, ST3}; pg8::gemm_phase<pg8::EpiPle, pg8::StaticOrder, PG8_ALIGN, PG8_SP2>(F.lds, g, S, E, F.wave); }
    }
    GRID_BAR();

    const int f_lane = fresh_lane();
    for (int m = gw; m < M; m += NGW) {
        float t = (f_lane < 16) ? ST3[(size_t)m * 16 + f_lane] : 0.f;
        const float rstd = 1.f / sqrtf(wave_sum(t) * (1.f / D) + RMS_EPS);
        GAS f32x4* xr = (GAS f32x4*)(out + (size_t)m * D) + f_lane;
#pragma unroll
        for (int j = 0; j < 4; ++j) { const f32x4 gm = ((const GAS f32x4*)g_final)[64 * j + f_lane]; xr[64 * j] = xr[64 * j] * rstd * gm; }
    }
}

extern "C" void kernel_launch(void* const* d_in, const int* in_sizes, int n_in, void* d_out, int out_size, void* d_ws, size_t ws_size, hipStream_t stream) {
    static int grid = 0;
    if (grid == 0) {
        if (n_in != 16 || in_sizes[0] != M * D || out_size != M * D || ws_size < WS_END) { fprintf(stderr, "kernel_launch: unexpected shapes (n_in %d, in0 %d, out %d, ws %zu); nothing launched\n", n_in, n_in > 0 ? in_sizes[0] : -1, out_size, ws_size); grid = -1; return; }
        int dev = 0, cus = 0, per_cu = 0;
        if (hipGetDevice(&dev) != hipSuccess || hipDeviceGetAttribute(&cus, hipDeviceAttributeMultiprocessorCount, dev) != hipSuccess) { grid = -1; return; }
        if (hipFuncSetAttribute((const void*)mk_fwd, hipFuncAttributeMaxDynamicSharedMemorySize, LDS_BYTES) != hipSuccess) { fprintf(stderr, "kernel_launch: hipFuncSetAttribute failed\n"); grid = -1; return; }
        if (hipOccupancyMaxActiveBlocksPerMultiprocessor(&per_cu, (const void*)mk_fwd, NWAVES * 64, LDS_BYTES) != hipSuccess || per_cu < 1) { fprintf(stderr, "kernel_launch: occupancy query failed (%d)\n", per_cu); (void)hipGetLastError(); per_cu = 1; }
        if (per_cu > 1) per_cu = 1;
        grid = cus * per_cu;
    }
    if (grid < 0) return;
    if (hipMemsetAsync((char*)d_ws + WS_CTL, 0, CTL_ZERO_BYTES, stream) != hipSuccess) { fprintf(stderr, "kernel_launch: memset failed\n"); return; }
    Args a{};
    for (int i = 0; i < 16; ++i) a.in[i] = (const float*)d_in[i];
    a.out = (float*)d_out; a.ws = (unsigned char*)d_ws;
    void* kargs[] = {&a};
    hipError_t e = hipLaunchCooperativeKernel((const void*)mk_fwd, dim3(grid), dim3(NWAVES * 64), kargs, LDS_BYTES, stream);
    if (e != hipSuccess) fprintf(stderr, "kernel_launch: cooperative launch failed: %s (grid %d)\n", hipGetErrorString(e), grid);
}
```

```cpp
#include <hip/hip_runtime.h>
#include <hip/hip_cooperative_groups.h>
#include <cstdio>
#include <cstdint>
__device__ __forceinline__ int fresh_lane() { int l; asm volatile("v_mbcnt_lo_u32_b32 %0, -1, 0\n\tv_mbcnt_hi_u32_b32 %0, -1, %0" : "=v"(l)); return l; }

namespace pg8 {

#define PG8_LAS __attribute__((address_space(3)))
typedef unsigned short bf16_t;
typedef short bf16x8 __attribute__((ext_vector_type(8)));
typedef float f32x4 __attribute__((ext_vector_type(4)));
typedef unsigned u32x4 __attribute__((ext_vector_type(4)));
constexpr int BM = 256, BK = 64, HALF = 128, HTB = HALF * BK * 2  , STAGE_BYTES = 8 * HTB, NXCD = 8, WGM = 8;

__host__ __device__ __forceinline__ int lds_byte(int r, int c) { const int st = (r >> 4) * 2 + (c >> 5), rr = r & 15, cc = c & 31, ob = rr * 64 + cc * 2; return st * 1024 + (ob ^ (((ob >> 9) & 1) << 5)); }
__host__ __device__ __forceinline__ void stage_rc(int b, int& R, int& C) { const int st = b / 1024, sb = b % 1024, swz = sb ^ (((sb >> 9) & 1) << 5); R = (st >> 1) * 16 + swz / 64; C = (st & 1) * 32 + (swz % 64) / 2; }
__host__ __device__ __forceinline__ int perm32(int rho) { const int n = rho >> 4, i = rho & 15; return 8 * (i >> 2) + 4 * n + (i & 3); }

struct Unit { int pm, pn; };
struct Gemm { const bf16_t* A; const bf16_t* Bt; int M, N, K, lda; };

struct StaticOrder {
    int nM, nN, nwg, G, c;
    __host__ __device__ void init(int M, int N, int G_, int c_) { nM = M / BM; nN = N / BM; nwg = nM * nN; G = G_; c = c_; }
    __host__ __device__ bool next(int i, Unit& u) const {
        const long L = (long)i * G + c; if (L >= nwg) return false;
        int wgid = (int)L; { const int q = nwg / NXCD, r = nwg % NXCD, xcd = wgid % NXCD, off = wgid / NXCD; wgid = (xcd < r ? xcd * (q + 1) : r * (q + 1) + (xcd - r) * q) + off; }
        const int nig = WGM * nN, gid = wgid / nig, fm = gid * WGM, gsz = (nM - fm) < WGM ? (nM - fm) : WGM;
        u.pm = fm + ((wgid % nig) % gsz); u.pn = (wgid % nig) / gsz; return true;
    }
    __device__ __forceinline__ void a_ready(const Unit&) const {}
    __device__ __forceinline__ void done(const Unit&) const {}
};

__device__ __forceinline__ unsigned cvt_pk_bf16(float lo, float hi) { unsigned r; asm volatile("v_cvt_pk_bf16_f32 %0, %1, %2" : "=v"(r) : "v"(lo), "v"(hi)); return r; }
typedef float f32x2 __attribute__((ext_vector_type(2)));
struct OneUnit { int pm, pn; __device__ bool next(int i, Unit& u) const { if (i) return false; u.pm = pm; u.pn = pn; return true; } __device__ __forceinline__ void a_ready(const Unit&) const {} __device__ __forceinline__ void done(const Unit&) const {} };
constexpr int ZP = 4352;
constexpr float C2F = 0.125f * 1.4426950408889634f;
__device__ __forceinline__ float sigmoidf_fast(float x) { return __builtin_amdgcn_rcpf(1.0f + __builtin_amdgcn_exp2f(-1.4426950408889634f * x)); }
__device__ __forceinline__ f32x4 bf4_lo(unsigned a, unsigned b) { return (f32x4){__uint_as_float(a << 16), __uint_as_float(a & 0xffff0000u), __uint_as_float(b << 16), __uint_as_float(b & 0xffff0000u)}; }
__device__ __forceinline__ u32x4 pack8(f32x4 v0, f32x4 v1) { u32x4 w; w.x = cvt_pk_bf16(v0[0], v0[1]); w.y = cvt_pk_bf16(v0[2], v0[3]); w.z = cvt_pk_bf16(v1[0], v1[1]); w.w = cvt_pk_bf16(v1[2], v1[3]); return w; }
__device__ __forceinline__ float rstd_from_stats(const float* st, int row) { const f32x4* s = (const f32x4*)(st + (size_t)row * 16); const f32x4 a = s[0], b = s[1], c = s[2], d = s[3];
    const float t = ((a[0] + a[1]) + (a[2] + a[3])) + ((b[0] + b[1]) + (b[2] + b[3])) + ((c[0] + c[1]) + (c[2] + c[3])) + ((d[0] + d[1]) + (d[2] + d[3])); return 1.0f / sqrtf(t * (1.0f / 1024.0f) + 1e-6f); }
#define EPI_ROWS(...) _Pragma("unroll") for (int ai = 0; ai < 2; ++ai) _Pragma("unroll") for (int m = 0; m < 4; ++m) { const int row = u.pm * BM + ai * HALF + wr * 64 + m * 16 + fr; __VA_ARGS__ asm volatile("" ::: "memory"); }
#define EPI_COLS(...) _Pragma("unroll") for (int bj = 0; bj < 2; ++bj) { const int col = u.pn * BM + bj * HALF + wc * 32 + 8 * fq; const f32x4 a0 = acc[ai][bj][m][0], a1 = acc[ai][bj][m][1]; __VA_ARGS__ }
struct EpiZ { static constexpr bool PERM = true, AFTER_DRAIN = false; bf16_t* Z; unsigned* NM; int pn_off;
    __device__ __forceinline__ void operator()(const f32x4 (&acc)[2][2][4][2], const Unit& u, int wr, int wc, int fr, int fq) const {
        const int pn = u.pn + pn_off; const int mode = (pn >= 9) ? 2 : ((pn == 0 || pn == 1 || pn == 3 || pn == 4) ? 1 : 0);
        const bool nrm = (pn >= 3 && pn <= 6); float mx0 = 0.f, mx1 = 0.f;
        EPI_ROWS( bf16_t* rowp = Z + (size_t)row * ZP; EPI_COLS( f32x4 v0 = a0, v1 = a1;
            if (mode == 1) { v0 = v0 * C2F; v1 = v1 * C2F; }
            else if (mode == 2) { _Pragma("unroll") for (int e = 0; e < 4; ++e) { v0[e] = sigmoidf_fast(v0[e]); v1[e] = sigmoidf_fast(v1[e]); } }
            if (nrm) { float ss = ((v0[0] * v0[0] + v0[1] * v0[1]) + (v0[2] * v0[2] + v0[3] * v0[3])) + ((v1[0] * v1[0] + v1[1] * v1[1]) + (v1[2] * v1[2] + v1[3] * v1[3]));
                ss += __shfl_xor(ss, 16); ss += __shfl_xor(ss, 32); if (bj == 0) mx0 = fmaxf(mx0, ss); else mx1 = fmaxf(mx1, ss); }
            *(u32x4*)(rowp + col + pn_off * BM) = pack8(v0, v1); ) )
        if (nrm) {
#pragma unroll
            for (int o = 1; o < 16; o <<= 1) { mx0 = fmaxf(mx0, __shfl_xor(mx0, o)); mx1 = fmaxf(mx1, __shfl_xor(mx1, o)); }
            if (fr == 0 && fq == 0) {
                const int isk = (pn >= 5), cr = (pn - (isk ? 5 : 3)) * 4 + (wc >> 1), half = wc & 1;
                unsigned* b0 = isk ? NM + 1024 + ((u.pm >> 5) * 8 + cr) * 2 + half : NM + (u.pm * 8 + cr) * 2 + half;
                atomicMax(b0, __float_as_uint(mx0 * 1.0001f)); atomicMax(b0 + 4, __float_as_uint(mx1 * 1.0001f));
            } }
    } };
#define EPI_GROUP(NR, ...) _Pragma("unroll") for (int ai = 0; ai < 2; ++ai) _Pragma("unroll") for (int mg = 0; mg < 4; mg += NR) { __VA_ARGS__ asm volatile("" ::: "memory"); }
#define EPI_ROWOF(mm) (u.pm * BM + ai * HALF + wr * 64 + (mm) * 16 + fr)
#define EPI_COLOF(bj) (u.pn * BM + (bj) * HALF + wc * 32 + 8 * fq)
struct EpiT1 { static constexpr bool PERM = true, AFTER_DRAIN = false; const bf16_t* G; bf16_t* T;
    __device__ __forceinline__ void operator()(const f32x4 (&acc)[2][2][4][2], const Unit& u, int wr, int wc, int fr, int fq) const {
        EPI_GROUP(4, u32x4 g[4][2];
            _Pragma("unroll") for (int i = 0; i < 4; ++i) _Pragma("unroll") for (int bj = 0; bj < 2; ++bj) g[i][bj] = *(const u32x4*)(G + (size_t)EPI_ROWOF(mg + i) * ZP + EPI_COLOF(bj));
            _Pragma("unroll") for (int i = 0; i < 4; ++i) _Pragma("unroll") for (int bj = 0; bj < 2; ++bj)
                *(u32x4*)(T + (size_t)EPI_ROWOF(mg + i) * 1024 + EPI_COLOF(bj)) = pack8(acc[ai][bj][mg + i][0] * bf4_lo(g[i][bj].x, g[i][bj].y), acc[ai][bj][mg + i][1] * bf4_lo(g[i][bj].z, g[i][bj].w)); )
    } };
struct EpiMix { static constexpr bool PERM = true, AFTER_DRAIN = false; const bf16_t* G; const bf16_t* T; bf16_t* O;
    __device__ __forceinline__ void operator()(const f32x4 (&acc)[2][2][4][2], const Unit& u, int wr, int wc, int fr, int fq) const {
        EPI_GROUP(4, u32x4 g[4][2]; u32x4 t[4][2];
            _Pragma("unroll") for (int i = 0; i < 4; ++i) _Pragma("unroll") for (int bj = 0; bj < 2; ++bj) { g[i][bj] = *(const u32x4*)(G + (size_t)EPI_ROWOF(mg + i) * ZP + EPI_COLOF(bj));
                t[i][bj] = *(const u32x4*)(T + (size_t)EPI_ROWOF(mg + i) * 1024 + EPI_COLOF(bj)); }
            _Pragma("unroll") for (int i = 0; i < 4; ++i) _Pragma("unroll") for (int bj = 0; bj < 2; ++bj) {
                const f32x4 v0 = bf4_lo(t[i][bj].x, t[i][bj].y) + acc[ai][bj][mg + i][0] * bf4_lo(g[i][bj].x, g[i][bj].y), v1 = bf4_lo(t[i][bj].z, t[i][bj].w) + acc[ai][bj][mg + i][1] * bf4_lo(g[i][bj].z, g[i][bj].w);
                *(u32x4*)(O + (size_t)EPI_ROWOF(mg + i) * 1024 + EPI_COLOF(bj)) = pack8(v0, v1); } )
    } };
struct EpiRes { static constexpr bool PERM = true, AFTER_DRAIN = false; const float* base; float* out; bf16_t* hb; float* st;
    __device__ __forceinline__ void operator()(const f32x4 (&acc)[2][2][4][2], const Unit& u, int wr, int wc, int fr, int fq) const {
        EPI_GROUP(4, f32x4 b[4][2][2];
            _Pragma("unroll") for (int i = 0; i < 4; ++i) _Pragma("unroll") for (int bj = 0; bj < 2; ++bj) { const float* bp = base + (size_t)EPI_ROWOF(mg + i) * 1024 + EPI_COLOF(bj); b[i][bj][0] = *(const f32x4*)bp; b[i][bj][1] = *(const f32x4*)(bp + 4); }
            _Pragma("unroll") for (int i = 0; i < 4; ++i) { float ss = 0.f; const int row = EPI_ROWOF(mg + i);
                _Pragma("unroll") for (int bj = 0; bj < 2; ++bj) { const size_t off = (size_t)row * 1024 + EPI_COLOF(bj); const f32x4 h0 = b[i][bj][0] + acc[ai][bj][mg + i][0], h1 = b[i][bj][1] + acc[ai][bj][mg + i][1];
                    *(f32x4*)(out + off) = h0; *(f32x4*)(out + off + 4) = h1; *(u32x4*)(hb + off) = pack8(h0, h1);
                    ss += ((h0[0] * h0[0] + h0[1] * h0[1]) + (h0[2] * h0[2] + h0[3] * h0[3])) + ((h1[0] * h1[0] + h1[1] * h1[1]) + (h1[2] * h1[2] + h1[3] * h1[3])); }
                ss += __shfl_xor(ss, 16); ss += __shfl_xor(ss, 32); if (fq == 0) st[(size_t)row * 16 + u.pn * 4 + wc] = ss; } )
    } };
struct EpiRelu2 { static constexpr bool PERM = true, AFTER_DRAIN = false; const float* st; bf16_t* O;
    __device__ __forceinline__ void operator()(const f32x4 (&acc)[2][2][4][2], const Unit& u, int wr, int wc, int fr, int fq) const {
        float rsv[2][4];
        _Pragma("unroll") for (int ai = 0; ai < 2; ++ai) { _Pragma("unroll") for (int m = 0; m < 4; ++m) rsv[ai][m] = rstd_from_stats(st, u.pm * BM + ai * HALF + wr * 64 + m * 16 + fr);
            asm volatile("" : "+v"(rsv[ai][0]), "+v"(rsv[ai][1]), "+v"(rsv[ai][2]), "+v"(rsv[ai][3]) :: "memory"); }
        EPI_ROWS( const float rs = rsv[ai][m]; EPI_COLS( f32x4 v0 = a0 * rs, v1 = a1 * rs;
            _Pragma("unroll") for (int e = 0; e < 4; ++e) { const float x0 = fmaxf(v0[e], 0.f), x1 = fmaxf(v1[e], 0.f); v0[e] = x0 * x0; v1[e] = x1 * x1; }
            *(u32x4*)(O + (size_t)row * 4096 + col) = pack8(v0, v1); ) )
    } };
struct EpiPP { static constexpr bool PERM = true, AFTER_DRAIN = false; bf16_t* T;
    __device__ __forceinline__ void operator()(const f32x4 (&acc)[2][2][4][2], const Unit& u, int wr, int wc, int fr, int fq) const {
        EPI_ROWS( EPI_COLS( *(u32x4*)(T + (size_t)row * 1024 + col) = pack8(a0, a1); ) )
    } };
struct EpiPle { static constexpr bool PERM = true, AFTER_DRAIN = false; const float* st_in; const bf16_t* T; float* h; float* st;
    __device__ __forceinline__ void operator()(const f32x4 (&acc)[2][2][4][2], const Unit& u, int wr, int wc, int fr, int fq) const {
        float rsv[2][4];
        _Pragma("unroll") for (int ai = 0; ai < 2; ++ai) { _Pragma("unroll") for (int m = 0; m < 4; ++m) rsv[ai][m] = rstd_from_stats(st_in, u.pm * BM + ai * HALF + wr * 64 + m * 16 + fr);
            asm volatile("" : "+v"(rsv[ai][0]), "+v"(rsv[ai][1]), "+v"(rsv[ai][2]), "+v"(rsv[ai][3]) :: "memory"); }
        EPI_GROUP(2, f32x4 hv[2][2][2]; u32x4 tv[2][2];
            _Pragma("unroll") for (int i = 0; i < 2; ++i) _Pragma("unroll") for (int bj = 0; bj < 2; ++bj) { const size_t off = (size_t)EPI_ROWOF(mg + i) * 1024 + EPI_COLOF(bj);
                    hv[i][bj][0] = *(const f32x4*)(h + off); hv[i][bj][1] = *(const f32x4*)(h + off + 4); tv[i][bj] = *(const u32x4*)(T + off); }
            _Pragma("unroll") for (int i = 0; i < 2; ++i) { float ss = 0.f; const int row = EPI_ROWOF(mg + i); const float rs = rsv[ai][mg + i];
                _Pragma("unroll") for (int bj = 0; bj < 2; ++bj) { const size_t off = (size_t)row * 1024 + EPI_COLOF(bj);
                    f32x4 g0 = acc[ai][bj][mg + i][0] * rs, g1 = acc[ai][bj][mg + i][1] * rs; _Pragma("unroll") for (int e = 0; e < 4; ++e) { g0[e] = sigmoidf_fast(g0[e]); g1[e] = sigmoidf_fast(g1[e]); }
                    const f32x4 h0 = hv[i][bj][0] + g0 * bf4_lo(tv[i][bj].x, tv[i][bj].y), h1 = hv[i][bj][1] + g1 * bf4_lo(tv[i][bj].z, tv[i][bj].w);
                    *(f32x4*)(h + off) = h0; *(f32x4*)(h + off + 4) = h1;
                    ss += ((h0[0] * h0[0] + h0[1] * h0[1]) + (h0[2] * h0[2] + h0[3] * h0[3])) + ((h1[0] * h1[0] + h1[1] * h1[1]) + (h1[2] * h1[2] + h1[3] * h1[3])); }
                ss += __shfl_xor(ss, 16); ss += __shfl_xor(ss, 32); if (fq == 0) st[(size_t)row * 16 + u.pn * 4 + wc] = ss; } )
    } };

struct EpiNone { static constexpr bool PERM = true, AFTER_DRAIN = false; float* sink;
    __device__ __forceinline__ void operator()(const f32x4 (&acc)[2][2][4][2], const Unit& u, int wr, int wc, int fr, int fq) const {
        if (acc[0][0][0][0][0] == 1.2345e33f) sink[0] = 1.f;
    } };

template <class Epi, class Sched, bool ALIGN_EPI = false, bool SP2 = false>
__device__ __forceinline__ void gemm_phase(PG8_LAS unsigned char* lds, const Gemm g, const Sched& S, const Epi& E, const int wave_s) {
    const int tid = wave_s * 64 + fresh_lane(), wid = wave_s, lane = tid & 63, wr = wid >> 2, wc = wid & 3, fr = lane & 15, fq = lane >> 4;
    const int K = g.K, nt = K / BK;
    unsigned voffA[2], voffB[2];
#pragma unroll
    for (int i = 0; i < 2; ++i) { int R, C; stage_rc(tid * 16 + i * 8192, R, C); const int Rb = Epi::PERM ? ((R & ~31) + perm32(R & 31)) : R;
        voffA[i] = (unsigned)(R * g.lda + C) * 2u; voffB[i] = (unsigned)(Rb * K + C) * 2u; }
    const size_t kstep = (size_t)(BK * 2);
    const size_t hstepA = (size_t)HALF * g.lda * 2, hstepB = (size_t)HALF * K * 2;
    const size_t tstepA = 2 * hstepA, tstepB = 2 * hstepB;
    const unsigned ldsw = (unsigned)wid * 1024u;
    const int aoff = lds_byte(wr * 64 + fr, fq * 8), boff = lds_byte(wc * 32 + fr, fq * 8);
#define PG8_SA(b, h) (((b) * 2 + (h)) * HTB)
#define PG8_SB(b, h) ((4 + (b) * 2 + (h)) * HTB)
#define PG8_STAGE(bufoff, gbase, voff) do { _Pragma("unroll") for (int _i = 0; _i < 2; ++_i) \
        __builtin_amdgcn_global_load_lds((const unsigned*)((const char*)(gbase) + (voff)[_i]), (PG8_LAS unsigned*)(lds + (bufoff) + ldsw + _i * 8192), 16, 0, 0); } while (0)
#define PG8_LDA(dst, b, h) do { _Pragma("unroll") for (int m = 0; m < 4; ++m) _Pragma("unroll") for (int k = 0; k < 2; ++k) dst[m][k] = *(const PG8_LAS bf16x8*)(lds + PG8_SA(b, h) + aoff + m * 2048 + k * 1024); } while (0)
#define PG8_LDB(dst, b, h) do { _Pragma("unroll") for (int n = 0; n < 2; ++n) _Pragma("unroll") for (int k = 0; k < 2; ++k) dst[n][k] = *(const PG8_LAS bf16x8*)(lds + PG8_SB(b, h) + boff + n * 2048 + k * 1024); } while (0)
#define PG8_MMA(ai, bj, At, Bt) do { __builtin_amdgcn_s_setprio(1); _Pragma("unroll") for (int m = 0; m < 4; ++m) _Pragma("unroll") for (int n = 0; n < 2; ++n) _Pragma("unroll") for (int k = 0; k < 2; ++k) \
        acc[ai][bj][m][n] = __builtin_amdgcn_mfma_f32_16x16x32_bf16(Bt[n][k], At[m][k], acc[ai][bj][m][n], 0, 0, 0); __builtin_amdgcn_s_setprio(0); } while (0)
#define PG8_WAIT_V(n) asm volatile("s_waitcnt vmcnt(" #n ")" ::: "memory")
#define PG8_WAIT_L(n) asm volatile("s_waitcnt lgkmcnt(" #n ")" ::: "memory")
#define PG8_BAR __builtin_amdgcn_s_barrier()
#define PG8_SCHED __builtin_amdgcn_sched_barrier(0)
    Unit cur, nxt; int ui = 0;
    if (!S.next(0, cur)) return;
    f32x4 acc[2][2][4][2];
#pragma unroll
    for (int a = 0; a < 2; ++a)
#pragma unroll
        for (int b = 0; b < 2; ++b)
#pragma unroll
            for (int m = 0; m < 4; ++m)
#pragma unroll
                for (int n = 0; n < 2; ++n) acc[a][b][m][n] = (f32x4){0.f, 0.f, 0.f, 0.f};
    bf16x8 At[4][2], B0[2][2], B1[2][2];
    const char* cA = (const char*)g.A + (size_t)cur.pm * tstepA; const char* cB = (const char*)g.Bt + (size_t)cur.pn * tstepB;
    S.a_ready(cur);
    if constexpr (SP2) {
        PG8_STAGE(PG8_SB(0, 0), cB, voffB); PG8_STAGE(PG8_SB(0, 1), cB + hstepB, voffB); PG8_STAGE(PG8_SA(0, 0), cA, voffA); PG8_STAGE(PG8_SA(0, 1), cA + hstepA, voffA);
        if (wr == 1) PG8_BAR;
        PG8_WAIT_V(2); PG8_BAR;
        PG8_STAGE(PG8_SB(1, 0), cB + kstep, voffB); PG8_STAGE(PG8_SA(1, 0), cA + kstep, voffA); PG8_STAGE(PG8_SB(1, 1), cB + hstepB + kstep, voffB);
        PG8_WAIT_V(6); PG8_BAR;
    } else {
        PG8_STAGE(PG8_SB(0, 0), cB, voffB); PG8_STAGE(PG8_SA(0, 0), cA, voffA); PG8_STAGE(PG8_SB(0, 1), cB + hstepB, voffB); PG8_STAGE(PG8_SA(0, 1), cA + hstepA, voffA);
        if (wr == 1) PG8_BAR;
        PG8_WAIT_V(4); PG8_BAR;
        PG8_STAGE(PG8_SB(1, 0), cB + kstep, voffB); PG8_STAGE(PG8_SA(1, 0), cA + kstep, voffA); PG8_STAGE(PG8_SB(1, 1), cB + hstepB + kstep, voffB);
        PG8_WAIT_V(6); PG8_BAR;
    }
    for (;;) {
        const bool has_next = S.next(ui + 1, nxt);
        const char* nA = has_next ? (const char*)g.A + (size_t)nxt.pm * tstepA : cA; const char* nB = has_next ? (const char*)g.Bt + (size_t)nxt.pn * tstepB : cB;
        for (int t = 0; t < nt; t += 2) {
            const bool last = (t == nt - 2);
            const char* a1 = cA + (size_t)(t + 1) * kstep;
            const char* a2 = last ? nA : cA + (size_t)(t + 2) * kstep; const char* b2 = last ? nB : cB + (size_t)(t + 2) * kstep;
            const char* a3 = a2 + kstep; const char* b3 = b2 + kstep;
            if (last && has_next) S.a_ready(nxt);
            if constexpr (SP2) {
            PG8_LDB(B0, 0, 0); PG8_LDB(B1, 0, 1); PG8_SCHED; PG8_LDA(At, 0, 0); PG8_STAGE(PG8_SA(1, 1), a1 + hstepA, voffA);
            PG8_WAIT_V(8); PG8_WAIT_L(0); PG8_BAR; PG8_MMA(0, 0, At, B0); PG8_MMA(0, 1, At, B1); PG8_BAR; PG8_SCHED;
            PG8_LDA(At, 0, 1); PG8_STAGE(PG8_SB(0, 0), b2, voffB); PG8_STAGE(PG8_SB(0, 1), b2 + hstepB, voffB); PG8_STAGE(PG8_SA(0, 0), a2, voffA);
            PG8_WAIT_V(8); PG8_WAIT_L(0); PG8_BAR; PG8_MMA(1, 0, At, B0); PG8_MMA(1, 1, At, B1); PG8_BAR; PG8_SCHED;
            PG8_LDB(B0, 1, 0); PG8_LDB(B1, 1, 1); PG8_SCHED; PG8_LDA(At, 1, 0); PG8_STAGE(PG8_SA(0, 1), a2 + hstepA, voffA);
            PG8_WAIT_V(8); PG8_WAIT_L(0); PG8_BAR; PG8_MMA(0, 0, At, B0); PG8_MMA(0, 1, At, B1); PG8_BAR; PG8_SCHED;
            PG8_LDA(At, 1, 1); PG8_STAGE(PG8_SB(1, 0), b3, voffB); PG8_STAGE(PG8_SB(1, 1), b3 + hstepB, voffB); PG8_STAGE(PG8_SA(1, 0), a3, voffA);
            PG8_WAIT_V(8); PG8_WAIT_L(0); PG8_BAR; PG8_MMA(1, 0, At, B0); PG8_MMA(1, 1, At, B1); PG8_BAR; PG8_SCHED;
            } else {
            PG8_LDB(B0, 0, 0); PG8_SCHED; PG8_LDA(At, 0, 0); PG8_STAGE(PG8_SA(1, 1), a1 + hstepA, voffA);
            PG8_WAIT_L(8); PG8_BAR; PG8_WAIT_L(0); PG8_MMA(0, 0, At, B0); PG8_BAR; PG8_SCHED;
            PG8_LDB(B1, 0, 1); PG8_STAGE(PG8_SB(0, 0), b2, voffB);
            PG8_BAR; PG8_WAIT_L(0); PG8_MMA(0, 1, At, B1); PG8_BAR;
            PG8_LDA(At, 0, 1); PG8_STAGE(PG8_SA(0, 0), a2, voffA);
            PG8_BAR; PG8_WAIT_L(0); PG8_MMA(1, 0, At, B0); PG8_BAR; PG8_SCHED;
            PG8_STAGE(PG8_SB(0, 1), b2 + hstepB, voffB);
            PG8_WAIT_V(6); PG8_BAR; PG8_MMA(1, 1, At, B1); PG8_BAR;
            PG8_LDB(B0, 1, 0); PG8_SCHED; PG8_LDA(At, 1, 0); PG8_STAGE(PG8_SA(0, 1), a2 + hstepA, voffA);
            PG8_WAIT_L(8); PG8_BAR; PG8_WAIT_L(0); PG8_MMA(0, 0, At, B0); PG8_BAR; PG8_SCHED;
            PG8_LDB(B1, 1, 1); PG8_STAGE(PG8_SB(1, 0), b3, voffB);
            PG8_BAR; PG8_WAIT_L(0); PG8_MMA(0, 1, At, B1); PG8_BAR;
            PG8_LDA(At, 1, 1); PG8_STAGE(PG8_SA(1, 0), a3, voffA);
            PG8_BAR; PG8_WAIT_L(0); PG8_MMA(1, 0, At, B0); PG8_BAR; PG8_SCHED;
            PG8_STAGE(PG8_SB(1, 1), b3 + hstepB, voffB);
            PG8_WAIT_V(6); PG8_BAR; PG8_MMA(1, 1, At, B1); PG8_BAR;
            }
        }
        if constexpr (ALIGN_EPI) { if (wr == 0) PG8_BAR; }
        if constexpr (!Epi::AFTER_DRAIN) { E(acc, cur, wr, wc, fr, fq); S.done(cur); }
        if (!has_next) break;
#pragma unroll
        for (int a = 0; a < 2; ++a)
#pragma unroll
            for (int b = 0; b < 2; ++b)
#pragma unroll
                for (int m = 0; m < 4; ++m)
#pragma unroll
                    for (int n = 0; n < 2; ++n) acc[a][b][m][n] = (f32x4){0.f, 0.f, 0.f, 0.f};
        cur = nxt; cA = nA; cB = nB; ++ui;
        if constexpr (ALIGN_EPI) { if (wr == 1) PG8_BAR; }
    }
    PG8_WAIT_V(0);
    if constexpr (!ALIGN_EPI) { if (wr == 0) PG8_BAR; }
    PG8_BAR;
    if constexpr (Epi::AFTER_DRAIN) { E.fused(acc, cur, wr, wc, fr, fq, lds, wid, lane); S.done(cur); }
#undef PG8_SA
#undef PG8_SB
#undef PG8_STAGE
#undef PG8_LDA
#undef PG8_LDB
#undef PG8_MMA
#undef PG8_WAIT_V
#undef PG8_WAIT_L
#undef PG8_BAR
#undef PG8_SCHED
}
}
#ifndef PG8_SP2
#define PG8_SP2 true
#endif
#ifndef PG8_ALIGN
#define PG8_ALIGN true
#endif
#include <hip/hip_bf16.h>
#include <cmath>
namespace attn_body {
using bf16=__hip_bfloat16;
using bf16x8=__attribute__((ext_vector_type(8)))short;
using s16x4=__attribute__((ext_vector_type(4)))short;
using f32x16=__attribute__((ext_vector_type(16)))float;
using u32x4=__attribute__((ext_vector_type(4)))unsigned;
constexpr int BATCH=2,SEQ=8192,D=64,DM=4352;
constexpr int NW=8,QBLK=32,QB=QBLK*NW,KVBLK=64,NQB=SEQ/QB;
constexpr int ATTN_PITCH=DM, ATTN_UNIT_ROWS=QB;
__device__ __forceinline__ int crow(int r,int hi){return (r&3)+8*(r>>2)+4*hi;}
#define SBAR() __builtin_amdgcn_sched_barrier(0)
__device__ __forceinline__ void cmask(f32x16&p0,f32x16&p1,int jb,int qrel,int hi){
  const float NEG=-INFINITY; int kb=64*jb+4*hi;
  #pragma unroll
  for(int r=0;r<16;++r){int kv=kb+(r&3)+8*(r>>2); if(kv>qrel)p0[r]=NEG; if(kv+32>qrel)p1[r]=NEG;}
}

constexpr int NSLOT=3, SLOTB=8192; typedef float f32x4v __attribute__((ext_vector_type(4))); constexpr int LDS_BIAS=86016;
constexpr int LDS_K=0, LDS_V=NSLOT*SLOTB, LDS_WS=2*NSLOT*SLOTB, LDS_OST=LDS_WS+NW*64*4, LDS_BYTES=LDS_OST+NW*4096;
constexpr float C2=0.125f*1.4426950408889634f;
__device__ __forceinline__ void glds16(const void*gsrc,unsigned lds_dst){unsigned keep;
  asm volatile("s_mov_b32 %0, m0\n\ts_mov_b32 m0, %2\n\ts_nop 0\n\tglobal_load_lds_dwordx4 %1, off\n\ts_mov_b32 m0, %0":"=&s"(keep):"v"(gsrc),"s"(lds_dst):"memory");}
__device__ __forceinline__ float max3f(float a,float b,float c){float r;asm("v_max3_f32 %0, %1, %2, %3":"=v"(r):"v"(a),"v"(b),"v"(c));return r;}
__device__ __forceinline__ float max2f(float a,float b){float r;asm("v_max_f32_e32 %0, %1, %2":"=v"(r):"v"(a),"v"(b));return r;}
__device__ __forceinline__ float fadd_s(float a,float b){float r;asm("v_add_f32_e32 %0, %1, %2":"=v"(r):"v"(a),"v"(b));return r;}
__device__ __forceinline__ float fsub_s(float a,float b){float r;asm("v_sub_f32_e32 %0, %1, %2":"=v"(r):"v"(a),"v"(b));return r;}
typedef float f32x2_t __attribute__((ext_vector_type(2))); typedef __bf16 bf16x2_t __attribute__((ext_vector_type(2)));
__device__ __forceinline__ unsigned cvtpk_s(float lo,float hi){f32x2_t v={lo,hi};bf16x2_t b=__builtin_convertvector(v,bf16x2_t);return __builtin_bit_cast(unsigned,b);}
#define WAIT_BAR(N) asm volatile("s_waitcnt vmcnt(" #N ") lgkmcnt(0)\n\ts_barrier":::"memory")

__device__ __forceinline__ void qkt(f32x16&p0,f32x16&p1,const char*Kslot,const bf16x8*qr,const f32x16&negm,int r32,int hi){
  const char*kb=Kslot+hi*1024+r32*16;
  #pragma unroll
  for(int d0=0;d0<4;++d0){
    const bf16x8 b0=*reinterpret_cast<const bf16x8*>(kb+d0*2048);
    const bf16x8 b1=*reinterpret_cast<const bf16x8*>(kb+d0*2048+512);
    if(d0==0){p0=__builtin_amdgcn_mfma_f32_32x32x16_bf16(b0,qr[0],negm,0,0,0);p1=__builtin_amdgcn_mfma_f32_32x32x16_bf16(b1,qr[0],negm,0,0,0);}
    else{p0=__builtin_amdgcn_mfma_f32_32x32x16_bf16(b0,qr[d0],p0,0,0,0);p1=__builtin_amdgcn_mfma_f32_32x32x16_bf16(b1,qr[d0],p1,0,0,0);}}
}
typedef __attribute__((address_space(3))) const char* lds_cptr;
typedef short v4i16_t __attribute__((ext_vector_type(4)));
__device__ __forceinline__ void kload8(bf16x8*kf,lds_cptr kp){
  kf[0]=*(const __attribute__((address_space(3))) bf16x8*)(kp);      kf[1]=*(const __attribute__((address_space(3))) bf16x8*)(kp+512);
  kf[2]=*(const __attribute__((address_space(3))) bf16x8*)(kp+2048); kf[3]=*(const __attribute__((address_space(3))) bf16x8*)(kp+2560);
  kf[4]=*(const __attribute__((address_space(3))) bf16x8*)(kp+4096); kf[5]=*(const __attribute__((address_space(3))) bf16x8*)(kp+4608);
  kf[6]=*(const __attribute__((address_space(3))) bf16x8*)(kp+6144); kf[7]=*(const __attribute__((address_space(3))) bf16x8*)(kp+6656);
}
__device__ __forceinline__ void kload2(bf16x8*kf,lds_cptr kp,int j){ kf[2*j]=*(const __attribute__((address_space(3))) bf16x8*)(kp+j*2048); kf[2*j+1]=*(const __attribute__((address_space(3))) bf16x8*)(kp+j*2048+512); }
__device__ __forceinline__ s16x4 vtr(lds_cptr p){ return __builtin_bit_cast(s16x4,__builtin_amdgcn_ds_read_tr16_b64_v4i16((__attribute__((address_space(3))) v4i16_t*)p)); }
__device__ __forceinline__ float rowmax(const f32x16&p0,const f32x16&p1){
  float a=max3f(p0[0],p0[1],p1[0]),b=max3f(p0[2],p0[3],p1[1]);a=max3f(a,p1[2],p1[3]);
  #pragma unroll
  for(int r=4;r<16;r+=4){a=max3f(a,p0[r],p0[r+1]);b=max3f(b,p0[r+2],p0[r+3]);a=max3f(a,p1[r],p1[r+1]);b=max3f(b,p1[r+2],p1[r+3]);}
  const float m=max2f(a,b);
  auto rr=__builtin_amdgcn_permlane32_swap(__float_as_uint(m),__float_as_uint(m),false,false);
  return max2f(__uint_as_float(rr[0]),__uint_as_float(rr[1]));
}
__device__ __forceinline__ void pv(f32x16*o,int vb,bf16x8 pa0,bf16x8 pa1,bf16x8 pa2,bf16x8 pa3){
  #pragma unroll
  for(int d0=0;d0<2;++d0){s16x4 lo[4],hi[4];
    #pragma unroll
    for(int ks=0;ks<4;++ks){
      asm volatile("ds_read_b64_tr_b16 %0,%1 offset:%c2":"=&v"(lo[ks]):"v"(vb),"i"(d0*4096+ks*1024):"memory");
      asm volatile("ds_read_b64_tr_b16 %0,%1 offset:%c2":"=&v"(hi[ks]):"v"(vb),"i"(d0*4096+ks*1024+512):"memory");}
    asm volatile("s_waitcnt lgkmcnt(0)":::"memory");SBAR();
    #define PK(k) (bf16x8){lo[k][0],lo[k][1],lo[k][2],lo[k][3],hi[k][0],hi[k][1],hi[k][2],hi[k][3]}
    o[d0]=__builtin_amdgcn_mfma_f32_32x32x16_bf16(pa0,PK(0),o[d0],0,0,0);
    o[d0]=__builtin_amdgcn_mfma_f32_32x32x16_bf16(pa1,PK(1),o[d0],0,0,0);
    o[d0]=__builtin_amdgcn_mfma_f32_32x32x16_bf16(pa2,PK(2),o[d0],0,0,0);
    o[d0]=__builtin_amdgcn_mfma_f32_32x32x16_bf16(pa3,PK(3),o[d0],0,0,0);
    #undef PK
  }
}

#ifndef ATTN_STORE16
#define ATTN_STORE16(p,v) (*(u32x4*)(p)=(v))
#endif
template<int THRL> __device__ __forceinline__ void attn_unit(const int wave_s,int qb,const bf16*Qh,const bf16*__restrict__ Kh,const bf16*__restrict__ Vh,bf16*Oh,const float*__restrict__ cbias,const float qk2,char*shm){
  const int wid=wave_s; const int tid=wave_s*64+fresh_lane(),lane=tid&63,r32=lane&31,hi=lane>>5;
  const int q0=qb*QB;
  const bf16*Qw=Qh+(long)(q0+wid*QBLK)*DM;
  int t0; { const int ntab=(q0+QB)/KVBLK; const float thr=cbias[q0]-(qk2+44.0f); const int l_=tid&63;
    const bool c0_=(l_<ntab-4)&&(cbias[l_*64+63]<thr), c1_=(l_+64<ntab-4)&&(cbias[(l_+64)*64+63]<thr);
    t0=(__builtin_popcountll(__ballot(c0_))+__builtin_popcountll(__ballot(c1_)))&~1; t0=__builtin_amdgcn_readfirstlane(t0); }
  Kh+=(long)t0*KVBLK*DM; Vh+=(long)t0*KVBLK*DM; cbias+=t0*KVBLK;
  const unsigned lds0=(unsigned)(uintptr_t)shm;
  float*wsf=(float*)(shm+LDS_WS)+wid*64;
  const bf16*ksrc=Kh+(long)lane*DM+wid*8;
  const bf16*vsrc=Vh+(long)(16*(wid&3)+(lane>>2))*DM+(wid>>2)*32+(lane&3)*8;
  const unsigned kdst=lds0+LDS_K+wid*1024, vdst=lds0+LDS_V+wid*1024;
  #define DMA_K(t,slot) glds16(ksrc+(long)(t)*KVBLK*DM,(unsigned)__builtin_amdgcn_readfirstlane(kdst+(slot)))
  #define DMA_V(t,slot) glds16(vsrc+(long)(t)*KVBLK*DM,(unsigned)__builtin_amdgcn_readfirstlane(vdst+(slot)))
  const int vb0=(int)(lds0+LDS_V)+((lane>>4)&1)*32+(lane&3)*8+(4*hi+((lane&15)>>2))*64;
  const char*Kbase=shm+LDS_K; bf16x8 kf[8];
  const lds_cptr shm3=(lds_cptr)shm; const lds_cptr kp0=shm3+LDS_K+hi*1024+r32*16; const lds_cptr vp0=shm3+LDS_V+((lane>>4)&1)*32+(lane&3)*8+(4*hi+((lane&15)>>2))*64;
  { const int nk4=((q0+QB)>>2)-t0*16; __attribute__((address_space(3))) f32x4v* bt=(__attribute__((address_space(3))) f32x4v*)((lds_cptr)shm+LDS_BIAS); for(int i=tid;i<nk4;i+=NW*64) bt[i]=((const f32x4v*)cbias)[i]; }
  const int NT=(q0+QB)/KVBLK-t0;
  DMA_K(0,0);DMA_V(0,0);DMA_K(1,SLOTB);
  bf16x8 qr[4];
  #pragma unroll
  for(int d0=0;d0<4;++d0)qr[d0]=*reinterpret_cast<const bf16x8*>(&Qw[(long)r32*DM+d0*16+hi*8]);
  float mhat=0.f,l_reg=0.f;float zf_=0.f;asm volatile("":"+v"(zf_));f32x16 o[2];f32x16 negm;
  _Pragma("unroll") for(int r=0;r<16;++r){o[0][r]=zf_;o[1][r]=zf_;negm[r]=zf_;} asm volatile("":"+v"(negm));
  const int qrel=wid*QBLK+r32;
  #define CMASK(P0,P1,t) do{int jb_=(t)-(NT-4); if(jb_>=0)cmask(P0,P1,jb_,qrel,hi);}while(0)
  #define BIAS(P0,P1,t) do{ const __attribute__((address_space(3))) f32x4v* bt_=(const __attribute__((address_space(3))) f32x4v*)(shm3+LDS_BIAS)+(t)*16+hi; \
    _Pragma("unroll") for(int i_=0;i_<4;++i_){ const f32x4v b0_=bt_[2*i_], b1_=bt_[8+2*i_]; \
      P0[4*i_]+=b0_[0];P0[4*i_+1]+=b0_[1];P0[4*i_+2]+=b0_[2];P0[4*i_+3]+=b0_[3]; P1[4*i_]+=b1_[0];P1[4*i_+1]+=b1_[1];P1[4*i_+2]+=b1_[2];P1[4*i_+3]+=b1_[3]; } }while(0)
  bool resc=false;
  #define START(P0,P1) do{ const float rm=rowmax(P0,P1); resc=false; \
    { const float dl=rm; mhat=fadd_s(mhat,dl); \
      _Pragma("unroll") for(int r=0;r<16;++r){P0[r]=fsub_s(P0[r],dl);P1[r]=fsub_s(P1[r],dl);} \
      _Pragma("unroll") for(int r=0;r<16;++r)negm[r]=-mhat; asm volatile("":"+v"(negm)); } \
    _Pragma("unroll") for(int r=0;r<16;++r)P0[r]=__builtin_amdgcn_exp2f(P0[r]); }while(0)
  #define RESC() do{ if(resc){ asm volatile("s_waitcnt lgkmcnt(0)":::"memory"); \
      _Pragma("unroll") for(int d_=0;d_<2;++d_) _Pragma("unroll") for(int r=0;r<16;++r)o[d_][r]*=wsf[crow(r,hi)]; } }while(0)
  f32x16 pA0,pA1,pB0,pB1;
  int sl_prev=0,sl_cur=0,sl_next=SLOTB;
  #define ROT() do{sl_prev=sl_cur;sl_cur=sl_next;sl_next=(sl_next==(NSLOT-1)*SLOTB)?0:sl_next+SLOTB;}while(0)
  DMA_K(2,2*SLOTB);
  WAIT_BAR(3);
  qkt(pA0,pA1,Kbase,qr,negm,r32,hi);asm volatile("s_nop 15\n\ts_nop 7":"+v"(pA0),"+v"(pA1));BIAS(pA0,pA1,0);CMASK(pA0,pA1,0);
  START(pA0,pA1);
  _Pragma("unroll") for(int r=0;r<16;++r)pA1[r]=__builtin_amdgcn_exp2f(pA1[r]);
  WAIT_BAR(0);
  DMA_K(3,0);DMA_V(1,SLOTB);
  ROT();
  kload8(kf,kp0+sl_cur);
  WAIT_BAR(2);
  s16x4 vlo[8],vhi[8]; u32x4 pw0,pw1,pw2,pw3;
  #define PKW(P,B) cvtpk_s(P[B],P[B+1])
  #define PAF(k) __builtin_bit_cast(bf16x8,pw##k)
  #define VFR(i) (bf16x8){vlo[i][0],vlo[i][1],vlo[i][2],vlo[i][3],vhi[i][0],vhi[i][1],vhi[i][2],vhi[i][3]}
  #define PIN(x) asm volatile("":"+v"(x))
  #define MX3(a,b,c) __builtin_fmaxf(__builtin_fmaxf((a),(b)),(c))
  #define GAPA(MF,A0,A1,A2,A3,W0,W1,PW) do{ MF; sacc+=A0; sacc+=A1; sacc+=A2; sacc+=A3; PIN(sacc); W0; W1; PIN(PW); SBAR(); }while(0)
  #define EX(v) __builtin_amdgcn_exp2f(v)
  #define GAPB(MF,X,B) do{ MF; X[B]=EX(X[B]); X[B+1]=EX(X[B+1]); X[B+2]=EX(X[B+2]); X[B+3]=EX(X[B+3]); PIN(X); SBAR(); }while(0)
  #define VRD(i) do{ vlo[i]=vtr(vp_+(((i)>>2)*4096+((i)&3)*1024)); vhi[i]=vtr(vp_+(((i)>>2)*4096+((i)&3)*1024+512)); }while(0)
  #define KRD(G,j) do{ if(G){ kload2(kf,kp0+sl_next,j); SBAR(); } }while(0)
  #define STEP(C0,C1,P0,P1,t,GK,GV,GL) do{ SBAR(); \
    const lds_cptr vp_=vp0+sl_prev; \
    VRD(0); SBAR(); float sacc=(P0[0]+P0[1]); \
    GAPA(C0=__builtin_amdgcn_mfma_f32_32x32x16_bf16(kf[0],qr[0],negm,0,0,0), P0[2],P0[3],P0[4],P0[5],     pw0[0]=PKW(P0,0), pw0[1]=PKW(P0,2), pw0); \
    VRD(4); SBAR(); GAPA(C1=__builtin_amdgcn_mfma_f32_32x32x16_bf16(kf[1],qr[0],negm,0,0,0), P0[6],P0[7],P0[8],P0[9],     pw0[2]=PKW(P0,4), pw0[3]=PKW(P0,6), pw0); \
    VRD(1); SBAR(); GAPA(C0=__builtin_amdgcn_mfma_f32_32x32x16_bf16(kf[2],qr[1],C0,0,0,0),   P0[10],P0[11],P0[12],P0[13], pw1[0]=PKW(P0,8), pw1[1]=PKW(P0,10), pw1); \
    VRD(5); SBAR(); GAPA(C1=__builtin_amdgcn_mfma_f32_32x32x16_bf16(kf[3],qr[1],C1,0,0,0),   P0[14],P0[15],P1[0],P1[1],   pw1[2]=PKW(P0,12),pw1[3]=PKW(P0,14), pw1); \
    VRD(2); SBAR(); GAPA(C0=__builtin_amdgcn_mfma_f32_32x32x16_bf16(kf[4],qr[2],C0,0,0,0),   P1[2],P1[3],P1[4],P1[5],     pw2[0]=PKW(P1,0), pw2[1]=PKW(P1,2), pw2); \
    VRD(6); SBAR(); GAPA(C1=__builtin_amdgcn_mfma_f32_32x32x16_bf16(kf[5],qr[2],C1,0,0,0),   P1[6],P1[7],P1[8],P1[9],     pw2[2]=PKW(P1,4), pw2[3]=PKW(P1,6), pw2); \
    VRD(3); SBAR(); GAPA(C0=__builtin_amdgcn_mfma_f32_32x32x16_bf16(kf[6],qr[3],C0,0,0,0),   P1[10],P1[11],P1[12],P1[13], pw3[0]=PKW(P1,8), pw3[1]=PKW(P1,10), pw3); \
    VRD(7); SBAR(); GAPA(C1=__builtin_amdgcn_mfma_f32_32x32x16_bf16(kf[7],qr[3],C1,0,0,0),   P1[14],P1[15],0.f,0.f,       pw3[2]=PKW(P1,12),pw3[3]=PKW(P1,14), pw3); \
    l_reg+=sacc; \
    if(GK){DMA_K((t)+3,sl_cur);} if(GV){DMA_V((t)+1,sl_next);} \
    BIAS(C0,C1,t); CMASK(C0,C1,t); \
    { float a=MX3(C0[0],C0[1],C1[0]),b=MX3(C0[2],C0[3],C1[1]); a=MX3(a,C1[2],C1[3]); \
      _Pragma("unroll") for(int r=4;r<16;r+=4){a=MX3(a,C0[r],C0[r+1]);b=MX3(b,C0[r+2],C0[r+3]);a=MX3(a,C1[r],C1[r+1]);b=MX3(b,C1[r+2],C1[r+3]);} \
      float rm=__builtin_fmaxf(a,b); { auto rr=__builtin_amdgcn_permlane32_swap(__float_as_uint(rm),__float_as_uint(rm),false,false); rm=__builtin_fmaxf(__uint_as_float(rr[0]),__uint_as_float(rr[1])); } \
      resc=false; \
      if(__builtin_expect(__any(rm>(float)THRL),0)){ const float dl=__builtin_fmaxf(rm,0.f); mhat+=dl; \
        _Pragma("unroll") for(int r=0;r<16;++r){C0[r]-=dl;C1[r]-=dl;} \
        _Pragma("unroll") for(int r=0;r<16;++r)negm[r]=-mhat; asm volatile("":"+v"(negm)); \
        const float f=__builtin_amdgcn_exp2f(-dl); l_reg*=f; if(hi==0)wsf[r32]=f; resc=true; } } \
    SBAR(); \
    GAPB(o[0]=__builtin_amdgcn_mfma_f32_32x32x16_bf16(PAF(0),VFR(0),o[0],0,0,0), C0,0); \
    GAPB(o[1]=__builtin_amdgcn_mfma_f32_32x32x16_bf16(PAF(0),VFR(4),o[1],0,0,0), C0,4); \
    KRD(GL,0); GAPB(o[0]=__builtin_amdgcn_mfma_f32_32x32x16_bf16(PAF(1),VFR(1),o[0],0,0,0), C0,8); \
    KRD(GL,1); GAPB(o[1]=__builtin_amdgcn_mfma_f32_32x32x16_bf16(PAF(1),VFR(5),o[1],0,0,0), C0,12); \
    KRD(GL,2); GAPB(o[0]=__builtin_amdgcn_mfma_f32_32x32x16_bf16(PAF(2),VFR(2),o[0],0,0,0), C1,0); \
    KRD(GL,3); GAPB(o[1]=__builtin_amdgcn_mfma_f32_32x32x16_bf16(PAF(2),VFR(6),o[1],0,0,0), C1,4); \
    GAPB(o[0]=__builtin_amdgcn_mfma_f32_32x32x16_bf16(PAF(3),VFR(3),o[0],0,0,0), C1,8); \
    GAPB(o[1]=__builtin_amdgcn_mfma_f32_32x32x16_bf16(PAF(3),VFR(7),o[1],0,0,0), C1,12); \
    }while(0)
  int t=1;
  #undef CMASK
  #define CMASK(P0,P1,t) do{}while(0)
  for(;t+5<NT;t+=2){
    STEP(pB0,pB1,pA0,pA1,t,true,true,true);     WAIT_BAR(2); RESC(); ROT();
    STEP(pA0,pA1,pB0,pB1,t+1,true,true,true);   WAIT_BAR(2); RESC(); ROT();
  }
  #undef CMASK
  #define CMASK(P0,P1,t) do{int jb_=(t)-(NT-4); if(jb_>=0)cmask(P0,P1,jb_,qrel,hi);}while(0)
  #define ENDW(tt) do{ if((tt)+3<NT){WAIT_BAR(2);} else if((tt)+2<NT){WAIT_BAR(1);} else {WAIT_BAR(0);} }while(0)
  for(;t+1<NT;t+=2){
    STEP(pB0,pB1,pA0,pA1,t,(t+3<NT),(t+1<NT),(t+1<NT));       ENDW(t);   RESC(); ROT();
    STEP(pA0,pA1,pB0,pB1,t+1,(t+4<NT),(t+2<NT),(t+2<NT));     ENDW(t+1); RESC(); ROT();
  }
  STEP(pB0,pB1,pA0,pA1,NT-1,false,false,false); RESC();
  { float sacc=pB0[0]+pB0[1]; _Pragma("unroll") for(int r=2;r<16;++r)sacc+=pB0[r]; _Pragma("unroll") for(int r=0;r<16;++r)sacc+=pB1[r]; l_reg+=sacc;
    pw0=(u32x4){PKW(pB0,0),PKW(pB0,2),PKW(pB0,4),PKW(pB0,6)};pw1=(u32x4){PKW(pB0,8),PKW(pB0,10),PKW(pB0,12),PKW(pB0,14)};pw2=(u32x4){PKW(pB1,0),PKW(pB1,2),PKW(pB1,4),PKW(pB1,6)};pw3=(u32x4){PKW(pB1,8),PKW(pB1,10),PKW(pB1,12),PKW(pB1,14)};
    SBAR(); pv(o,vb0+sl_cur,PAF(0),PAF(1),PAF(2),PAF(3)); }
  #undef PKW
  #undef PAF
  #undef VFR
  #undef PIN
  #undef MX3
  #undef GAPA
  #undef GAPB
  #undef EX
  #undef VRD
  #undef KRD
  #undef STEP
  #undef ENDW
  {auto rr=__builtin_amdgcn_permlane32_swap(__float_as_uint(l_reg),__float_as_uint(l_reg),false,false);l_reg=__uint_as_float(rr[0])+__uint_as_float(rr[1]);}
  if(hi==0)wsf[32+r32]=l_reg;asm volatile("s_waitcnt lgkmcnt(0)":::"memory");
  float rli[16];
  #pragma unroll
  for(int r=0;r<16;++r)rli[r]=__builtin_amdgcn_rcpf(wsf[32+crow(r,hi)]);
  bf16*Ow=Oh+(long)(q0+wid*QBLK)*DM;
  { bf16*stg=(bf16*)(shm+LDS_OST)+wid*2048;
    #pragma unroll
    for(int r=0;r<16;++r){const int orow=crow(r,hi);
      #pragma unroll
      for(int d0=0;d0<2;++d0)stg[orow*64+d0*32+r32]=__float2bfloat16(o[d0][r]*rli[r]);}
    asm volatile("s_waitcnt lgkmcnt(0)":::"memory");
    #pragma unroll
    for(int i=0;i<4;++i){const int row=i*8+(lane>>3),ch=lane&7; const u32x4 v=*(const u32x4*)(stg+row*64+ch*8); ATTN_STORE16(Ow+(long)row*DM+ch*8,v);} }
  asm volatile("s_waitcnt lgkmcnt(0)\n\ts_barrier":::"memory");
  #undef DMA_K
  #undef DMA_V
  #undef CMASK
  #undef START
  #undef RESC
  #undef ROT
  #undef BIAS
}
constexpr int ATTN_LDS_BYTES=LDS_BYTES;
constexpr int SWA_K=0, SWA_V=6*SLOTB, SWA_OST=12*SLOTB, SWA_WS=133120;
__device__ __forceinline__ void swa_unit(const int wave_s,int qb,const bf16*Qh,const bf16*__restrict__ Kh,const bf16*__restrict__ Vh,bf16*Oh,float slope2,float sink2,char*shm){
  const int wid=wave_s; const int tid=wave_s*64+fresh_lane(),lane=tid&63,r32=lane&31,hi=lane>>5;
  const int q0=qb*QB, c0=4*qb-2;
  const bf16*Qw=Qh+(long)(q0+wid*QBLK)*DM;
  const unsigned lds0=(unsigned)(uintptr_t)shm;
  float*wsf=(float*)(shm+SWA_WS)+wid*64;
  const bf16*ksrc=Kh+(long)lane*DM+wid*8;
  const bf16*vsrc=Vh+(long)(16*(wid&3)+(lane>>2))*DM+(wid>>2)*32+(lane&3)*8;
  const unsigned kdst=lds0+SWA_K+wid*1024, vdst=lds0+SWA_V+wid*1024;
  #pragma unroll
  for(int s=0;s<6;++s){ const int ch=c0+s; if(ch>=0){ glds16(ksrc+(long)ch*KVBLK*DM,(unsigned)__builtin_amdgcn_readfirstlane(kdst+s*SLOTB)); glds16(vsrc+(long)ch*KVBLK*DM,(unsigned)__builtin_amdgcn_readfirstlane(vdst+s*SLOTB)); } }
  bf16x8 qr[4];
  #pragma unroll
  for(int d0=0;d0<4;++d0)qr[d0]=*reinterpret_cast<const bf16x8*>(&Qw[(long)r32*DM+d0*16+hi*8]);
  WAIT_BAR(0);
  const int wc=wid>>1, qrel=(wid&1)*32+r32;
  f32x16 zero=f32x16{}; asm volatile("":"+v"(zero));
  f32x16 S[3][2];
  #pragma unroll
  for(int t=0;t<3;++t){
    if(c0+wc+t>=0){
      qkt(S[t][0],S[t][1],shm+SWA_K+(wc+t)*SLOTB,qr,zero,r32,hi);
      const float qf=(float)(64*(2-t)+qrel-4*hi);
      #pragma unroll
      for(int r=0;r<16;++r){ const float dd=qf-(float)((r&3)+8*(r>>2)); S[t][0][r]=__builtin_fmaf(-slope2,__builtin_fabsf(dd),S[t][0][r]); S[t][1][r]=__builtin_fmaf(-slope2,__builtin_fabsf(dd-32.f),S[t][1][r]); }
    } else {
      #pragma unroll
      for(int r=0;r<16;++r){ S[t][0][r]=-INFINITY; S[t][1][r]=-INFINITY; }
    }
  }
  float m=sink2;
  #pragma unroll
  for(int t=0;t<3;++t) m=__builtin_fmaxf(m,rowmax(S[t][0],S[t][1]));
  float l=0.f;
  #pragma unroll
  for(int t=0;t<3;++t){
    #pragma unroll
    for(int r=0;r<16;++r){ S[t][0][r]=__builtin_amdgcn_exp2f(S[t][0][r]-m); S[t][1][r]=__builtin_amdgcn_exp2f(S[t][1][r]-m); l+=S[t][0][r]+S[t][1][r]; }
  }
  {auto rr=__builtin_amdgcn_permlane32_swap(__float_as_uint(l),__float_as_uint(l),false,false);l=__uint_as_float(rr[0])+__uint_as_float(rr[1]);}
  l+=__builtin_amdgcn_exp2f(sink2-m);
  f32x16 o[2];o[0]=f32x16{};o[1]=f32x16{};
  const int vb0=(int)(lds0+SWA_V)+((lane>>4)&1)*32+(lane&3)*8+(4*hi+((lane&15)>>2))*64;
  #pragma unroll
  for(int t=0;t<3;++t){
    if(c0+wc+t>=0){
      #define PKW(P,B) cvtpk_s(P[B],P[B+1])
      const u32x4 pw0=(u32x4){PKW(S[t][0],0),PKW(S[t][0],2),PKW(S[t][0],4),PKW(S[t][0],6)},pw1=(u32x4){PKW(S[t][0],8),PKW(S[t][0],10),PKW(S[t][0],12),PKW(S[t][0],14)};
      const u32x4 pw2=(u32x4){PKW(S[t][1],0),PKW(S[t][1],2),PKW(S[t][1],4),PKW(S[t][1],6)},pw3=(u32x4){PKW(S[t][1],8),PKW(S[t][1],10),PKW(S[t][1],12),PKW(S[t][1],14)};
      #undef PKW
      SBAR(); pv(o,vb0+(wc+t)*SLOTB,__builtin_bit_cast(bf16x8,pw0),__builtin_bit_cast(bf16x8,pw1),__builtin_bit_cast(bf16x8,pw2),__builtin_bit_cast(bf16x8,pw3));
    }
  }
  if(hi==0)wsf[32+r32]=l;asm volatile("s_waitcnt lgkmcnt(0)":::"memory");
  float rli[16];
  #pragma unroll
  for(int r=0;r<16;++r)rli[r]=__builtin_amdgcn_rcpf(wsf[32+crow(r,hi)]);
  bf16*Ow=Oh+(long)(q0+wid*QBLK)*DM;
  { bf16*stg=(bf16*)(shm+SWA_OST)+wid*2048;
    #pragma unroll
    for(int r=0;r<16;++r){const int orow=crow(r,hi);
      #pragma unroll
      for(int d0=0;d0<2;++d0)stg[orow*64+d0*32+r32]=__float2bfloat16(o[d0][r]*rli[r]);}
    asm volatile("s_waitcnt lgkmcnt(0)":::"memory");
    #pragma unroll
    for(int i=0;i<4;++i){const int row=i*8+(lane>>3),ch=lane&7; const u32x4 v=*(const u32x4*)(stg+row*64+ch*8); ATTN_STORE16(Ow+(long)row*DM+ch*8,v);} }
  asm volatile("s_waitcnt lgkmcnt(0)\n\ts_barrier":::"memory");
}

#undef SBAR
#undef WAIT_BAR
}

namespace cg = cooperative_groups;
constexpr int NWAVES = 8;
constexpr int BATCH = 2, T = 8192, D = 1024, FF = 4096, PLE = 256, DIN_SRC = 4360, NZ = 4352, M = BATCH * T;
constexpr float RMS_EPS = 1e-6f, LOG2E = 1.4426950408889634f;
constexpr size_t MiB = 1u << 20;
constexpr size_t WS_WIN = 0, WS_WA = 9 * MiB, WS_WB = 10 * MiB, WS_WMIX = 11 * MiB, WS_W1 = 13 * MiB, WS_W2 = 21 * MiB, WS_WG = 29 * MiB, WS_WP = 31 * MiB;
constexpr size_t WS_LF = 31 * MiB + 512 * 1024, WS_CB = 32 * MiB;
constexpr size_t WS_NM = 32 * MiB + 512 * 1024;
constexpr size_t WS_ST1 = 33 * MiB, WS_ST2 = 34 * MiB, WS_ST3 = 35 * MiB;
constexpr size_t WS_PB = 36 * MiB;
constexpr size_t WS_XN = 44 * MiB;
constexpr size_t WS_HN = 76 * MiB;
constexpr size_t WS_Z = 108 * MiB;
constexpr size_t WS_CTL = 244 * MiB, CTL_ZERO_BYTES = 16384;
constexpr size_t WS_END = 245 * MiB;
constexpr int RING_BYTES = 131072, LDS_BYTES = 147456, MISC_OFF = RING_BYTES + 320;
#define GAS __attribute__((address_space(1)))
#define LAS __attribute__((address_space(3)))
typedef unsigned short bf16;
typedef unsigned v4u __attribute__((ext_vector_type(4)));
typedef unsigned v2u __attribute__((ext_vector_type(2)));
typedef float f32x4 __attribute__((ext_vector_type(4)));
#define LDS_WAIT() asm volatile("s_waitcnt lgkmcnt(0)" ::: "memory")
__device__ __forceinline__ unsigned f2bf(float f) { unsigned u = __builtin_bit_cast(unsigned, f); return (u + 0x7fffu + ((u >> 16) & 1u)) >> 16; }
__device__ __forceinline__ unsigned pk2(float lo, float hi) { return f2bf(lo) | (f2bf(hi) << 16); }
__device__ __forceinline__ float wave_sum(float v) {
#pragma unroll
    for (int o = 1; o < 64; o <<= 1) v += __shfl_xor(v, o);
    return v;
}
#define RLX_AGENT __ATOMIC_RELAXED, __HIP_MEMORY_SCOPE_AGENT
#define XB_TMO      128
#define XB_XCNT(j)  (256  + 64 * (j))
#define XB_XSUB(j)  (1280 + 64 * (j))
#define XB_XGEN(j)  (2304 + 64 * (j))
#define XB_TOP      3328
#define XB_TOPGEN   3392
#define XCD_BAR_WORDS 3456
#define XB_SPIN_CAP (1u << 18)

__device__ __forceinline__ unsigned xb_ld(unsigned* p)              { return __hip_atomic_load(p, __ATOMIC_RELAXED, __HIP_MEMORY_SCOPE_AGENT); }
__device__ __forceinline__ unsigned xb_add(unsigned* p, unsigned v) { return __hip_atomic_fetch_add(p, v, __ATOMIC_RELAXED, __HIP_MEMORY_SCOPE_AGENT); }
__device__ __forceinline__ unsigned xb_xcc_id() { return (unsigned)__builtin_amdgcn_s_getreg((3 << 11) | 20) & 0xFu; }
#define XB_SPIN(cond, bar) do { unsigned _sp = 0; while (cond) { __builtin_amdgcn_s_sleep(1); \
    if ((++_sp & 255u) == 0u) { if (xb_ld(&(bar)[XB_TMO])) break; if (_sp > XB_SPIN_CAP) { atomicAdd(&(bar)[XB_TMO], 1u); break; } } } } while (0)

struct XcdBarrier {
    unsigned* bar; unsigned x;
    volatile LAS unsigned* st;
};

__device__ __forceinline__ XcdBarrier xcd_barrier_post(unsigned* bar, volatile LAS unsigned* st) {
    XcdBarrier b; b.bar = bar; b.x = xb_xcc_id(); b.st = st;
    if (threadIdx.x == 0) (void)xb_add(&bar[XB_XCNT(b.x)], 1u);
    return b;
}
__device__ __forceinline__ void xcd_barrier_complete(unsigned* bar, unsigned x, unsigned& nloc, unsigned& nx) {
    const unsigned G = gridDim.x * gridDim.y * gridDim.z;
    unsigned sum, cnt, mine, sp = 0u;
    for (;;) {
        sum = 0u; cnt = 0u; mine = 0u;
#pragma unroll
        for (unsigned j = 0; j < 16; ++j) { const unsigned c = xb_ld(&bar[XB_XCNT(j)]); sum += c; cnt += (c > 0u) ? 1u : 0u; mine = (j == x) ? c : mine; }
        if (sum == G) break;
        __builtin_amdgcn_s_sleep(1);
        if ((++sp & 255u) == 0u) { if (xb_ld(&bar[XB_TMO])) break; if (sp > XB_SPIN_CAP) { atomicAdd(&bar[XB_TMO], 1u); break; } }
    }
    nloc = mine > 0u ? mine : 1u; nx = cnt > 0u ? cnt : 1u;
}

__device__ __forceinline__ void xcd_barrier(const XcdBarrier& b, const bool t0) {
    asm volatile("s_waitcnt vmcnt(0)" ::: "memory");
    __syncthreads();
    if (t0) {
        unsigned* bar = b.bar;
        __builtin_amdgcn_s_waitcnt(0);
        unsigned nloc = b.st[0], nx = b.st[1];
        if (nloc == 0u) { xcd_barrier_complete(bar, b.x, nloc, nx); b.st[0] = nloc; b.st[1] = nx; }
        const unsigned old = xb_add(&bar[XB_XSUB(b.x)], 1u);
        const unsigned gen = old / nloc;
        if (old + 1u == (gen + 1u) * nloc) {
            __builtin_amdgcn_fence(__ATOMIC_RELEASE, "agent");
            asm volatile("s_waitcnt vmcnt(0)" ::: "memory");
            const unsigned og = xb_add(&bar[XB_TOP], 1u);
            const unsigned tg = og / nx;
            if (og + 1u == (tg + 1u) * nx) xb_add(&bar[XB_TOPGEN], 1u);
            else XB_SPIN(xb_ld(&bar[XB_TOPGEN]) == tg, bar);
            __builtin_amdgcn_fence(__ATOMIC_ACQUIRE, "agent");
            xb_add(&bar[XB_XGEN(b.x)], 1u);
            asm volatile("s_waitcnt vmcnt(0)" ::: "memory");
        } else {
            XB_SPIN(xb_ld(&bar[XB_XGEN(b.x)]) == gen, bar);
            __builtin_amdgcn_fence(__ATOMIC_ACQUIRE, "agent");
            asm volatile("s_waitcnt vmcnt(0)" ::: "memory");
        }
    }
    __syncthreads();
}
struct Frame {
    LAS unsigned char* lds; int wave, vcu, G;
};
__device__ __forceinline__ void p0_transpose_item(const float* W, int ldw, int K, int N, int split, int extra, const float* gs, bf16* WT, LAS float* scr, int item, int lane) {
    const int nblk = N / 32, kb = item / nblk, nb = item % nblk, k0 = 64 * kb, n0 = 32 * nb, s0 = n0 + (n0 >= split ? extra : 0);
    const float* src = W + (size_t)(k0 + (lane >> 5)) * ldw + s0 + (lane & 31);
    float w[32];
#pragma unroll
    for (int i = 0; i < 32; ++i) w[i] = src[(size_t)(2 * i) * ldw];
    const int c = lane & 7;
    f32x4 g0 = (f32x4){1.f, 1.f, 1.f, 1.f}, g1 = g0;
    if (gs) { g0 = *(const f32x4*)(gs + k0 + 8 * c); g1 = *(const f32x4*)(gs + k0 + 8 * c + 4); }
#pragma unroll
    for (int i = 0; i < 32; ++i) scr[(2 * i + (lane >> 5)) * 33 + (lane & 31)] = w[i];
    LDS_WAIT(); asm volatile("" ::: "memory");
#pragma unroll
    for (int j = 0; j < 4; ++j) { const int n = (lane >> 3) + 8 * j; const LAS float* s = scr + (8 * c) * 33 + n;
        v4u o; o.x = pk2(s[0 * 33] * g0.x, s[1 * 33] * g0.y); o.y = pk2(s[2 * 33] * g0.z, s[3 * 33] * g0.w); o.z = pk2(s[4 * 33] * g1.x, s[5 * 33] * g1.y); o.w = pk2(s[6 * 33] * g1.z, s[7 * 33] * g1.w);
        *(GAS v4u*)(WT + (size_t)(n0 + n) * K + k0 + 8 * c) = o; }
    LDS_WAIT(); asm volatile("" ::: "memory");
}
struct Args { const float* in[16]; float* out; unsigned char* ws; };
constexpr int WF_OFF = 8 * 8704;

__global__ void __launch_bounds__(NWAVES * 64, 2) mk_fwd(Args args) {
    extern __shared__ __attribute__((aligned(16))) unsigned char lds[];
    cg::grid_group grid = cg::this_grid();
    Frame F;
    F.lds = (LAS unsigned char*)lds;
    F.wave = __builtin_amdgcn_readfirstlane((int)threadIdx.x >> 6);
    F.G = gridDim.x; { const int bx = blockIdx.x; F.vcu = (F.G % 8 == 0) ? (bx % 8) * (F.G / 8) + bx / 8 : bx; }
    unsigned char* ws = args.ws;
    const float* x = args.in[0]; const float* p_in = args.in[1]; const float* g_mix = args.in[2]; const float* w_in = args.in[3]; const float* b_forget = args.in[4];
    const float* sinks = args.in[5]; const float* w_br_swa = args.in[6]; const float* w_br_fox = args.in[7]; const float* w_mix = args.in[8]; const float* g_mlp = args.in[9];
    const float* w_ff1 = args.in[10]; const float* w_ff2 = args.in[11]; const float* g_ple = args.in[12]; const float* w_pg = args.in[13]; const float* w_pp = args.in[14]; const float* g_final = args.in[15];
    float* out = args.out;
    bf16 *WIN_t = (bf16*)(ws + WS_WIN), *WA_t = (bf16*)(ws + WS_WA), *WB_t = (bf16*)(ws + WS_WB), *WMIX_t = (bf16*)(ws + WS_WMIX), *W1_t = (bf16*)(ws + WS_W1), *W2_t = (bf16*)(ws + WS_W2), *WG_t = (bf16*)(ws + WS_WG), *WP_t = (bf16*)(ws + WS_WP);
    float *LF = (float*)(ws + WS_LF), *CB = (float*)(ws + WS_CB), *ST1 = (float*)(ws + WS_ST1), *ST2 = (float*)(ws + WS_ST2), *ST3 = (float*)(ws + WS_ST3);
    bf16 *PB = (bf16*)(ws + WS_PB), *XN = (bf16*)(ws + WS_XN), *HN = (bf16*)(ws + WS_HN), *Z = (bf16*)(ws + WS_Z), *HB = (bf16*)(ws + WS_Z); bf16* PP = (bf16*)(ws + WS_Z);
    unsigned* NM = (unsigned*)(ws + WS_NM);
    const int gw = F.vcu * NWAVES + F.wave, NGW = F.G * NWAVES;

    for (int u = threadIdx.x; u < 128; u += NWAVES * 64) ((LAS unsigned*)(F.lds + RING_BYTES))[u] = 0u;
    __syncthreads();
    XcdBarrier bar = xcd_barrier_post((unsigned*)(ws + WS_CTL), (volatile LAS unsigned*)(F.lds + MISC_OFF) + 8);
#define GRID_BAR() do { const int l_ = fresh_lane(); xcd_barrier(bar, (F.wave == 0) && (l_ == 0)); } while (0)
    {
        const int p0_tid = threadIdx.x, p0_lane = p0_tid & 63;
        for (int i = blockIdx.x * (NWAVES * 64) + p0_tid; i < 1024 + 32; i += F.G * NWAVES * 64) NM[i] = 0u;
        LAS float* wfT = (LAS float*)(F.lds + WF_OFF);
        for (int i = p0_tid; i < 8 * D; i += NWAVES * 64) { const int k = i >> 3, h = i & 7; wfT[h * 1024 + k] = g_mix[k] * w_in[(size_t)k * DIN_SRC + 2304 + h]; }
        __syncthreads();
        f32x4 gm4[4];
#pragma unroll
        for (int j = 0; j < 4; ++j) gm4[j] = ((const GAS f32x4*)g_mix)[64 * j + p0_lane];
        const float bfg = b_forget[p0_lane & 7];
        f32x4 v[4];
        if (gw < M) { const GAS f32x4* xr = (const GAS f32x4*)(x + (size_t)gw * D) + p0_lane;
#pragma unroll
            for (int j = 0; j < 4; ++j) v[j] = xr[64 * j]; }
        for (int m = gw; m < M; m += NGW) {
            f32x4 vn[4]; const int mn = (m + NGW < M) ? m + NGW : m;
            { const GAS f32x4* xr = (const GAS f32x4*)(x + (size_t)mn * D) + p0_lane;
#pragma unroll
              for (int j = 0; j < 4; ++j) vn[j] = xr[64 * j]; }
            float ss = 0.f;
#pragma unroll
            for (int j = 0; j < 4; ++j) ss += (v[j].x * v[j].x + v[j].y * v[j].y) + (v[j].z * v[j].z + v[j].w * v[j].w);
            float a8[8];
#pragma unroll
            for (int h = 0; h < 8; ++h) { float a = 0.f;
#pragma unroll
                for (int j = 0; j < 4; ++j) { const f32x4 w = ((const LAS f32x4*)wfT)[h * 256 + 64 * j + p0_lane]; a += (v[j].x * w.x + v[j].y * w.y) + (v[j].z * w.z + v[j].w * w.w); }
                a8[h] = a; }
#pragma unroll
            for (int o = 1; o < 64; o <<= 1) { ss += __shfl_xor(ss, o);
#pragma unroll
                for (int h = 0; h < 8; ++h) a8[h] += __shfl_xor(a8[h], o); }
            const float rstd = 1.f / sqrtf(ss * (1.f / D) + RMS_EPS);
            float fsel = a8[0];
#pragma unroll
            for (int h = 1; h < 8; ++h) fsel = (p0_lane == h) ? a8[h] : fsel;
            if (p0_lane < 8) { const float xf = fsel * rstd + bfg; const float ls = fminf(xf, 0.f) - log1pf(expf(-fabsf(xf)));
                LF[(size_t)((m >> 13) * 8 + p0_lane) * T + (m & (T - 1))] = ls; }
            GAS unsigned long long* o8 = (GAS unsigned long long*)(XN + (size_t)m * D) + p0_lane;
#pragma unroll
            for (int j = 0; j < 4; ++j) { const f32x4 y = v[j] * rstd * gm4[j];
                o8[64 * j] = (unsigned long long)pk2(y.x, y.y) | ((unsigned long long)pk2(y.z, y.w) << 32); }
#pragma unroll
            for (int j = 0; j < 4; ++j) v[j] = vn[j];
        }
        for (int i = gw * 64 + p0_lane; i < M * PLE / 32; i += NGW * 64) { f32x4 a[8];
#pragma unroll
            for (int q = 0; q < 4; ++q) { a[2 * q] = ((const GAS f32x4*)p_in)[2 * (i + q * (M * PLE / 32))]; a[2 * q + 1] = ((const GAS f32x4*)p_in)[2 * (i + q * (M * PLE / 32)) + 1]; }
#pragma unroll
            for (int q = 0; q < 4; ++q) { v4u o; o.x = pk2(a[2 * q].x, a[2 * q].y); o.y = pk2(a[2 * q].z, a[2 * q].w); o.z = pk2(a[2 * q + 1].x, a[2 * q + 1].y); o.w = pk2(a[2 * q + 1].z, a[2 * q + 1].w); ((GAS v4u*)PB)[i + q * (M * PLE / 32)] = o; } }
        LAS float* scr = (LAS float*)(F.lds + F.wave * 8704);
        constexpr int I_IN = (D / 64) * (NZ / 32), I_A = (512 / 64) * (D / 32), I_MIX = (D / 64) * (D / 32), I_1 = (D / 64) * (FF / 32), I_2 = (FF / 64) * (D / 32), I_P = (PLE / 64) * (D / 32);
        constexpr int NITEMS = I_IN + 2 * I_A + I_MIX + I_1 + I_2 + I_MIX + I_P;
        for (int it = gw; it < NITEMS; it += NGW) {
            int r = it;
            if (r < I_IN) { p0_transpose_item(w_in, DIN_SRC, D, NZ, 2304, 8, nullptr, WIN_t, scr, r, p0_lane); continue; } r -= I_IN;
            if (r < I_A) { p0_transpose_item(w_br_swa, D, 512, D, 1 << 30, 0, nullptr, WA_t, scr, r, p0_lane); continue; } r -= I_A;
            if (r < I_A) { p0_transpose_item(w_br_fox, D, 512, D, 1 << 30, 0, nullptr, WB_t, scr, r, p0_lane); continue; } r -= I_A;
            if (r < I_MIX) { p0_transpose_item(w_mix, D, D, D, 1 << 30, 0, nullptr, WMIX_t, scr, r, p0_lane); continue; } r -= I_MIX;
            if (r < I_1) { p0_transpose_item(w_ff1, FF, D, FF, 1 << 30, 0, g_mlp, W1_t, scr, r, p0_lane); continue; } r -= I_1;
            if (r < I_2) { p0_transpose_item(w_ff2, D, FF, D, 1 << 30, 0, nullptr, W2_t, scr, r, p0_lane); continue; } r -= I_2;
            if (r < I_MIX) { p0_transpose_item(w_pg, D, D, D, 1 << 30, 0, g_ple, WG_t, scr, r, p0_lane); continue; } r -= I_MIX;
            p0_transpose_item(w_pp, D, PLE, D, 1 << 30, 0, nullptr, WP_t, scr, r, p0_lane);
        }
    }
    grid.sync();

    for (int bh = blockIdx.x; bh < 16; bh += gridDim.x) {
        const int c_lane = fresh_lane(), c_tid = F.wave * 64 + c_lane;
        const GAS f32x4* src = (const GAS f32x4*)(LF + (size_t)bh * T) + c_tid * 4;
        f32x4 v[4]; float run = 0.f;
#pragma unroll
        for (int j = 0; j < 4; ++j) { v[j] = src[j];
#pragma unroll
            for (int e = 0; e < 4; ++e) { run += v[j][e]; v[j][e] = run; } }
        float sc = run;
#pragma unroll
        for (int o = 1; o < 64; o <<= 1) { const float n = __shfl_up(sc, o); if (c_lane >= o) sc += n; }
        LAS float* wt = (LAS float*)F.lds;
        if (c_lane == 63) wt[F.wave] = sc;
        __syncthreads();
        float woff = 0.f;
        for (int w = 0; w < F.wave; ++w) woff += wt[w];
        const float off = woff + sc - run;
        GAS f32x4* dst = (GAS f32x4*)(CB + (size_t)bh * T) + c_tid * 4;
#pragma unroll
        for (int j = 0; j < 4; ++j) dst[j] = (v[j] + off) * (-LOG2E);
        __syncthreads();
    }
    {
        pg8::Gemm g{XN, WIN_t, M, NZ, D, D}; pg8::StaticOrder S; S.init(M, NZ, F.G, (int)blockIdx.x);
        pg8::EpiZ E{Z, NM, 0};
        pg8::gemm_phase<pg8::EpiZ, pg8::StaticOrder, PG8_ALIGN, PG8_SP2>(F.lds, g, S, E, F.wave);
    }
    GRID_BAR();

    {
        unsigned* qctr = (unsigned*)(ws + WS_CTL) + 3584;
        volatile LAS unsigned* qslot = (volatile LAS unsigned*)(F.lds + RING_BYTES + 16);
        for (;;) {
            { const int l_ = fresh_lane(); if (F.wave == 0 && l_ == 0) qslot[0] = __hip_atomic_fetch_add(qctr, 1u, __ATOMIC_RELAXED, __HIP_MEMORY_SCOPE_AGENT); }
            __syncthreads();
            const int idx = __builtin_amdgcn_readfirstlane((int)qslot[0]);
            __syncthreads();
            if (idx >= 64 + 512 + 512) break;
            if (idx < 64) {
                continue;
            } else if (idx < 64 + 512) {
                const int j = idx - 64, qb = 31 - (j >> 4), bh = j & 15, b = bh >> 3, h = bh & 7;
                const attn_body::bf16* Zb = (const attn_body::bf16*)Z + (size_t)b * T * NZ;
                const attn_body::bf16* Qh = Zb + 768 + h * 64; const attn_body::bf16* Kh = Zb + 1280 + h * 64; const attn_body::bf16* Vh = Zb + 1792 + h * 64;
                const float* cb = CB + (size_t)bh * T;
                const float km = sqrtf(__uint_as_float(NM[1024 + bh * 2]) + __uint_as_float(NM[1024 + bh * 2 + 1]));
                const int pmA = b * 32 + qb;
                const float qkA = 2.04f * km * sqrtf(__uint_as_float(NM[(pmA * 8 + h) * 2]) + __uint_as_float(NM[(pmA * 8 + h) * 2 + 1]));
                attn_body::attn_unit<24>(F.wave, qb, Qh, Kh, Vh, (attn_body::bf16*)Qh, cb, qkA, (char*)lds);
            } else {
                const int j = idx - 64 - 512, bh = j >> 5, qb = j & 31, b = bh >> 3, h = bh & 7;
                const attn_body::bf16* Zb = (const attn_body::bf16*)Z + (size_t)b * T * NZ;
                const attn_body::bf16* Qh = Zb + h * 64; const attn_body::bf16* Kh = Zb + 512 + (h >> 2) * 64; const attn_body::bf16* Vh = Zb + 640 + (h >> 2) * 64;
                const float slope2 = exp2f(-(float)(h + 1)) * LOG2E, sink2 = sinks[h] * LOG2E;
                attn_body::swa_unit(F.wave, qb, Qh, Kh, Vh, (attn_body::bf16*)Qh, slope2, sink2, (char*)lds);
            }
        }
    }
    GRID_BAR();

    {
        pg8::StaticOrder S; S.init(M, D, F.G, (int)blockIdx.x);
        { pg8::Gemm g{Z, WA_t, M, D, 512, NZ}; pg8::EpiT1 E{Z + 2304, (bf16*)out}; pg8::gemm_phase<pg8::EpiT1, pg8::StaticOrder, PG8_ALIGN, PG8_SP2>(F.lds, g, S, E, F.wave); }
        { pg8::Gemm g{Z + 768, WB_t, M, D, 512, NZ}; pg8::EpiMix E{Z + 3328, (const bf16*)out, XN}; pg8::gemm_phase<pg8::EpiMix, pg8::StaticOrder, PG8_ALIGN, PG8_SP2>(F.lds, g, S, E, F.wave); }
    }
    GRID_BAR();

    {
        pg8::Gemm g{XN, WMIX_t, M, D, D, D}; pg8::StaticOrder S; S.init(M, D, F.G, (int)blockIdx.x);
        pg8::EpiRes E{x, out, HN, ST1};
        pg8::gemm_phase<pg8::EpiRes, pg8::StaticOrder, PG8_ALIGN, PG8_SP2>(F.lds, g, S, E, F.wave);
    }
    GRID_BAR();

    {
        pg8::Gemm g{HN, W1_t, M, FF, D, D}; pg8::StaticOrder S; S.init(M, FF, F.G, (int)blockIdx.x);
        pg8::EpiRelu2 E{ST1, HB};
        pg8::gemm_phase<pg8::EpiRelu2, pg8::StaticOrder, PG8_ALIGN, PG8_SP2>(F.lds, g, S, E, F.wave);
    }
    GRID_BAR();

    {
        pg8::Gemm g{HB, W2_t, M, D, FF, FF}; pg8::StaticOrder S; S.init(M, D, F.G, (int)blockIdx.x);
        pg8::EpiRes E{out, out, XN, ST2};
        pg8::gemm_phase<pg8::EpiRes, pg8::StaticOrder, PG8_ALIGN, PG8_SP2>(F.lds, g, S, E, F.wave);
    }
    GRID_BAR();

    {
        pg8::StaticOrder S; S.init(M, D, F.G, (int)blockIdx.x);
        { pg8::Gemm g{PB, WP_t, M, D, PLE, PLE}; pg8::EpiPP E{PP}; pg8::gemm_phase<pg8::EpiPP, pg8::StaticOrder, PG8_ALIGN, PG8_SP2>(F.lds, g, S, E, F.wave); }
        { pg8::Gemm g{XN, WG_t, M, D, D, D}; pg8::EpiPle E{ST2, PP, out, ST3}; pg8::gemm_phase<pg8::EpiPle, pg8::StaticOrder, PG8_ALIGN, PG8_SP2>(F.lds, g, S, E, F.wave); }
    }
    GRID_BAR();

    const int f_lane = fresh_lane();
    for (int m = gw; m < M; m += NGW) {
        float t = (f_lane < 16) ? ST3[(size_t)m * 16 + f_lane] : 0.f;
        const float rstd = 1.f / sqrtf(wave_sum(t) * (1.f / D) + RMS_EPS);
        GAS f32x4* xr = (GAS f32x4*)(out + (size_t)m * D) + f_lane;
#pragma unroll
        for (int j = 0; j < 4; ++j) { const f32x4 gm = ((const GAS f32x4*)g_final)[64 * j + f_lane]; xr[64 * j] = xr[64 * j] * rstd * gm; }
    }
}

extern "C" void kernel_launch(void* const* d_in, const int* in_sizes, int n_in, void* d_out, int out_size, void* d_ws, size_t ws_size, hipStream_t stream) {
    static int grid = 0;
    if (grid == 0) {
        if (n_in != 16 || in_sizes[0] != M * D || out_size != M * D || ws_size < WS_END) { fprintf(stderr, "kernel_launch: unexpected shapes (n_in %d, in0 %d, out %d, ws %zu); nothing launched\n", n_in, n_in > 0 ? in_sizes[0] : -1, out_size, ws_size); grid = -1; return; }
        int dev = 0, cus = 0, per_cu = 0;
        if (hipGetDevice(&dev) != hipSuccess || hipDeviceGetAttribute(&cus, hipDeviceAttributeMultiprocessorCount, dev) != hipSuccess) { grid = -1; return; }
        if (hipFuncSetAttribute((const void*)mk_fwd, hipFuncAttributeMaxDynamicSharedMemorySize, LDS_BYTES) != hipSuccess) { fprintf(stderr, "kernel_launch: hipFuncSetAttribute failed\n"); grid = -1; return; }
        if (hipOccupancyMaxActiveBlocksPerMultiprocessor(&per_cu, (const void*)mk_fwd, NWAVES * 64, LDS_BYTES) != hipSuccess || per_cu < 1) { fprintf(stderr, "kernel_launch: occupancy query failed (%d)\n", per_cu); (void)hipGetLastError(); per_cu = 1; }
        if (per_cu > 1) per_cu = 1;
        grid = cus * per_cu;
    }
    if (grid < 0) return;
    if (hipMemsetAsync((char*)d_ws + WS_CTL, 0, CTL_ZERO_BYTES, stream) != hipSuccess) { fprintf(stderr, "kernel_launch: memset failed\n"); return; }
    Args a{};
    for (int i = 0; i < 16; ++i) a.in[i] = (const float*)d_in[i];
    a.out = (float*)d_out; a.ws = (unsigned char*)d_ws;
    void* kargs[] = {&a};
    hipError_t e = hipLaunchCooperativeKernel((const void*)mk_fwd, dim3(grid), dim3(NWAVES * 64), kargs, LDS_BYTES, stream);
    if (e != hipSuccess) fprintf(stderr, "kernel_launch: cooperative launch failed: %s (grid %d)\n", hipGetErrorString(e), grid);
}
```

```cpp
#include <hip/hip_runtime.h>
#include <hip/hip_cooperative_groups.h>
#include <cstdio>
#include <cstdint>
__device__ __forceinline__ int fresh_lane() { int l; asm volatile("v_mbcnt_lo_u32_b32 %0, -1, 0\n\tv_mbcnt_hi_u32_b32 %0, -1, %0" : "=v"(l)); return l; }

namespace pg8 {

#define PG8_LAS __attribute__((address_space(3)))
typedef unsigned short bf16_t;
typedef short bf16x8 __attribute__((ext_vector_type(8)));
typedef float f32x4 __attribute__((ext_vector_type(4)));
typedef unsigned u32x4 __attribute__((ext_vector_type(4)));
constexpr int BM = 256, BK = 64, HALF = 128, HTB = HALF * BK * 2  , STAGE_BYTES = 8 * HTB, NXCD = 8, WGM = 8;

__host__ __device__ __forceinline__ int lds_byte(int r, int c) { const int st = (r >> 4) * 2 + (c >> 5), rr = r & 15, cc = c & 31, ob = rr * 64 + cc * 2; return st * 1024 + (ob ^ (((ob >> 9) & 1) << 5)); }
__host__ __device__ __forceinline__ void stage_rc(int b, int& R, int& C) { const int st = b / 1024, sb = b % 1024, swz = sb ^ (((sb >> 9) & 1) << 5); R = (st >> 1) * 16 + swz / 64; C = (st & 1) * 32 + (swz % 64) / 2; }
__host__ __device__ __forceinline__ int perm32(int rho) { const int n = rho >> 4, i = rho & 15; return 8 * (i >> 2) + 4 * n + (i & 3); }

struct Unit { int pm, pn; };
struct Gemm { const bf16_t* A; const bf16_t* Bt; int M, N, K, lda; };

struct StaticOrder {
    int nM, nN, nwg, G, c;
    __host__ __device__ void init(int M, int N, int G_, int c_) { nM = M / BM; nN = N / BM; nwg = nM * nN; G = G_; c = c_; }
    __host__ __device__ bool next(int i, Unit& u) const {
        const long L = (long)i * G + c; if (L >= nwg) return false;
        int wgid = (int)L; { const int q = nwg / NXCD, r = nwg % NXCD, xcd = wgid % NXCD, off = wgid / NXCD; wgid = (xcd < r ? xcd * (q + 1) : r * (q + 1) + (xcd - r) * q) + off; }
        const int nig = WGM * nN, gid = wgid / nig, fm = gid * WGM, gsz = (nM - fm) < WGM ? (nM - fm) : WGM;
        u.pm = fm + ((wgid % nig) % gsz); u.pn = (wgid % nig) / gsz; return true;
    }
    __device__ __forceinline__ void a_ready(const Unit&) const {}
    __device__ __forceinline__ void done(const Unit&) const {}
};

__device__ __forceinline__ unsigned cvt_pk_bf16(float lo, float hi) { unsigned r; asm volatile("v_cvt_pk_bf16_f32 %0, %1, %2" : "=v"(r) : "v"(lo), "v"(hi)); return r; }
typedef float f32x2 __attribute__((ext_vector_type(2)));
struct OneUnit { int pm, pn; __device__ bool next(int i, Unit& u) const { if (i) return false; u.pm = pm; u.pn = pn; return true; } __device__ __forceinline__ void a_ready(const Unit&) const {} __device__ __forceinline__ void done(const Unit&) const {} };
constexpr int ZP = 4352;
constexpr float C2F = 0.125f * 1.4426950408889634f;
__device__ __forceinline__ float sigmoidf_fast(float x) { return __builtin_amdgcn_rcpf(1.0f + __builtin_amdgcn_exp2f(-1.4426950408889634f * x)); }
__device__ __forceinline__ f32x4 bf4_lo(unsigned a, unsigned b) { return (f32x4){__uint_as_float(a << 16), __uint_as_float(a & 0xffff0000u), __uint_as_float(b << 16), __uint_as_float(b & 0xffff0000u)}; }
__device__ __forceinline__ u32x4 pack8(f32x4 v0, f32x4 v1) { u32x4 w; w.x = cvt_pk_bf16(v0[0], v0[1]); w.y = cvt_pk_bf16(v0[2], v0[3]); w.z = cvt_pk_bf16(v1[0], v1[1]); w.w = cvt_pk_bf16(v1[2], v1[3]); return w; }
__device__ __forceinline__ float rstd_from_stats(const float* st, int row) { const f32x4* s = (const f32x4*)(st + (size_t)row * 16); const f32x4 a = s[0], b = s[1], c = s[2], d = s[3];
    const float t = ((a[0] + a[1]) + (a[2] + a[3])) + ((b[0] + b[1]) + (b[2] + b[3])) + ((c[0] + c[1]) + (c[2] + c[3])) + ((d[0] + d[1]) + (d[2] + d[3])); return 1.0f / sqrtf(t * (1.0f / 1024.0f) + 1e-6f); }
#define EPI_ROWS(...) _Pragma("unroll") for (int ai = 0; ai < 2; ++ai) _Pragma("unroll") for (int m = 0; m < 4; ++m) { const int row = u.pm * BM + ai * HALF + wr * 64 + m * 16 + fr; __VA_ARGS__ asm volatile("" ::: "memory"); }
#define EPI_COLS(...) _Pragma("unroll") for (int bj = 0; bj < 2; ++bj) { const int col = u.pn * BM + bj * HALF + wc * 32 + 8 * fq; const f32x4 a0 = acc[ai][bj][m][0], a1 = acc[ai][bj][m][1]; __VA_ARGS__ }
struct EpiZ { static constexpr bool PERM = true, AFTER_DRAIN = false; bf16_t* Z; unsigned* NM; int pn_off;
    __device__ __forceinline__ void operator()(const f32x4 (&acc)[2][2][4][2], const Unit& u, int wr, int wc, int fr, int fq) const {
        const int pn = u.pn + pn_off; const int mode = (pn >= 9) ? 2 : ((pn == 0 || pn == 1 || pn == 3 || pn == 4) ? 1 : 0);
        const bool nrm = (pn >= 3 && pn <= 6); float mx0 = 0.f, mx1 = 0.f;
        EPI_ROWS( bf16_t* rowp = Z + (size_t)row * ZP; EPI_COLS( f32x4 v0 = a0, v1 = a1;
            if (mode == 1) { v0 = v0 * C2F; v1 = v1 * C2F; }
            else if (mode == 2) { _Pragma("unroll") for (int e = 0; e < 4; ++e) { v0[e] = sigmoidf_fast(v0[e]); v1[e] = sigmoidf_fast(v1[e]); } }
            if (nrm) { float ss = ((v0[0] * v0[0] + v0[1] * v0[1]) + (v0[2] * v0[2] + v0[3] * v0[3])) + ((v1[0] * v1[0] + v1[1] * v1[1]) + (v1[2] * v1[2] + v1[3] * v1[3]));
                ss += __shfl_xor(ss, 16); ss += __shfl_xor(ss, 32); if (bj == 0) mx0 = fmaxf(mx0, ss); else mx1 = fmaxf(mx1, ss); }
            *(u32x4*)(rowp + col + pn_off * BM) = pack8(v0, v1); ) )
        if (nrm) {
#pragma unroll
            for (int o = 1; o < 16; o <<= 1) { mx0 = fmaxf(mx0, __shfl_xor(mx0, o)); mx1 = fmaxf(mx1, __shfl_xor(mx1, o)); }
            if (fr == 0 && fq == 0) {
                const int isk = (pn >= 5), cr = (pn - (isk ? 5 : 3)) * 4 + (wc >> 1), half = wc & 1;
                unsigned* b0 = isk ? NM + 1024 + ((u.pm >> 5) * 8 + cr) * 2 + half : NM + (u.pm * 8 + cr) * 2 + half;
                atomicMax(b0, __float_as_uint(mx0 * 1.0001f)); atomicMax(b0 + 4, __float_as_uint(mx1 * 1.0001f));
            } }
    } };
#define EPI_GROUP(NR, ...) _Pragma("unroll") for (int ai = 0; ai < 2; ++ai) _Pragma("unroll") for (int mg = 0; mg < 4; mg += NR) { __VA_ARGS__ asm volatile("" ::: "memory"); }
#define EPI_ROWOF(mm) (u.pm * BM + ai * HALF + wr * 64 + (mm) * 16 + fr)
#define EPI_COLOF(bj) (u.pn * BM + (bj) * HALF + wc * 32 + 8 * fq)
struct EpiT1 { static constexpr bool PERM = true, AFTER_DRAIN = false; const bf16_t* G; bf16_t* T;
    __device__ __forceinline__ void operator()(const f32x4 (&acc)[2][2][4][2], const Unit& u, int wr, int wc, int fr, int fq) const {
        EPI_GROUP(4, u32x4 g[4][2];
            _Pragma("unroll") for (int i = 0; i < 4; ++i) _Pragma("unroll") for (int bj = 0; bj < 2; ++bj) g[i][bj] = *(const u32x4*)(G + (size_t)EPI_ROWOF(mg + i) * ZP + EPI_COLOF(bj));
            _Pragma("unroll") for (int i = 0; i < 4; ++i) _Pragma("unroll") for (int bj = 0; bj < 2; ++bj)
                *(u32x4*)(T + (size_t)EPI_ROWOF(mg + i) * 1024 + EPI_COLOF(bj)) = pack8(acc[ai][bj][mg + i][0] * bf4_lo(g[i][bj].x, g[i][bj].y), acc[ai][bj][mg + i][1] * bf4_lo(g[i][bj].z, g[i][bj].w)); )
    } };
struct EpiMix { static constexpr bool PERM = true, AFTER_DRAIN = false; const bf16_t* G; const bf16_t* T; bf16_t* O;
    __device__ __forceinline__ void operator()(const f32x4 (&acc)[2][2][4][2], const Unit& u, int wr, int wc, int fr, int fq) const {
        EPI_GROUP(4, u32x4 g[4][2]; u32x4 t[4][2];
            _Pragma("unroll") for (int i = 0; i < 4; ++i) _Pragma("unroll") for (int bj = 0; bj < 2; ++bj) { g[i][bj] = *(const u32x4*)(G + (size_t)EPI_ROWOF(mg + i) * ZP + EPI_COLOF(bj));
                t[i][bj] = *(const u32x4*)(T + (size_t)EPI_ROWOF(mg + i) * 1024 + EPI_COLOF(bj)); }
            _Pragma("unroll") for (int i = 0; i < 4; ++i) _Pragma("unroll") for (int bj = 0; bj < 2; ++bj) {
                const f32x4 v0 = bf4_lo(t[i][bj].x, t[i][bj].y) + acc[ai][bj][mg + i][0] * bf4_lo(g[i][bj].x, g[i][bj].y), v1 = bf4_lo(t[i][bj].z, t[i][bj].w) + acc[ai][bj][mg + i][1] * bf4_lo(g[i][bj].z, g[i][bj].w);
                *(u32x4*)(O + (size_t)EPI_ROWOF(mg + i) * 1024 + EPI_COLOF(bj)) = pack8(v0, v1); } )
    } };
template <bool BASE_BF16> struct EpiRes { static constexpr bool PERM = true, AFTER_DRAIN = false; const void* base; bf16_t* hb; float* st;
    __device__ __forceinline__ void operator()(const f32x4 (&acc)[2][2][4][2], const Unit& u, int wr, int wc, int fr, int fq) const {
        EPI_GROUP(4, f32x4 b[4][2][2];
            _Pragma("unroll") for (int i = 0; i < 4; ++i) _Pragma("unroll") for (int bj = 0; bj < 2; ++bj) { const size_t off = (size_t)EPI_ROWOF(mg + i) * 1024 + EPI_COLOF(bj);
                if constexpr (BASE_BF16) { const u32x4 r = *(const u32x4*)((const bf16_t*)base + off); b[i][bj][0] = bf4_lo(r.x, r.y); b[i][bj][1] = bf4_lo(r.z, r.w); }
                else { const float* bp = (const float*)base + off; b[i][bj][0] = *(const f32x4*)bp; b[i][bj][1] = *(const f32x4*)(bp + 4); } }
            _Pragma("unroll") for (int i = 0; i < 4; ++i) { float ss = 0.f; const int row = EPI_ROWOF(mg + i);
                _Pragma("unroll") for (int bj = 0; bj < 2; ++bj) { const size_t off = (size_t)row * 1024 + EPI_COLOF(bj); const f32x4 h0 = b[i][bj][0] + acc[ai][bj][mg + i][0], h1 = b[i][bj][1] + acc[ai][bj][mg + i][1];
                    *(u32x4*)(hb + off) = pack8(h0, h1);
                    ss += ((h0[0] * h0[0] + h0[1] * h0[1]) + (h0[2] * h0[2] + h0[3] * h0[3])) + ((h1[0] * h1[0] + h1[1] * h1[1]) + (h1[2] * h1[2] + h1[3] * h1[3])); }
                ss += __shfl_xor(ss, 16); ss += __shfl_xor(ss, 32); if (fq == 0) st[(size_t)row * 16 + u.pn * 4 + wc] = ss; } )
    } };
struct EpiRelu2 { static constexpr bool PERM = true, AFTER_DRAIN = false; const float* st; bf16_t* O;
    __device__ __forceinline__ void operator()(const f32x4 (&acc)[2][2][4][2], const Unit& u, int wr, int wc, int fr, int fq) const {
        float rsv[2][4];
        _Pragma("unroll") for (int ai = 0; ai < 2; ++ai) { _Pragma("unroll") for (int m = 0; m < 4; ++m) rsv[ai][m] = rstd_from_stats(st, u.pm * BM + ai * HALF + wr * 64 + m * 16 + fr);
            asm volatile("" : "+v"(rsv[ai][0]), "+v"(rsv[ai][1]), "+v"(rsv[ai][2]), "+v"(rsv[ai][3]) :: "memory"); }
        EPI_ROWS( const float rs = rsv[ai][m]; EPI_COLS( f32x4 v0 = a0 * rs, v1 = a1 * rs;
            _Pragma("unroll") for (int e = 0; e < 4; ++e) { const float x0 = fmaxf(v0[e], 0.f), x1 = fmaxf(v1[e], 0.f); v0[e] = x0 * x0; v1[e] = x1 * x1; }
            *(u32x4*)(O + (size_t)row * 4096 + col) = pack8(v0, v1); ) )
    } };
struct EpiPP { static constexpr bool PERM = true, AFTER_DRAIN = false; bf16_t* T;
    __device__ __forceinline__ void operator()(const f32x4 (&acc)[2][2][4][2], const Unit& u, int wr, int wc, int fr, int fq) const {
        EPI_ROWS( EPI_COLS( *(u32x4*)(T + (size_t)row * 1024 + col) = pack8(a0, a1); ) )
    } };
struct EpiPle { static constexpr bool PERM = true, AFTER_DRAIN = false; const float* st_in; const bf16_t* T; const bf16_t* hsrc; float* out; float* st;
    __device__ __forceinline__ void operator()(const f32x4 (&acc)[2][2][4][2], const Unit& u, int wr, int wc, int fr, int fq) const {
        float rsv[2][4];
        _Pragma("unroll") for (int ai = 0; ai < 2; ++ai) { _Pragma("unroll") for (int m = 0; m < 4; ++m) rsv[ai][m] = rstd_from_stats(st_in, u.pm * BM + ai * HALF + wr * 64 + m * 16 + fr);
            asm volatile("" : "+v"(rsv[ai][0]), "+v"(rsv[ai][1]), "+v"(rsv[ai][2]), "+v"(rsv[ai][3]) :: "memory"); }
        EPI_GROUP(2, u32x4 hv[2][2]; u32x4 tv[2][2];
            _Pragma("unroll") for (int i = 0; i < 2; ++i) _Pragma("unroll") for (int bj = 0; bj < 2; ++bj) { const size_t off = (size_t)EPI_ROWOF(mg + i) * 1024 + EPI_COLOF(bj);
                    hv[i][bj] = *(const u32x4*)(hsrc + off); tv[i][bj] = *(const u32x4*)(T + off); }
            _Pragma("unroll") for (int i = 0; i < 2; ++i) { float ss = 0.f; const int row = EPI_ROWOF(mg + i); const float rs = rsv[ai][mg + i];
                _Pragma("unroll") for (int bj = 0; bj < 2; ++bj) { const size_t off = (size_t)row * 1024 + EPI_COLOF(bj);
                    f32x4 g0 = acc[ai][bj][mg + i][0] * rs, g1 = acc[ai][bj][mg + i][1] * rs; _Pragma("unroll") for (int e = 0; e < 4; ++e) { g0[e] = sigmoidf_fast(g0[e]); g1[e] = sigmoidf_fast(g1[e]); }
                    const f32x4 h0 = bf4_lo(hv[i][bj].x, hv[i][bj].y) + g0 * bf4_lo(tv[i][bj].x, tv[i][bj].y), h1 = bf4_lo(hv[i][bj].z, hv[i][bj].w) + g1 * bf4_lo(tv[i][bj].z, tv[i][bj].w);
                    *(f32x4*)(out + off) = h0; *(f32x4*)(out + off + 4) = h1;
                    ss += ((h0[0] * h0[0] + h0[1] * h0[1]) + (h0[2] * h0[2] + h0[3] * h0[3])) + ((h1[0] * h1[0] + h1[1] * h1[1]) + (h1[2] * h1[2] + h1[3] * h1[3])); }
                ss += __shfl_xor(ss, 16); ss += __shfl_xor(ss, 32); if (fq == 0) st[(size_t)row * 16 + u.pn * 4 + wc] = ss; } )
    } };
struct EpiNone { static constexpr bool PERM = true, AFTER_DRAIN = false; float* sink;
    __device__ __forceinline__ void operator()(const f32x4 (&acc)[2][2][4][2], const Unit& u, int wr, int wc, int fr, int fq) const {
        if (acc[0][0][0][0][0] == 1.2345e33f) sink[0] = 1.f;
    } };

template <class Epi, class Sched, bool ALIGN_EPI = false, bool SP2 = false>
__device__ __forceinline__ void gemm_phase(PG8_LAS unsigned char* lds, const Gemm g, const Sched& S, const Epi& E, const int wave_s) {
    const int tid = wave_s * 64 + fresh_lane(), wid = wave_s, lane = tid & 63, wr = wid >> 2, wc = wid & 3, fr = lane & 15, fq = lane >> 4;
    const int K = g.K, nt = K / BK;
    unsigned voffA[2], voffB[2];
#pragma unroll
    for (int i = 0; i < 2; ++i) { int R, C; stage_rc(tid * 16 + i * 8192, R, C); const int Rb = Epi::PERM ? ((R & ~31) + perm32(R & 31)) : R;
        voffA[i] = (unsigned)(R * g.lda + C) * 2u; voffB[i] = (unsigned)(Rb * K + C) * 2u; }
    const size_t kstep = (size_t)(BK * 2);
    const size_t hstepA = (size_t)HALF * g.lda * 2, hstepB = (size_t)HALF * K * 2;
    const size_t tstepA = 2 * hstepA, tstepB = 2 * hstepB;
    const unsigned ldsw = (unsigned)wid * 1024u;
    const int aoff = lds_byte(wr * 64 + fr, fq * 8), boff = lds_byte(wc * 32 + fr, fq * 8);
#define PG8_SA(b, h) (((b) * 2 + (h)) * HTB)
#define PG8_SB(b, h) ((4 + (b) * 2 + (h)) * HTB)
#define PG8_STAGE(bufoff, gbase, voff) do { _Pragma("unroll") for (int _i = 0; _i < 2; ++_i) \
        __builtin_amdgcn_global_load_lds((const unsigned*)((const char*)(gbase) + (voff)[_i]), (PG8_LAS unsigned*)(lds + (bufoff) + ldsw + _i * 8192), 16, 0, 0); } while (0)
#define PG8_LDA(dst, b, h) do { _Pragma("unroll") for (int m = 0; m < 4; ++m) _Pragma("unroll") for (int k = 0; k < 2; ++k) dst[m][k] = *(const PG8_LAS bf16x8*)(lds + PG8_SA(b, h) + aoff + m * 2048 + k * 1024); } while (0)
#define PG8_LDB(dst, b, h) do { _Pragma("unroll") for (int n = 0; n < 2; ++n) _Pragma("unroll") for (int k = 0; k < 2; ++k) dst[n][k] = *(const PG8_LAS bf16x8*)(lds + PG8_SB(b, h) + boff + n * 2048 + k * 1024); } while (0)
#define PG8_MMA(ai, bj, At, Bt) do { __builtin_amdgcn_s_setprio(1); _Pragma("unroll") for (int m = 0; m < 4; ++m) _Pragma("unroll") for (int n = 0; n < 2; ++n) _Pragma("unroll") for (int k = 0; k < 2; ++k) \
        acc[ai][bj][m][n] = __builtin_amdgcn_mfma_f32_16x16x32_bf16(Bt[n][k], At[m][k], acc[ai][bj][m][n], 0, 0, 0); __builtin_amdgcn_s_setprio(0); } while (0)
#define PG8_WAIT_V(n) asm volatile("s_waitcnt vmcnt(" #n ")" ::: "memory")
#define PG8_WAIT_L(n) asm volatile("s_waitcnt lgkmcnt(" #n ")" ::: "memory")
#define PG8_BAR __builtin_amdgcn_s_barrier()
#define PG8_SCHED __builtin_amdgcn_sched_barrier(0)
    Unit cur, nxt; int ui = 0;
    if (!S.next(0, cur)) return;
    f32x4 acc[2][2][4][2];
#pragma unroll
    for (int a = 0; a < 2; ++a)
#pragma unroll
        for (int b = 0; b < 2; ++b)
#pragma unroll
            for (int m = 0; m < 4; ++m)
#pragma unroll
                for (int n = 0; n < 2; ++n) acc[a][b][m][n] = (f32x4){0.f, 0.f, 0.f, 0.f};
    bf16x8 At[4][2], B0[2][2], B1[2][2];
    const char* cA = (const char*)g.A + (size_t)cur.pm * tstepA; const char* cB = (const char*)g.Bt + (size_t)cur.pn * tstepB;
    S.a_ready(cur);
    if constexpr (SP2) {
        PG8_STAGE(PG8_SB(0, 0), cB, voffB); PG8_STAGE(PG8_SB(0, 1), cB + hstepB, voffB); PG8_STAGE(PG8_SA(0, 0), cA, voffA); PG8_STAGE(PG8_SA(0, 1), cA + hstepA, voffA);
        if (wr == 1) PG8_BAR;
        PG8_WAIT_V(2); PG8_BAR;
        PG8_STAGE(PG8_SB(1, 0), cB + kstep, voffB); PG8_STAGE(PG8_SA(1, 0), cA + kstep, voffA); PG8_STAGE(PG8_SB(1, 1), cB + hstepB + kstep, voffB);
        PG8_WAIT_V(6); PG8_BAR;
    } else {
        PG8_STAGE(PG8_SB(0, 0), cB, voffB); PG8_STAGE(PG8_SA(0, 0), cA, voffA); PG8_STAGE(PG8_SB(0, 1), cB + hstepB, voffB); PG8_STAGE(PG8_SA(0, 1), cA + hstepA, voffA);
        if (wr == 1) PG8_BAR;
        PG8_WAIT_V(4); PG8_BAR;
        PG8_STAGE(PG8_SB(1, 0), cB + kstep, voffB); PG8_STAGE(PG8_SA(1, 0), cA + kstep, voffA); PG8_STAGE(PG8_SB(1, 1), cB + hstepB + kstep, voffB);
        PG8_WAIT_V(6); PG8_BAR;
    }
    for (;;) {
        const bool has_next = S.next(ui + 1, nxt);
        const char* nA = has_next ? (const char*)g.A + (size_t)nxt.pm * tstepA : cA; const char* nB = has_next ? (const char*)g.Bt + (size_t)nxt.pn * tstepB : cB;
        for (int t = 0; t < nt; t += 2) {
            const bool last = (t == nt - 2);
            const char* a1 = cA + (size_t)(t + 1) * kstep;
            const char* a2 = last ? nA : cA + (size_t)(t + 2) * kstep; const char* b2 = last ? nB : cB + (size_t)(t + 2) * kstep;
            const char* a3 = a2 + kstep; const char* b3 = b2 + kstep;
            if (last && has_next) S.a_ready(nxt);
            if constexpr (SP2) {
            PG8_LDB(B0, 0, 0); PG8_LDB(B1, 0, 1); PG8_SCHED; PG8_LDA(At, 0, 0); PG8_STAGE(PG8_SA(1, 1), a1 + hstepA, voffA);
            PG8_WAIT_V(8); PG8_WAIT_L(0); PG8_BAR; PG8_MMA(0, 0, At, B0); PG8_MMA(0, 1, At, B1); PG8_BAR; PG8_SCHED;
            PG8_LDA(At, 0, 1); PG8_STAGE(PG8_SB(0, 0), b2, voffB); PG8_STAGE(PG8_SB(0, 1), b2 + hstepB, voffB); PG8_STAGE(PG8_SA(0, 0), a2, voffA);
            PG8_WAIT_V(8); PG8_WAIT_L(0); PG8_BAR; PG8_MMA(1, 0, At, B0); PG8_MMA(1, 1, At, B1); PG8_BAR; PG8_SCHED;
            PG8_LDB(B0, 1, 0); PG8_LDB(B1, 1, 1); PG8_SCHED; PG8_LDA(At, 1, 0); PG8_STAGE(PG8_SA(0, 1), a2 + hstepA, voffA);
            PG8_WAIT_V(8); PG8_WAIT_L(0); PG8_BAR; PG8_MMA(0, 0, At, B0); PG8_MMA(0, 1, At, B1); PG8_BAR; PG8_SCHED;
            PG8_LDA(At, 1, 1); PG8_STAGE(PG8_SB(1, 0), b3, voffB); PG8_STAGE(PG8_SB(1, 1), b3 + hstepB, voffB); PG8_STAGE(PG8_SA(1, 0), a3, voffA);
            PG8_WAIT_V(8); PG8_WAIT_L(0); PG8_BAR; PG8_MMA(1, 0, At, B0); PG8_MMA(1, 1, At, B1); PG8_BAR; PG8_SCHED;
            } else {
            PG8_LDB(B0, 0, 0); PG8_SCHED; PG8_LDA(At, 0, 0); PG8_STAGE(PG8_SA(1, 1), a1 + hstepA, voffA);
            PG8_WAIT_L(8); PG8_BAR; PG8_WAIT_L(0); PG8_MMA(0, 0, At, B0); PG8_BAR; PG8_SCHED;
            PG8_LDB(B1, 0, 1); PG8_STAGE(PG8_SB(0, 0), b2, voffB);
            PG8_BAR; PG8_WAIT_L(0); PG8_MMA(0, 1, At, B1); PG8_BAR;
            PG8_LDA(At, 0, 1); PG8_STAGE(PG8_SA(0, 0), a2, voffA);
            PG8_BAR; PG8_WAIT_L(0); PG8_MMA(1, 0, At, B0); PG8_BAR; PG8_SCHED;
            PG8_STAGE(PG8_SB(0, 1), b2 + hstepB, voffB);
            PG8_WAIT_V(6); PG8_BAR; PG8_MMA(1, 1, At, B1); PG8_BAR;
            PG8_LDB(B0, 1, 0); PG8_SCHED; PG8_LDA(At, 1, 0); PG8_STAGE(PG8_SA(0, 1), a2 + hstepA, voffA);
            PG8_WAIT_L(8); PG8_BAR; PG8_WAIT_L(0); PG8_MMA(0, 0, At, B0); PG8_BAR; PG8_SCHED;
            PG8_LDB(B1, 1, 1); PG8_STAGE(PG8_SB(1, 0), b3, voffB);
            PG8_BAR; PG8_WAIT_L(0); PG8_MMA(0, 1, At, B1); PG8_BAR;
            PG8_LDA(At, 1, 1); PG8_STAGE(PG8_SA(1, 0), a3, voffA);
            PG8_BAR; PG8_WAIT_L(0); PG8_MMA(1, 0, At, B0); PG8_BAR; PG8_SCHED;
            PG8_STAGE(PG8_SB(1, 1), b3 + hstepB, voffB);
            PG8_WAIT_V(6); PG8_BAR; PG8_MMA(1, 1, At, B1); PG8_BAR;
            }
        }
        if constexpr (ALIGN_EPI) { if (wr == 0) PG8_BAR; }
        if constexpr (!Epi::AFTER_DRAIN) { E(acc, cur, wr, wc, fr, fq); S.done(cur); }
        if (!has_next) break;
#pragma unroll
        for (int a = 0; a < 2; ++a)
#pragma unroll
            for (int b = 0; b < 2; ++b)
#pragma unroll
                for (int m = 0; m < 4; ++m)
#pragma unroll
                    for (int n = 0; n < 2; ++n) acc[a][b][m][n] = (f32x4){0.f, 0.f, 0.f, 0.f};
        cur = nxt; cA = nA; cB = nB; ++ui;
        if constexpr (ALIGN_EPI) { if (wr == 1) PG8_BAR; }
    }
    PG8_WAIT_V(0);
    if constexpr (!ALIGN_EPI) { if (wr == 0) PG8_BAR; }
    PG8_BAR;
    if constexpr (Epi::AFTER_DRAIN) { E.fused(acc, cur, wr, wc, fr, fq, lds, wid, lane); S.done(cur); }
#undef PG8_SA
#undef PG8_SB
#undef PG8_STAGE
#undef PG8_LDA
#undef PG8_LDB
#undef PG8_MMA
#undef PG8_WAIT_V
#undef PG8_WAIT_L
#undef PG8_BAR
#undef PG8_SCHED
}
}
#ifndef PG8_SP2
#define PG8_SP2 true
#endif
#ifndef PG8_ALIGN
#define PG8_ALIGN true
#endif
#include <hip/hip_bf16.h>
#include <cmath>
namespace attn_body {
using bf16=__hip_bfloat16;
using bf16x8=__attribute__((ext_vector_type(8)))short;
using s16x4=__attribute__((ext_vector_type(4)))short;
using f32x16=__attribute__((ext_vector_type(16)))float;
using u32x4=__attribute__((ext_vector_type(4)))unsigned;
constexpr int BATCH=2,SEQ=8192,D=64,DM=4352;
constexpr int NW=8,QBLK=32,QB=QBLK*NW,KVBLK=64,NQB=SEQ/QB;
constexpr int ATTN_PITCH=DM, ATTN_UNIT_ROWS=QB;
__device__ __forceinline__ int crow(int r,int hi){return (r&3)+8*(r>>2)+4*hi;}
#define SBAR() __builtin_amdgcn_sched_barrier(0)
__device__ __forceinline__ void cmask(f32x16&p0,f32x16&p1,int jb,int qrel,int hi){
  const float NEG=-INFINITY; int kb=64*jb+4*hi;
  #pragma unroll
  for(int r=0;r<16;++r){int kv=kb+(r&3)+8*(r>>2); if(kv>qrel)p0[r]=NEG; if(kv+32>qrel)p1[r]=NEG;}
}

constexpr int NSLOT=3, SLOTB=8192; typedef float f32x4v __attribute__((ext_vector_type(4))); constexpr int LDS_BIAS=86016;
constexpr int LDS_K=0, LDS_V=NSLOT*SLOTB, LDS_WS=2*NSLOT*SLOTB, LDS_OST=LDS_WS+NW*64*4, LDS_BYTES=LDS_OST+NW*4096;
constexpr float C2=0.125f*1.4426950408889634f;
__device__ __forceinline__ void glds16(const void*gsrc,unsigned lds_dst){unsigned keep;
  asm volatile("s_mov_b32 %0, m0\n\ts_mov_b32 m0, %2\n\ts_nop 0\n\tglobal_load_lds_dwordx4 %1, off\n\ts_mov_b32 m0, %0":"=&s"(keep):"v"(gsrc),"s"(lds_dst):"memory");}
__device__ __forceinline__ float max3f(float a,float b,float c){float r;asm("v_max3_f32 %0, %1, %2, %3":"=v"(r):"v"(a),"v"(b),"v"(c));return r;}
__device__ __forceinline__ float max2f(float a,float b){float r;asm("v_max_f32_e32 %0, %1, %2":"=v"(r):"v"(a),"v"(b));return r;}
__device__ __forceinline__ float fadd_s(float a,float b){float r;asm("v_add_f32_e32 %0, %1, %2":"=v"(r):"v"(a),"v"(b));return r;}
__device__ __forceinline__ float fsub_s(float a,float b){float r;asm("v_sub_f32_e32 %0, %1, %2":"=v"(r):"v"(a),"v"(b));return r;}
typedef float f32x2_t __attribute__((ext_vector_type(2))); typedef __bf16 bf16x2_t __attribute__((ext_vector_type(2)));
__device__ __forceinline__ unsigned cvtpk_s(float lo,float hi){f32x2_t v={lo,hi};bf16x2_t b=__builtin_convertvector(v,bf16x2_t);return __builtin_bit_cast(unsigned,b);}
#define WAIT_BAR(N) asm volatile("s_waitcnt vmcnt(" #N ") lgkmcnt(0)\n\ts_barrier":::"memory")

__device__ __forceinline__ void qkt(f32x16&p0,f32x16&p1,const char*Kslot,const bf16x8*qr,const f32x16&negm,int r32,int hi){
  const char*kb=Kslot+hi*1024+r32*16;
  #pragma unroll
  for(int d0=0;d0<4;++d0){
    const bf16x8 b0=*reinterpret_cast<const bf16x8*>(kb+d0*2048);
    const bf16x8 b1=*reinterpret_cast<const bf16x8*>(kb+d0*2048+512);
    if(d0==0){p0=__builtin_amdgcn_mfma_f32_32x32x16_bf16(b0,qr[0],negm,0,0,0);p1=__builtin_amdgcn_mfma_f32_32x32x16_bf16(b1,qr[0],negm,0,0,0);}
    else{p0=__builtin_amdgcn_mfma_f32_32x32x16_bf16(b0,qr[d0],p0,0,0,0);p1=__builtin_amdgcn_mfma_f32_32x32x16_bf16(b1,qr[d0],p1,0,0,0);}}
}
typedef __attribute__((address_space(3))) const char* lds_cptr;
typedef short v4i16_t __attribute__((ext_vector_type(4)));
__device__ __forceinline__ void kload8(bf16x8*kf,lds_cptr kp){
  kf[0]=*(const __attribute__((address_space(3))) bf16x8*)(kp);      kf[1]=*(const __attribute__((address_space(3))) bf16x8*)(kp+512);
  kf[2]=*(const __attribute__((address_space(3))) bf16x8*)(kp+2048); kf[3]=*(const __attribute__((address_space(3))) bf16x8*)(kp+2560);
  kf[4]=*(const __attribute__((address_space(3))) bf16x8*)(kp+4096); kf[5]=*(const __attribute__((address_space(3))) bf16x8*)(kp+4608);
  kf[6]=*(const __attribute__((address_space(3))) bf16x8*)(kp+6144); kf[7]=*(const __attribute__((address_space(3))) bf16x8*)(kp+6656);
}
__device__ __forceinline__ void kload2(bf16x8*kf,lds_cptr kp,int j){ kf[2*j]=*(const __attribute__((address_space(3))) bf16x8*)(kp+j*2048); kf[2*j+1]=*(const __attribute__((address_space(3))) bf16x8*)(kp+j*2048+512); }
__device__ __forceinline__ s16x4 vtr(lds_cptr p){ return __builtin_bit_cast(s16x4,__builtin_amdgcn_ds_read_tr16_b64_v4i16((__attribute__((address_space(3))) v4i16_t*)p)); }
__device__ __forceinline__ float rowmax(const f32x16&p0,const f32x16&p1){
  float a=max3f(p0[0],p0[1],p1[0]),b=max3f(p0[2],p0[3],p1[1]);a=max3f(a,p1[2],p1[3]);
  #pragma unroll
  for(int r=4;r<16;r+=4){a=max3f(a,p0[r],p0[r+1]);b=max3f(b,p0[r+2],p0[r+3]);a=max3f(a,p1[r],p1[r+1]);b=max3f(b,p1[r+2],p1[r+3]);}
  const float m=max2f(a,b);
  auto rr=__builtin_amdgcn_permlane32_swap(__float_as_uint(m),__float_as_uint(m),false,false);
  return max2f(__uint_as_float(rr[0]),__uint_as_float(rr[1]));
}
__device__ __forceinline__ void pv(f32x16*o,int vb,bf16x8 pa0,bf16x8 pa1,bf16x8 pa2,bf16x8 pa3){
  #pragma unroll
  for(int d0=0;d0<2;++d0){s16x4 lo[4],hi[4];
    #pragma unroll
    for(int ks=0;ks<4;++ks){
      asm volatile("ds_read_b64_tr_b16 %0,%1 offset:%c2":"=&v"(lo[ks]):"v"(vb),"i"(d0*4096+ks*1024):"memory");
      asm volatile("ds_read_b64_tr_b16 %0,%1 offset:%c2":"=&v"(hi[ks]):"v"(vb),"i"(d0*4096+ks*1024+512):"memory");}
    asm volatile("s_waitcnt lgkmcnt(0)":::"memory");SBAR();
    #define PK(k) (bf16x8){lo[k][0],lo[k][1],lo[k][2],lo[k][3],hi[k][0],hi[k][1],hi[k][2],hi[k][3]}
    o[d0]=__builtin_amdgcn_mfma_f32_32x32x16_bf16(pa0,PK(0),o[d0],0,0,0);
    o[d0]=__builtin_amdgcn_mfma_f32_32x32x16_bf16(pa1,PK(1),o[d0],0,0,0);
    o[d0]=__builtin_amdgcn_mfma_f32_32x32x16_bf16(pa2,PK(2),o[d0],0,0,0);
    o[d0]=__builtin_amdgcn_mfma_f32_32x32x16_bf16(pa3,PK(3),o[d0],0,0,0);
    #undef PK
  }
}

#ifndef ATTN_STORE16
#define ATTN_STORE16(p,v) (*(u32x4*)(p)=(v))
#endif
template<int THRL> __device__ __forceinline__ void attn_unit(const int wave_s,int qb,const bf16*Qh,const bf16*__restrict__ Kh,const bf16*__restrict__ Vh,bf16*Oh,const float*__restrict__ cbias,const float qk2,char*shm){
  const int wid=wave_s; const int tid=wave_s*64+fresh_lane(),lane=tid&63,r32=lane&31,hi=lane>>5;
  const int q0=qb*QB;
  const bf16*Qw=Qh+(long)(q0+wid*QBLK)*DM;
  int t0; { const int ntab=(q0+QB)/KVBLK; const float thr=cbias[q0]-(qk2+44.0f); const int l_=tid&63;
    const bool c0_=(l_<ntab-4)&&(cbias[l_*64+63]<thr), c1_=(l_+64<ntab-4)&&(cbias[(l_+64)*64+63]<thr);
    t0=(__builtin_popcountll(__ballot(c0_))+__builtin_popcountll(__ballot(c1_)))&~1; t0=__builtin_amdgcn_readfirstlane(t0); }
  Kh+=(long)t0*KVBLK*DM; Vh+=(long)t0*KVBLK*DM; cbias+=t0*KVBLK;
  const unsigned lds0=(unsigned)(uintptr_t)shm;
  float*wsf=(float*)(shm+LDS_WS)+wid*64;
  const bf16*ksrc=Kh+(long)lane*DM+wid*8;
  const bf16*vsrc=Vh+(long)(16*(wid&3)+(lane>>2))*DM+(wid>>2)*32+(lane&3)*8;
  const unsigned kdst=lds0+LDS_K+wid*1024, vdst=lds0+LDS_V+wid*1024;
  #define DMA_K(t,slot) glds16(ksrc+(long)(t)*KVBLK*DM,(unsigned)__builtin_amdgcn_readfirstlane(kdst+(slot)))
  #define DMA_V(t,slot) glds16(vsrc+(long)(t)*KVBLK*DM,(unsigned)__builtin_amdgcn_readfirstlane(vdst+(slot)))
  const int vb0=(int)(lds0+LDS_V)+((lane>>4)&1)*32+(lane&3)*8+(4*hi+((lane&15)>>2))*64;
  const char*Kbase=shm+LDS_K; bf16x8 kf[8];
  const lds_cptr shm3=(lds_cptr)shm; const lds_cptr kp0=shm3+LDS_K+hi*1024+r32*16; const lds_cptr vp0=shm3+LDS_V+((lane>>4)&1)*32+(lane&3)*8+(4*hi+((lane&15)>>2))*64;
  { const int nk4=((q0+QB)>>2)-t0*16; __attribute__((address_space(3))) f32x4v* bt=(__attribute__((address_space(3))) f32x4v*)((lds_cptr)shm+LDS_BIAS); for(int i=tid;i<nk4;i+=NW*64) bt[i]=((const f32x4v*)cbias)[i]; }
  const int NT=(q0+QB)/KVBLK-t0;
  DMA_K(0,0);DMA_V(0,0);DMA_K(1,SLOTB);
  bf16x8 qr[4];
  #pragma unroll
  for(int d0=0;d0<4;++d0)qr[d0]=*reinterpret_cast<const bf16x8*>(&Qw[(long)r32*DM+d0*16+hi*8]);
  float mhat=0.f,l_reg=0.f;float zf_=0.f;asm volatile("":"+v"(zf_));f32x16 o[2];f32x16 negm;
  _Pragma("unroll") for(int r=0;r<16;++r){o[0][r]=zf_;o[1][r]=zf_;negm[r]=zf_;} asm volatile("":"+v"(negm));
  const int qrel=wid*QBLK+r32;
  #define CMASK(P0,P1,t) do{int jb_=(t)-(NT-4); if(jb_>=0)cmask(P0,P1,jb_,qrel,hi);}while(0)
  #define BIAS(P0,P1,t) do{ const __attribute__((address_space(3))) f32x4v* bt_=(const __attribute__((address_space(3))) f32x4v*)(shm3+LDS_BIAS)+(t)*16+hi; \
    _Pragma("unroll") for(int i_=0;i_<4;++i_){ const f32x4v b0_=bt_[2*i_], b1_=bt_[8+2*i_]; \
      P0[4*i_]+=b0_[0];P0[4*i_+1]+=b0_[1];P0[4*i_+2]+=b0_[2];P0[4*i_+3]+=b0_[3]; P1[4*i_]+=b1_[0];P1[4*i_+1]+=b1_[1];P1[4*i_+2]+=b1_[2];P1[4*i_+3]+=b1_[3]; } }while(0)
  bool resc=false;
  #define START(P0,P1) do{ const float rm=rowmax(P0,P1); resc=false; \
    { const float dl=rm; mhat=fadd_s(mhat,dl); \
      _Pragma("unroll") for(int r=0;r<16;++r){P0[r]=fsub_s(P0[r],dl);P1[r]=fsub_s(P1[r],dl);} \
      _Pragma("unroll") for(int r=0;r<16;++r)negm[r]=-mhat; asm volatile("":"+v"(negm)); } \
    _Pragma("unroll") for(int r=0;r<16;++r)P0[r]=__builtin_amdgcn_exp2f(P0[r]); }while(0)
  #define RESC() do{ if(resc){ asm volatile("s_waitcnt lgkmcnt(0)":::"memory"); \
      _Pragma("unroll") for(int d_=0;d_<2;++d_) _Pragma("unroll") for(int r=0;r<16;++r)o[d_][r]*=wsf[crow(r,hi)]; } }while(0)
  f32x16 pA0,pA1,pB0,pB1;
  int sl_prev=0,sl_cur=0,sl_next=SLOTB;
  #define ROT() do{sl_prev=sl_cur;sl_cur=sl_next;sl_next=(sl_next==(NSLOT-1)*SLOTB)?0:sl_next+SLOTB;}while(0)
  DMA_K(2,2*SLOTB);
  WAIT_BAR(3);
  qkt(pA0,pA1,Kbase,qr,negm,r32,hi);asm volatile("s_nop 15\n\ts_nop 7":"+v"(pA0),"+v"(pA1));BIAS(pA0,pA1,0);CMASK(pA0,pA1,0);
  START(pA0,pA1);
  _Pragma("unroll") for(int r=0;r<16;++r)pA1[r]=__builtin_amdgcn_exp2f(pA1[r]);
  WAIT_BAR(0);
  DMA_K(3,0);DMA_V(1,SLOTB);
  ROT();
  kload8(kf,kp0+sl_cur);
  WAIT_BAR(2);
  s16x4 vlo[8],vhi[8]; u32x4 pw0,pw1,pw2,pw3;
  #define PKW(P,B) cvtpk_s(P[B],P[B+1])
  #define PAF(k) __builtin_bit_cast(bf16x8,pw##k)
  #define VFR(i) (bf16x8){vlo[i][0],vlo[i][1],vlo[i][2],vlo[i][3],vhi[i][0],vhi[i][1],vhi[i][2],vhi[i][3]}
  #define PIN(x) asm volatile("":"+v"(x))
  #define MX3(a,b,c) __builtin_fmaxf(__builtin_fmaxf((a),(b)),(c))
  #define GAPA(MF,A0,A1,A2,A3,W0,W1,PW) do{ MF; sacc+=A0; sacc+=A1; sacc+=A2; sacc+=A3; PIN(sacc); W0; W1; PIN(PW); SBAR(); }while(0)
  #define EX(v) __builtin_amdgcn_exp2f(v)
  #define GAPB(MF,X,B) do{ MF; X[B]=EX(X[B]); X[B+1]=EX(X[B+1]); X[B+2]=EX(X[B+2]); X[B+3]=EX(X[B+3]); PIN(X); SBAR(); }while(0)
  #define VRD(i) do{ vlo[i]=vtr(vp_+(((i)>>2)*4096+((i)&3)*1024)); vhi[i]=vtr(vp_+(((i)>>2)*4096+((i)&3)*1024+512)); }while(0)
  #define KRD(G,j) do{ if(G){ kload2(kf,kp0+sl_next,j); SBAR(); } }while(0)
  #define STEP(C0,C1,P0,P1,t,GK,GV,GL) do{ SBAR(); \
    const lds_cptr vp_=vp0+sl_prev; \
    VRD(0); SBAR(); float sacc=(P0[0]+P0[1]); \
    GAPA(C0=__builtin_amdgcn_mfma_f32_32x32x16_bf16(kf[0],qr[0],negm,0,0,0), P0[2],P0[3],P0[4],P0[5],     pw0[0]=PKW(P0,0), pw0[1]=PKW(P0,2), pw0); \
    VRD(4); SBAR(); GAPA(C1=__builtin_amdgcn_mfma_f32_32x32x16_bf16(kf[1],qr[0],negm,0,0,0), P0[6],P0[7],P0[8],P0[9],     pw0[2]=PKW(P0,4), pw0[3]=PKW(P0,6), pw0); \
    VRD(1); SBAR(); GAPA(C0=__builtin_amdgcn_mfma_f32_32x32x16_bf16(kf[2],qr[1],C0,0,0,0),   P0[10],P0[11],P0[12],P0[13], pw1[0]=PKW(P0,8), pw1[1]=PKW(P0,10), pw1); \
    VRD(5); SBAR(); GAPA(C1=__builtin_amdgcn_mfma_f32_32x32x16_bf16(kf[3],qr[1],C1,0,0,0),   P0[14],P0[15],P1[0],P1[1],   pw1[2]=PKW(P0,12),pw1[3]=PKW(P0,14), pw1); \
    VRD(2); SBAR(); GAPA(C0=__builtin_amdgcn_mfma_f32_32x32x16_bf16(kf[4],qr[2],C0,0,0,0),   P1[2],P1[3],P1[4],P1[5],     pw2[0]=PKW(P1,0), pw2[1]=PKW(P1,2), pw2); \
    VRD(6); SBAR(); GAPA(C1=__builtin_amdgcn_mfma_f32_32x32x16_bf16(kf[5],qr[2],C1,0,0,0),   P1[6],P1[7],P1[8],P1[9],     pw2[2]=PKW(P1,4), pw2[3]=PKW(P1,6), pw2); \
    VRD(3); SBAR(); GAPA(C0=__builtin_amdgcn_mfma_f32_32x32x16_bf16(kf[6],qr[3],C0,0,0,0),   P1[10],P1[11],P1[12],P1[13], pw3[0]=PKW(P1,8), pw3[1]=PKW(P1,10), pw3); \
    VRD(7); SBAR(); GAPA(C1=__builtin_amdgcn_mfma_f32_32x32x16_bf16(kf[7],qr[3],C1,0,0,0),   P1[14],P1[15],0.f,0.f,       pw3[2]=PKW(P1,12),pw3[3]=PKW(P1,14), pw3); \
    l_reg+=sacc; \
    if(GK){DMA_K((t)+3,sl_cur);} if(GV){DMA_V((t)+1,sl_next);} \
    BIAS(C0,C1,t); CMASK(C0,C1,t); \
    { float a=MX3(C0[0],C0[1],C1[0]),b=MX3(C0[2],C0[3],C1[1]); a=MX3(a,C1[2],C1[3]); \
      _Pragma("unroll") for(int r=4;r<16;r+=4){a=MX3(a,C0[r],C0[r+1]);b=MX3(b,C0[r+2],C0[r+3]);a=MX3(a,C1[r],C1[r+1]);b=MX3(b,C1[r+2],C1[r+3]);} \
      float rm=__builtin_fmaxf(a,b); { auto rr=__builtin_amdgcn_permlane32_swap(__float_as_uint(rm),__float_as_uint(rm),false,false); rm=__builtin_fmaxf(__uint_as_float(rr[0]),__uint_as_float(rr[1])); } \
      resc=false; \
      if(__builtin_expect(__any(rm>(float)THRL),0)){ const float dl=__builtin_fmaxf(rm,0.f); mhat+=dl; \
        _Pragma("unroll") for(int r=0;r<16;++r){C0[r]-=dl;C1[r]-=dl;} \
        _Pragma("unroll") for(int r=0;r<16;++r)negm[r]=-mhat; asm volatile("":"+v"(negm)); \
        const float f=__builtin_amdgcn_exp2f(-dl); l_reg*=f; if(hi==0)wsf[r32]=f; resc=true; } } \
    SBAR(); \
    GAPB(o[0]=__builtin_amdgcn_mfma_f32_32x32x16_bf16(PAF(0),VFR(0),o[0],0,0,0), C0,0); \
    GAPB(o[1]=__builtin_amdgcn_mfma_f32_32x32x16_bf16(PAF(0),VFR(4),o[1],0,0,0), C0,4); \
    KRD(GL,0); GAPB(o[0]=__builtin_amdgcn_mfma_f32_32x32x16_bf16(PAF(1),VFR(1),o[0],0,0,0), C0,8); \
    KRD(GL,1); GAPB(o[1]=__builtin_amdgcn_mfma_f32_32x32x16_bf16(PAF(1),VFR(5),o[1],0,0,0), C0,12); \
    KRD(GL,2); GAPB(o[0]=__builtin_amdgcn_mfma_f32_32x32x16_bf16(PAF(2),VFR(2),o[0],0,0,0), C1,0); \
    KRD(GL,3); GAPB(o[1]=__builtin_amdgcn_mfma_f32_32x32x16_bf16(PAF(2),VFR(6),o[1],0,0,0), C1,4); \
    GAPB(o[0]=__builtin_amdgcn_mfma_f32_32x32x16_bf16(PAF(3),VFR(3),o[0],0,0,0), C1,8); \
    GAPB(o[1]=__builtin_amdgcn_mfma_f32_32x32x16_bf16(PAF(3),VFR(7),o[1],0,0,0), C1,12); \
    }while(0)
  int t=1;
  #undef CMASK
  #define CMASK(P0,P1,t) do{}while(0)
  for(;t+5<NT;t+=2){
    STEP(pB0,pB1,pA0,pA1,t,true,true,true);     WAIT_BAR(2); RESC(); ROT();
    STEP(pA0,pA1,pB0,pB1,t+1,true,true,true);   WAIT_BAR(2); RESC(); ROT();
  }
  #undef CMASK
  #define CMASK(P0,P1,t) do{int jb_=(t)-(NT-4); if(jb_>=0)cmask(P0,P1,jb_,qrel,hi);}while(0)
  #define ENDW(tt) do{ if((tt)+3<NT){WAIT_BAR(2);} else if((tt)+2<NT){WAIT_BAR(1);} else {WAIT_BAR(0);} }while(0)
  for(;t+1<NT;t+=2){
    STEP(pB0,pB1,pA0,pA1,t,(t+3<NT),(t+1<NT),(t+1<NT));       ENDW(t);   RESC(); ROT();
    STEP(pA0,pA1,pB0,pB1,t+1,(t+4<NT),(t+2<NT),(t+2<NT));     ENDW(t+1); RESC(); ROT();
  }
  STEP(pB0,pB1,pA0,pA1,NT-1,false,false,false); RESC();
  { float sacc=pB0[0]+pB0[1]; _Pragma("unroll") for(int r=2;r<16;++r)sacc+=pB0[r]; _Pragma("unroll") for(int r=0;r<16;++r)sacc+=pB1[r]; l_reg+=sacc;
    pw0=(u32x4){PKW(pB0,0),PKW(pB0,2),PKW(pB0,4),PKW(pB0,6)};pw1=(u32x4){PKW(pB0,8),PKW(pB0,10),PKW(pB0,12),PKW(pB0,14)};pw2=(u32x4){PKW(pB1,0),PKW(pB1,2),PKW(pB1,4),PKW(pB1,6)};pw3=(u32x4){PKW(pB1,8),PKW(pB1,10),PKW(pB1,12),PKW(pB1,14)};
    SBAR(); pv(o,vb0+sl_cur,PAF(0),PAF(1),PAF(2),PAF(3)); }
  #undef PKW
  #undef PAF
  #undef VFR
  #undef PIN
  #undef MX3
  #undef GAPA
  #undef GAPB
  #undef EX
  #undef VRD
  #undef KRD
  #undef STEP
  #undef ENDW
  {auto rr=__builtin_amdgcn_permlane32_swap(__float_as_uint(l_reg),__float_as_uint(l_reg),false,false);l_reg=__uint_as_float(rr[0])+__uint_as_float(rr[1]);}
  if(hi==0)wsf[32+r32]=l_reg;asm volatile("s_waitcnt lgkmcnt(0)":::"memory");
  float rli[16];
  #pragma unroll
  for(int r=0;r<16;++r)rli[r]=__builtin_amdgcn_rcpf(wsf[32+crow(r,hi)]);
  bf16*Ow=Oh+(long)(q0+wid*QBLK)*DM;
  { bf16*stg=(bf16*)(shm+LDS_OST)+wid*2048;
    #pragma unroll
    for(int r=0;r<16;++r){const int orow=crow(r,hi);
      #pragma unroll
      for(int d0=0;d0<2;++d0)stg[orow*64+d0*32+r32]=__float2bfloat16(o[d0][r]*rli[r]);}
    asm volatile("s_waitcnt lgkmcnt(0)":::"memory");
    #pragma unroll
    for(int i=0;i<4;++i){const int row=i*8+(lane>>3),ch=lane&7; const u32x4 v=*(const u32x4*)(stg+row*64+ch*8); ATTN_STORE16(Ow+(long)row*DM+ch*8,v);} }
  asm volatile("s_waitcnt lgkmcnt(0)\n\ts_barrier":::"memory");
  #undef DMA_K
  #undef DMA_V
  #undef CMASK
  #undef START
  #undef RESC
  #undef ROT
  #undef BIAS
}
constexpr int ATTN_LDS_BYTES=LDS_BYTES;
constexpr int SWA_K=0, SWA_V=6*SLOTB, SWA_OST=12*SLOTB, SWA_WS=133120;
__device__ __forceinline__ void swa_unit(const int wave_s,int qb,const bf16*Qh,const bf16*__restrict__ Kh,const bf16*__restrict__ Vh,bf16*Oh,float slope2,float sink2,char*shm){
  const int wid=wave_s; const int tid=wave_s*64+fresh_lane(),lane=tid&63,r32=lane&31,hi=lane>>5;
  const int q0=qb*QB, c0=4*qb-2;
  const bf16*Qw=Qh+(long)(q0+wid*QBLK)*DM;
  const unsigned lds0=(unsigned)(uintptr_t)shm;
  float*wsf=(float*)(shm+SWA_WS)+wid*64;
  const bf16*ksrc=Kh+(long)lane*DM+wid*8;
  const bf16*vsrc=Vh+(long)(16*(wid&3)+(lane>>2))*DM+(wid>>2)*32+(lane&3)*8;
  const unsigned kdst=lds0+SWA_K+wid*1024, vdst=lds0+SWA_V+wid*1024;
  #pragma unroll
  for(int s=0;s<6;++s){ const int ch=c0+s; if(ch>=0){ glds16(ksrc+(long)ch*KVBLK*DM,(unsigned)__builtin_amdgcn_readfirstlane(kdst+s*SLOTB)); glds16(vsrc+(long)ch*KVBLK*DM,(unsigned)__builtin_amdgcn_readfirstlane(vdst+s*SLOTB)); } }
  bf16x8 qr[4];
  #pragma unroll
  for(int d0=0;d0<4;++d0)qr[d0]=*reinterpret_cast<const bf16x8*>(&Qw[(long)r32*DM+d0*16+hi*8]);
  WAIT_BAR(0);
  const int wc=wid>>1, qrel=(wid&1)*32+r32;
  f32x16 zero=f32x16{}; asm volatile("":"+v"(zero));
  f32x16 S[3][2];
  #pragma unroll
  for(int t=0;t<3;++t){
    if(c0+wc+t>=0){
      qkt(S[t][0],S[t][1],shm+SWA_K+(wc+t)*SLOTB,qr,zero,r32,hi);
      const float qf=(float)(64*(2-t)+qrel-4*hi);
      #pragma unroll
      for(int r=0;r<16;++r){ const float dd=qf-(float)((r&3)+8*(r>>2)); S[t][0][r]=__builtin_fmaf(-slope2,__builtin_fabsf(dd),S[t][0][r]); S[t][1][r]=__builtin_fmaf(-slope2,__builtin_fabsf(dd-32.f),S[t][1][r]); }
    } else {
      #pragma unroll
      for(int r=0;r<16;++r){ S[t][0][r]=-INFINITY; S[t][1][r]=-INFINITY; }
    }
  }
  float m=sink2;
  #pragma unroll
  for(int t=0;t<3;++t) m=__builtin_fmaxf(m,rowmax(S[t][0],S[t][1]));
  float l=0.f;
  #pragma unroll
  for(int t=0;t<3;++t){
    #pragma unroll
    for(int r=0;r<16;++r){ S[t][0][r]=__builtin_amdgcn_exp2f(S[t][0][r]-m); S[t][1][r]=__builtin_amdgcn_exp2f(S[t][1][r]-m); l+=S[t][0][r]+S[t][1][r]; }
  }
  {auto rr=__builtin_amdgcn_permlane32_swap(__float_as_uint(l),__float_as_uint(l),false,false);l=__uint_as_float(rr[0])+__uint_as_float(rr[1]);}
  l+=__builtin_amdgcn_exp2f(sink2-m);
  f32x16 o[2];o[0]=f32x16{};o[1]=f32x16{};
  const int vb0=(int)(lds0+SWA_V)+((lane>>4)&1)*32+(lane&3)*8+(4*hi+((lane&15)>>2))*64;
  #pragma unroll
  for(int t=0;t<3;++t){
    if(c0+wc+t>=0){
      #define PKW(P,B) cvtpk_s(P[B],P[B+1])
      const u32x4 pw0=(u32x4){PKW(S[t][0],0),PKW(S[t][0],2),PKW(S[t][0],4),PKW(S[t][0],6)},pw1=(u32x4){PKW(S[t][0],8),PKW(S[t][0],10),PKW(S[t][0],12),PKW(S[t][0],14)};
      const u32x4 pw2=(u32x4){PKW(S[t][1],0),PKW(S[t][1],2),PKW(S[t][1],4),PKW(S[t][1],6)},pw3=(u32x4){PKW(S[t][1],8),PKW(S[t][1],10),PKW(S[t][1],12),PKW(S[t][1],14)};
      #undef PKW
      SBAR(); pv(o,vb0+(wc+t)*SLOTB,__builtin_bit_cast(bf16x8,pw0),__builtin_bit_cast(bf16x8,pw1),__builtin_bit_cast(bf16x8,pw2),__builtin_bit_cast(bf16x8,pw3));
    }
  }
  if(hi==0)wsf[32+r32]=l;asm volatile("s_waitcnt lgkmcnt(0)":::"memory");
  float rli[16];
  #pragma unroll
  for(int r=0;r<16;++r)rli[r]=__builtin_amdgcn_rcpf(wsf[32+crow(r,hi)]);
  bf16*Ow=Oh+(long)(q0+wid*QBLK)*DM;
  { bf16*stg=(bf16*)(shm+SWA_OST)+wid*2048;
    #pragma unroll
    for(int r=0;r<16;++r){const int orow=crow(r,hi);
      #pragma unroll
      for(int d0=0;d0<2;++d0)stg[orow*64+d0*32+r32]=__float2bfloat16(o[d0][r]*rli[r]);}
    asm volatile("s_waitcnt lgkmcnt(0)":::"memory");
    #pragma unroll
    for(int i=0;i<4;++i){const int row=i*8+(lane>>3),ch=lane&7; const u32x4 v=*(const u32x4*)(stg+row*64+ch*8); ATTN_STORE16(Ow+(long)row*DM+ch*8,v);} }
  asm volatile("s_waitcnt lgkmcnt(0)\n\ts_barrier":::"memory");
}

#undef SBAR
#undef WAIT_BAR
}

namespace cg = cooperative_groups;
constexpr int NWAVES = 8;
constexpr int BATCH = 2, T = 8192, D = 1024, FF = 4096, PLE = 256, DIN_SRC = 4360, NZ = 4352, M = BATCH * T;
constexpr float RMS_EPS = 1e-6f, LOG2E = 1.4426950408889634f;
constexpr size_t MiB = 1u << 20;
constexpr size_t WS_WIN = 0, WS_WA = 9 * MiB, WS_WB = 10 * MiB, WS_WMIX = 11 * MiB, WS_W1 = 13 * MiB, WS_W2 = 21 * MiB, WS_WG = 29 * MiB, WS_WP = 31 * MiB;
constexpr size_t WS_LF = 31 * MiB + 512 * 1024, WS_CB = 32 * MiB;
constexpr size_t WS_NM = 32 * MiB + 512 * 1024;
constexpr size_t WS_ST1 = 33 * MiB, WS_ST2 = 34 * MiB, WS_ST3 = 35 * MiB;
constexpr size_t WS_PB = 36 * MiB;
constexpr size_t WS_XN = 44 * MiB;
constexpr size_t WS_HN = 76 * MiB;
constexpr size_t WS_Z = 108 * MiB;
constexpr size_t WS_CTL = 244 * MiB, CTL_ZERO_BYTES = 16384;
constexpr size_t WS_END = 245 * MiB;
constexpr int RING_BYTES = 131072, LDS_BYTES = 147456, MISC_OFF = RING_BYTES + 320;
#define GAS __attribute__((address_space(1)))
#define LAS __attribute__((address_space(3)))
typedef unsigned short bf16;
typedef unsigned v4u __attribute__((ext_vector_type(4)));
typedef unsigned v2u __attribute__((ext_vector_type(2)));
typedef float f32x4 __attribute__((ext_vector_type(4)));
#define LDS_WAIT() asm volatile("s_waitcnt lgkmcnt(0)" ::: "memory")
__device__ __forceinline__ unsigned f2bf(float f) { unsigned u = __builtin_bit_cast(unsigned, f); return (u + 0x7fffu + ((u >> 16) & 1u)) >> 16; }
__device__ __forceinline__ unsigned pk2(float lo, float hi) { return f2bf(lo) | (f2bf(hi) << 16); }
__device__ __forceinline__ float wave_sum(float v) {
#pragma unroll
    for (int o = 1; o < 64; o <<= 1) v += __shfl_xor(v, o);
    return v;
}
#define RLX_AGENT __ATOMIC_RELAXED, __HIP_MEMORY_SCOPE_AGENT
#define XB_TMO      128
#define XB_XCNT(j)  (256  + 64 * (j))
#define XB_XSUB(j)  (1280 + 64 * (j))
#define XB_XGEN(j)  (2304 + 64 * (j))
#define XB_TOP      3328
#define XB_TOPGEN   3392
#define XCD_BAR_WORDS 3456
#define XB_SPIN_CAP (1u << 18)

__device__ __forceinline__ unsigned xb_ld(unsigned* p)              { return __hip_atomic_load(p, __ATOMIC_RELAXED, __HIP_MEMORY_SCOPE_AGENT); }
__device__ __forceinline__ unsigned xb_add(unsigned* p, unsigned v) { return __hip_atomic_fetch_add(p, v, __ATOMIC_RELAXED, __HIP_MEMORY_SCOPE_AGENT); }
__device__ __forceinline__ unsigned xb_xcc_id() { return (unsigned)__builtin_amdgcn_s_getreg((3 << 11) | 20) & 0xFu; }
#define XB_SPIN(cond, bar) do { unsigned _sp = 0; while (cond) { __builtin_amdgcn_s_sleep(1); \
    if ((++_sp & 255u) == 0u) { if (xb_ld(&(bar)[XB_TMO])) break; if (_sp > XB_SPIN_CAP) { atomicAdd(&(bar)[XB_TMO], 1u); break; } } } } while (0)

struct XcdBarrier {
    unsigned* bar; unsigned x;
    volatile LAS unsigned* st;
};

__device__ __forceinline__ XcdBarrier xcd_barrier_post(unsigned* bar, volatile LAS unsigned* st) {
    XcdBarrier b; b.bar = bar; b.x = xb_xcc_id(); b.st = st;
    if (threadIdx.x == 0) (void)xb_add(&bar[XB_XCNT(b.x)], 1u);
    return b;
}
__device__ __forceinline__ void xcd_barrier_complete(unsigned* bar, unsigned x, unsigned& nloc, unsigned& nx) {
    const unsigned G = gridDim.x * gridDim.y * gridDim.z;
    unsigned sum, cnt, mine, sp = 0u;
    for (;;) {
        sum = 0u; cnt = 0u; mine = 0u;
#pragma unroll
        for (unsigned j = 0; j < 16; ++j) { const unsigned c = xb_ld(&bar[XB_XCNT(j)]); sum += c; cnt += (c > 0u) ? 1u : 0u; mine = (j == x) ? c : mine; }
        if (sum == G) break;
        __builtin_amdgcn_s_sleep(1);
        if ((++sp & 255u) == 0u) { if (xb_ld(&bar[XB_TMO])) break; if (sp > XB_SPIN_CAP) { atomicAdd(&bar[XB_TMO], 1u); break; } }
    }
    nloc = mine > 0u ? mine : 1u; nx = cnt > 0u ? cnt : 1u;
}

__device__ __forceinline__ void xcd_barrier(const XcdBarrier& b, const bool t0) {
    asm volatile("s_waitcnt vmcnt(0)" ::: "memory");
    __syncthreads();
    if (t0) {
        unsigned* bar = b.bar;
        __builtin_amdgcn_s_waitcnt(0);
        unsigned nloc = b.st[0], nx = b.st[1];
        if (nloc == 0u) { xcd_barrier_complete(bar, b.x, nloc, nx); b.st[0] = nloc; b.st[1] = nx; }
        const unsigned old = xb_add(&bar[XB_XSUB(b.x)], 1u);
        const unsigned gen = old / nloc;
        if (old + 1u == (gen + 1u) * nloc) {
            __builtin_amdgcn_fence(__ATOMIC_RELEASE, "agent");
            asm volatile("s_waitcnt vmcnt(0)" ::: "memory");
            const unsigned og = xb_add(&bar[XB_TOP], 1u);
            const unsigned tg = og / nx;
            if (og + 1u == (tg + 1u) * nx) xb_add(&bar[XB_TOPGEN], 1u);
            else XB_SPIN(xb_ld(&bar[XB_TOPGEN]) == tg, bar);
            __builtin_amdgcn_fence(__ATOMIC_ACQUIRE, "agent");
            xb_add(&bar[XB_XGEN(b.x)], 1u);
            asm volatile("s_waitcnt vmcnt(0)" ::: "memory");
        } else {
            XB_SPIN(xb_ld(&bar[XB_XGEN(b.x)]) == gen, bar);
            __builtin_amdgcn_fence(__ATOMIC_ACQUIRE, "agent");
            asm volatile("s_waitcnt vmcnt(0)" ::: "memory");
        }
    }
    __syncthreads();
}
struct Frame {
    LAS unsigned char* lds; int wave, vcu, G;
};
__device__ __forceinline__ void p0_transpose_item(const float* W, int ldw, int K, int N, int split, int extra, const float* gs, bf16* WT, LAS float* scr, int item, int lane) {
    const int nblk = N / 32, kb = item / nblk, nb = item % nblk, k0 = 64 * kb, n0 = 32 * nb, s0 = n0 + (n0 >= split ? extra : 0);
    const float* src = W + (size_t)(k0 + (lane >> 5)) * ldw + s0 + (lane & 31);
    float w[32];
#pragma unroll
    for (int i = 0; i < 32; ++i) w[i] = src[(size_t)(2 * i) * ldw];
    const int c = lane & 7;
    f32x4 g0 = (f32x4){1.f, 1.f, 1.f, 1.f}, g1 = g0;
    if (gs) { g0 = *(const f32x4*)(gs + k0 + 8 * c); g1 = *(const f32x4*)(gs + k0 + 8 * c + 4); }
#pragma unroll
    for (int i = 0; i < 32; ++i) scr[(2 * i + (lane >> 5)) * 33 + (lane & 31)] = w[i];
    LDS_WAIT(); asm volatile("" ::: "memory");
#pragma unroll
    for (int j = 0; j < 4; ++j) { const int n = (lane >> 3) + 8 * j; const LAS float* s = scr + (8 * c) * 33 + n;
        v4u o; o.x = pk2(s[0 * 33] * g0.x, s[1 * 33] * g0.y); o.y = pk2(s[2 * 33] * g0.z, s[3 * 33] * g0.w); o.z = pk2(s[4 * 33] * g1.x, s[5 * 33] * g1.y); o.w = pk2(s[6 * 33] * g1.z, s[7 * 33] * g1.w);
        *(GAS v4u*)(WT + (size_t)(n0 + n) * K + k0 + 8 * c) = o; }
    LDS_WAIT(); asm volatile("" ::: "memory");
}
struct Args { const float* in[16]; float* out; unsigned char* ws; };
constexpr int WF_OFF = 8 * 8704;

__global__ void __launch_bounds__(NWAVES * 64, 2) mk_fwd(Args args) {
    extern __shared__ __attribute__((aligned(16))) unsigned char lds[];
    cg::grid_group grid = cg::this_grid();
    Frame F;
    F.lds = (LAS unsigned char*)lds;
    F.wave = __builtin_amdgcn_readfirstlane((int)threadIdx.x >> 6);
    F.G = gridDim.x; { const int bx = blockIdx.x; F.vcu = (F.G % 8 == 0) ? (bx % 8) * (F.G / 8) + bx / 8 : bx; }
    unsigned char* ws = args.ws;
    const float* x = args.in[0]; const float* p_in = args.in[1]; const float* g_mix = args.in[2]; const float* w_in = args.in[3]; const float* b_forget = args.in[4];
    const float* sinks = args.in[5]; const float* w_br_swa = args.in[6]; const float* w_br_fox = args.in[7]; const float* w_mix = args.in[8]; const float* g_mlp = args.in[9];
    const float* w_ff1 = args.in[10]; const float* w_ff2 = args.in[11]; const float* g_ple = args.in[12]; const float* w_pg = args.in[13]; const float* w_pp = args.in[14]; const float* g_final = args.in[15];
    float* out = args.out;
    bf16 *WIN_t = (bf16*)(ws + WS_WIN), *WA_t = (bf16*)(ws + WS_WA), *WB_t = (bf16*)(ws + WS_WB), *WMIX_t = (bf16*)(ws + WS_WMIX), *W1_t = (bf16*)(ws + WS_W1), *W2_t = (bf16*)(ws + WS_W2), *WG_t = (bf16*)(ws + WS_WG), *WP_t = (bf16*)(ws + WS_WP);
    float *LF = (float*)(ws + WS_LF), *CB = (float*)(ws + WS_CB), *ST1 = (float*)(ws + WS_ST1), *ST2 = (float*)(ws + WS_ST2), *ST3 = (float*)(ws + WS_ST3);
    bf16 *PB = (bf16*)(ws + WS_PB), *XN = (bf16*)(ws + WS_XN), *HN = (bf16*)(ws + WS_HN), *Z = (bf16*)(ws + WS_Z), *HB = (bf16*)(ws + WS_Z); bf16* PP = (bf16*)(ws + WS_Z);
    unsigned* NM = (unsigned*)(ws + WS_NM);
    const int gw = F.vcu * NWAVES + F.wave, NGW = F.G * NWAVES;

    for (int u = threadIdx.x; u < 128; u += NWAVES * 64) ((LAS unsigned*)(F.lds + RING_BYTES))[u] = 0u;
    __syncthreads();
    XcdBarrier bar = xcd_barrier_post((unsigned*)(ws + WS_CTL), (volatile LAS unsigned*)(F.lds + MISC_OFF) + 8);
#define GRID_BAR() do { const int l_ = fresh_lane(); xcd_barrier(bar, (F.wave == 0) && (l_ == 0)); } while (0)
    {
        const int p0_tid = threadIdx.x, p0_lane = p0_tid & 63;
        for (int i = blockIdx.x * (NWAVES * 64) + p0_tid; i < 1024 + 32; i += F.G * NWAVES * 64) NM[i] = 0u;
        LAS float* wfT = (LAS float*)(F.lds + WF_OFF);
        for (int i = p0_tid; i < 8 * D; i += NWAVES * 64) { const int k = i >> 3, h = i & 7; wfT[h * 1024 + k] = g_mix[k] * w_in[(size_t)k * DIN_SRC + 2304 + h]; }
        __syncthreads();
        f32x4 gm4[4];
#pragma unroll
        for (int j = 0; j < 4; ++j) gm4[j] = ((const GAS f32x4*)g_mix)[64 * j + p0_lane];
        const float bfg = b_forget[p0_lane & 7];
        f32x4 v[4];
        if (gw < M) { const GAS f32x4* xr = (const GAS f32x4*)(x + (size_t)gw * D) + p0_lane;
#pragma unroll
            for (int j = 0; j < 4; ++j) v[j] = xr[64 * j]; }
        for (int m = gw; m < M; m += NGW) {
            f32x4 vn[4]; const int mn = (m + NGW < M) ? m + NGW : m;
            { const GAS f32x4* xr = (const GAS f32x4*)(x + (size_t)mn * D) + p0_lane;
#pragma unroll
              for (int j = 0; j < 4; ++j) vn[j] = xr[64 * j]; }
            float ss = 0.f;
#pragma unroll
            for (int j = 0; j < 4; ++j) ss += (v[j].x * v[j].x + v[j].y * v[j].y) + (v[j].z * v[j].z + v[j].w * v[j].w);
            float a8[8];
#pragma unroll
            for (int h = 0; h < 8; ++h) { float a = 0.f;
#pragma unroll
                for (int j = 0; j < 4; ++j) { const f32x4 w = ((const LAS f32x4*)wfT)[h * 256 + 64 * j + p0_lane]; a += (v[j].x * w.x + v[j].y * w.y) + (v[j].z * w.z + v[j].w * w.w); }
                a8[h] = a; }
#pragma unroll
            for (int o = 1; o < 64; o <<= 1) { ss += __shfl_xor(ss, o);
#pragma unroll
                for (int h = 0; h < 8; ++h) a8[h] += __shfl_xor(a8[h], o); }
            const float rstd = 1.f / sqrtf(ss * (1.f / D) + RMS_EPS);
            float fsel = a8[0];
#pragma unroll
            for (int h = 1; h < 8; ++h) fsel = (p0_lane == h) ? a8[h] : fsel;
            if (p0_lane < 8) { const float xf = fsel * rstd + bfg; const float ls = fminf(xf, 0.f) - log1pf(expf(-fabsf(xf)));
                LF[(size_t)((m >> 13) * 8 + p0_lane) * T + (m & (T - 1))] = ls; }
            GAS unsigned long long* o8 = (GAS unsigned long long*)(XN + (size_t)m * D) + p0_lane;
#pragma unroll
            for (int j = 0; j < 4; ++j) { const f32x4 y = v[j] * rstd * gm4[j];
                o8[64 * j] = (unsigned long long)pk2(y.x, y.y) | ((unsigned long long)pk2(y.z, y.w) << 32); }
#pragma unroll
            for (int j = 0; j < 4; ++j) v[j] = vn[j];
        }
        for (int i = gw * 64 + p0_lane; i < M * PLE / 32; i += NGW * 64) { f32x4 a[8];
#pragma unroll
            for (int q = 0; q < 4; ++q) { a[2 * q] = ((const GAS f32x4*)p_in)[2 * (i + q * (M * PLE / 32))]; a[2 * q + 1] = ((const GAS f32x4*)p_in)[2 * (i + q * (M * PLE / 32)) + 1]; }
#pragma unroll
            for (int q = 0; q < 4; ++q) { v4u o; o.x = pk2(a[2 * q].x, a[2 * q].y); o.y = pk2(a[2 * q].z, a[2 * q].w); o.z = pk2(a[2 * q + 1].x, a[2 * q + 1].y); o.w = pk2(a[2 * q + 1].z, a[2 * q + 1].w); ((GAS v4u*)PB)[i + q * (M * PLE / 32)] = o; } }
        LAS float* scr = (LAS float*)(F.lds + F.wave * 8704);
        constexpr int I_IN = (D / 64) * (NZ / 32), I_A = (512 / 64) * (D / 32), I_MIX = (D / 64) * (D / 32), I_1 = (D / 64) * (FF / 32), I_2 = (FF / 64) * (D / 32), I_P = (PLE / 64) * (D / 32);
        constexpr int NITEMS = I_IN + 2 * I_A + I_MIX + I_1 + I_2 + I_MIX + I_P;
        for (int it = gw; it < NITEMS; it += NGW) {
            int r = it;
            if (r < I_IN) { p0_transpose_item(w_in, DIN_SRC, D, NZ, 2304, 8, nullptr, WIN_t, scr, r, p0_lane); continue; } r -= I_IN;
            if (r < I_A) { p0_transpose_item(w_br_swa, D, 512, D, 1 << 30, 0, nullptr, WA_t, scr, r, p0_lane); continue; } r -= I_A;
            if (r < I_A) { p0_transpose_item(w_br_fox, D, 512, D, 1 << 30, 0, nullptr, WB_t, scr, r, p0_lane); continue; } r -= I_A;
            if (r < I_MIX) { p0_transpose_item(w_mix, D, D, D, 1 << 30, 0, nullptr, WMIX_t, scr, r, p0_lane); continue; } r -= I_MIX;
            if (r < I_1) { p0_transpose_item(w_ff1, FF, D, FF, 1 << 30, 0, g_mlp, W1_t, scr, r, p0_lane); continue; } r -= I_1;
            if (r < I_2) { p0_transpose_item(w_ff2, D, FF, D, 1 << 30, 0, nullptr, W2_t, scr, r, p0_lane); continue; } r -= I_2;
            if (r < I_MIX) { p0_transpose_item(w_pg, D, D, D, 1 << 30, 0, g_ple, WG_t, scr, r, p0_lane); continue; } r -= I_MIX;
            p0_transpose_item(w_pp, D, PLE, D, 1 << 30, 0, nullptr, WP_t, scr, r, p0_lane);
        }
    }
    grid.sync();

    for (int bh = blockIdx.x; bh < 16; bh += gridDim.x) {
        const int c_lane = fresh_lane(), c_tid = F.wave * 64 + c_lane;
        const GAS f32x4* src = (const GAS f32x4*)(LF + (size_t)bh * T) + c_tid * 4;
        f32x4 v[4]; float run = 0.f;
#pragma unroll
        for (int j = 0; j < 4; ++j) { v[j] = src[j];
#pragma unroll
            for (int e = 0; e < 4; ++e) { run += v[j][e]; v[j][e] = run; } }
        float sc = run;
#pragma unroll
        for (int o = 1; o < 64; o <<= 1) { const float n = __shfl_up(sc, o); if (c_lane >= o) sc += n; }
        LAS float* wt = (LAS float*)F.lds;
        if (c_lane == 63) wt[F.wave] = sc;
        __syncthreads();
        float woff = 0.f;
        for (int w = 0; w < F.wave; ++w) woff += wt[w];
        const float off = woff + sc - run;
        GAS f32x4* dst = (GAS f32x4*)(CB + (size_t)bh * T) + c_tid * 4;
#pragma unroll
        for (int j = 0; j < 4; ++j) dst[j] = (v[j] + off) * (-LOG2E);
        __syncthreads();
    }
    {
        pg8::Gemm g{XN, WIN_t, M, NZ, D, D}; pg8::StaticOrder S; S.init(M, NZ, F.G, (int)blockIdx.x);
        pg8::EpiZ E{Z, NM, 0};
        pg8::gemm_phase<pg8::EpiZ, pg8::StaticOrder, PG8_ALIGN, PG8_SP2>(F.lds, g, S, E, F.wave);
    }
    GRID_BAR();

    {
        unsigned* qctr = (unsigned*)(ws + WS_CTL) + 3584;
        volatile LAS unsigned* qslot = (volatile LAS unsigned*)(F.lds + RING_BYTES + 16);
        for (;;) {
            { const int l_ = fresh_lane(); if (F.wave == 0 && l_ == 0) qslot[0] = __hip_atomic_fetch_add(qctr, 1u, __ATOMIC_RELAXED, __HIP_MEMORY_SCOPE_AGENT); }
            __syncthreads();
            const int idx = __builtin_amdgcn_readfirstlane((int)qslot[0]);
            __syncthreads();
            if (idx >= 64 + 512 + 512) break;
            if (idx < 64) {
                continue;
            } else if (idx < 64 + 512) {
                const int j = idx - 64, qb = 31 - (j >> 4), bh = j & 15, b = bh >> 3, h = bh & 7;
                const attn_body::bf16* Zb = (const attn_body::bf16*)Z + (size_t)b * T * NZ;
                const attn_body::bf16* Qh = Zb + 768 + h * 64; const attn_body::bf16* Kh = Zb + 1280 + h * 64; const attn_body::bf16* Vh = Zb + 1792 + h * 64;
                const float* cb = CB + (size_t)bh * T;
                const float km = sqrtf(__uint_as_float(NM[1024 + bh * 2]) + __uint_as_float(NM[1024 + bh * 2 + 1]));
                const int pmA = b * 32 + qb;
                const float qkA = 2.04f * km * sqrtf(__uint_as_float(NM[(pmA * 8 + h) * 2]) + __uint_as_float(NM[(pmA * 8 + h) * 2 + 1]));
                attn_body::attn_unit<24>(F.wave, qb, Qh, Kh, Vh, (attn_body::bf16*)Qh, cb, qkA, (char*)lds);
            } else {
                const int j = idx - 64 - 512, bh = j >> 5, qb = j & 31, b = bh >> 3, h = bh & 7;
                const attn_body::bf16* Zb = (const attn_body::bf16*)Z + (size_t)b * T * NZ;
                const attn_body::bf16* Qh = Zb + h * 64; const attn_body::bf16* Kh = Zb + 512 + (h >> 2) * 64; const attn_body::bf16* Vh = Zb + 640 + (h >> 2) * 64;
                const float slope2 = exp2f(-(float)(h + 1)) * LOG2E, sink2 = sinks[h] * LOG2E;
                attn_body::swa_unit(F.wave, qb, Qh, Kh, Vh, (attn_body::bf16*)Qh, slope2, sink2, (char*)lds);
            }
        }
    }
    GRID_BAR();

    {
        pg8::StaticOrder S; S.init(M, D, F.G, (int)blockIdx.x);
        { pg8::Gemm g{Z, WA_t, M, D, 512, NZ}; pg8::EpiT1 E{Z + 2304, (bf16*)out}; pg8::gemm_phase<pg8::EpiT1, pg8::StaticOrder, PG8_ALIGN, PG8_SP2>(F.lds, g, S, E, F.wave); }
        { pg8::Gemm g{Z + 768, WB_t, M, D, 512, NZ}; pg8::EpiMix E{Z + 3328, (const bf16*)out, XN}; pg8::gemm_phase<pg8::EpiMix, pg8::StaticOrder, PG8_ALIGN, PG8_SP2>(F.lds, g, S, E, F.wave); }
    }
    GRID_BAR();

    {
        pg8::Gemm g{XN, WMIX_t, M, D, D, D}; pg8::StaticOrder S; S.init(M, D, F.G, (int)blockIdx.x);
        pg8::EpiRes<false> E{x, HN, ST1};
        pg8::gemm_phase<pg8::EpiRes<false>, pg8::StaticOrder, PG8_ALIGN, PG8_SP2>(F.lds, g, S, E, F.wave);
    }
    GRID_BAR();

    {
        pg8::Gemm g{HN, W1_t, M, FF, D, D}; pg8::StaticOrder S; S.init(M, FF, F.G, (int)blockIdx.x);
        pg8::EpiRelu2 E{ST1, HB};
        pg8::gemm_phase<pg8::EpiRelu2, pg8::StaticOrder, PG8_ALIGN, PG8_SP2>(F.lds, g, S, E, F.wave);
    }
    GRID_BAR();

    {
        pg8::Gemm g{HB, W2_t, M, D, FF, FF}; pg8::StaticOrder S; S.init(M, D, F.G, (int)blockIdx.x);
        pg8::EpiRes<true> E{HN, XN, ST2};
        pg8::gemm_phase<pg8::EpiRes<true>, pg8::StaticOrder, PG8_ALIGN, PG8_SP2>(F.lds, g, S, E, F.wave);
    }
    GRID_BAR();

    {
        pg8::StaticOrder S; S.init(M, D, F.G, (int)blockIdx.x);
        { pg8::Gemm g{PB, WP_t, M, D, PLE, PLE}; pg8::EpiPP E{PP}; pg8::gemm_phase<pg8::EpiPP, pg8::StaticOrder, PG8_ALIGN, PG8_SP2>(F.lds, g, S, E, F.wave); }
        { pg8::Gemm g{XN, WG_t, M, D, D, D}; pg8::EpiPle E{ST2, PP, XN, out, ST3}; pg8::gemm_phase<pg8::EpiPle, pg8::StaticOrder, PG8_ALIGN, PG8_SP2>(F.lds, g, S, E, F.wave); }
    }
    GRID_BAR();

    const int f_lane = fresh_lane();
    for (int m = gw; m < M; m += NGW) {
        float t = (f_lane < 16) ? ST3[(size_t)m * 16 + f_lane] : 0.f;
        const float rstd = 1.f / sqrtf(wave_sum(t) * (1.f / D) + RMS_EPS);
        GAS f32x4* xr = (GAS f32x4*)(out + (size_t)m * D) + f_lane;
#pragma unroll
        for (int j = 0; j < 4; ++j) { const f32x4 gm = ((const GAS f32x4*)g_final)[64 * j + f_lane]; xr[64 * j] = xr[64 * j] * rstd * gm; }
    }
}

extern "C" void kernel_launch(void* const* d_in, const int* in_sizes, int n_in, void* d_out, int out_size, void* d_ws, size_t ws_size, hipStream_t stream) {
    static int grid = 0;
    if (grid == 0) {
        if (n_in != 16 || in_sizes[0] != M * D || out_size != M * D || ws_size < WS_END) { fprintf(stderr, "kernel_launch: unexpected shapes (n_in %d, in0 %d, out %d, ws %zu); nothing launched\n", n_in, n_in > 0 ? in_sizes[0] : -1, out_size, ws_size); grid = -1; return; }
        int dev = 0, cus = 0, per_cu = 0;
        if (hipGetDevice(&dev) != hipSuccess || hipDeviceGetAttribute(&cus, hipDeviceAttributeMultiprocessorCount, dev) != hipSuccess) { grid = -1; return; }
        if (hipFuncSetAttribute((const void*)mk_fwd, hipFuncAttributeMaxDynamicSharedMemorySize, LDS_BYTES) != hipSuccess) { fprintf(stderr, "kernel_launch: hipFuncSetAttribute failed\n"); grid = -1; return; }
        if (hipOccupancyMaxActiveBlocksPerMultiprocessor(&per_cu, (const void*)mk_fwd, NWAVES * 64, LDS_BYTES) != hipSuccess || per_cu < 1) { fprintf(stderr, "kernel_launch: occupancy query failed (%d)\n", per_cu); (void)hipGetLastError(); per_cu = 1; }
        if (per_cu > 1) per_cu = 1;
        grid = cus * per_cu;
    }
    if (grid < 0) return;
    if (hipMemsetAsync((char*)d_ws + WS_CTL, 0, CTL_ZERO_BYTES, stream) != hipSuccess) { fprintf(stderr, "kernel_launch: memset failed\n"); return; }
    Args a{};
    for (int i = 0; i < 16; ++i) a.in[i] = (const float*)d_in[i];
    a.out = (float*)d_out; a.ws = (unsigned char*)d_ws;
    void* kargs[] = {&a};
    hipError_t e = hipLaunchCooperativeKernel((const void*)mk_fwd, dim3(grid), dim3(NWAVES * 64), kargs, LDS_BYTES, stream);
    if (e != hipSuccess) fprintf(stderr, "kernel_launch: cooperative launch failed: %s (grid %d)\n", hipGetErrorString(e), grid);
}
```

```cpp
#include <hip/hip_runtime.h>
#include <hip/hip_cooperative_groups.h>
#include <cstdio>
#include <cstdint>
__device__ __forceinline__ int fresh_lane() { int l; asm volatile("v_mbcnt_lo_u32_b32 %0, -1, 0\n\tv_mbcnt_hi_u32_b32 %0, -1, %0" : "=v"(l)); return l; }

namespace pg8 {

#define PG8_LAS __attribute__((address_space(3)))
typedef unsigned short bf16_t;
typedef short bf16x8 __attribute__((ext_vector_type(8)));
typedef float f32x4 __attribute__((ext_vector_type(4)));
typedef unsigned u32x4 __attribute__((ext_vector_type(4)));
constexpr int BM = 256, BK = 64, HALF = 128, HTB = HALF * BK * 2  , STAGE_BYTES = 8 * HTB, NXCD = 8, WGM = 8;

__host__ __device__ __forceinline__ int lds_byte(int r, int c) { const int st = (r >> 4) * 2 + (c >> 5), rr = r & 15, cc = c & 31, ob = rr * 64 + cc * 2; return st * 1024 + (ob ^ (((ob >> 9) & 1) << 5)); }
__host__ __device__ __forceinline__ void stage_rc(int b, int& R, int& C) { const int st = b / 1024, sb = b % 1024, swz = sb ^ (((sb >> 9) & 1) << 5); R = (st >> 1) * 16 + swz / 64; C = (st & 1) * 32 + (swz % 64) / 2; }
__host__ __device__ __forceinline__ int perm32(int rho) { const int n = rho >> 4, i = rho & 15; return 8 * (i >> 2) + 4 * n + (i & 3); }

struct Unit { int pm, pn; };
struct Gemm { const bf16_t* A; const bf16_t* Bt; int M, N, K, lda; };

struct StaticOrder {
    int nM, nN, nwg, G, c;
    __host__ __device__ void init(int M, int N, int G_, int c_) { nM = M / BM; nN = N / BM; nwg = nM * nN; G = G_; c = c_; }
    __host__ __device__ bool next(int i, Unit& u) const {
        const long L = (long)i * G + c; if (L >= nwg) return false;
        int wgid = (int)L; { const int q = nwg / NXCD, r = nwg % NXCD, xcd = wgid % NXCD, off = wgid / NXCD; wgid = (xcd < r ? xcd * (q + 1) : r * (q + 1) + (xcd - r) * q) + off; }
        const int nig = WGM * nN, gid = wgid / nig, fm = gid * WGM, gsz = (nM - fm) < WGM ? (nM - fm) : WGM;
        u.pm = fm + ((wgid % nig) % gsz); u.pn = (wgid % nig) / gsz; return true;
    }
    __device__ __forceinline__ void a_ready(const Unit&) const {}
    __device__ __forceinline__ void done(const Unit&) const {}
};

__device__ __forceinline__ unsigned cvt_pk_bf16(float lo, float hi) { unsigned r; asm volatile("v_cvt_pk_bf16_f32 %0, %1, %2" : "=v"(r) : "v"(lo), "v"(hi)); return r; }
typedef float f32x2 __attribute__((ext_vector_type(2)));
struct OneUnit { int pm, pn; __device__ bool next(int i, Unit& u) const { if (i) return false; u.pm = pm; u.pn = pn; return true; } __device__ __forceinline__ void a_ready(const Unit&) const {} __device__ __forceinline__ void done(const Unit&) const {} };
constexpr int ZP = 4352;
constexpr float C2F = 0.125f * 1.4426950408889634f;
__device__ __forceinline__ float sigmoidf_fast(float x) { return __builtin_amdgcn_rcpf(1.0f + __builtin_amdgcn_exp2f(-1.4426950408889634f * x)); }
__device__ __forceinline__ f32x4 bf4_lo(unsigned a, unsigned b) { return (f32x4){__uint_as_float(a << 16), __uint_as_float(a & 0xffff0000u), __uint_as_float(b << 16), __uint_as_float(b & 0xffff0000u)}; }
__device__ __forceinline__ u32x4 pack8(f32x4 v0, f32x4 v1) { u32x4 w; w.x = cvt_pk_bf16(v0[0], v0[1]); w.y = cvt_pk_bf16(v0[2], v0[3]); w.z = cvt_pk_bf16(v1[0], v1[1]); w.w = cvt_pk_bf16(v1[2], v1[3]); return w; }
__device__ __forceinline__ float rstd_from_stats(const float* st, int row) { const f32x4* s = (const f32x4*)(st + (size_t)row * 16); const f32x4 a = s[0], b = s[1], c = s[2], d = s[3];
    const float t = ((a[0] + a[1]) + (a[2] + a[3])) + ((b[0] + b[1]) + (b[2] + b[3])) + ((c[0] + c[1]) + (c[2] + c[3])) + ((d[0] + d[1]) + (d[2] + d[3])); return 1.0f / sqrtf(t * (1.0f / 1024.0f) + 1e-6f); }
#define EPI_ROWS(...) _Pragma("unroll") for (int ai = 0; ai < 2; ++ai) _Pragma("unroll") for (int m = 0; m < 4; ++m) { const int row = u.pm * BM + ai * HALF + wr * 64 + m * 16 + fr; __VA_ARGS__ asm volatile("" ::: "memory"); }
#define EPI_COLS(...) _Pragma("unroll") for (int bj = 0; bj < 2; ++bj) { const int col = u.pn * BM + bj * HALF + wc * 32 + 8 * fq; const f32x4 a0 = acc[ai][bj][m][0], a1 = acc[ai][bj][m][1]; __VA_ARGS__ }
struct EpiZ { static constexpr bool PERM = true, AFTER_DRAIN = false; bf16_t* Z; unsigned* NM; int pn_off;
    __device__ __forceinline__ void operator()(const f32x4 (&acc)[2][2][4][2], const Unit& u, int wr, int wc, int fr, int fq) const {
        const int pn = u.pn + pn_off; const int mode = (pn >= 9) ? 2 : ((pn == 0 || pn == 1 || pn == 3 || pn == 4) ? 1 : 0);
        const bool nrm = (pn >= 3 && pn <= 6); float mx0 = 0.f, mx1 = 0.f;
        EPI_ROWS( bf16_t* rowp = Z + (size_t)row * ZP; EPI_COLS( f32x4 v0 = a0, v1 = a1;
            if (mode == 1) { v0 = v0 * C2F; v1 = v1 * C2F; }
            else if (mode == 2) { _Pragma("unroll") for (int e = 0; e < 4; ++e) { v0[e] = sigmoidf_fast(v0[e]); v1[e] = sigmoidf_fast(v1[e]); } }
            if (nrm) { float ss = ((v0[0] * v0[0] + v0[1] * v0[1]) + (v0[2] * v0[2] + v0[3] * v0[3])) + ((v1[0] * v1[0] + v1[1] * v1[1]) + (v1[2] * v1[2] + v1[3] * v1[3]));
                ss += __shfl_xor(ss, 16); ss += __shfl_xor(ss, 32); if (bj == 0) mx0 = fmaxf(mx0, ss); else mx1 = fmaxf(mx1, ss); }
            *(u32x4*)(rowp + col + pn_off * BM) = pack8(v0, v1); ) )
        if (nrm) {
#pragma unroll
            for (int o = 1; o < 16; o <<= 1) { mx0 = fmaxf(mx0, __shfl_xor(mx0, o)); mx1 = fmaxf(mx1, __shfl_xor(mx1, o)); }
            if (fr == 0 && fq == 0) {
                const int isk = (pn >= 5), cr = (pn - (isk ? 5 : 3)) * 4 + (wc >> 1), half = wc & 1;
                unsigned* b0 = isk ? NM + 1024 + ((u.pm >> 5) * 8 + cr) * 2 + half : NM + (u.pm * 8 + cr) * 2 + half;
                atomicMax(b0, __float_as_uint(mx0 * 1.0001f)); atomicMax(b0 + 4, __float_as_uint(mx1 * 1.0001f));
            } }
    } };
#define EPI_GROUP(NR, ...) _Pragma("unroll") for (int ai = 0; ai < 2; ++ai) _Pragma("unroll") for (int mg = 0; mg < 4; mg += NR) { __VA_ARGS__ asm volatile("" ::: "memory"); }
#define EPI_ROWOF(mm) (u.pm * BM + ai * HALF + wr * 64 + (mm) * 16 + fr)
#define EPI_COLOF(bj) (u.pn * BM + (bj) * HALF + wc * 32 + 8 * fq)
struct EpiT1 { static constexpr bool PERM = true, AFTER_DRAIN = false; const bf16_t* G; bf16_t* T;
    __device__ __forceinline__ void operator()(const f32x4 (&acc)[2][2][4][2], const Unit& u, int wr, int wc, int fr, int fq) const {
        EPI_GROUP(4, u32x4 g[4][2];
            _Pragma("unroll") for (int i = 0; i < 4; ++i) _Pragma("unroll") for (int bj = 0; bj < 2; ++bj) g[i][bj] = *(const u32x4*)(G + (size_t)EPI_ROWOF(mg + i) * ZP + EPI_COLOF(bj));
            _Pragma("unroll") for (int i = 0; i < 4; ++i) _Pragma("unroll") for (int bj = 0; bj < 2; ++bj)
                *(u32x4*)(T + (size_t)EPI_ROWOF(mg + i) * 1024 + EPI_COLOF(bj)) = pack8(acc[ai][bj][mg + i][0] * bf4_lo(g[i][bj].x, g[i][bj].y), acc[ai][bj][mg + i][1] * bf4_lo(g[i][bj].z, g[i][bj].w)); )
    } };
struct EpiMix { static constexpr bool PERM = true, AFTER_DRAIN = false; const bf16_t* G; const bf16_t* T; bf16_t* O;
    __device__ __forceinline__ void operator()(const f32x4 (&acc)[2][2][4][2], const Unit& u, int wr, int wc, int fr, int fq) const {
        EPI_GROUP(4, u32x4 g[4][2]; u32x4 t[4][2];
            _Pragma("unroll") for (int i = 0; i < 4; ++i) _Pragma("unroll") for (int bj = 0; bj < 2; ++bj) { g[i][bj] = *(const u32x4*)(G + (size_t)EPI_ROWOF(mg + i) * ZP + EPI_COLOF(bj));
                t[i][bj] = *(const u32x4*)(T + (size_t)EPI_ROWOF(mg + i) * 1024 + EPI_COLOF(bj)); }
            _Pragma("unroll") for (int i = 0; i < 4; ++i) _Pragma("unroll") for (int bj = 0; bj < 2; ++bj) {
                const f32x4 v0 = bf4_lo(t[i][bj].x, t[i][bj].y) + acc[ai][bj][mg + i][0] * bf4_lo(g[i][bj].x, g[i][bj].y), v1 = bf4_lo(t[i][bj].z, t[i][bj].w) + acc[ai][bj][mg + i][1] * bf4_lo(g[i][bj].z, g[i][bj].w);
                *(u32x4*)(O + (size_t)EPI_ROWOF(mg + i) * 1024 + EPI_COLOF(bj)) = pack8(v0, v1); } )
    } };
template <bool BASE_BF16> struct EpiRes { static constexpr bool PERM = true, AFTER_DRAIN = false; const void* base; bf16_t* hb; float* st;
    __device__ __forceinline__ void operator()(const f32x4 (&acc)[2][2][4][2], const Unit& u, int wr, int wc, int fr, int fq) const {
        EPI_GROUP(4, f32x4 b[4][2][2];
            _Pragma("unroll") for (int i = 0; i < 4; ++i) _Pragma("unroll") for (int bj = 0; bj < 2; ++bj) { const size_t off = (size_t)EPI_ROWOF(mg + i) * 1024 + EPI_COLOF(bj);
                if constexpr (BASE_BF16) { const u32x4 r = *(const u32x4*)((const bf16_t*)base + off); b[i][bj][0] = bf4_lo(r.x, r.y); b[i][bj][1] = bf4_lo(r.z, r.w); }
                else { const float* bp = (const float*)base + off; b[i][bj][0] = *(const f32x4*)bp; b[i][bj][1] = *(const f32x4*)(bp + 4); } }
            _Pragma("unroll") for (int i = 0; i < 4; ++i) { float ss = 0.f; const int row = EPI_ROWOF(mg + i);
                _Pragma("unroll") for (int bj = 0; bj < 2; ++bj) { const size_t off = (size_t)row * 1024 + EPI_COLOF(bj); const f32x4 h0 = b[i][bj][0] + acc[ai][bj][mg + i][0], h1 = b[i][bj][1] + acc[ai][bj][mg + i][1];
                    *(u32x4*)(hb + off) = pack8(h0, h1);
                    ss += ((h0[0] * h0[0] + h0[1] * h0[1]) + (h0[2] * h0[2] + h0[3] * h0[3])) + ((h1[0] * h1[0] + h1[1] * h1[1]) + (h1[2] * h1[2] + h1[3] * h1[3])); }
                ss += __shfl_xor(ss, 16); ss += __shfl_xor(ss, 32); if (fq == 0) st[(size_t)row * 16 + u.pn * 4 + wc] = ss; } )
    } };
struct EpiRelu2 { static constexpr bool PERM = true, AFTER_DRAIN = false; const float* st; bf16_t* O;
    __device__ __forceinline__ void operator()(const f32x4 (&acc)[2][2][4][2], const Unit& u, int wr, int wc, int fr, int fq) const {
        float rsv[2][4];
        _Pragma("unroll") for (int ai = 0; ai < 2; ++ai) { _Pragma("unroll") for (int m = 0; m < 4; ++m) rsv[ai][m] = rstd_from_stats(st, u.pm * BM + ai * HALF + wr * 64 + m * 16 + fr);
            asm volatile("" : "+v"(rsv[ai][0]), "+v"(rsv[ai][1]), "+v"(rsv[ai][2]), "+v"(rsv[ai][3]) :: "memory"); }
        EPI_ROWS( const float rs = rsv[ai][m]; EPI_COLS( f32x4 v0 = a0 * rs, v1 = a1 * rs;
            _Pragma("unroll") for (int e = 0; e < 4; ++e) { const float x0 = fmaxf(v0[e], 0.f), x1 = fmaxf(v1[e], 0.f); v0[e] = x0 * x0; v1[e] = x1 * x1; }
            *(u32x4*)(O + (size_t)row * 4096 + col) = pack8(v0, v1); ) )
    } };
struct EpiPP { static constexpr bool PERM = true, AFTER_DRAIN = false; bf16_t* T;
    __device__ __forceinline__ void operator()(const f32x4 (&acc)[2][2][4][2], const Unit& u, int wr, int wc, int fr, int fq) const {
        EPI_ROWS( EPI_COLS( *(u32x4*)(T + (size_t)row * 1024 + col) = pack8(a0, a1); ) )
    } };
struct EpiPle { static constexpr bool PERM = true, AFTER_DRAIN = false; const float* st_in; const bf16_t* T; const bf16_t* hsrc; bf16_t* out; float* st;
    __device__ __forceinline__ void operator()(const f32x4 (&acc)[2][2][4][2], const Unit& u, int wr, int wc, int fr, int fq) const {
        float rsv[2][4];
        _Pragma("unroll") for (int ai = 0; ai < 2; ++ai) { _Pragma("unroll") for (int m = 0; m < 4; ++m) rsv[ai][m] = rstd_from_stats(st_in, u.pm * BM + ai * HALF + wr * 64 + m * 16 + fr);
            asm volatile("" : "+v"(rsv[ai][0]), "+v"(rsv[ai][1]), "+v"(rsv[ai][2]), "+v"(rsv[ai][3]) :: "memory"); }
        EPI_GROUP(2, u32x4 hv[2][2]; u32x4 tv[2][2];
            _Pragma("unroll") for (int i = 0; i < 2; ++i) _Pragma("unroll") for (int bj = 0; bj < 2; ++bj) { const size_t off = (size_t)EPI_ROWOF(mg + i) * 1024 + EPI_COLOF(bj);
                    hv[i][bj] = *(const u32x4*)(hsrc + off); tv[i][bj] = *(const u32x4*)(T + off); }
            _Pragma("unroll") for (int i = 0; i < 2; ++i) { float ss = 0.f; const int row = EPI_ROWOF(mg + i); const float rs = rsv[ai][mg + i];
                _Pragma("unroll") for (int bj = 0; bj < 2; ++bj) { const size_t off = (size_t)row * 1024 + EPI_COLOF(bj);
                    f32x4 g0 = acc[ai][bj][mg + i][0] * rs, g1 = acc[ai][bj][mg + i][1] * rs; _Pragma("unroll") for (int e = 0; e < 4; ++e) { g0[e] = sigmoidf_fast(g0[e]); g1[e] = sigmoidf_fast(g1[e]); }
                    const f32x4 h0 = bf4_lo(hv[i][bj].x, hv[i][bj].y) + g0 * bf4_lo(tv[i][bj].x, tv[i][bj].y), h1 = bf4_lo(hv[i][bj].z, hv[i][bj].w) + g1 * bf4_lo(tv[i][bj].z, tv[i][bj].w);
                    *(u32x4*)(out + off) = pack8(h0, h1);
                    ss += ((h0[0] * h0[0] + h0[1] * h0[1]) + (h0[2] * h0[2] + h0[3] * h0[3])) + ((h1[0] * h1[0] + h1[1] * h1[1]) + (h1[2] * h1[2] + h1[3] * h1[3])); }
                ss += __shfl_xor(ss, 16); ss += __shfl_xor(ss, 32); if (fq == 0) st[(size_t)row * 16 + u.pn * 4 + wc] = ss; } )
    } };
struct EpiNone { static constexpr bool PERM = true, AFTER_DRAIN = false; float* sink;
    __device__ __forceinline__ void operator()(const f32x4 (&acc)[2][2][4][2], const Unit& u, int wr, int wc, int fr, int fq) const {
        if (acc[0][0][0][0][0] == 1.2345e33f) sink[0] = 1.f;
    } };

template <class Epi, class Sched, bool ALIGN_EPI = false, bool SP2 = false>
__device__ __forceinline__ void gemm_phase(PG8_LAS unsigned char* lds, const Gemm g, const Sched& S, const Epi& E, const int wave_s) {
    const int tid = wave_s * 64 + fresh_lane(), wid = wave_s, lane = tid & 63, wr = wid >> 2, wc = wid & 3, fr = lane & 15, fq = lane >> 4;
    const int K = g.K, nt = K / BK;
    unsigned voffA[2], voffB[2];
#pragma unroll
    for (int i = 0; i < 2; ++i) { int R, C; stage_rc(tid * 16 + i * 8192, R, C); const int Rb = Epi::PERM ? ((R & ~31) + perm32(R & 31)) : R;
        voffA[i] = (unsigned)(R * g.lda + C) * 2u; voffB[i] = (unsigned)(Rb * K + C) * 2u; }
    const size_t kstep = (size_t)(BK * 2);
    const size_t hstepA = (size_t)HALF * g.lda * 2, hstepB = (size_t)HALF * K * 2;
    const size_t tstepA = 2 * hstepA, tstepB = 2 * hstepB;
    const unsigned ldsw = (unsigned)wid * 1024u;
    const int aoff = lds_byte(wr * 64 + fr, fq * 8), boff = lds_byte(wc * 32 + fr, fq * 8);
#define PG8_SA(b, h) (((b) * 2 + (h)) * HTB)
#define PG8_SB(b, h) ((4 + (b) * 2 + (h)) * HTB)
#define PG8_STAGE(bufoff, gbase, voff) do { _Pragma("unroll") for (int _i = 0; _i < 2; ++_i) \
        __builtin_amdgcn_global_load_lds((const unsigned*)((const char*)(gbase) + (voff)[_i]), (PG8_LAS unsigned*)(lds + (bufoff) + ldsw + _i * 8192), 16, 0, 0); } while (0)
#define PG8_LDA(dst, b, h) do { _Pragma("unroll") for (int m = 0; m < 4; ++m) _Pragma("unroll") for (int k = 0; k < 2; ++k) dst[m][k] = *(const PG8_LAS bf16x8*)(lds + PG8_SA(b, h) + aoff + m * 2048 + k * 1024); } while (0)
#define PG8_LDB(dst, b, h) do { _Pragma("unroll") for (int n = 0; n < 2; ++n) _Pragma("unroll") for (int k = 0; k < 2; ++k) dst[n][k] = *(const PG8_LAS bf16x8*)(lds + PG8_SB(b, h) + boff + n * 2048 + k * 1024); } while (0)
#define PG8_MMA(ai, bj, At, Bt) do { __builtin_amdgcn_s_setprio(1); _Pragma("unroll") for (int m = 0; m < 4; ++m) _Pragma("unroll") for (int n = 0; n < 2; ++n) _Pragma("unroll") for (int k = 0; k < 2; ++k) \
        acc[ai][bj][m][n] = __builtin_amdgcn_mfma_f32_16x16x32_bf16(Bt[n][k], At[m][k], acc[ai][bj][m][n], 0, 0, 0); __builtin_amdgcn_s_setprio(0); } while (0)
#define PG8_WAIT_V(n) asm volatile("s_waitcnt vmcnt(" #n ")" ::: "memory")
#define PG8_WAIT_L(n) asm volatile("s_waitcnt lgkmcnt(" #n ")" ::: "memory")
#define PG8_BAR __builtin_amdgcn_s_barrier()
#define PG8_SCHED __builtin_amdgcn_sched_barrier(0)
    Unit cur, nxt; int ui = 0;
    if (!S.next(0, cur)) return;
    f32x4 acc[2][2][4][2];
#pragma unroll
    for (int a = 0; a < 2; ++a)
#pragma unroll
        for (int b = 0; b < 2; ++b)
#pragma unroll
            for (int m = 0; m < 4; ++m)
#pragma unroll
                for (int n = 0; n < 2; ++n) acc[a][b][m][n] = (f32x4){0.f, 0.f, 0.f, 0.f};
    bf16x8 At[4][2], B0[2][2], B1[2][2];
    const char* cA = (const char*)g.A + (size_t)cur.pm * tstepA; const char* cB = (const char*)g.Bt + (size_t)cur.pn * tstepB;
    S.a_ready(cur);
    if constexpr (SP2) {
        PG8_STAGE(PG8_SB(0, 0), cB, voffB); PG8_STAGE(PG8_SB(0, 1), cB + hstepB, voffB); PG8_STAGE(PG8_SA(0, 0), cA, voffA); PG8_STAGE(PG8_SA(0, 1), cA + hstepA, voffA);
        if (wr == 1) PG8_BAR;
        PG8_WAIT_V(2); PG8_BAR;
        PG8_STAGE(PG8_SB(1, 0), cB + kstep, voffB); PG8_STAGE(PG8_SA(1, 0), cA + kstep, voffA); PG8_STAGE(PG8_SB(1, 1), cB + hstepB + kstep, voffB);
        PG8_WAIT_V(6); PG8_BAR;
    } else {
        PG8_STAGE(PG8_SB(0, 0), cB, voffB); PG8_STAGE(PG8_SA(0, 0), cA, voffA); PG8_STAGE(PG8_SB(0, 1), cB + hstepB, voffB); PG8_STAGE(PG8_SA(0, 1), cA + hstepA, voffA);
        if (wr == 1) PG8_BAR;
        PG8_WAIT_V(4); PG8_BAR;
        PG8_STAGE(PG8_SB(1, 0), cB + kstep, voffB); PG8_STAGE(PG8_SA(1, 0), cA + kstep, voffA); PG8_STAGE(PG8_SB(1, 1), cB + hstepB + kstep, voffB);
        PG8_WAIT_V(6); PG8_BAR;
    }
    for (;;) {
        const bool has_next = S.next(ui + 1, nxt);
        const char* nA = has_next ? (const char*)g.A + (size_t)nxt.pm * tstepA : cA; const char* nB = has_next ? (const char*)g.Bt + (size_t)nxt.pn * tstepB : cB;
        for (int t = 0; t < nt; t += 2) {
            const bool last = (t == nt - 2);
            const char* a1 = cA + (size_t)(t + 1) * kstep;
            const char* a2 = last ? nA : cA + (size_t)(t + 2) * kstep; const char* b2 = last ? nB : cB + (size_t)(t + 2) * kstep;
            const char* a3 = a2 + kstep; const char* b3 = b2 + kstep;
            if (last && has_next) S.a_ready(nxt);
            if constexpr (SP2) {
            PG8_LDB(B0, 0, 0); PG8_LDB(B1, 0, 1); PG8_SCHED; PG8_LDA(At, 0, 0); PG8_STAGE(PG8_SA(1, 1), a1 + hstepA, voffA);
            PG8_WAIT_V(8); PG8_WAIT_L(0); PG8_BAR; PG8_MMA(0, 0, At, B0); PG8_MMA(0, 1, At, B1); PG8_BAR; PG8_SCHED;
            PG8_LDA(At, 0, 1); PG8_STAGE(PG8_SB(0, 0), b2, voffB); PG8_STAGE(PG8_SB(0, 1), b2 + hstepB, voffB); PG8_STAGE(PG8_SA(0, 0), a2, voffA);
            PG8_WAIT_V(8); PG8_WAIT_L(0); PG8_BAR; PG8_MMA(1, 0, At, B0); PG8_MMA(1, 1, At, B1); PG8_BAR; PG8_SCHED;
            PG8_LDB(B0, 1, 0); PG8_LDB(B1, 1, 1); PG8_SCHED; PG8_LDA(At, 1, 0); PG8_STAGE(PG8_SA(0, 1), a2 + hstepA, voffA);
            PG8_WAIT_V(8); PG8_WAIT_L(0); PG8_BAR; PG8_MMA(0, 0, At, B0); PG8_MMA(0, 1, At, B1); PG8_BAR; PG8_SCHED;
            PG8_LDA(At, 1, 1); PG8_STAGE(PG8_SB(1, 0), b3, voffB); PG8_STAGE(PG8_SB(1, 1), b3 + hstepB, voffB); PG8_STAGE(PG8_SA(1, 0), a3, voffA);
            PG8_WAIT_V(8); PG8_WAIT_L(0); PG8_BAR; PG8_MMA(1, 0, At, B0); PG8_MMA(1, 1, At, B1); PG8_BAR; PG8_SCHED;
            } else {
            PG8_LDB(B0, 0, 0); PG8_SCHED; PG8_LDA(At, 0, 0); PG8_STAGE(PG8_SA(1, 1), a1 + hstepA, voffA);
            PG8_WAIT_L(8); PG8_BAR; PG8_WAIT_L(0); PG8_MMA(0, 0, At, B0); PG8_BAR; PG8_SCHED;
            PG8_LDB(B1, 0, 1); PG8_STAGE(PG8_SB(0, 0), b2, voffB);
            PG8_BAR; PG8_WAIT_L(0); PG8_MMA(0, 1, At, B1); PG8_BAR;
            PG8_LDA(At, 0, 1); PG8_STAGE(PG8_SA(0, 0), a2, voffA);
            PG8_BAR; PG8_WAIT_L(0); PG8_MMA(1, 0, At, B0); PG8_BAR; PG8_SCHED;
            PG8_STAGE(PG8_SB(0, 1), b2 + hstepB, voffB);
            PG8_WAIT_V(6); PG8_BAR; PG8_MMA(1, 1, At, B1); PG8_BAR;
            PG8_LDB(B0, 1, 0); PG8_SCHED; PG8_LDA(At, 1, 0); PG8_STAGE(PG8_SA(0, 1), a2 + hstepA, voffA);
            PG8_WAIT_L(8); PG8_BAR; PG8_WAIT_L(0); PG8_MMA(0, 0, At, B0); PG8_BAR; PG8_SCHED;
            PG8_LDB(B1, 1, 1); PG8_STAGE(PG8_SB(1, 0), b3, voffB);
            PG8_BAR; PG8_WAIT_L(0); PG8_MMA(0, 1, At, B1); PG8_BAR;
            PG8_LDA(At, 1, 1); PG8_STAGE(PG8_SA(1, 0), a3, voffA);
            PG8_BAR; PG8_WAIT_L(0); PG8_MMA(1, 0, At, B0); PG8_BAR; PG8_SCHED;
            PG8_STAGE(PG8_SB(1, 1), b3 + hstepB, voffB);
            PG8_WAIT_V(6); PG8_BAR; PG8_MMA(1, 1, At, B1); PG8_BAR;
            }
        }
        if constexpr (ALIGN_EPI) { if (wr == 0) PG8_BAR; }
        if constexpr (!Epi::AFTER_DRAIN) { E(acc, cur, wr, wc, fr, fq); S.done(cur); }
        if (!has_next) break;
#pragma unroll
        for (int a = 0; a < 2; ++a)
#pragma unroll
            for (int b = 0; b < 2; ++b)
#pragma unroll
                for (int m = 0; m < 4; ++m)
#pragma unroll
                    for (int n = 0; n < 2; ++n) acc[a][b][m][n] = (f32x4){0.f, 0.f, 0.f, 0.f};
        cur = nxt; cA = nA; cB = nB; ++ui;
        if constexpr (ALIGN_EPI) { if (wr == 1) PG8_BAR; }
    }
    PG8_WAIT_V(0);
    if constexpr (!ALIGN_EPI) { if (wr == 0) PG8_BAR; }
    PG8_BAR;
    if constexpr (Epi::AFTER_DRAIN) { E.fused(acc, cur, wr, wc, fr, fq, lds, wid, lane); S.done(cur); }
#undef PG8_SA
#undef PG8_SB
#undef PG8_STAGE
#undef PG8_LDA
#undef PG8_LDB
#undef PG8_MMA
#undef PG8_WAIT_V
#undef PG8_WAIT_L
#undef PG8_BAR
#undef PG8_SCHED
}
}
#ifndef PG8_SP2
#define PG8_SP2 true
#endif
#ifndef PG8_ALIGN
#define PG8_ALIGN true
#endif
#include <hip/hip_bf16.h>
#include <cmath>
namespace attn_body {
using bf16=__hip_bfloat16;
using bf16x8=__attribute__((ext_vector_type(8)))short;
using s16x4=__attribute__((ext_vector_type(4)))short;
using f32x16=__attribute__((ext_vector_type(16)))float;
using u32x4=__attribute__((ext_vector_type(4)))unsigned;
constexpr int BATCH=2,SEQ=8192,D=64,DM=4352;
constexpr int NW=8,QBLK=32,QB=QBLK*NW,KVBLK=64,NQB=SEQ/QB;
constexpr int ATTN_PITCH=DM, ATTN_UNIT_ROWS=QB;
__device__ __forceinline__ int crow(int r,int hi){return (r&3)+8*(r>>2)+4*hi;}
#define SBAR() __builtin_amdgcn_sched_barrier(0)
__device__ __forceinline__ void cmask(f32x16&p0,f32x16&p1,int jb,int qrel,int hi){
  const float NEG=-INFINITY; int kb=64*jb+4*hi;
  #pragma unroll
  for(int r=0;r<16;++r){int kv=kb+(r&3)+8*(r>>2); if(kv>qrel)p0[r]=NEG; if(kv+32>qrel)p1[r]=NEG;}
}

constexpr int NSLOT=3, SLOTB=8192; typedef float f32x4v __attribute__((ext_vector_type(4))); constexpr int LDS_BIAS=86016;
constexpr int LDS_K=0, LDS_V=NSLOT*SLOTB, LDS_WS=2*NSLOT*SLOTB, LDS_OST=LDS_WS+NW*64*4, LDS_BYTES=LDS_OST+NW*4096;
constexpr float C2=0.125f*1.4426950408889634f;
__device__ __forceinline__ void glds16(const void*gsrc,unsigned lds_dst){unsigned keep;
  asm volatile("s_mov_b32 %0, m0\n\ts_mov_b32 m0, %2\n\ts_nop 0\n\tglobal_load_lds_dwordx4 %1, off\n\ts_mov_b32 m0, %0":"=&s"(keep):"v"(gsrc),"s"(lds_dst):"memory");}
__device__ __forceinline__ float max3f(float a,float b,float c){float r;asm("v_max3_f32 %0, %1, %2, %3":"=v"(r):"v"(a),"v"(b),"v"(c));return r;}
__device__ __forceinline__ float max2f(float a,float b){float r;asm("v_max_f32_e32 %0, %1, %2":"=v"(r):"v"(a),"v"(b));return r;}
__device__ __forceinline__ float fadd_s(float a,float b){float r;asm("v_add_f32_e32 %0, %1, %2":"=v"(r):"v"(a),"v"(b));return r;}
__device__ __forceinline__ float fsub_s(float a,float b){float r;asm("v_sub_f32_e32 %0, %1, %2":"=v"(r):"v"(a),"v"(b));return r;}
typedef float f32x2_t __attribute__((ext_vector_type(2))); typedef __bf16 bf16x2_t __attribute__((ext_vector_type(2)));
__device__ __forceinline__ unsigned cvtpk_s(float lo,float hi){f32x2_t v={lo,hi};bf16x2_t b=__builtin_convertvector(v,bf16x2_t);return __builtin_bit_cast(unsigned,b);}
#define WAIT_BAR(N) asm volatile("s_waitcnt vmcnt(" #N ") lgkmcnt(0)\n\ts_barrier":::"memory")

__device__ __forceinline__ void qkt(f32x16&p0,f32x16&p1,const char*Kslot,const bf16x8*qr,const f32x16&negm,int r32,int hi){
  const char*kb=Kslot+hi*1024+r32*16;
  #pragma unroll
  for(int d0=0;d0<4;++d0){
    const bf16x8 b0=*reinterpret_cast<const bf16x8*>(kb+d0*2048);
    const bf16x8 b1=*reinterpret_cast<const bf16x8*>(kb+d0*2048+512);
    if(d0==0){p0=__builtin_amdgcn_mfma_f32_32x32x16_bf16(b0,qr[0],negm,0,0,0);p1=__builtin_amdgcn_mfma_f32_32x32x16_bf16(b1,qr[0],negm,0,0,0);}
    else{p0=__builtin_amdgcn_mfma_f32_32x32x16_bf16(b0,qr[d0],p0,0,0,0);p1=__builtin_amdgcn_mfma_f32_32x32x16_bf16(b1,qr[d0],p1,0,0,0);}}
}
typedef __attribute__((address_space(3))) const char* lds_cptr;
typedef short v4i16_t __attribute__((ext_vector_type(4)));
__device__ __forceinline__ void kload8(bf16x8*kf,lds_cptr kp){
  kf[0]=*(const __attribute__((address_space(3))) bf16x8*)(kp);      kf[1]=*(const __attribute__((address_space(3))) bf16x8*)(kp+512);
  kf[2]=*(const __attribute__((address_space(3))) bf16x8*)(kp+2048); kf[3]=*(const __attribute__((address_space(3))) bf16x8*)(kp+2560);
  kf[4]=*(const __attribute__((address_space(3))) bf16x8*)(kp+4096); kf[5]=*(const __attribute__((address_space(3))) bf16x8*)(kp+4608);
  kf[6]=*(const __attribute__((address_space(3))) bf16x8*)(kp+6144); kf[7]=*(const __attribute__((address_space(3))) bf16x8*)(kp+6656);
}
__device__ __forceinline__ void kload2(bf16x8*kf,lds_cptr kp,int j){ kf[2*j]=*(const __attribute__((address_space(3))) bf16x8*)(kp+j*2048); kf[2*j+1]=*(const __attribute__((address_space(3))) bf16x8*)(kp+j*2048+512); }
__device__ __forceinline__ s16x4 vtr(lds_cptr p){ return __builtin_bit_cast(s16x4,__builtin_amdgcn_ds_read_tr16_b64_v4i16((__attribute__((address_space(3))) v4i16_t*)p)); }
__device__ __forceinline__ float rowmax(const f32x16&p0,const f32x16&p1){
  float a=max3f(p0[0],p0[1],p1[0]),b=max3f(p0[2],p0[3],p1[1]);a=max3f(a,p1[2],p1[3]);
  #pragma unroll
  for(int r=4;r<16;r+=4){a=max3f(a,p0[r],p0[r+1]);b=max3f(b,p0[r+2],p0[r+3]);a=max3f(a,p1[r],p1[r+1]);b=max3f(b,p1[r+2],p1[r+3]);}
  const float m=max2f(a,b);
  auto rr=__builtin_amdgcn_permlane32_swap(__float_as_uint(m),__float_as_uint(m),false,false);
  return max2f(__uint_as_float(rr[0]),__uint_as_float(rr[1]));
}
__device__ __forceinline__ void pv(f32x16*o,int vb,bf16x8 pa0,bf16x8 pa1,bf16x8 pa2,bf16x8 pa3){
  #pragma unroll
  for(int d0=0;d0<2;++d0){s16x4 lo[4],hi[4];
    #pragma unroll
    for(int ks=0;ks<4;++ks){
      asm volatile("ds_read_b64_tr_b16 %0,%1 offset:%c2":"=&v"(lo[ks]):"v"(vb),"i"(d0*4096+ks*1024):"memory");
      asm volatile("ds_read_b64_tr_b16 %0,%1 offset:%c2":"=&v"(hi[ks]):"v"(vb),"i"(d0*4096+ks*1024+512):"memory");}
    asm volatile("s_waitcnt lgkmcnt(0)":::"memory");SBAR();
    #define PK(k) (bf16x8){lo[k][0],lo[k][1],lo[k][2],lo[k][3],hi[k][0],hi[k][1],hi[k][2],hi[k][3]}
    o[d0]=__builtin_amdgcn_mfma_f32_32x32x16_bf16(pa0,PK(0),o[d0],0,0,0);
    o[d0]=__builtin_amdgcn_mfma_f32_32x32x16_bf16(pa1,PK(1),o[d0],0,0,0);
    o[d0]=__builtin_amdgcn_mfma_f32_32x32x16_bf16(pa2,PK(2),o[d0],0,0,0);
    o[d0]=__builtin_amdgcn_mfma_f32_32x32x16_bf16(pa3,PK(3),o[d0],0,0,0);
    #undef PK
  }
}

#ifndef ATTN_STORE16
#define ATTN_STORE16(p,v) (*(u32x4*)(p)=(v))
#endif
template<int THRL> __device__ __forceinline__ void attn_unit(const int wave_s,int qb,const bf16*Qh,const bf16*__restrict__ Kh,const bf16*__restrict__ Vh,bf16*Oh,const float*__restrict__ cbias,const float qk2,char*shm){
  const int wid=wave_s; const int tid=wave_s*64+fresh_lane(),lane=tid&63,r32=lane&31,hi=lane>>5;
  const int q0=qb*QB;
  const bf16*Qw=Qh+(long)(q0+wid*QBLK)*DM;
  int t0; { const int ntab=(q0+QB)/KVBLK; const float thr=cbias[q0]-(qk2+44.0f); const int l_=tid&63;
    const bool c0_=(l_<ntab-4)&&(cbias[l_*64+63]<thr), c1_=(l_+64<ntab-4)&&(cbias[(l_+64)*64+63]<thr);
    t0=(__builtin_popcountll(__ballot(c0_))+__builtin_popcountll(__ballot(c1_)))&~1; t0=__builtin_amdgcn_readfirstlane(t0); }
  Kh+=(long)t0*KVBLK*DM; Vh+=(long)t0*KVBLK*DM; cbias+=t0*KVBLK;
  const unsigned lds0=(unsigned)(uintptr_t)shm;
  float*wsf=(float*)(shm+LDS_WS)+wid*64;
  const bf16*ksrc=Kh+(long)lane*DM+wid*8;
  const bf16*vsrc=Vh+(long)(16*(wid&3)+(lane>>2))*DM+(wid>>2)*32+(lane&3)*8;
  const unsigned kdst=lds0+LDS_K+wid*1024, vdst=lds0+LDS_V+wid*1024;
  #define DMA_K(t,slot) glds16(ksrc+(long)(t)*KVBLK*DM,(unsigned)__builtin_amdgcn_readfirstlane(kdst+(slot)))
  #define DMA_V(t,slot) glds16(vsrc+(long)(t)*KVBLK*DM,(unsigned)__builtin_amdgcn_readfirstlane(vdst+(slot)))
  const int vb0=(int)(lds0+LDS_V)+((lane>>4)&1)*32+(lane&3)*8+(4*hi+((lane&15)>>2))*64;
  const char*Kbase=shm+LDS_K; bf16x8 kf[8];
  const lds_cptr shm3=(lds_cptr)shm; const lds_cptr kp0=shm3+LDS_K+hi*1024+r32*16; const lds_cptr vp0=shm3+LDS_V+((lane>>4)&1)*32+(lane&3)*8+(4*hi+((lane&15)>>2))*64;
  { const int nk4=((q0+QB)>>2)-t0*16; __attribute__((address_space(3))) f32x4v* bt=(__attribute__((address_space(3))) f32x4v*)((lds_cptr)shm+LDS_BIAS); for(int i=tid;i<nk4;i+=NW*64) bt[i]=((const f32x4v*)cbias)[i]; }
  const int NT=(q0+QB)/KVBLK-t0;
  DMA_K(0,0);DMA_V(0,0);DMA_K(1,SLOTB);
  bf16x8 qr[4];
  #pragma unroll
  for(int d0=0;d0<4;++d0)qr[d0]=*reinterpret_cast<const bf16x8*>(&Qw[(long)r32*DM+d0*16+hi*8]);
  float mhat=0.f,l_reg=0.f;float zf_=0.f;asm volatile("":"+v"(zf_));f32x16 o[2];f32x16 negm;
  _Pragma("unroll") for(int r=0;r<16;++r){o[0][r]=zf_;o[1][r]=zf_;negm[r]=zf_;} asm volatile("":"+v"(negm));
  const int qrel=wid*QBLK+r32;
  #define CMASK(P0,P1,t) do{int jb_=(t)-(NT-4); if(jb_>=0)cmask(P0,P1,jb_,qrel,hi);}while(0)
  #define BIAS(P0,P1,t) do{ const __attribute__((address_space(3))) f32x4v* bt_=(const __attribute__((address_space(3))) f32x4v*)(shm3+LDS_BIAS)+(t)*16+hi; \
    _Pragma("unroll") for(int i_=0;i_<4;++i_){ const f32x4v b0_=bt_[2*i_], b1_=bt_[8+2*i_]; \
      P0[4*i_]+=b0_[0];P0[4*i_+1]+=b0_[1];P0[4*i_+2]+=b0_[2];P0[4*i_+3]+=b0_[3]; P1[4*i_]+=b1_[0];P1[4*i_+1]+=b1_[1];P1[4*i_+2]+=b1_[2];P1[4*i_+3]+=b1_[3]; } }while(0)
  bool resc=false;
  #define START(P0,P1) do{ const float rm=rowmax(P0,P1); resc=false; \
    { const float dl=rm; mhat=fadd_s(mhat,dl); \
      _Pragma("unroll") for(int r=0;r<16;++r){P0[r]=fsub_s(P0[r],dl);P1[r]=fsub_s(P1[r],dl);} \
      _Pragma("unroll") for(int r=0;r<16;++r)negm[r]=-mhat; asm volatile("":"+v"(negm)); } \
    _Pragma("unroll") for(int r=0;r<16;++r)P0[r]=__builtin_amdgcn_exp2f(P0[r]); }while(0)
  #define RESC() do{ if(resc){ asm volatile("s_waitcnt lgkmcnt(0)":::"memory"); \
      _Pragma("unroll") for(int d_=0;d_<2;++d_) _Pragma("unroll") for(int r=0;r<16;++r)o[d_][r]*=wsf[crow(r,hi)]; } }while(0)
  f32x16 pA0,pA1,pB0,pB1;
  int sl_prev=0,sl_cur=0,sl_next=SLOTB;
  #define ROT() do{sl_prev=sl_cur;sl_cur=sl_next;sl_next=(sl_next==(NSLOT-1)*SLOTB)?0:sl_next+SLOTB;}while(0)
  DMA_K(2,2*SLOTB);
  WAIT_BAR(3);
  qkt(pA0,pA1,Kbase,qr,negm,r32,hi);asm volatile("s_nop 15\n\ts_nop 7":"+v"(pA0),"+v"(pA1));BIAS(pA0,pA1,0);CMASK(pA0,pA1,0);
  START(pA0,pA1);
  _Pragma("unroll") for(int r=0;r<16;++r)pA1[r]=__builtin_amdgcn_exp2f(pA1[r]);
  WAIT_BAR(0);
  DMA_K(3,0);DMA_V(1,SLOTB);
  ROT();
  kload8(kf,kp0+sl_cur);
  WAIT_BAR(2);
  s16x4 vlo[8],vhi[8]; u32x4 pw0,pw1,pw2,pw3;
  #define PKW(P,B) cvtpk_s(P[B],P[B+1])
  #define PAF(k) __builtin_bit_cast(bf16x8,pw##k)
  #define VFR(i) (bf16x8){vlo[i][0],vlo[i][1],vlo[i][2],vlo[i][3],vhi[i][0],vhi[i][1],vhi[i][2],vhi[i][3]}
  #define PIN(x) asm volatile("":"+v"(x))
  #define MX3(a,b,c) __builtin_fmaxf(__builtin_fmaxf((a),(b)),(c))
  #define GAPA(MF,A0,A1,A2,A3,W0,W1,PW) do{ MF; sacc+=A0; sacc+=A1; sacc+=A2; sacc+=A3; PIN(sacc); W0; W1; PIN(PW); SBAR(); }while(0)
  #define EX(v) __builtin_amdgcn_exp2f(v)
  #define GAPB(MF,X,B) do{ MF; X[B]=EX(X[B]); X[B+1]=EX(X[B+1]); X[B+2]=EX(X[B+2]); X[B+3]=EX(X[B+3]); PIN(X); SBAR(); }while(0)
  #define VRD(i) do{ vlo[i]=vtr(vp_+(((i)>>2)*4096+((i)&3)*1024)); vhi[i]=vtr(vp_+(((i)>>2)*4096+((i)&3)*1024+512)); }while(0)
  #define KRD(G,j) do{ if(G){ kload2(kf,kp0+sl_next,j); SBAR(); } }while(0)
  #define STEP(C0,C1,P0,P1,t,GK,GV,GL) do{ SBAR(); \
    const lds_cptr vp_=vp0+sl_prev; \
    VRD(0); SBAR(); float sacc=(P0[0]+P0[1]); \
    GAPA(C0=__builtin_amdgcn_mfma_f32_32x32x16_bf16(kf[0],qr[0],negm,0,0,0), P0[2],P0[3],P0[4],P0[5],     pw0[0]=PKW(P0,0), pw0[1]=PKW(P0,2), pw0); \
    VRD(4); SBAR(); GAPA(C1=__builtin_amdgcn_mfma_f32_32x32x16_bf16(kf[1],qr[0],negm,0,0,0), P0[6],P0[7],P0[8],P0[9],     pw0[2]=PKW(P0,4), pw0[3]=PKW(P0,6), pw0); \
    VRD(1); SBAR(); GAPA(C0=__builtin_amdgcn_mfma_f32_32x32x16_bf16(kf[2],qr[1],C0,0,0,0),   P0[10],P0[11],P0[12],P0[13], pw1[0]=PKW(P0,8), pw1[1]=PKW(P0,10), pw1); \
    VRD(5); SBAR(); GAPA(C1=__builtin_amdgcn_mfma_f32_32x32x16_bf16(kf[3],qr[1],C1,0,0,0),   P0[14],P0[15],P1[0],P1[1],   pw1[2]=PKW(P0,12),pw1[3]=PKW(P0,14), pw1); \
    VRD(2); SBAR(); GAPA(C0=__builtin_amdgcn_mfma_f32_32x32x16_bf16(kf[4],qr[2],C0,0,0,0),   P1[2],P1[3],P1[4],P1[5],     pw2[0]=PKW(P1,0), pw2[1]=PKW(P1,2), pw2); \
    VRD(6); SBAR(); GAPA(C1=__builtin_amdgcn_mfma_f32_32x32x16_bf16(kf[5],qr[2],C1,0,0,0),   P1[6],P1[7],P1[8],P1[9],     pw2[2]=PKW(P1,4), pw2[3]=PKW(P1,6), pw2); \
    VRD(3); SBAR(); GAPA(C0=__builtin_amdgcn_mfma_f32_32x32x16_bf16(kf[6],qr[3],C0,0,0,0),   P1[10],P1[11],P1[12],P1[13], pw3[0]=PKW(P1,8), pw3[1]=PKW(P1,10), pw3); \
    VRD(7); SBAR(); GAPA(C1=__builtin_amdgcn_mfma_f32_32x32x16_bf16(kf[7],qr[3],C1,0,0,0),   P1[14],P1[15],0.f,0.f,       pw3[2]=PKW(P1,12),pw3[3]=PKW(P1,14), pw3); \
    l_reg+=sacc; \
    if(GK){DMA_K((t)+3,sl_cur);} if(GV){DMA_V((t)+1,sl_next);} \
    BIAS(C0,C1,t); CMASK(C0,C1,t); \
    { float a=MX3(C0[0],C0[1],C1[0]),b=MX3(C0[2],C0[3],C1[1]); a=MX3(a,C1[2],C1[3]); \
      _Pragma("unroll") for(int r=4;r<16;r+=4){a=MX3(a,C0[r],C0[r+1]);b=MX3(b,C0[r+2],C0[r+3]);a=MX3(a,C1[r],C1[r+1]);b=MX3(b,C1[r+2],C1[r+3]);} \
      float rm=__builtin_fmaxf(a,b); { auto rr=__builtin_amdgcn_permlane32_swap(__float_as_uint(rm),__float_as_uint(rm),false,false); rm=__builtin_fmaxf(__uint_as_float(rr[0]),__uint_as_float(rr[1])); } \
      resc=false; \
      if(__builtin_expect(__any(rm>(float)THRL),0)){ const float dl=__builtin_fmaxf(rm,0.f); mhat+=dl; \
        _Pragma("unroll") for(int r=0;r<16;++r){C0[r]-=dl;C1[r]-=dl;} \
        _Pragma("unroll") for(int r=0;r<16;++r)negm[r]=-mhat; asm volatile("":"+v"(negm)); \
        const float f=__builtin_amdgcn_exp2f(-dl); l_reg*=f; if(hi==0)wsf[r32]=f; resc=true; } } \
    SBAR(); \
    GAPB(o[0]=__builtin_amdgcn_mfma_f32_32x32x16_bf16(PAF(0),VFR(0),o[0],0,0,0), C0,0); \
    GAPB(o[1]=__builtin_amdgcn_mfma_f32_32x32x16_bf16(PAF(0),VFR(4),o[1],0,0,0), C0,4); \
    KRD(GL,0); GAPB(o[0]=__builtin_amdgcn_mfma_f32_32x32x16_bf16(PAF(1),VFR(1),o[0],0,0,0), C0,8); \
    KRD(GL,1); GAPB(o[1]=__builtin_amdgcn_mfma_f32_32x32x16_bf16(PAF(1),VFR(5),o[1],0,0,0), C0,12); \
    KRD(GL,2); GAPB(o[0]=__builtin_amdgcn_mfma_f32_32x32x16_bf16(PAF(2),VFR(2),o[0],0,0,0), C1,0); \
    KRD(GL,3); GAPB(o[1]=__builtin_amdgcn_mfma_f32_32x32x16_bf16(PAF(2),VFR(6),o[1],0,0,0), C1,4); \
    GAPB(o[0]=__builtin_amdgcn_mfma_f32_32x32x16_bf16(PAF(3),VFR(3),o[0],0,0,0), C1,8); \
    GAPB(o[1]=__builtin_amdgcn_mfma_f32_32x32x16_bf16(PAF(3),VFR(7),o[1],0,0,0), C1,12); \
    }while(0)
  int t=1;
  #undef CMASK
  #define CMASK(P0,P1,t) do{}while(0)
  for(;t+5<NT;t+=2){
    STEP(pB0,pB1,pA0,pA1,t,true,true,true);     WAIT_BAR(2); RESC(); ROT();
    STEP(pA0,pA1,pB0,pB1,t+1,true,true,true);   WAIT_BAR(2); RESC(); ROT();
  }
  #undef CMASK
  #define CMASK(P0,P1,t) do{int jb_=(t)-(NT-4); if(jb_>=0)cmask(P0,P1,jb_,qrel,hi);}while(0)
  #define ENDW(tt) do{ if((tt)+3<NT){WAIT_BAR(2);} else if((tt)+2<NT){WAIT_BAR(1);} else {WAIT_BAR(0);} }while(0)
  for(;t+1<NT;t+=2){
    STEP(pB0,pB1,pA0,pA1,t,(t+3<NT),(t+1<NT),(t+1<NT));       ENDW(t);   RESC(); ROT();
    STEP(pA0,pA1,pB0,pB1,t+1,(t+4<NT),(t+2<NT),(t+2<NT));     ENDW(t+1); RESC(); ROT();
  }
  STEP(pB0,pB1,pA0,pA1,NT-1,false,false,false); RESC();
  { float sacc=pB0[0]+pB0[1]; _Pragma("unroll") for(int r=2;r<16;++r)sacc+=pB0[r]; _Pragma("unroll") for(int r=0;r<16;++r)sacc+=pB1[r]; l_reg+=sacc;
    pw0=(u32x4){PKW(pB0,0),PKW(pB0,2),PKW(pB0,4),PKW(pB0,6)};pw1=(u32x4){PKW(pB0,8),PKW(pB0,10),PKW(pB0,12),PKW(pB0,14)};pw2=(u32x4){PKW(pB1,0),PKW(pB1,2),PKW(pB1,4),PKW(pB1,6)};pw3=(u32x4){PKW(pB1,8),PKW(pB1,10),PKW(pB1,12),PKW(pB1,14)};
    SBAR(); pv(o,vb0+sl_cur,PAF(0),PAF(1),PAF(2),PAF(3)); }
  #undef PKW
  #undef PAF
  #undef VFR
  #undef PIN
  #undef MX3
  #undef GAPA
  #undef GAPB
  #undef EX
  #undef VRD
  #undef KRD
  #undef STEP
  #undef ENDW
  {auto rr=__builtin_amdgcn_permlane32_swap(__float_as_uint(l_reg),__float_as_uint(l_reg),false,false);l_reg=__uint_as_float(rr[0])+__uint_as_float(rr[1]);}
  if(hi==0)wsf[32+r32]=l_reg;asm volatile("s_waitcnt lgkmcnt(0)":::"memory");
  float rli[16];
  #pragma unroll
  for(int r=0;r<16;++r)rli[r]=__builtin_amdgcn_rcpf(wsf[32+crow(r,hi)]);
  bf16*Ow=Oh+(long)(q0+wid*QBLK)*DM;
  { bf16*stg=(bf16*)(shm+LDS_OST)+wid*2048;
    #pragma unroll
    for(int r=0;r<16;++r){const int orow=crow(r,hi);
      #pragma unroll
      for(int d0=0;d0<2;++d0)stg[orow*64+d0*32+r32]=__float2bfloat16(o[d0][r]*rli[r]);}
    asm volatile("s_waitcnt lgkmcnt(0)":::"memory");
    #pragma unroll
    for(int i=0;i<4;++i){const int row=i*8+(lane>>3),ch=lane&7; const u32x4 v=*(const u32x4*)(stg+row*64+ch*8); ATTN_STORE16(Ow+(long)row*DM+ch*8,v);} }
  asm volatile("s_waitcnt lgkmcnt(0)\n\ts_barrier":::"memory");
  #undef DMA_K
  #undef DMA_V
  #undef CMASK
  #undef START
  #undef RESC
  #undef ROT
  #undef BIAS
}
constexpr int ATTN_LDS_BYTES=LDS_BYTES;
constexpr int SWA_K=0, SWA_V=6*SLOTB, SWA_OST=12*SLOTB, SWA_WS=133120;
__device__ __forceinline__ void swa_unit(const int wave_s,int qb,const bf16*Qh,const bf16*__restrict__ Kh,const bf16*__restrict__ Vh,bf16*Oh,float slope2,float sink2,char*shm){
  const int wid=wave_s; const int tid=wave_s*64+fresh_lane(),lane=tid&63,r32=lane&31,hi=lane>>5;
  const int q0=qb*QB, c0=4*qb-2;
  const bf16*Qw=Qh+(long)(q0+wid*QBLK)*DM;
  const unsigned lds0=(unsigned)(uintptr_t)shm;
  float*wsf=(float*)(shm+SWA_WS)+wid*64;
  const bf16*ksrc=Kh+(long)lane*DM+wid*8;
  const bf16*vsrc=Vh+(long)(16*(wid&3)+(lane>>2))*DM+(wid>>2)*32+(lane&3)*8;
  const unsigned kdst=lds0+SWA_K+wid*1024, vdst=lds0+SWA_V+wid*1024;
  #pragma unroll
  for(int s=0;s<6;++s){ const int ch=c0+s; if(ch>=0){ glds16(ksrc+(long)ch*KVBLK*DM,(unsigned)__builtin_amdgcn_readfirstlane(kdst+s*SLOTB)); glds16(vsrc+(long)ch*KVBLK*DM,(unsigned)__builtin_amdgcn_readfirstlane(vdst+s*SLOTB)); } }
  bf16x8 qr[4];
  #pragma unroll
  for(int d0=0;d0<4;++d0)qr[d0]=*reinterpret_cast<const bf16x8*>(&Qw[(long)r32*DM+d0*16+hi*8]);
  WAIT_BAR(0);
  const int wc=wid>>1, qrel=(wid&1)*32+r32;
  f32x16 zero=f32x16{}; asm volatile("":"+v"(zero));
  f32x16 S[3][2];
  #pragma unroll
  for(int t=0;t<3;++t){
    if(c0+wc+t>=0){
      qkt(S[t][0],S[t][1],shm+SWA_K+(wc+t)*SLOTB,qr,zero,r32,hi);
      const float qf=(float)(64*(2-t)+qrel-4*hi);
      #pragma unroll
      for(int r=0;r<16;++r){ const float dd=qf-(float)((r&3)+8*(r>>2)); S[t][0][r]=__builtin_fmaf(-slope2,__builtin_fabsf(dd),S[t][0][r]); S[t][1][r]=__builtin_fmaf(-slope2,__builtin_fabsf(dd-32.f),S[t][1][r]); }
    } else {
      #pragma unroll
      for(int r=0;r<16;++r){ S[t][0][r]=-INFINITY; S[t][1][r]=-INFINITY; }
    }
  }
  float m=sink2;
  #pragma unroll
  for(int t=0;t<3;++t) m=__builtin_fmaxf(m,rowmax(S[t][0],S[t][1]));
  float l=0.f;
  #pragma unroll
  for(int t=0;t<3;++t){
    #pragma unroll
    for(int r=0;r<16;++r){ S[t][0][r]=__builtin_amdgcn_exp2f(S[t][0][r]-m); S[t][1][r]=__builtin_amdgcn_exp2f(S[t][1][r]-m); l+=S[t][0][r]+S[t][1][r]; }
  }
  {auto rr=__builtin_amdgcn_permlane32_swap(__float_as_uint(l),__float_as_uint(l),false,false);l=__uint_as_float(rr[0])+__uint_as_float(rr[1]);}
  l+=__builtin_amdgcn_exp2f(sink2-m);
  f32x16 o[2];o[0]=f32x16{};o[1]=f32x16{};
  const int vb0=(int)(lds0+SWA_V)+((lane>>4)&1)*32+(lane&3)*8+(4*hi+((lane&15)>>2))*64;
  #pragma unroll
  for(int t=0;t<3;++t){
    if(c0+wc+t>=0){
      #define PKW(P,B) cvtpk_s(P[B],P[B+1])
      const u32x4 pw0=(u32x4){PKW(S[t][0],0),PKW(S[t][0],2),PKW(S[t][0],4),PKW(S[t][0],6)},pw1=(u32x4){PKW(S[t][0],8),PKW(S[t][0],10),PKW(S[t][0],12),PKW(S[t][0],14)};
      const u32x4 pw2=(u32x4){PKW(S[t][1],0),PKW(S[t][1],2),PKW(S[t][1],4),PKW(S[t][1],6)},pw3=(u32x4){PKW(S[t][1],8),PKW(S[t][1],10),PKW(S[t][1],12),PKW(S[t][1],14)};
      #undef PKW
      SBAR(); pv(o,vb0+(wc+t)*SLOTB,__builtin_bit_cast(bf16x8,pw0),__builtin_bit_cast(bf16x8,pw1),__builtin_bit_cast(bf16x8,pw2),__builtin_bit_cast(bf16x8,pw3));
    }
  }
  if(hi==0)wsf[32+r32]=l;asm volatile("s_waitcnt lgkmcnt(0)":::"memory");
  float rli[16];
  #pragma unroll
  for(int r=0;r<16;++r)rli[r]=__builtin_amdgcn_rcpf(wsf[32+crow(r,hi)]);
  bf16*Ow=Oh+(long)(q0+wid*QBLK)*DM;
  { bf16*stg=(bf16*)(shm+SWA_OST)+wid*2048;
    #pragma unroll
    for(int r=0;r<16;++r){const int orow=crow(r,hi);
      #pragma unroll
      for(int d0=0;d0<2;++d0)stg[orow*64+d0*32+r32]=__float2bfloat16(o[d0][r]*rli[r]);}
    asm volatile("s_waitcnt lgkmcnt(0)":::"memory");
    #pragma unroll
    for(int i=0;i<4;++i){const int row=i*8+(lane>>3),ch=lane&7; const u32x4 v=*(const u32x4*)(stg+row*64+ch*8); ATTN_STORE16(Ow+(long)row*DM+ch*8,v);} }
  asm volatile("s_waitcnt lgkmcnt(0)\n\ts_barrier":::"memory");
}

#undef SBAR
#undef WAIT_BAR
}

namespace cg = cooperative_groups;
constexpr int NWAVES = 8;
constexpr int BATCH = 2, T = 8192, D = 1024, FF = 4096, PLE = 256, DIN_SRC = 4360, NZ = 4352, M = BATCH * T;
constexpr float RMS_EPS = 1e-6f, LOG2E = 1.4426950408889634f;
constexpr size_t MiB = 1u << 20;
constexpr size_t WS_WIN = 0, WS_WA = 9 * MiB, WS_WB = 10 * MiB, WS_WMIX = 11 * MiB, WS_W1 = 13 * MiB, WS_W2 = 21 * MiB, WS_WG = 29 * MiB, WS_WP = 31 * MiB;
constexpr size_t WS_LF = 31 * MiB + 512 * 1024, WS_CB = 32 * MiB;
constexpr size_t WS_NM = 32 * MiB + 512 * 1024;
constexpr size_t WS_ST1 = 33 * MiB, WS_ST2 = 34 * MiB, WS_ST3 = 35 * MiB;
constexpr size_t WS_PB = 36 * MiB;
constexpr size_t WS_XN = 44 * MiB;
constexpr size_t WS_HN = 76 * MiB;
constexpr size_t WS_Z = 108 * MiB;
constexpr size_t WS_CTL = 244 * MiB, CTL_ZERO_BYTES = 16384;
constexpr size_t WS_END = 245 * MiB;
constexpr int RING_BYTES = 131072, LDS_BYTES = 147456, MISC_OFF = RING_BYTES + 320;
#define GAS __attribute__((address_space(1)))
#define LAS __attribute__((address_space(3)))
typedef unsigned short bf16;
typedef unsigned v4u __attribute__((ext_vector_type(4)));
typedef unsigned v2u __attribute__((ext_vector_type(2)));
typedef float f32x4 __attribute__((ext_vector_type(4)));
#define LDS_WAIT() asm volatile("s_waitcnt lgkmcnt(0)" ::: "memory")
__device__ __forceinline__ unsigned f2bf(float f) { unsigned u = __builtin_bit_cast(unsigned, f); return (u + 0x7fffu + ((u >> 16) & 1u)) >> 16; }
__device__ __forceinline__ unsigned pk2(float lo, float hi) { return f2bf(lo) | (f2bf(hi) << 16); }
__device__ __forceinline__ float wave_sum(float v) {
#pragma unroll
    for (int o = 1; o < 64; o <<= 1) v += __shfl_xor(v, o);
    return v;
}
#define RLX_AGENT __ATOMIC_RELAXED, __HIP_MEMORY_SCOPE_AGENT
#define XB_TMO      128
#define XB_XCNT(j)  (256  + 64 * (j))
#define XB_XSUB(j)  (1280 + 64 * (j))
#define XB_XGEN(j)  (2304 + 64 * (j))
#define XB_TOP      3328
#define XB_TOPGEN   3392
#define XCD_BAR_WORDS 3456
#define XB_SPIN_CAP (1u << 18)

__device__ __forceinline__ unsigned xb_ld(unsigned* p)              { return __hip_atomic_load(p, __ATOMIC_RELAXED, __HIP_MEMORY_SCOPE_AGENT); }
__device__ __forceinline__ unsigned xb_add(unsigned* p, unsigned v) { return __hip_atomic_fetch_add(p, v, __ATOMIC_RELAXED, __HIP_MEMORY_SCOPE_AGENT); }
__device__ __forceinline__ unsigned xb_xcc_id() { return (unsigned)__builtin_amdgcn_s_getreg((3 << 11) | 20) & 0xFu; }
#define XB_SPIN(cond, bar) do { unsigned _sp = 0; while (cond) { __builtin_amdgcn_s_sleep(1); \
    if ((++_sp & 255u) == 0u) { if (xb_ld(&(bar)[XB_TMO])) break; if (_sp > XB_SPIN_CAP) { atomicAdd(&(bar)[XB_TMO], 1u); break; } } } } while (0)

struct XcdBarrier {
    unsigned* bar; unsigned x;
    volatile LAS unsigned* st;
};

__device__ __forceinline__ XcdBarrier xcd_barrier_post(unsigned* bar, volatile LAS unsigned* st) {
    XcdBarrier b; b.bar = bar; b.x = xb_xcc_id(); b.st = st;
    if (threadIdx.x == 0) (void)xb_add(&bar[XB_XCNT(b.x)], 1u);
    return b;
}
__device__ __forceinline__ void xcd_barrier_complete(unsigned* bar, unsigned x, unsigned& nloc, unsigned& nx) {
    const unsigned G = gridDim.x * gridDim.y * gridDim.z;
    unsigned sum, cnt, mine, sp = 0u;
    for (;;) {
        sum = 0u; cnt = 0u; mine = 0u;
#pragma unroll
        for (unsigned j = 0; j < 16; ++j) { const unsigned c = xb_ld(&bar[XB_XCNT(j)]); sum += c; cnt += (c > 0u) ? 1u : 0u; mine = (j == x) ? c : mine; }
        if (sum == G) break;
        __builtin_amdgcn_s_sleep(1);
        if ((++sp & 255u) == 0u) { if (xb_ld(&bar[XB_TMO])) break; if (sp > XB_SPIN_CAP) { atomicAdd(&bar[XB_TMO], 1u); break; } }
    }
    nloc = mine > 0u ? mine : 1u; nx = cnt > 0u ? cnt : 1u;
}

__device__ __forceinline__ void xcd_barrier(const XcdBarrier& b, const bool t0) {
    asm volatile("s_waitcnt vmcnt(0)" ::: "memory");
    __syncthreads();
    if (t0) {
        unsigned* bar = b.bar;
        __builtin_amdgcn_s_waitcnt(0);
        unsigned nloc = b.st[0], nx = b.st[1];
        if (nloc == 0u) { xcd_barrier_complete(bar, b.x, nloc, nx); b.st[0] = nloc; b.st[1] = nx; }
        const unsigned old = xb_add(&bar[XB_XSUB(b.x)], 1u);
        const unsigned gen = old / nloc;
        if (old + 1u == (gen + 1u) * nloc) {
            __builtin_amdgcn_fence(__ATOMIC_RELEASE, "agent");
            asm volatile("s_waitcnt vmcnt(0)" ::: "memory");
            const unsigned og = xb_add(&bar[XB_TOP], 1u);
            const unsigned tg = og / nx;
            if (og + 1u == (tg + 1u) * nx) xb_add(&bar[XB_TOPGEN], 1u);
            else XB_SPIN(xb_ld(&bar[XB_TOPGEN]) == tg, bar);
            __builtin_amdgcn_fence(__ATOMIC_ACQUIRE, "agent");
            xb_add(&bar[XB_XGEN(b.x)], 1u);
            asm volatile("s_waitcnt vmcnt(0)" ::: "memory");
        } else {
            XB_SPIN(xb_ld(&bar[XB_XGEN(b.x)]) == gen, bar);
            __builtin_amdgcn_fence(__ATOMIC_ACQUIRE, "agent");
            asm volatile("s_waitcnt vmcnt(0)" ::: "memory");
        }
    }
    __syncthreads();
}
struct Frame {
    LAS unsigned char* lds; int wave, vcu, G;
};
__device__ __forceinline__ void p0_transpose_item(const float* W, int ldw, int K, int N, int split, int extra, const float* gs, bf16* WT, LAS float* scr, int item, int lane) {
    const int nblk = N / 32, kb = item / nblk, nb = item % nblk, k0 = 64 * kb, n0 = 32 * nb, s0 = n0 + (n0 >= split ? extra : 0);
    const float* src = W + (size_t)(k0 + (lane >> 5)) * ldw + s0 + (lane & 31);
    float w[32];
#pragma unroll
    for (int i = 0; i < 32; ++i) w[i] = src[(size_t)(2 * i) * ldw];
    const int c = lane & 7;
    f32x4 g0 = (f32x4){1.f, 1.f, 1.f, 1.f}, g1 = g0;
    if (gs) { g0 = *(const f32x4*)(gs + k0 + 8 * c); g1 = *(const f32x4*)(gs + k0 + 8 * c + 4); }
#pragma unroll
    for (int i = 0; i < 32; ++i) scr[(2 * i + (lane >> 5)) * 33 + (lane & 31)] = w[i];
    LDS_WAIT(); asm volatile("" ::: "memory");
#pragma unroll
    for (int j = 0; j < 4; ++j) { const int n = (lane >> 3) + 8 * j; const LAS float* s = scr + (8 * c) * 33 + n;
        v4u o; o.x = pk2(s[0 * 33] * g0.x, s[1 * 33] * g0.y); o.y = pk2(s[2 * 33] * g0.z, s[3 * 33] * g0.w); o.z = pk2(s[4 * 33] * g1.x, s[5 * 33] * g1.y); o.w = pk2(s[6 * 33] * g1.z, s[7 * 33] * g1.w);
        *(GAS v4u*)(WT + (size_t)(n0 + n) * K + k0 + 8 * c) = o; }
    LDS_WAIT(); asm volatile("" ::: "memory");
}
struct Args { const float* in[16]; float* out; unsigned char* ws; };
constexpr int WF_OFF = 8 * 8704;

__global__ void __launch_bounds__(NWAVES * 64, 2) mk_fwd(Args args) {
    extern __shared__ __attribute__((aligned(16))) unsigned char lds[];
    cg::grid_group grid = cg::this_grid();
    Frame F;
    F.lds = (LAS unsigned char*)lds;
    F.wave = __builtin_amdgcn_readfirstlane((int)threadIdx.x >> 6);
    F.G = gridDim.x; { const int bx = blockIdx.x; F.vcu = (F.G % 8 == 0) ? (bx % 8) * (F.G / 8) + bx / 8 : bx; }
    unsigned char* ws = args.ws;
    const float* x = args.in[0]; const float* p_in = args.in[1]; const float* g_mix = args.in[2]; const float* w_in = args.in[3]; const float* b_forget = args.in[4];
    const float* sinks = args.in[5]; const float* w_br_swa = args.in[6]; const float* w_br_fox = args.in[7]; const float* w_mix = args.in[8]; const float* g_mlp = args.in[9];
    const float* w_ff1 = args.in[10]; const float* w_ff2 = args.in[11]; const float* g_ple = args.in[12]; const float* w_pg = args.in[13]; const float* w_pp = args.in[14]; const float* g_final = args.in[15];
    float* out = args.out;
    bf16 *WIN_t = (bf16*)(ws + WS_WIN), *WA_t = (bf16*)(ws + WS_WA), *WB_t = (bf16*)(ws + WS_WB), *WMIX_t = (bf16*)(ws + WS_WMIX), *W1_t = (bf16*)(ws + WS_W1), *W2_t = (bf16*)(ws + WS_W2), *WG_t = (bf16*)(ws + WS_WG), *WP_t = (bf16*)(ws + WS_WP);
    float *LF = (float*)(ws + WS_LF), *CB = (float*)(ws + WS_CB), *ST1 = (float*)(ws + WS_ST1), *ST2 = (float*)(ws + WS_ST2), *ST3 = (float*)(ws + WS_ST3);
    bf16 *PB = (bf16*)(ws + WS_PB), *XN = (bf16*)(ws + WS_XN), *HN = (bf16*)(ws + WS_HN), *Z = (bf16*)(ws + WS_Z), *HB = (bf16*)(ws + WS_Z); bf16* PP = (bf16*)(ws + WS_Z);
    unsigned* NM = (unsigned*)(ws + WS_NM);
    const int gw = F.vcu * NWAVES + F.wave, NGW = F.G * NWAVES;

    for (int u = threadIdx.x; u < 128; u += NWAVES * 64) ((LAS unsigned*)(F.lds + RING_BYTES))[u] = 0u;
    __syncthreads();
    XcdBarrier bar = xcd_barrier_post((unsigned*)(ws + WS_CTL), (volatile LAS unsigned*)(F.lds + MISC_OFF) + 8);
#define GRID_BAR() do { const int l_ = fresh_lane(); xcd_barrier(bar, (F.wave == 0) && (l_ == 0)); } while (0)
    {
        const int p0_tid = threadIdx.x, p0_lane = p0_tid & 63;
        for (int i = blockIdx.x * (NWAVES * 64) + p0_tid; i < 1024 + 32; i += F.G * NWAVES * 64) NM[i] = 0u;
        LAS float* wfT = (LAS float*)(F.lds + WF_OFF);
        for (int i = p0_tid; i < 8 * D; i += NWAVES * 64) { const int k = i >> 3, h = i & 7; wfT[h * 1024 + k] = g_mix[k] * w_in[(size_t)k * DIN_SRC + 2304 + h]; }
        __syncthreads();
        f32x4 gm4[4];
#pragma unroll
        for (int j = 0; j < 4; ++j) gm4[j] = ((const GAS f32x4*)g_mix)[64 * j + p0_lane];
        const float bfg = b_forget[p0_lane & 7];
        f32x4 v[4];
        if (gw < M) { const GAS f32x4* xr = (const GAS f32x4*)(x + (size_t)gw * D) + p0_lane;
#pragma unroll
            for (int j = 0; j < 4; ++j) v[j] = xr[64 * j]; }
        for (int m = gw; m < M; m += NGW) {
            f32x4 vn[4]; const int mn = (m + NGW < M) ? m + NGW : m;
            { const GAS f32x4* xr = (const GAS f32x4*)(x + (size_t)mn * D) + p0_lane;
#pragma unroll
              for (int j = 0; j < 4; ++j) vn[j] = xr[64 * j]; }
            float ss = 0.f;
#pragma unroll
            for (int j = 0; j < 4; ++j) ss += (v[j].x * v[j].x + v[j].y * v[j].y) + (v[j].z * v[j].z + v[j].w * v[j].w);
            float a8[8];
#pragma unroll
            for (int h = 0; h < 8; ++h) { float a = 0.f;
#pragma unroll
                for (int j = 0; j < 4; ++j) { const f32x4 w = ((const LAS f32x4*)wfT)[h * 256 + 64 * j + p0_lane]; a += (v[j].x * w.x + v[j].y * w.y) + (v[j].z * w.z + v[j].w * w.w); }
                a8[h] = a; }
#pragma unroll
            for (int o = 1; o < 64; o <<= 1) { ss += __shfl_xor(ss, o);
#pragma unroll
                for (int h = 0; h < 8; ++h) a8[h] += __shfl_xor(a8[h], o); }
            const float rstd = 1.f / sqrtf(ss * (1.f / D) + RMS_EPS);
            float fsel = a8[0];
#pragma unroll
            for (int h = 1; h < 8; ++h) fsel = (p0_lane == h) ? a8[h] : fsel;
            if (p0_lane < 8) { const float xf = fsel * rstd + bfg; const float ls = fminf(xf, 0.f) - log1pf(expf(-fabsf(xf)));
                LF[(size_t)((m >> 13) * 8 + p0_lane) * T + (m & (T - 1))] = ls; }
            GAS unsigned long long* o8 = (GAS unsigned long long*)(XN + (size_t)m * D) + p0_lane;
#pragma unroll
            for (int j = 0; j < 4; ++j) { const f32x4 y = v[j] * rstd * gm4[j];
                o8[64 * j] = (unsigned long long)pk2(y.x, y.y) | ((unsigned long long)pk2(y.z, y.w) << 32); }
#pragma unroll
            for (int j = 0; j < 4; ++j) v[j] = vn[j];
        }
        for (int i = gw * 64 + p0_lane; i < M * PLE / 32; i += NGW * 64) { f32x4 a[8];
#pragma unroll
            for (int q = 0; q < 4; ++q) { a[2 * q] = ((const GAS f32x4*)p_in)[2 * (i + q * (M * PLE / 32))]; a[2 * q + 1] = ((const GAS f32x4*)p_in)[2 * (i + q * (M * PLE / 32)) + 1]; }
#pragma unroll
            for (int q = 0; q < 4; ++q) { v4u o; o.x = pk2(a[2 * q].x, a[2 * q].y); o.y = pk2(a[2 * q].z, a[2 * q].w); o.z = pk2(a[2 * q + 1].x, a[2 * q + 1].y); o.w = pk2(a[2 * q + 1].z, a[2 * q + 1].w); ((GAS v4u*)PB)[i + q * (M * PLE / 32)] = o; } }
        LAS float* scr = (LAS float*)(F.lds + F.wave * 8704);
        constexpr int I_IN = (D / 64) * (NZ / 32);
        for (int it = gw; it < I_IN; it += NGW) p0_transpose_item(w_in, DIN_SRC, D, NZ, 2304, 8, nullptr, WIN_t, scr, it, p0_lane);
    }
    grid.sync();

    for (int bh = blockIdx.x; bh < 16; bh += gridDim.x) {
        const int c_lane = fresh_lane(), c_tid = F.wave * 64 + c_lane;
        const GAS f32x4* src = (const GAS f32x4*)(LF + (size_t)bh * T) + c_tid * 4;
        f32x4 v[4]; float run = 0.f;
#pragma unroll
        for (int j = 0; j < 4; ++j) { v[j] = src[j];
#pragma unroll
            for (int e = 0; e < 4; ++e) { run += v[j][e]; v[j][e] = run; } }
        float sc = run;
#pragma unroll
        for (int o = 1; o < 64; o <<= 1) { const float n = __shfl_up(sc, o); if (c_lane >= o) sc += n; }
        LAS float* wt = (LAS float*)F.lds;
        if (c_lane == 63) wt[F.wave] = sc;
        __syncthreads();
        float woff = 0.f;
        for (int w = 0; w < F.wave; ++w) woff += wt[w];
        const float off = woff + sc - run;
        GAS f32x4* dst = (GAS f32x4*)(CB + (size_t)bh * T) + c_tid * 4;
#pragma unroll
        for (int j = 0; j < 4; ++j) dst[j] = (v[j] + off) * (-LOG2E);
        __syncthreads();
    }
    {
        pg8::Gemm g{XN, WIN_t, M, NZ, D, D}; pg8::StaticOrder S; S.init(M, NZ, F.G, (int)blockIdx.x);
        pg8::EpiZ E{Z, NM, 0};
        pg8::gemm_phase<pg8::EpiZ, pg8::StaticOrder, PG8_ALIGN, PG8_SP2>(F.lds, g, S, E, F.wave);
    }
    {
        const int nfive = (M / 256) * (NZ / 256) - 4 * F.G;
        const int nconv = (nfive > 0 && nfive < F.G) ? F.G - nfive : F.G, cidx = (nfive > 0 && nfive < F.G) ? (int)blockIdx.x - nfive : (int)blockIdx.x;
        if (cidx >= 0) {
            const int w_lane = fresh_lane();
            LAS float* scr = (LAS float*)(F.lds + F.wave * 8704);
            constexpr int I_A = (512 / 64) * (D / 32), I_MIX = (D / 64) * (D / 32), I_1 = (D / 64) * (FF / 32), I_2 = (FF / 64) * (D / 32), I_P = (PLE / 64) * (D / 32);
            constexpr int NITEMS = 2 * I_A + I_MIX + I_1 + I_2 + I_MIX + I_P;
            for (int it = cidx * NWAVES + F.wave; it < NITEMS; it += nconv * NWAVES) {
                int r = it;
                if (r < I_A) { p0_transpose_item(w_br_swa, D, 512, D, 1 << 30, 0, nullptr, WA_t, scr, r, w_lane); continue; } r -= I_A;
                if (r < I_A) { p0_transpose_item(w_br_fox, D, 512, D, 1 << 30, 0, nullptr, WB_t, scr, r, w_lane); continue; } r -= I_A;
                if (r < I_MIX) { p0_transpose_item(w_mix, D, D, D, 1 << 30, 0, nullptr, WMIX_t, scr, r, w_lane); continue; } r -= I_MIX;
                if (r < I_1) { p0_transpose_item(w_ff1, FF, D, FF, 1 << 30, 0, g_mlp, W1_t, scr, r, w_lane); continue; } r -= I_1;
                if (r < I_2) { p0_transpose_item(w_ff2, D, FF, D, 1 << 30, 0, nullptr, W2_t, scr, r, w_lane); continue; } r -= I_2;
                if (r < I_MIX) { p0_transpose_item(w_pg, D, D, D, 1 << 30, 0, g_ple, WG_t, scr, r, w_lane); continue; } r -= I_MIX;
                p0_transpose_item(w_pp, D, PLE, D, 1 << 30, 0, nullptr, WP_t, scr, r, w_lane);
            }
        }
    }
    GRID_BAR();

    {
        unsigned* qctr = (unsigned*)(ws + WS_CTL) + 3584;
        volatile LAS unsigned* qslot = (volatile LAS unsigned*)(F.lds + RING_BYTES + 16);
        for (;;) {
            { const int l_ = fresh_lane(); if (F.wave == 0 && l_ == 0) qslot[0] = __hip_atomic_fetch_add(qctr, 1u, __ATOMIC_RELAXED, __HIP_MEMORY_SCOPE_AGENT); }
            __syncthreads();
            const int idx = __builtin_amdgcn_readfirstlane((int)qslot[0]);
            __syncthreads();
            if (idx >= 64 + 512 + 512) break;
            if (idx < 64) {
                continue;
            } else if (idx < 64 + 512) {
                const int j = idx - 64, qb = 31 - (j >> 4), bh = j & 15, b = bh >> 3, h = bh & 7;
                const attn_body::bf16* Zb = (const attn_body::bf16*)Z + (size_t)b * T * NZ;
                const attn_body::bf16* Qh = Zb + 768 + h * 64; const attn_body::bf16* Kh = Zb + 1280 + h * 64; const attn_body::bf16* Vh = Zb + 1792 + h * 64;
                const float* cb = CB + (size_t)bh * T;
                const float km = sqrtf(__uint_as_float(NM[1024 + bh * 2]) + __uint_as_float(NM[1024 + bh * 2 + 1]));
                const int pmA = b * 32 + qb;
                const float qkA = 2.04f * km * sqrtf(__uint_as_float(NM[(pmA * 8 + h) * 2]) + __uint_as_float(NM[(pmA * 8 + h) * 2 + 1]));
                attn_body::attn_unit<24>(F.wave, qb, Qh, Kh, Vh, (attn_body::bf16*)Qh, cb, qkA, (char*)lds);
            } else {
                const int j = idx - 64 - 512, bh = j >> 5, qb = j & 31, b = bh >> 3, h = bh & 7;
                const attn_body::bf16* Zb = (const attn_body::bf16*)Z + (size_t)b * T * NZ;
                const attn_body::bf16* Qh = Zb + h * 64; const attn_body::bf16* Kh = Zb + 512 + (h >> 2) * 64; const attn_body::bf16* Vh = Zb + 640 + (h >> 2) * 64;
                const float slope2 = exp2f(-(float)(h + 1)) * LOG2E, sink2 = sinks[h] * LOG2E;
                attn_body::swa_unit(F.wave, qb, Qh, Kh, Vh, (attn_body::bf16*)Qh, slope2, sink2, (char*)lds);
            }
        }
    }
    GRID_BAR();

    {
        pg8::StaticOrder S; S.init(M, D, F.G, (int)blockIdx.x);
        { pg8::Gemm g{Z, WA_t, M, D, 512, NZ}; pg8::EpiT1 E{Z + 2304, (bf16*)out}; pg8::gemm_phase<pg8::EpiT1, pg8::StaticOrder, PG8_ALIGN, PG8_SP2>(F.lds, g, S, E, F.wave); }
        { pg8::Gemm g{Z + 768, WB_t, M, D, 512, NZ}; pg8::EpiMix E{Z + 3328, (const bf16*)out, XN}; pg8::gemm_phase<pg8::EpiMix, pg8::StaticOrder, PG8_ALIGN, PG8_SP2>(F.lds, g, S, E, F.wave); }
    }
    GRID_BAR();

    {
        pg8::Gemm g{XN, WMIX_t, M, D, D, D}; pg8::StaticOrder S; S.init(M, D, F.G, (int)blockIdx.x);
        pg8::EpiRes<false> E{x, HN, ST1};
        pg8::gemm_phase<pg8::EpiRes<false>, pg8::StaticOrder, PG8_ALIGN, PG8_SP2>(F.lds, g, S, E, F.wave);
    }
    GRID_BAR();

    {
        pg8::Gemm g{HN, W1_t, M, FF, D, D}; pg8::StaticOrder S; S.init(M, FF, F.G, (int)blockIdx.x);
        pg8::EpiRelu2 E{ST1, HB};
        pg8::gemm_phase<pg8::EpiRelu2, pg8::StaticOrder, PG8_ALIGN, PG8_SP2>(F.lds, g, S, E, F.wave);
    }
    GRID_BAR();

    {
        pg8::Gemm g{HB, W2_t, M, D, FF, FF}; pg8::StaticOrder S; S.init(M, D, F.G, (int)blockIdx.x);
        pg8::EpiRes<true> E{HN, XN, ST2};
        pg8::gemm_phase<pg8::EpiRes<true>, pg8::StaticOrder, PG8_ALIGN, PG8_SP2>(F.lds, g, S, E, F.wave);
    }
    GRID_BAR();

    {
        pg8::StaticOrder S; S.init(M, D, F.G, (int)blockIdx.x);
        { pg8::Gemm g{PB, WP_t, M, D, PLE, PLE}; pg8::EpiPP E{PP}; pg8::gemm_phase<pg8::EpiPP, pg8::StaticOrder, PG8_ALIGN, PG8_SP2>(F.lds, g, S, E, F.wave); }
        { pg8::Gemm g{XN, WG_t, M, D, D, D}; pg8::EpiPle E{ST2, PP, XN, HN, ST3}; pg8::gemm_phase<pg8::EpiPle, pg8::StaticOrder, PG8_ALIGN, PG8_SP2>(F.lds, g, S, E, F.wave); }
    }
    GRID_BAR();

    const int f_lane = fresh_lane();
    for (int m = gw; m < M; m += NGW) {
        float t = (f_lane < 16) ? ST3[(size_t)m * 16 + f_lane] : 0.f;
        const float rstd = 1.f / sqrtf(wave_sum(t) * (1.f / D) + RMS_EPS);
        const GAS v2u* hr = (const GAS v2u*)(HN + (size_t)m * D) + f_lane;
        GAS f32x4* xr = (GAS f32x4*)(out + (size_t)m * D) + f_lane;
#pragma unroll
        for (int j = 0; j < 4; ++j) { const v2u hv = hr[64 * j]; const f32x4 gm = ((const GAS f32x4*)g_final)[64 * j + f_lane];
            const f32x4 hf = (f32x4){__uint_as_float(hv.x << 16), __uint_as_float(hv.x & 0xffff0000u), __uint_as_float(hv.y << 16), __uint_as_float(hv.y & 0xffff0000u)};
            xr[64 * j] = hf * rstd * gm; }
    }
}

extern "C" void kernel_launch(void* const* d_in, const int* in_sizes, int n_in, void* d_out, int out_size, void* d_ws, size_t ws_size, hipStream_t stream) {
    static int grid = 0;
    if (grid == 0) {
        if (n_in != 16 || in_sizes[0] != M * D || out_size != M * D || ws_size < WS_END) { fprintf(stderr, "kernel_launch: unexpected shapes (n_in %d, in0 %d, out %d, ws %zu); nothing launched\n", n_in, n_in > 0 ? in_sizes[0] : -1, out_size, ws_size); grid = -1; return; }
        int dev = 0, cus = 0, per_cu = 0;
        if (hipGetDevice(&dev) != hipSuccess || hipDeviceGetAttribute(&cus, hipDeviceAttributeMultiprocessorCount, dev) != hipSuccess) { grid = -1; return; }
        if (hipFuncSetAttribute((const void*)mk_fwd, hipFuncAttributeMaxDynamicSharedMemorySize, LDS_BYTES) != hipSuccess) { fprintf(stderr, "kernel_launch: hipFuncSetAttribute failed\n"); grid = -1; return; }
        if (hipOccupancyMaxActiveBlocksPerMultiprocessor(&per_cu, (const void*)mk_fwd, NWAVES * 64, LDS_BYTES) != hipSuccess || per_cu < 1) { fprintf(stderr, "kernel_launch: occupancy query failed (%d)\n", per_cu); (void)hipGetLastError(); per_cu = 1; }
        if (per_cu > 1) per_cu = 1;
        grid = cus * per_cu;
    }
    if (grid < 0) return;
    if (hipMemsetAsync((char*)d_ws + WS_CTL, 0, CTL_ZERO_BYTES, stream) != hipSuccess) { fprintf(stderr, "kernel_launch: memset failed\n"); return; }
    Args a{};
    for (int i = 0; i < 16; ++i) a.in[i] = (const float*)d_in[i];
    a.out = (float*)d_out; a.ws = (unsigned char*)d_ws;
    void* kargs[] = {&a};
    hipError_t e = hipLaunchCooperativeKernel((const void*)mk_fwd, dim3(grid), dim3(NWAVES * 64), kargs, LDS_BYTES, stream);
    if (e != hipSuccess) fprintf(stderr, "kernel_launch: cooperative launch failed: %s (grid %d)\n", hipGetErrorString(e), grid);
}
```

```cpp
#include <hip/hip_runtime.h>
#include <hip/hip_cooperative_groups.h>
#include <cstdio>
#include <cstdint>
__device__ __forceinline__ int fresh_lane() { int l; asm volatile("v_mbcnt_lo_u32_b32 %0, -1, 0\n\tv_mbcnt_hi_u32_b32 %0, -1, %0" : "=v"(l)); return l; }

namespace pg8 {

#define PG8_LAS __attribute__((address_space(3)))
typedef unsigned short bf16_t;
typedef short bf16x8 __attribute__((ext_vector_type(8)));
typedef float f32x4 __attribute__((ext_vector_type(4)));
typedef unsigned u32x4 __attribute__((ext_vector_type(4)));
constexpr int BM = 256, BK = 64, HALF = 128, HTB = HALF * BK * 2  , STAGE_BYTES = 8 * HTB, NXCD = 8, WGM = 8;

__host__ __device__ __forceinline__ int lds_byte(int r, int c) { const int st = (r >> 4) * 2 + (c >> 5), rr = r & 15, cc = c & 31, ob = rr * 64 + cc * 2; return st * 1024 + (ob ^ (((ob >> 9) & 1) << 5)); }
__host__ __device__ __forceinline__ void stage_rc(int b, int& R, int& C) { const int st = b / 1024, sb = b % 1024, swz = sb ^ (((sb >> 9) & 1) << 5); R = (st >> 1) * 16 + swz / 64; C = (st & 1) * 32 + (swz % 64) / 2; }
__host__ __device__ __forceinline__ int perm32(int rho) { const int n = rho >> 4, i = rho & 15; return 8 * (i >> 2) + 4 * n + (i & 3); }

struct Unit { int pm, pn, part; };
struct Gemm { const bf16_t* A; const bf16_t* Bt; int M, N, K, lda; };

struct StaticOrder {
    int nM, nN, nwg, G, c;
    __host__ __device__ void init(int M, int N, int G_, int c_) { nM = M / BM; nN = N / BM; nwg = nM * nN; G = G_; c = c_; }
    __host__ __device__ bool next(int i, Unit& u) const {
        const long L = (long)i * G + c; if (L >= nwg) return false;
        int wgid = (int)L; { const int q = nwg / NXCD, r = nwg % NXCD, xcd = wgid % NXCD, off = wgid / NXCD; wgid = (xcd < r ? xcd * (q + 1) : r * (q + 1) + (xcd - r) * q) + off; }
        const int nig = WGM * nN, gid = wgid / nig, fm = gid * WGM, gsz = (nM - fm) < WGM ? (nM - fm) : WGM;
        u.pm = fm + ((wgid % nig) % gsz); u.pn = (wgid % nig) / gsz; return true;
    }
    __device__ __forceinline__ void a_ready(const Unit&) const {}
    __device__ __forceinline__ void done(const Unit&) const {}
};

__device__ __forceinline__ unsigned cvt_pk_bf16(float lo, float hi) { unsigned r; asm volatile("v_cvt_pk_bf16_f32 %0, %1, %2" : "=v"(r) : "v"(lo), "v"(hi)); return r; }
typedef float f32x2 __attribute__((ext_vector_type(2)));
struct OneUnit { int pm, pn; __device__ bool next(int i, Unit& u) const { if (i) return false; u.pm = pm; u.pn = pn; return true; } __device__ __forceinline__ void a_ready(const Unit&) const {} __device__ __forceinline__ void done(const Unit&) const {} };
constexpr int ZP = 4352;
constexpr float C2F = 0.125f * 1.4426950408889634f;
__device__ __forceinline__ float sigmoidf_fast(float x) { return __builtin_amdgcn_rcpf(1.0f + __builtin_amdgcn_exp2f(-1.4426950408889634f * x)); }
__device__ __forceinline__ f32x4 bf4_lo(unsigned a, unsigned b) { return (f32x4){__uint_as_float(a << 16), __uint_as_float(a & 0xffff0000u), __uint_as_float(b << 16), __uint_as_float(b & 0xffff0000u)}; }
__device__ __forceinline__ u32x4 pack8(f32x4 v0, f32x4 v1) { u32x4 w; w.x = cvt_pk_bf16(v0[0], v0[1]); w.y = cvt_pk_bf16(v0[2], v0[3]); w.z = cvt_pk_bf16(v1[0], v1[1]); w.w = cvt_pk_bf16(v1[2], v1[3]); return w; }
__device__ __forceinline__ float rstd_from_stats(const float* st, int row) { const f32x4* s = (const f32x4*)(st + (size_t)row * 16); const f32x4 a = s[0], b = s[1], c = s[2], d = s[3];
    const float t = ((a[0] + a[1]) + (a[2] + a[3])) + ((b[0] + b[1]) + (b[2] + b[3])) + ((c[0] + c[1]) + (c[2] + c[3])) + ((d[0] + d[1]) + (d[2] + d[3])); return 1.0f / sqrtf(t * (1.0f / 1024.0f) + 1e-6f); }
#define EPI_ROWS(...) _Pragma("unroll") for (int ai = 0; ai < 2; ++ai) _Pragma("unroll") for (int m = 0; m < 4; ++m) { const int row = u.pm * BM + ai * HALF + wr * 64 + m * 16 + fr; __VA_ARGS__ asm volatile("" ::: "memory"); }
#define EPI_COLS(...) _Pragma("unroll") for (int bj = 0; bj < 2; ++bj) { const int col = u.pn * BM + bj * HALF + wc * 32 + 8 * fq; const f32x4 a0 = acc[ai][bj][m][0], a1 = acc[ai][bj][m][1]; __VA_ARGS__ }
struct EpiZ { static constexpr bool PERM = true, AFTER_DRAIN = false, PAIRED = false; bf16_t* Z; unsigned* NM; int pn_off;
    __device__ __forceinline__ void operator()(const f32x4 (&acc)[2][2][4][2], const Unit& u, int wr, int wc, int fr, int fq) const {
        const int pn = u.pn + pn_off; const int mode = (pn >= 9) ? 2 : ((pn == 0 || pn == 1 || pn == 3 || pn == 4) ? 1 : 0);
        const bool nrm = (pn >= 3 && pn <= 6); float mx0 = 0.f, mx1 = 0.f;
        EPI_ROWS( bf16_t* rowp = Z + (size_t)row * ZP; EPI_COLS( f32x4 v0 = a0, v1 = a1;
            if (mode == 1) { v0 = v0 * C2F; v1 = v1 * C2F; }
            else if (mode == 2) { _Pragma("unroll") for (int e = 0; e < 4; ++e) { v0[e] = sigmoidf_fast(v0[e]); v1[e] = sigmoidf_fast(v1[e]); } }
            if (nrm) { float ss = ((v0[0] * v0[0] + v0[1] * v0[1]) + (v0[2] * v0[2] + v0[3] * v0[3])) + ((v1[0] * v1[0] + v1[1] * v1[1]) + (v1[2] * v1[2] + v1[3] * v1[3]));
                ss += __shfl_xor(ss, 16); ss += __shfl_xor(ss, 32); if (bj == 0) mx0 = fmaxf(mx0, ss); else mx1 = fmaxf(mx1, ss); }
            *(u32x4*)(rowp + col + pn_off * BM) = pack8(v0, v1); ) )
        if (nrm) {
#pragma unroll
            for (int o = 1; o < 16; o <<= 1) { mx0 = fmaxf(mx0, __shfl_xor(mx0, o)); mx1 = fmaxf(mx1, __shfl_xor(mx1, o)); }
            if (fr == 0 && fq == 0) {
                const int isk = (pn >= 5), cr = (pn - (isk ? 5 : 3)) * 4 + (wc >> 1), half = wc & 1;
                unsigned* b0 = isk ? NM + 1024 + ((u.pm >> 5) * 8 + cr) * 2 + half : NM + (u.pm * 8 + cr) * 2 + half;
                atomicMax(b0, __float_as_uint(mx0 * 1.0001f)); atomicMax(b0 + 4, __float_as_uint(mx1 * 1.0001f));
            } }
    } };
#define EPI_GROUP(NR, ...) _Pragma("unroll") for (int ai = 0; ai < 2; ++ai) _Pragma("unroll") for (int mg = 0; mg < 4; mg += NR) { __VA_ARGS__ asm volatile("" ::: "memory"); }
#define EPI_ROWOF(mm) (u.pm * BM + ai * HALF + wr * 64 + (mm) * 16 + fr)
#define EPI_COLOF(bj) (u.pn * BM + (bj) * HALF + wc * 32 + 8 * fq)
struct EpiT1 { static constexpr bool PERM = true, AFTER_DRAIN = false, PAIRED = false; const bf16_t* G; bf16_t* T;
    __device__ __forceinline__ void operator()(const f32x4 (&acc)[2][2][4][2], const Unit& u, int wr, int wc, int fr, int fq) const {
        EPI_GROUP(4, u32x4 g[4][2];
            _Pragma("unroll") for (int i = 0; i < 4; ++i) _Pragma("unroll") for (int bj = 0; bj < 2; ++bj) g[i][bj] = *(const u32x4*)(G + (size_t)EPI_ROWOF(mg + i) * ZP + EPI_COLOF(bj));
            _Pragma("unroll") for (int i = 0; i < 4; ++i) _Pragma("unroll") for (int bj = 0; bj < 2; ++bj)
                *(u32x4*)(T + (size_t)EPI_ROWOF(mg + i) * 1024 + EPI_COLOF(bj)) = pack8(acc[ai][bj][mg + i][0] * bf4_lo(g[i][bj].x, g[i][bj].y), acc[ai][bj][mg + i][1] * bf4_lo(g[i][bj].z, g[i][bj].w)); )
    } };
struct EpiMix { static constexpr bool PERM = true, AFTER_DRAIN = false, PAIRED = false; const bf16_t* G; const bf16_t* T; bf16_t* O;
    __device__ __forceinline__ void operator()(const f32x4 (&acc)[2][2][4][2], const Unit& u, int wr, int wc, int fr, int fq) const {
        EPI_GROUP(4, u32x4 g[4][2]; u32x4 t[4][2];
            _Pragma("unroll") for (int i = 0; i < 4; ++i) _Pragma("unroll") for (int bj = 0; bj < 2; ++bj) { g[i][bj] = *(const u32x4*)(G + (size_t)EPI_ROWOF(mg + i) * ZP + EPI_COLOF(bj));
                t[i][bj] = *(const u32x4*)(T + (size_t)EPI_ROWOF(mg + i) * 1024 + EPI_COLOF(bj)); }
            _Pragma("unroll") for (int i = 0; i < 4; ++i) _Pragma("unroll") for (int bj = 0; bj < 2; ++bj) {
                const f32x4 v0 = bf4_lo(t[i][bj].x, t[i][bj].y) + acc[ai][bj][mg + i][0] * bf4_lo(g[i][bj].x, g[i][bj].y), v1 = bf4_lo(t[i][bj].z, t[i][bj].w) + acc[ai][bj][mg + i][1] * bf4_lo(g[i][bj].z, g[i][bj].w);
                *(u32x4*)(O + (size_t)EPI_ROWOF(mg + i) * 1024 + EPI_COLOF(bj)) = pack8(v0, v1); } )
    } };
template <bool BASE_BF16> struct EpiRes { static constexpr bool PERM = true, AFTER_DRAIN = false, PAIRED = false; const void* base; bf16_t* hb; float* st;
    __device__ __forceinline__ void operator()(const f32x4 (&acc)[2][2][4][2], const Unit& u, int wr, int wc, int fr, int fq) const {
        EPI_GROUP(4, f32x4 b[4][2][2];
            _Pragma("unroll") for (int i = 0; i < 4; ++i) _Pragma("unroll") for (int bj = 0; bj < 2; ++bj) { const size_t off = (size_t)EPI_ROWOF(mg + i) * 1024 + EPI_COLOF(bj);
                if constexpr (BASE_BF16) { const u32x4 r = *(const u32x4*)((const bf16_t*)base + off); b[i][bj][0] = bf4_lo(r.x, r.y); b[i][bj][1] = bf4_lo(r.z, r.w); }
                else { const float* bp = (const float*)base + off; b[i][bj][0] = *(const f32x4*)bp; b[i][bj][1] = *(const f32x4*)(bp + 4); } }
            _Pragma("unroll") for (int i = 0; i < 4; ++i) { float ss = 0.f; const int row = EPI_ROWOF(mg + i);
                _Pragma("unroll") for (int bj = 0; bj < 2; ++bj) { const size_t off = (size_t)row * 1024 + EPI_COLOF(bj); const f32x4 h0 = b[i][bj][0] + acc[ai][bj][mg + i][0], h1 = b[i][bj][1] + acc[ai][bj][mg + i][1];
                    *(u32x4*)(hb + off) = pack8(h0, h1);
                    ss += ((h0[0] * h0[0] + h0[1] * h0[1]) + (h0[2] * h0[2] + h0[3] * h0[3])) + ((h1[0] * h1[0] + h1[1] * h1[1]) + (h1[2] * h1[2] + h1[3] * h1[3])); }
                ss += __shfl_xor(ss, 16); ss += __shfl_xor(ss, 32); if (fq == 0) st[(size_t)row * 16 + u.pn * 4 + wc] = ss; } )
    } };
struct EpiRelu2 { static constexpr bool PERM = true, AFTER_DRAIN = false, PAIRED = false; const float* st; bf16_t* O;
    __device__ __forceinline__ void operator()(const f32x4 (&acc)[2][2][4][2], const Unit& u, int wr, int wc, int fr, int fq) const {
        float rsv[2][4];
        _Pragma("unroll") for (int ai = 0; ai < 2; ++ai) { _Pragma("unroll") for (int m = 0; m < 4; ++m) rsv[ai][m] = rstd_from_stats(st, u.pm * BM + ai * HALF + wr * 64 + m * 16 + fr);
            asm volatile("" : "+v"(rsv[ai][0]), "+v"(rsv[ai][1]), "+v"(rsv[ai][2]), "+v"(rsv[ai][3]) :: "memory"); }
        EPI_ROWS( const float rs = rsv[ai][m]; EPI_COLS( f32x4 v0 = a0 * rs, v1 = a1 * rs;
            _Pragma("unroll") for (int e = 0; e < 4; ++e) { const float x0 = fmaxf(v0[e], 0.f), x1 = fmaxf(v1[e], 0.f); v0[e] = x0 * x0; v1[e] = x1 * x1; }
            *(u32x4*)(O + (size_t)row * 4096 + col) = pack8(v0, v1); ) )
    } };
struct EpiPP { static constexpr bool PERM = true, AFTER_DRAIN = false, PAIRED = false; bf16_t* T;
    __device__ __forceinline__ void operator()(const f32x4 (&acc)[2][2][4][2], const Unit& u, int wr, int wc, int fr, int fq) const {
        EPI_ROWS( EPI_COLS( *(u32x4*)(T + (size_t)row * 1024 + col) = pack8(a0, a1); ) )
    } };
struct EpiPle { static constexpr bool PERM = true, AFTER_DRAIN = false, PAIRED = false; const float* st_in; const bf16_t* T; const bf16_t* hsrc; bf16_t* out; float* st;
    __device__ __forceinline__ void operator()(const f32x4 (&acc)[2][2][4][2], const Unit& u, int wr, int wc, int fr, int fq) const {
        float rsv[2][4];
        _Pragma("unroll") for (int ai = 0; ai < 2; ++ai) { _Pragma("unroll") for (int m = 0; m < 4; ++m) rsv[ai][m] = rstd_from_stats(st_in, u.pm * BM + ai * HALF + wr * 64 + m * 16 + fr);
            asm volatile("" : "+v"(rsv[ai][0]), "+v"(rsv[ai][1]), "+v"(rsv[ai][2]), "+v"(rsv[ai][3]) :: "memory"); }
        EPI_GROUP(2, u32x4 hv[2][2]; u32x4 tv[2][2];
            _Pragma("unroll") for (int i = 0; i < 2; ++i) _Pragma("unroll") for (int bj = 0; bj < 2; ++bj) { const size_t off = (size_t)EPI_ROWOF(mg + i) * 1024 + EPI_COLOF(bj);
                    hv[i][bj] = *(const u32x4*)(hsrc + off); tv[i][bj] = *(const u32x4*)(T + off); }
            _Pragma("unroll") for (int i = 0; i < 2; ++i) { float ss = 0.f; const int row = EPI_ROWOF(mg + i); const float rs = rsv[ai][mg + i];
                _Pragma("unroll") for (int bj = 0; bj < 2; ++bj) { const size_t off = (size_t)row * 1024 + EPI_COLOF(bj);
                    f32x4 g0 = acc[ai][bj][mg + i][0] * rs, g1 = acc[ai][bj][mg + i][1] * rs; _Pragma("unroll") for (int e = 0; e < 4; ++e) { g0[e] = sigmoidf_fast(g0[e]); g1[e] = sigmoidf_fast(g1[e]); }
                    const f32x4 h0 = bf4_lo(hv[i][bj].x, hv[i][bj].y) + g0 * bf4_lo(tv[i][bj].x, tv[i][bj].y), h1 = bf4_lo(hv[i][bj].z, hv[i][bj].w) + g1 * bf4_lo(tv[i][bj].z, tv[i][bj].w);
                    *(u32x4*)(out + off) = pack8(h0, h1);
                    ss += ((h0[0] * h0[0] + h0[1] * h0[1]) + (h0[2] * h0[2] + h0[3] * h0[3])) + ((h1[0] * h1[0] + h1[1] * h1[1]) + (h1[2] * h1[2] + h1[3] * h1[3])); }
                ss += __shfl_xor(ss, 16); ss += __shfl_xor(ss, 32); if (fq == 0) st[(size_t)row * 16 + u.pn * 4 + wc] = ss; } )
    } };
struct EpiNone { static constexpr bool PERM = true, AFTER_DRAIN = false, PAIRED = false; float* sink;
    __device__ __forceinline__ void operator()(const f32x4 (&acc)[2][2][4][2], const Unit& u, int wr, int wc, int fr, int fq) const {
        if (acc[0][0][0][0][0] == 1.2345e33f) sink[0] = 1.f;
    } };

struct PairOrder { StaticOrder so; __device__ __forceinline__ bool next(int i, Unit& u) const { if (!so.next(i >> 1, u)) return false; u.part = i & 1; return true; }
    __device__ __forceinline__ void a_ready(const Unit&) const {} __device__ __forceinline__ void done(const Unit&) const {} };
struct EpiPair { static constexpr bool PERM = true, AFTER_DRAIN = false, PAIRED = true; const bf16_t* G0; const bf16_t* G1; bf16_t* O; size_t oA, oB;
    __device__ __forceinline__ size_t offA(const Unit& u) const { return u.part ? oA : 0; }
    __device__ __forceinline__ size_t offB(const Unit& u) const { return u.part ? oB : 0; }
    __device__ __forceinline__ static f32x4 clampg(f32x4 g) { return (f32x4){fmaxf(g[0], 1e-20f), fmaxf(g[1], 1e-20f), fmaxf(g[2], 1e-20f), fmaxf(g[3], 1e-20f)}; }
    __device__ __forceinline__ static f32x4 rcp4(f32x4 g) { return (f32x4){__builtin_amdgcn_rcpf(g[0]), __builtin_amdgcn_rcpf(g[1]), __builtin_amdgcn_rcpf(g[2]), __builtin_amdgcn_rcpf(g[3])}; }
    __device__ __forceinline__ void pair(f32x4 (&acc)[2][2][4][2], const Unit& u, int wr, int wc, int fr, int fq) const {
        if (u.part == 0) {
            EPI_GROUP(4, u32x4 g0[4][2]; u32x4 g1[4][2];
                _Pragma("unroll") for (int i = 0; i < 4; ++i) _Pragma("unroll") for (int bj = 0; bj < 2; ++bj) { const size_t off = (size_t)EPI_ROWOF(mg + i) * ZP + EPI_COLOF(bj); g0[i][bj] = *(const u32x4*)(G0 + off); g1[i][bj] = *(const u32x4*)(G1 + off); }
                _Pragma("unroll") for (int i = 0; i < 4; ++i) _Pragma("unroll") for (int bj = 0; bj < 2; ++bj) {
                    acc[ai][bj][mg + i][0] = acc[ai][bj][mg + i][0] * (bf4_lo(g0[i][bj].x, g0[i][bj].y) * rcp4(clampg(bf4_lo(g1[i][bj].x, g1[i][bj].y))));
                    acc[ai][bj][mg + i][1] = acc[ai][bj][mg + i][1] * (bf4_lo(g0[i][bj].z, g0[i][bj].w) * rcp4(clampg(bf4_lo(g1[i][bj].z, g1[i][bj].w)))); } )
        } else {
            EPI_GROUP(4, u32x4 g1[4][2];
                _Pragma("unroll") for (int i = 0; i < 4; ++i) _Pragma("unroll") for (int bj = 0; bj < 2; ++bj) g1[i][bj] = *(const u32x4*)(G1 + (size_t)EPI_ROWOF(mg + i) * ZP + EPI_COLOF(bj));
                _Pragma("unroll") for (int i = 0; i < 4; ++i) _Pragma("unroll") for (int bj = 0; bj < 2; ++bj)
                    *(u32x4*)(O + (size_t)EPI_ROWOF(mg + i) * 1024 + EPI_COLOF(bj)) = pack8(acc[ai][bj][mg + i][0] * clampg(bf4_lo(g1[i][bj].x, g1[i][bj].y)), acc[ai][bj][mg + i][1] * clampg(bf4_lo(g1[i][bj].z, g1[i][bj].w))); )
        }
    } };

template <class Epi, class Sched, bool ALIGN_EPI = false, bool SP2 = false>
__device__ __forceinline__ void gemm_phase(PG8_LAS unsigned char* lds, const Gemm g, const Sched& S, const Epi& E, const int wave_s) {
    const int tid = wave_s * 64 + fresh_lane(), wid = wave_s, lane = tid & 63, wr = wid >> 2, wc = wid & 3, fr = lane & 15, fq = lane >> 4;
    const int K = g.K, nt = K / BK;
    unsigned voffA[2], voffB[2];
#pragma unroll
    for (int i = 0; i < 2; ++i) { int R, C; stage_rc(tid * 16 + i * 8192, R, C); const int Rb = Epi::PERM ? ((R & ~31) + perm32(R & 31)) : R;
        voffA[i] = (unsigned)(R * g.lda + C) * 2u; voffB[i] = (unsigned)(Rb * K + C) * 2u; }
    const size_t kstep = (size_t)(BK * 2);
    const size_t hstepA = (size_t)HALF * g.lda * 2, hstepB = (size_t)HALF * K * 2;
    const size_t tstepA = 2 * hstepA, tstepB = 2 * hstepB;
    const unsigned ldsw = (unsigned)wid * 1024u;
    const int aoff = lds_byte(wr * 64 + fr, fq * 8), boff = lds_byte(wc * 32 + fr, fq * 8);
#define PG8_SA(b, h) (((b) * 2 + (h)) * HTB)
#define PG8_SB(b, h) ((4 + (b) * 2 + (h)) * HTB)
#define PG8_STAGE(bufoff, gbase, voff) do { _Pragma("unroll") for (int _i = 0; _i < 2; ++_i) \
        __builtin_amdgcn_global_load_lds((const unsigned*)((const char*)(gbase) + (voff)[_i]), (PG8_LAS unsigned*)(lds + (bufoff) + ldsw + _i * 8192), 16, 0, 0); } while (0)
#define PG8_LDA(dst, b, h) do { _Pragma("unroll") for (int m = 0; m < 4; ++m) _Pragma("unroll") for (int k = 0; k < 2; ++k) dst[m][k] = *(const PG8_LAS bf16x8*)(lds + PG8_SA(b, h) + aoff + m * 2048 + k * 1024); } while (0)
#define PG8_LDB(dst, b, h) do { _Pragma("unroll") for (int n = 0; n < 2; ++n) _Pragma("unroll") for (int k = 0; k < 2; ++k) dst[n][k] = *(const PG8_LAS bf16x8*)(lds + PG8_SB(b, h) + boff + n * 2048 + k * 1024); } while (0)
#define PG8_MMA(ai, bj, At, Bt) do { __builtin_amdgcn_s_setprio(1); _Pragma("unroll") for (int m = 0; m < 4; ++m) _Pragma("unroll") for (int n = 0; n < 2; ++n) _Pragma("unroll") for (int k = 0; k < 2; ++k) \
        acc[ai][bj][m][n] = __builtin_amdgcn_mfma_f32_16x16x32_bf16(Bt[n][k], At[m][k], acc[ai][bj][m][n], 0, 0, 0); __builtin_amdgcn_s_setprio(0); } while (0)
#define PG8_WAIT_V(n) asm volatile("s_waitcnt vmcnt(" #n ")" ::: "memory")
#define PG8_WAIT_L(n) asm volatile("s_waitcnt lgkmcnt(" #n ")" ::: "memory")
#define PG8_BAR __builtin_amdgcn_s_barrier()
#define PG8_SCHED __builtin_amdgcn_sched_barrier(0)
    Unit cur, nxt; int ui = 0;
    if (!S.next(0, cur)) return;
    f32x4 acc[2][2][4][2];
#pragma unroll
    for (int a = 0; a < 2; ++a)
#pragma unroll
        for (int b = 0; b < 2; ++b)
#pragma unroll
            for (int m = 0; m < 4; ++m)
#pragma unroll
                for (int n = 0; n < 2; ++n) acc[a][b][m][n] = (f32x4){0.f, 0.f, 0.f, 0.f};
    bf16x8 At[4][2], B0[2][2], B1[2][2];
    const char* cA = (const char*)g.A + (size_t)cur.pm * tstepA; const char* cB = (const char*)g.Bt + (size_t)cur.pn * tstepB;
    if constexpr (Epi::PAIRED) { cA += E.offA(cur); cB += E.offB(cur); }
    S.a_ready(cur);
    if constexpr (SP2) {
        PG8_STAGE(PG8_SB(0, 0), cB, voffB); PG8_STAGE(PG8_SB(0, 1), cB + hstepB, voffB); PG8_STAGE(PG8_SA(0, 0), cA, voffA); PG8_STAGE(PG8_SA(0, 1), cA + hstepA, voffA);
        if (wr == 1) PG8_BAR;
        PG8_WAIT_V(2); PG8_BAR;
        PG8_STAGE(PG8_SB(1, 0), cB + kstep, voffB); PG8_STAGE(PG8_SA(1, 0), cA + kstep, voffA); PG8_STAGE(PG8_SB(1, 1), cB + hstepB + kstep, voffB);
        PG8_WAIT_V(6); PG8_BAR;
    } else {
        PG8_STAGE(PG8_SB(0, 0), cB, voffB); PG8_STAGE(PG8_SA(0, 0), cA, voffA); PG8_STAGE(PG8_SB(0, 1), cB + hstepB, voffB); PG8_STAGE(PG8_SA(0, 1), cA + hstepA, voffA);
        if (wr == 1) PG8_BAR;
        PG8_WAIT_V(4); PG8_BAR;
        PG8_STAGE(PG8_SB(1, 0), cB + kstep, voffB); PG8_STAGE(PG8_SA(1, 0), cA + kstep, voffA); PG8_STAGE(PG8_SB(1, 1), cB + hstepB + kstep, voffB);
        PG8_WAIT_V(6); PG8_BAR;
    }
    for (;;) {
        const bool has_next = S.next(ui + 1, nxt);
        size_t oa_ = 0, ob_ = 0; if constexpr (Epi::PAIRED) { if (has_next) { oa_ = E.offA(nxt); ob_ = E.offB(nxt); } }
        const char* nA = has_next ? (const char*)g.A + (size_t)nxt.pm * tstepA + oa_ : cA; const char* nB = has_next ? (const char*)g.Bt + (size_t)nxt.pn * tstepB + ob_ : cB;
        for (int t = 0; t < nt; t += 2) {
            const bool last = (t == nt - 2);
            const char* a1 = cA + (size_t)(t + 1) * kstep;
            const char* a2 = last ? nA : cA + (size_t)(t + 2) * kstep; const char* b2 = last ? nB : cB + (size_t)(t + 2) * kstep;
            const char* a3 = a2 + kstep; const char* b3 = b2 + kstep;
            if (last && has_next) S.a_ready(nxt);
            if constexpr (SP2) {
            PG8_LDB(B0, 0, 0); PG8_LDB(B1, 0, 1); PG8_SCHED; PG8_LDA(At, 0, 0); PG8_STAGE(PG8_SA(1, 1), a1 + hstepA, voffA);
            PG8_WAIT_V(8); PG8_WAIT_L(0); PG8_BAR; PG8_MMA(0, 0, At, B0); PG8_MMA(0, 1, At, B1); PG8_BAR; PG8_SCHED;
            PG8_LDA(At, 0, 1); PG8_STAGE(PG8_SB(0, 0), b2, voffB); PG8_STAGE(PG8_SB(0, 1), b2 + hstepB, voffB); PG8_STAGE(PG8_SA(0, 0), a2, voffA);
            PG8_WAIT_V(8); PG8_WAIT_L(0); PG8_BAR; PG8_MMA(1, 0, At, B0); PG8_MMA(1, 1, At, B1); PG8_BAR; PG8_SCHED;
            PG8_LDB(B0, 1, 0); PG8_LDB(B1, 1, 1); PG8_SCHED; PG8_LDA(At, 1, 0); PG8_STAGE(PG8_SA(0, 1), a2 + hstepA, voffA);
            PG8_WAIT_V(8); PG8_WAIT_L(0); PG8_BAR; PG8_MMA(0, 0, At, B0); PG8_MMA(0, 1, At, B1); PG8_BAR; PG8_SCHED;
            PG8_LDA(At, 1, 1); PG8_STAGE(PG8_SB(1, 0), b3, voffB); PG8_STAGE(PG8_SB(1, 1), b3 + hstepB, voffB); PG8_STAGE(PG8_SA(1, 0), a3, voffA);
            PG8_WAIT_V(8); PG8_WAIT_L(0); PG8_BAR; PG8_MMA(1, 0, At, B0); PG8_MMA(1, 1, At, B1); PG8_BAR; PG8_SCHED;
            } else {
            PG8_LDB(B0, 0, 0); PG8_SCHED; PG8_LDA(At, 0, 0); PG8_STAGE(PG8_SA(1, 1), a1 + hstepA, voffA);
            PG8_WAIT_L(8); PG8_BAR; PG8_WAIT_L(0); PG8_MMA(0, 0, At, B0); PG8_BAR; PG8_SCHED;
            PG8_LDB(B1, 0, 1); PG8_STAGE(PG8_SB(0, 0), b2, voffB);
            PG8_BAR; PG8_WAIT_L(0); PG8_MMA(0, 1, At, B1); PG8_BAR;
            PG8_LDA(At, 0, 1); PG8_STAGE(PG8_SA(0, 0), a2, voffA);
            PG8_BAR; PG8_WAIT_L(0); PG8_MMA(1, 0, At, B0); PG8_BAR; PG8_SCHED;
            PG8_STAGE(PG8_SB(0, 1), b2 + hstepB, voffB);
            PG8_WAIT_V(6); PG8_BAR; PG8_MMA(1, 1, At, B1); PG8_BAR;
            PG8_LDB(B0, 1, 0); PG8_SCHED; PG8_LDA(At, 1, 0); PG8_STAGE(PG8_SA(0, 1), a2 + hstepA, voffA);
            PG8_WAIT_L(8); PG8_BAR; PG8_WAIT_L(0); PG8_MMA(0, 0, At, B0); PG8_BAR; PG8_SCHED;
            PG8_LDB(B1, 1, 1); PG8_STAGE(PG8_SB(1, 0), b3, voffB);
            PG8_BAR; PG8_WAIT_L(0); PG8_MMA(0, 1, At, B1); PG8_BAR;
            PG8_LDA(At, 1, 1); PG8_STAGE(PG8_SA(1, 0), a3, voffA);
            PG8_BAR; PG8_WAIT_L(0); PG8_MMA(1, 0, At, B0); PG8_BAR; PG8_SCHED;
            PG8_STAGE(PG8_SB(1, 1), b3 + hstepB, voffB);
            PG8_WAIT_V(6); PG8_BAR; PG8_MMA(1, 1, At, B1); PG8_BAR;
            }
        }
        if constexpr (ALIGN_EPI) { if (wr == 0) PG8_BAR; }
        if constexpr (Epi::PAIRED) { E.pair(acc, cur, wr, wc, fr, fq); } else if constexpr (!Epi::AFTER_DRAIN) { E(acc, cur, wr, wc, fr, fq); S.done(cur); }
        if (!has_next) break;
        if (!Epi::PAIRED || nxt.part == 0)
#pragma unroll
        for (int a = 0; a < 2; ++a)
#pragma unroll
            for (int b = 0; b < 2; ++b)
#pragma unroll
                for (int m = 0; m < 4; ++m)
#pragma unroll
                    for (int n = 0; n < 2; ++n) acc[a][b][m][n] = (f32x4){0.f, 0.f, 0.f, 0.f};
        cur = nxt; cA = nA; cB = nB; ++ui;
        if constexpr (ALIGN_EPI) { if (wr == 1) PG8_BAR; }
    }
    PG8_WAIT_V(0);
    if constexpr (!ALIGN_EPI) { if (wr == 0) PG8_BAR; }
    PG8_BAR;
    if constexpr (Epi::AFTER_DRAIN) { E.fused(acc, cur, wr, wc, fr, fq, lds, wid, lane); S.done(cur); }
#undef PG8_SA
#undef PG8_SB
#undef PG8_STAGE
#undef PG8_LDA
#undef PG8_LDB
#undef PG8_MMA
#undef PG8_WAIT_V
#undef PG8_WAIT_L
#undef PG8_BAR
#undef PG8_SCHED
}
}
#ifndef PG8_SP2
#define PG8_SP2 true
#endif
#ifndef PG8_ALIGN
#define PG8_ALIGN true
#endif
#include <hip/hip_bf16.h>
#include <cmath>
namespace attn_body {
using bf16=__hip_bfloat16;
using bf16x8=__attribute__((ext_vector_type(8)))short;
using s16x4=__attribute__((ext_vector_type(4)))short;
using f32x16=__attribute__((ext_vector_type(16)))float;
using u32x4=__attribute__((ext_vector_type(4)))unsigned;
constexpr int BATCH=2,SEQ=8192,D=64,DM=4352;
constexpr int NW=8,QBLK=32,QB=QBLK*NW,KVBLK=64,NQB=SEQ/QB;
constexpr int ATTN_PITCH=DM, ATTN_UNIT_ROWS=QB;
__device__ __forceinline__ int crow(int r,int hi){return (r&3)+8*(r>>2)+4*hi;}
#define SBAR() __builtin_amdgcn_sched_barrier(0)
__device__ __forceinline__ void cmask(f32x16&p0,f32x16&p1,int jb,int qrel,int hi){
  const float NEG=-INFINITY; int kb=64*jb+4*hi;
  #pragma unroll
  for(int r=0;r<16;++r){int kv=kb+(r&3)+8*(r>>2); if(kv>qrel)p0[r]=NEG; if(kv+32>qrel)p1[r]=NEG;}
}

constexpr int NSLOT=3, SLOTB=8192; typedef float f32x4v __attribute__((ext_vector_type(4))); constexpr int LDS_BIAS=86016;
constexpr int LDS_K=0, LDS_V=NSLOT*SLOTB, LDS_WS=2*NSLOT*SLOTB, LDS_OST=LDS_WS+NW*64*4, LDS_BYTES=LDS_OST+NW*4096;
constexpr float C2=0.125f*1.4426950408889634f;
__device__ __forceinline__ void glds16(const void*gsrc,unsigned lds_dst){unsigned keep;
  asm volatile("s_mov_b32 %0, m0\n\ts_mov_b32 m0, %2\n\ts_nop 0\n\tglobal_load_lds_dwordx4 %1, off\n\ts_mov_b32 m0, %0":"=&s"(keep):"v"(gsrc),"s"(lds_dst):"memory");}
__device__ __forceinline__ float max3f(float a,float b,float c){float r;asm("v_max3_f32 %0, %1, %2, %3":"=v"(r):"v"(a),"v"(b),"v"(c));return r;}
__device__ __forceinline__ float max2f(float a,float b){float r;asm("v_max_f32_e32 %0, %1, %2":"=v"(r):"v"(a),"v"(b));return r;}
__device__ __forceinline__ float fadd_s(float a,float b){float r;asm("v_add_f32_e32 %0, %1, %2":"=v"(r):"v"(a),"v"(b));return r;}
__device__ __forceinline__ float fsub_s(float a,float b){float r;asm("v_sub_f32_e32 %0, %1, %2":"=v"(r):"v"(a),"v"(b));return r;}
typedef float f32x2_t __attribute__((ext_vector_type(2))); typedef __bf16 bf16x2_t __attribute__((ext_vector_type(2)));
__device__ __forceinline__ unsigned cvtpk_s(float lo,float hi){f32x2_t v={lo,hi};bf16x2_t b=__builtin_convertvector(v,bf16x2_t);return __builtin_bit_cast(unsigned,b);}
#define WAIT_BAR(N) asm volatile("s_waitcnt vmcnt(" #N ") lgkmcnt(0)\n\ts_barrier":::"memory")

__device__ __forceinline__ void qkt(f32x16&p0,f32x16&p1,const char*Kslot,const bf16x8*qr,const f32x16&negm,int r32,int hi){
  const char*kb=Kslot+hi*1024+r32*16;
  #pragma unroll
  for(int d0=0;d0<4;++d0){
    const bf16x8 b0=*reinterpret_cast<const bf16x8*>(kb+d0*2048);
    const bf16x8 b1=*reinterpret_cast<const bf16x8*>(kb+d0*2048+512);
    if(d0==0){p0=__builtin_amdgcn_mfma_f32_32x32x16_bf16(b0,qr[0],negm,0,0,0);p1=__builtin_amdgcn_mfma_f32_32x32x16_bf16(b1,qr[0],negm,0,0,0);}
    else{p0=__builtin_amdgcn_mfma_f32_32x32x16_bf16(b0,qr[d0],p0,0,0,0);p1=__builtin_amdgcn_mfma_f32_32x32x16_bf16(b1,qr[d0],p1,0,0,0);}}
}
typedef __attribute__((address_space(3))) const char* lds_cptr;
typedef short v4i16_t __attribute__((ext_vector_type(4)));
__device__ __forceinline__ void kload8(bf16x8*kf,lds_cptr kp){
  kf[0]=*(const __attribute__((address_space(3))) bf16x8*)(kp);      kf[1]=*(const __attribute__((address_space(3))) bf16x8*)(kp+512);
  kf[2]=*(const __attribute__((address_space(3))) bf16x8*)(kp+2048); kf[3]=*(const __attribute__((address_space(3))) bf16x8*)(kp+2560);
  kf[4]=*(const __attribute__((address_space(3))) bf16x8*)(kp+4096); kf[5]=*(const __attribute__((address_space(3))) bf16x8*)(kp+4608);
  kf[6]=*(const __attribute__((address_space(3))) bf16x8*)(kp+6144); kf[7]=*(const __attribute__((address_space(3))) bf16x8*)(kp+6656);
}
__device__ __forceinline__ void kload2(bf16x8*kf,lds_cptr kp,int j){ kf[2*j]=*(const __attribute__((address_space(3))) bf16x8*)(kp+j*2048); kf[2*j+1]=*(const __attribute__((address_space(3))) bf16x8*)(kp+j*2048+512); }
__device__ __forceinline__ s16x4 vtr(lds_cptr p){ return __builtin_bit_cast(s16x4,__builtin_amdgcn_ds_read_tr16_b64_v4i16((__attribute__((address_space(3))) v4i16_t*)p)); }
__device__ __forceinline__ float rowmax(const f32x16&p0,const f32x16&p1){
  float a=max3f(p0[0],p0[1],p1[0]),b=max3f(p0[2],p0[3],p1[1]);a=max3f(a,p1[2],p1[3]);
  #pragma unroll
  for(int r=4;r<16;r+=4){a=max3f(a,p0[r],p0[r+1]);b=max3f(b,p0[r+2],p0[r+3]);a=max3f(a,p1[r],p1[r+1]);b=max3f(b,p1[r+2],p1[r+3]);}
  const float m=max2f(a,b);
  auto rr=__builtin_amdgcn_permlane32_swap(__float_as_uint(m),__float_as_uint(m),false,false);
  return max2f(__uint_as_float(rr[0]),__uint_as_float(rr[1]));
}
__device__ __forceinline__ void pv(f32x16*o,int vb,bf16x8 pa0,bf16x8 pa1,bf16x8 pa2,bf16x8 pa3){
  #pragma unroll
  for(int d0=0;d0<2;++d0){s16x4 lo[4],hi[4];
    #pragma unroll
    for(int ks=0;ks<4;++ks){
      asm volatile("ds_read_b64_tr_b16 %0,%1 offset:%c2":"=&v"(lo[ks]):"v"(vb),"i"(d0*4096+ks*1024):"memory");
      asm volatile("ds_read_b64_tr_b16 %0,%1 offset:%c2":"=&v"(hi[ks]):"v"(vb),"i"(d0*4096+ks*1024+512):"memory");}
    asm volatile("s_waitcnt lgkmcnt(0)":::"memory");SBAR();
    #define PK(k) (bf16x8){lo[k][0],lo[k][1],lo[k][2],lo[k][3],hi[k][0],hi[k][1],hi[k][2],hi[k][3]}
    o[d0]=__builtin_amdgcn_mfma_f32_32x32x16_bf16(pa0,PK(0),o[d0],0,0,0);
    o[d0]=__builtin_amdgcn_mfma_f32_32x32x16_bf16(pa1,PK(1),o[d0],0,0,0);
    o[d0]=__builtin_amdgcn_mfma_f32_32x32x16_bf16(pa2,PK(2),o[d0],0,0,0);
    o[d0]=__builtin_amdgcn_mfma_f32_32x32x16_bf16(pa3,PK(3),o[d0],0,0,0);
    #undef PK
  }
}

#ifndef ATTN_STORE16
#define ATTN_STORE16(p,v) (*(u32x4*)(p)=(v))
#endif
template<int THRL> __device__ __forceinline__ void attn_unit(const int wave_s,int qb,const bf16*Qh,const bf16*__restrict__ Kh,const bf16*__restrict__ Vh,bf16*Oh,const float*__restrict__ cbias,const float qk2,char*shm){
  const int wid=wave_s; const int tid=wave_s*64+fresh_lane(),lane=tid&63,r32=lane&31,hi=lane>>5;
  const int q0=qb*QB;
  const bf16*Qw=Qh+(long)(q0+wid*QBLK)*DM;
  int t0; { const int ntab=(q0+QB)/KVBLK; const float thr=cbias[q0]-(qk2+44.0f); const int l_=tid&63;
    const bool c0_=(l_<ntab-4)&&(cbias[l_*64+63]<thr), c1_=(l_+64<ntab-4)&&(cbias[(l_+64)*64+63]<thr);
    t0=(__builtin_popcountll(__ballot(c0_))+__builtin_popcountll(__ballot(c1_)))&~1; t0=__builtin_amdgcn_readfirstlane(t0); }
  Kh+=(long)t0*KVBLK*DM; Vh+=(long)t0*KVBLK*DM; cbias+=t0*KVBLK;
  const unsigned lds0=(unsigned)(uintptr_t)shm;
  float*wsf=(float*)(shm+LDS_WS)+wid*64;
  const bf16*ksrc=Kh+(long)lane*DM+wid*8;
  const bf16*vsrc=Vh+(long)(16*(wid&3)+(lane>>2))*DM+(wid>>2)*32+(lane&3)*8;
  const unsigned kdst=lds0+LDS_K+wid*1024, vdst=lds0+LDS_V+wid*1024;
  #define DMA_K(t,slot) glds16(ksrc+(long)(t)*KVBLK*DM,(unsigned)__builtin_amdgcn_readfirstlane(kdst+(slot)))
  #define DMA_V(t,slot) glds16(vsrc+(long)(t)*KVBLK*DM,(unsigned)__builtin_amdgcn_readfirstlane(vdst+(slot)))
  const int vb0=(int)(lds0+LDS_V)+((lane>>4)&1)*32+(lane&3)*8+(4*hi+((lane&15)>>2))*64;
  const char*Kbase=shm+LDS_K; bf16x8 kf[8];
  const lds_cptr shm3=(lds_cptr)shm; const lds_cptr kp0=shm3+LDS_K+hi*1024+r32*16; const lds_cptr vp0=shm3+LDS_V+((lane>>4)&1)*32+(lane&3)*8+(4*hi+((lane&15)>>2))*64;
  { const int nk4=((q0+QB)>>2)-t0*16; __attribute__((address_space(3))) f32x4v* bt=(__attribute__((address_space(3))) f32x4v*)((lds_cptr)shm+LDS_BIAS); for(int i=tid;i<nk4;i+=NW*64) bt[i]=((const f32x4v*)cbias)[i]; }
  const int NT=(q0+QB)/KVBLK-t0;
  DMA_K(0,0);DMA_V(0,0);DMA_K(1,SLOTB);
  bf16x8 qr[4];
  #pragma unroll
  for(int d0=0;d0<4;++d0)qr[d0]=*reinterpret_cast<const bf16x8*>(&Qw[(long)r32*DM+d0*16+hi*8]);
  float mhat=0.f,l_reg=0.f;float zf_=0.f;asm volatile("":"+v"(zf_));f32x16 o[2];f32x16 negm;
  _Pragma("unroll") for(int r=0;r<16;++r){o[0][r]=zf_;o[1][r]=zf_;negm[r]=zf_;} asm volatile("":"+v"(negm));
  const int qrel=wid*QBLK+r32;
  #define CMASK(P0,P1,t) do{int jb_=(t)-(NT-4); if(jb_>=0)cmask(P0,P1,jb_,qrel,hi);}while(0)
  #define BIAS(P0,P1,t) do{ const __attribute__((address_space(3))) f32x4v* bt_=(const __attribute__((address_space(3))) f32x4v*)(shm3+LDS_BIAS)+(t)*16+hi; \
    _Pragma("unroll") for(int i_=0;i_<4;++i_){ const f32x4v b0_=bt_[2*i_], b1_=bt_[8+2*i_]; \
      P0[4*i_]+=b0_[0];P0[4*i_+1]+=b0_[1];P0[4*i_+2]+=b0_[2];P0[4*i_+3]+=b0_[3]; P1[4*i_]+=b1_[0];P1[4*i_+1]+=b1_[1];P1[4*i_+2]+=b1_[2];P1[4*i_+3]+=b1_[3]; } }while(0)
  bool resc=false;
  #define START(P0,P1) do{ const float rm=rowmax(P0,P1); resc=false; \
    { const float dl=rm; mhat=fadd_s(mhat,dl); \
      _Pragma("unroll") for(int r=0;r<16;++r){P0[r]=fsub_s(P0[r],dl);P1[r]=fsub_s(P1[r],dl);} \
      _Pragma("unroll") for(int r=0;r<16;++r)negm[r]=-mhat; asm volatile("":"+v"(negm)); } \
    _Pragma("unroll") for(int r=0;r<16;++r)P0[r]=__builtin_amdgcn_exp2f(P0[r]); }while(0)
  #define RESC() do{ if(resc){ asm volatile("s_waitcnt lgkmcnt(0)":::"memory"); \
      _Pragma("unroll") for(int d_=0;d_<2;++d_) _Pragma("unroll") for(int r=0;r<16;++r)o[d_][r]*=wsf[crow(r,hi)]; } }while(0)
  f32x16 pA0,pA1,pB0,pB1;
  int sl_prev=0,sl_cur=0,sl_next=SLOTB;
  #define ROT() do{sl_prev=sl_cur;sl_cur=sl_next;sl_next=(sl_next==(NSLOT-1)*SLOTB)?0:sl_next+SLOTB;}while(0)
  DMA_K(2,2*SLOTB);
  WAIT_BAR(3);
  qkt(pA0,pA1,Kbase,qr,negm,r32,hi);asm volatile("s_nop 15\n\ts_nop 7":"+v"(pA0),"+v"(pA1));BIAS(pA0,pA1,0);CMASK(pA0,pA1,0);
  START(pA0,pA1);
  _Pragma("unroll") for(int r=0;r<16;++r)pA1[r]=__builtin_amdgcn_exp2f(pA1[r]);
  WAIT_BAR(0);
  DMA_K(3,0);DMA_V(1,SLOTB);
  ROT();
  kload8(kf,kp0+sl_cur);
  WAIT_BAR(2);
  s16x4 vlo[8],vhi[8]; u32x4 pw0,pw1,pw2,pw3;
  #define PKW(P,B) cvtpk_s(P[B],P[B+1])
  #define PAF(k) __builtin_bit_cast(bf16x8,pw##k)
  #define VFR(i) (bf16x8){vlo[i][0],vlo[i][1],vlo[i][2],vlo[i][3],vhi[i][0],vhi[i][1],vhi[i][2],vhi[i][3]}
  #define PIN(x) asm volatile("":"+v"(x))
  #define MX3(a,b,c) __builtin_fmaxf(__builtin_fmaxf((a),(b)),(c))
  #define GAPA(MF,A0,A1,A2,A3,W0,W1,PW) do{ MF; sacc+=A0; sacc+=A1; sacc+=A2; sacc+=A3; PIN(sacc); W0; W1; PIN(PW); SBAR(); }while(0)
  #define EX(v) __builtin_amdgcn_exp2f(v)
  #define GAPB(MF,X,B) do{ MF; X[B]=EX(X[B]); X[B+1]=EX(X[B+1]); X[B+2]=EX(X[B+2]); X[B+3]=EX(X[B+3]); PIN(X); SBAR(); }while(0)
  #define VRD(i) do{ vlo[i]=vtr(vp_+(((i)>>2)*4096+((i)&3)*1024)); vhi[i]=vtr(vp_+(((i)>>2)*4096+((i)&3)*1024+512)); }while(0)
  #define KRD(G,j) do{ if(G){ kload2(kf,kp0+sl_next,j); SBAR(); } }while(0)
  #define STEP(C0,C1,P0,P1,t,GK,GV,GL) do{ SBAR(); \
    const lds_cptr vp_=vp0+sl_prev; \
    VRD(0); SBAR(); float sacc=(P0[0]+P0[1]); \
    GAPA(C0=__builtin_amdgcn_mfma_f32_32x32x16_bf16(kf[0],qr[0],negm,0,0,0), P0[2],P0[3],P0[4],P0[5],     pw0[0]=PKW(P0,0), pw0[1]=PKW(P0,2), pw0); \
    VRD(4); SBAR(); GAPA(C1=__builtin_amdgcn_mfma_f32_32x32x16_bf16(kf[1],qr[0],negm,0,0,0), P0[6],P0[7],P0[8],P0[9],     pw0[2]=PKW(P0,4), pw0[3]=PKW(P0,6), pw0); \
    VRD(1); SBAR(); GAPA(C0=__builtin_amdgcn_mfma_f32_32x32x16_bf16(kf[2],qr[1],C0,0,0,0),   P0[10],P0[11],P0[12],P0[13], pw1[0]=PKW(P0,8), pw1[1]=PKW(P0,10), pw1); \
    VRD(5); SBAR(); GAPA(C1=__builtin_amdgcn_mfma_f32_32x32x16_bf16(kf[3],qr[1],C1,0,0,0),   P0[14],P0[15],P1[0],P1[1],   pw1[2]=PKW(P0,12),pw1[3]=PKW(P0,14), pw1); \
    VRD(2); SBAR(); GAPA(C0=__builtin_amdgcn_mfma_f32_32x32x16_bf16(kf[4],qr[2],C0,0,0,0),   P1[2],P1[3],P1[4],P1[5],     pw2[0]=PKW(P1,0), pw2[1]=PKW(P1,2), pw2); \
    VRD(6); SBAR(); GAPA(C1=__builtin_amdgcn_mfma_f32_32x32x16_bf16(kf[5],qr[2],C1,0,0,0),   P1[6],P1[7],P1[8],P1[9],     pw2[2]=PKW(P1,4), pw2[3]=PKW(P1,6), pw2); \
    VRD(3); SBAR(); GAPA(C0=__builtin_amdgcn_mfma_f32_32x32x16_bf16(kf[6],qr[3],C0,0,0,0),   P1[10],P1[11],P1[12],P1[13], pw3[0]=PKW(P1,8), pw3[1]=PKW(P1,10), pw3); \
    VRD(7); SBAR(); GAPA(C1=__builtin_amdgcn_mfma_f32_32x32x16_bf16(kf[7],qr[3],C1,0,0,0),   P1[14],P1[15],0.f,0.f,       pw3[2]=PKW(P1,12),pw3[3]=PKW(P1,14), pw3); \
    l_reg+=sacc; \
    if(GK){DMA_K((t)+3,sl_cur);} if(GV){DMA_V((t)+1,sl_next);} \
    BIAS(C0,C1,t); CMASK(C0,C1,t); \
    { float a=MX3(C0[0],C0[1],C1[0]),b=MX3(C0[2],C0[3],C1[1]); a=MX3(a,C1[2],C1[3]); \
      _Pragma("unroll") for(int r=4;r<16;r+=4){a=MX3(a,C0[r],C0[r+1]);b=MX3(b,C0[r+2],C0[r+3]);a=MX3(a,C1[r],C1[r+1]);b=MX3(b,C1[r+2],C1[r+3]);} \
      float rm=__builtin_fmaxf(a,b); { auto rr=__builtin_amdgcn_permlane32_swap(__float_as_uint(rm),__float_as_uint(rm),false,false); rm=__builtin_fmaxf(__uint_as_float(rr[0]),__uint_as_float(rr[1])); } \
      resc=false; \
      if(__builtin_expect(__any(rm>(float)THRL),0)){ const float dl=__builtin_fmaxf(rm,0.f); mhat+=dl; \
        _Pragma("unroll") for(int r=0;r<16;++r){C0[r]-=dl;C1[r]-=dl;} \
        _Pragma("unroll") for(int r=0;r<16;++r)negm[r]=-mhat; asm volatile("":"+v"(negm)); \
        const float f=__builtin_amdgcn_exp2f(-dl); l_reg*=f; if(hi==0)wsf[r32]=f; resc=true; } } \
    SBAR(); \
    GAPB(o[0]=__builtin_amdgcn_mfma_f32_32x32x16_bf16(PAF(0),VFR(0),o[0],0,0,0), C0,0); \
    GAPB(o[1]=__builtin_amdgcn_mfma_f32_32x32x16_bf16(PAF(0),VFR(4),o[1],0,0,0), C0,4); \
    KRD(GL,0); GAPB(o[0]=__builtin_amdgcn_mfma_f32_32x32x16_bf16(PAF(1),VFR(1),o[0],0,0,0), C0,8); \
    KRD(GL,1); GAPB(o[1]=__builtin_amdgcn_mfma_f32_32x32x16_bf16(PAF(1),VFR(5),o[1],0,0,0), C0,12); \
    KRD(GL,2); GAPB(o[0]=__builtin_amdgcn_mfma_f32_32x32x16_bf16(PAF(2),VFR(2),o[0],0,0,0), C1,0); \
    KRD(GL,3); GAPB(o[1]=__builtin_amdgcn_mfma_f32_32x32x16_bf16(PAF(2),VFR(6),o[1],0,0,0), C1,4); \
    GAPB(o[0]=__builtin_amdgcn_mfma_f32_32x32x16_bf16(PAF(3),VFR(3),o[0],0,0,0), C1,8); \
    GAPB(o[1]=__builtin_amdgcn_mfma_f32_32x32x16_bf16(PAF(3),VFR(7),o[1],0,0,0), C1,12); \
    }while(0)
  int t=1;
  #undef CMASK
  #define CMASK(P0,P1,t) do{}while(0)
  for(;t+5<NT;t+=2){
    STEP(pB0,pB1,pA0,pA1,t,true,true,true);     WAIT_BAR(2); RESC(); ROT();
    STEP(pA0,pA1,pB0,pB1,t+1,true,true,true);   WAIT_BAR(2); RESC(); ROT();
  }
  #undef CMASK
  #define CMASK(P0,P1,t) do{int jb_=(t)-(NT-4); if(jb_>=0)cmask(P0,P1,jb_,qrel,hi);}while(0)
  #define ENDW(tt) do{ if((tt)+3<NT){WAIT_BAR(2);} else if((tt)+2<NT){WAIT_BAR(1);} else {WAIT_BAR(0);} }while(0)
  for(;t+1<NT;t+=2){
    STEP(pB0,pB1,pA0,pA1,t,(t+3<NT),(t+1<NT),(t+1<NT));       ENDW(t);   RESC(); ROT();
    STEP(pA0,pA1,pB0,pB1,t+1,(t+4<NT),(t+2<NT),(t+2<NT));     ENDW(t+1); RESC(); ROT();
  }
  STEP(pB0,pB1,pA0,pA1,NT-1,false,false,false); RESC();
  { float sacc=pB0[0]+pB0[1]; _Pragma("unroll") for(int r=2;r<16;++r)sacc+=pB0[r]; _Pragma("unroll") for(int r=0;r<16;++r)sacc+=pB1[r]; l_reg+=sacc;
    pw0=(u32x4){PKW(pB0,0),PKW(pB0,2),PKW(pB0,4),PKW(pB0,6)};pw1=(u32x4){PKW(pB0,8),PKW(pB0,10),PKW(pB0,12),PKW(pB0,14)};pw2=(u32x4){PKW(pB1,0),PKW(pB1,2),PKW(pB1,4),PKW(pB1,6)};pw3=(u32x4){PKW(pB1,8),PKW(pB1,10),PKW(pB1,12),PKW(pB1,14)};
    SBAR(); pv(o,vb0+sl_cur,PAF(0),PAF(1),PAF(2),PAF(3)); }
  #undef PKW
  #undef PAF
  #undef VFR
  #undef PIN
  #undef MX3
  #undef GAPA
  #undef GAPB
  #undef EX
  #undef VRD
  #undef KRD
  #undef STEP
  #undef ENDW
  {auto rr=__builtin_amdgcn_permlane32_swap(__float_as_uint(l_reg),__float_as_uint(l_reg),false,false);l_reg=__uint_as_float(rr[0])+__uint_as_float(rr[1]);}
  if(hi==0)wsf[32+r32]=l_reg;asm volatile("s_waitcnt lgkmcnt(0)":::"memory");
  float rli[16];
  #pragma unroll
  for(int r=0;r<16;++r)rli[r]=__builtin_amdgcn_rcpf(wsf[32+crow(r,hi)]);
  bf16*Ow=Oh+(long)(q0+wid*QBLK)*DM;
  { bf16*stg=(bf16*)(shm+LDS_OST)+wid*2048;
    #pragma unroll
    for(int r=0;r<16;++r){const int orow=crow(r,hi);
      #pragma unroll
      for(int d0=0;d0<2;++d0)stg[orow*64+d0*32+r32]=__float2bfloat16(o[d0][r]*rli[r]);}
    asm volatile("s_waitcnt lgkmcnt(0)":::"memory");
    #pragma unroll
    for(int i=0;i<4;++i){const int row=i*8+(lane>>3),ch=lane&7; const u32x4 v=*(const u32x4*)(stg+row*64+ch*8); ATTN_STORE16(Ow+(long)row*DM+ch*8,v);} }
  asm volatile("s_waitcnt lgkmcnt(0)\n\ts_barrier":::"memory");
  #undef DMA_K
  #undef DMA_V
  #undef CMASK
  #undef START
  #undef RESC
  #undef ROT
  #undef BIAS
}
constexpr int ATTN_LDS_BYTES=LDS_BYTES;
constexpr int SWA_K=0, SWA_V=6*SLOTB, SWA_OST=12*SLOTB, SWA_WS=133120;
__device__ __forceinline__ void swa_unit(const int wave_s,int qb,const bf16*Qh,const bf16*__restrict__ Kh,const bf16*__restrict__ Vh,bf16*Oh,float slope2,float sink2,char*shm){
  const int wid=wave_s; const int tid=wave_s*64+fresh_lane(),lane=tid&63,r32=lane&31,hi=lane>>5;
  const int q0=qb*QB, c0=4*qb-2;
  const bf16*Qw=Qh+(long)(q0+wid*QBLK)*DM;
  const unsigned lds0=(unsigned)(uintptr_t)shm;
  float*wsf=(float*)(shm+SWA_WS)+wid*64;
  const bf16*ksrc=Kh+(long)lane*DM+wid*8;
  const bf16*vsrc=Vh+(long)(16*(wid&3)+(lane>>2))*DM+(wid>>2)*32+(lane&3)*8;
  const unsigned kdst=lds0+SWA_K+wid*1024, vdst=lds0+SWA_V+wid*1024;
  #pragma unroll
  for(int s=0;s<6;++s){ const int ch=c0+s; if(ch>=0){ glds16(ksrc+(long)ch*KVBLK*DM,(unsigned)__builtin_amdgcn_readfirstlane(kdst+s*SLOTB)); glds16(vsrc+(long)ch*KVBLK*DM,(unsigned)__builtin_amdgcn_readfirstlane(vdst+s*SLOTB)); } }
  bf16x8 qr[4];
  #pragma unroll
  for(int d0=0;d0<4;++d0)qr[d0]=*reinterpret_cast<const bf16x8*>(&Qw[(long)r32*DM+d0*16+hi*8]);
  WAIT_BAR(0);
  const int wc=wid>>1, qrel=(wid&1)*32+r32;
  f32x16 zero=f32x16{}; asm volatile("":"+v"(zero));
  f32x16 S[3][2];
  #pragma unroll
  for(int t=0;t<3;++t){
    if(c0+wc+t>=0){
      qkt(S[t][0],S[t][1],shm+SWA_K+(wc+t)*SLOTB,qr,zero,r32,hi);
      const float qf=(float)(64*(2-t)+qrel-4*hi);
      #pragma unroll
      for(int r=0;r<16;++r){ const float dd=qf-(float)((r&3)+8*(r>>2)); S[t][0][r]=__builtin_fmaf(-slope2,__builtin_fabsf(dd),S[t][0][r]); S[t][1][r]=__builtin_fmaf(-slope2,__builtin_fabsf(dd-32.f),S[t][1][r]); }
    } else {
      #pragma unroll
      for(int r=0;r<16;++r){ S[t][0][r]=-INFINITY; S[t][1][r]=-INFINITY; }
    }
  }
  float m=sink2;
  #pragma unroll
  for(int t=0;t<3;++t) m=__builtin_fmaxf(m,rowmax(S[t][0],S[t][1]));
  float l=0.f;
  #pragma unroll
  for(int t=0;t<3;++t){
    #pragma unroll
    for(int r=0;r<16;++r){ S[t][0][r]=__builtin_amdgcn_exp2f(S[t][0][r]-m); S[t][1][r]=__builtin_amdgcn_exp2f(S[t][1][r]-m); l+=S[t][0][r]+S[t][1][r]; }
  }
  {auto rr=__builtin_amdgcn_permlane32_swap(__float_as_uint(l),__float_as_uint(l),false,false);l=__uint_as_float(rr[0])+__uint_as_float(rr[1]);}
  l+=__builtin_amdgcn_exp2f(sink2-m);
  f32x16 o[2];o[0]=f32x16{};o[1]=f32x16{};
  const int vb0=(int)(lds0+SWA_V)+((lane>>4)&1)*32+(lane&3)*8+(4*hi+((lane&15)>>2))*64;
  #pragma unroll
  for(int t=0;t<3;++t){
    if(c0+wc+t>=0){
      #define PKW(P,B) cvtpk_s(P[B],P[B+1])
      const u32x4 pw0=(u32x4){PKW(S[t][0],0),PKW(S[t][0],2),PKW(S[t][0],4),PKW(S[t][0],6)},pw1=(u32x4){PKW(S[t][0],8),PKW(S[t][0],10),PKW(S[t][0],12),PKW(S[t][0],14)};
      const u32x4 pw2=(u32x4){PKW(S[t][1],0),PKW(S[t][1],2),PKW(S[t][1],4),PKW(S[t][1],6)},pw3=(u32x4){PKW(S[t][1],8),PKW(S[t][1],10),PKW(S[t][1],12),PKW(S[t][1],14)};
      #undef PKW
      SBAR(); pv(o,vb0+(wc+t)*SLOTB,__builtin_bit_cast(bf16x8,pw0),__builtin_bit_cast(bf16x8,pw1),__builtin_bit_cast(bf16x8,pw2),__builtin_bit_cast(bf16x8,pw3));
    }
  }
  if(hi==0)wsf[32+r32]=l;asm volatile("s_waitcnt lgkmcnt(0)":::"memory");
  float rli[16];
  #pragma unroll
  for(int r=0;r<16;++r)rli[r]=__builtin_amdgcn_rcpf(wsf[32+crow(r,hi)]);
  bf16*Ow=Oh+(long)(q0+wid*QBLK)*DM;
  { bf16*stg=(bf16*)(shm+SWA_OST)+wid*2048;
    #pragma unroll
    for(int r=0;r<16;++r){const int orow=crow(r,hi);
      #pragma unroll
      for(int d0=0;d0<2;++d0)stg[orow*64+d0*32+r32]=__float2bfloat16(o[d0][r]*rli[r]);}
    asm volatile("s_waitcnt lgkmcnt(0)":::"memory");
    #pragma unroll
    for(int i=0;i<4;++i){const int row=i*8+(lane>>3),ch=lane&7; const u32x4 v=*(const u32x4*)(stg+row*64+ch*8); ATTN_STORE16(Ow+(long)row*DM+ch*8,v);} }
  asm volatile("s_waitcnt lgkmcnt(0)\n\ts_barrier":::"memory");
}

#undef SBAR
#undef WAIT_BAR
}

namespace cg = cooperative_groups;
constexpr int NWAVES = 8;
constexpr int BATCH = 2, T = 8192, D = 1024, FF = 4096, PLE = 256, DIN_SRC = 4360, NZ = 4352, M = BATCH * T;
constexpr float RMS_EPS = 1e-6f, LOG2E = 1.4426950408889634f;
constexpr size_t MiB = 1u << 20;
constexpr size_t WS_WIN = 0, WS_WA = 9 * MiB, WS_WB = 10 * MiB, WS_WMIX = 11 * MiB, WS_W1 = 13 * MiB, WS_W2 = 21 * MiB, WS_WG = 29 * MiB, WS_WP = 31 * MiB;
constexpr size_t WS_LF = 31 * MiB + 512 * 1024, WS_CB = 32 * MiB;
constexpr size_t WS_NM = 32 * MiB + 512 * 1024;
constexpr size_t WS_ST1 = 33 * MiB, WS_ST2 = 34 * MiB, WS_ST3 = 35 * MiB;
constexpr size_t WS_PB = 36 * MiB;
constexpr size_t WS_XN = 44 * MiB;
constexpr size_t WS_HN = 76 * MiB;
constexpr size_t WS_Z = 108 * MiB;
constexpr size_t WS_CTL = 244 * MiB, CTL_ZERO_BYTES = 16384;
constexpr size_t WS_END = 245 * MiB;
constexpr int RING_BYTES = 131072, LDS_BYTES = 147456, MISC_OFF = RING_BYTES + 320;
#define GAS __attribute__((address_space(1)))
#define LAS __attribute__((address_space(3)))
typedef unsigned short bf16;
typedef unsigned v4u __attribute__((ext_vector_type(4)));
typedef unsigned v2u __attribute__((ext_vector_type(2)));
typedef float f32x4 __attribute__((ext_vector_type(4)));
#define LDS_WAIT() asm volatile("s_waitcnt lgkmcnt(0)" ::: "memory")
__device__ __forceinline__ unsigned f2bf(float f) { unsigned u = __builtin_bit_cast(unsigned, f); return (u + 0x7fffu + ((u >> 16) & 1u)) >> 16; }
__device__ __forceinline__ unsigned pk2(float lo, float hi) { return f2bf(lo) | (f2bf(hi) << 16); }
__device__ __forceinline__ float wave_sum(float v) {
#pragma unroll
    for (int o = 1; o < 64; o <<= 1) v += __shfl_xor(v, o);
    return v;
}
#define RLX_AGENT __ATOMIC_RELAXED, __HIP_MEMORY_SCOPE_AGENT
#define XB_TMO      128
#define XB_XCNT(j)  (256  + 64 * (j))
#define XB_XSUB(j)  (1280 + 64 * (j))
#define XB_XGEN(j)  (2304 + 64 * (j))
#define XB_TOP      3328
#define XB_TOPGEN   3392
#define XCD_BAR_WORDS 3456
#define XB_SPIN_CAP (1u << 18)

__device__ __forceinline__ unsigned xb_ld(unsigned* p)              { return __hip_atomic_load(p, __ATOMIC_RELAXED, __HIP_MEMORY_SCOPE_AGENT); }
__device__ __forceinline__ unsigned xb_add(unsigned* p, unsigned v) { return __hip_atomic_fetch_add(p, v, __ATOMIC_RELAXED, __HIP_MEMORY_SCOPE_AGENT); }
__device__ __forceinline__ unsigned xb_xcc_id() { return (unsigned)__builtin_amdgcn_s_getreg((3 << 11) | 20) & 0xFu; }
#define XB_SPIN(cond, bar) do { unsigned _sp = 0; while (cond) { __builtin_amdgcn_s_sleep(1); \
    if ((++_sp & 255u) == 0u) { if (xb_ld(&(bar)[XB_TMO])) break; if (_sp > XB_SPIN_CAP) { atomicAdd(&(bar)[XB_TMO], 1u); break; } } } } while (0)

struct XcdBarrier {
    unsigned* bar; unsigned x;
    volatile LAS unsigned* st;
};

__device__ __forceinline__ XcdBarrier xcd_barrier_post(unsigned* bar, volatile LAS unsigned* st) {
    XcdBarrier b; b.bar = bar; b.x = xb_xcc_id(); b.st = st;
    if (threadIdx.x == 0) (void)xb_add(&bar[XB_XCNT(b.x)], 1u);
    return b;
}
__device__ __forceinline__ void xcd_barrier_complete(unsigned* bar, unsigned x, unsigned& nloc, unsigned& nx) {
    const unsigned G = gridDim.x * gridDim.y * gridDim.z;
    unsigned sum, cnt, mine, sp = 0u;
    for (;;) {
        sum = 0u; cnt = 0u; mine = 0u;
#pragma unroll
        for (unsigned j = 0; j < 16; ++j) { const unsigned c = xb_ld(&bar[XB_XCNT(j)]); sum += c; cnt += (c > 0u) ? 1u : 0u; mine = (j == x) ? c : mine; }
        if (sum == G) break;
        __builtin_amdgcn_s_sleep(1);
        if ((++sp & 255u) == 0u) { if (xb_ld(&bar[XB_TMO])) break; if (sp > XB_SPIN_CAP) { atomicAdd(&bar[XB_TMO], 1u); break; } }
    }
    nloc = mine > 0u ? mine : 1u; nx = cnt > 0u ? cnt : 1u;
}

__device__ __forceinline__ void xcd_barrier(const XcdBarrier& b, const bool t0) {
    asm volatile("s_waitcnt vmcnt(0)" ::: "memory");
    __syncthreads();
    if (t0) {
        unsigned* bar = b.bar;
        __builtin_amdgcn_s_waitcnt(0);
        unsigned nloc = b.st[0], nx = b.st[1];
        if (nloc == 0u) { xcd_barrier_complete(bar, b.x, nloc, nx); b.st[0] = nloc; b.st[1] = nx; }
        const unsigned old = xb_add(&bar[XB_XSUB(b.x)], 1u);
        const unsigned gen = old / nloc;
        if (old + 1u == (gen + 1u) * nloc) {
            __builtin_amdgcn_fence(__ATOMIC_RELEASE, "agent");
            asm volatile("s_waitcnt vmcnt(0)" ::: "memory");
            const unsigned og = xb_add(&bar[XB_TOP], 1u);
            const unsigned tg = og / nx;
            if (og + 1u == (tg + 1u) * nx) xb_add(&bar[XB_TOPGEN], 1u);
            else XB_SPIN(xb_ld(&bar[XB_TOPGEN]) == tg, bar);
            __builtin_amdgcn_fence(__ATOMIC_ACQUIRE, "agent");
            xb_add(&bar[XB_XGEN(b.x)], 1u);
            asm volatile("s_waitcnt vmcnt(0)" ::: "memory");
        } else {
            XB_SPIN(xb_ld(&bar[XB_XGEN(b.x)]) == gen, bar);
            __builtin_amdgcn_fence(__ATOMIC_ACQUIRE, "agent");
            asm volatile("s_waitcnt vmcnt(0)" ::: "memory");
        }
    }
    __syncthreads();
}
struct Frame {
    LAS unsigned char* lds; int wave, vcu, G;
};
__device__ __forceinline__ void p0_transpose_item(const float* W, int ldw, int K, int N, int split, int extra, const float* gs, bf16* WT, LAS float* scr, int item, int lane) {
    const int nblk = N / 32, kb = item / nblk, nb = item % nblk, k0 = 64 * kb, n0 = 32 * nb, s0 = n0 + (n0 >= split ? extra : 0);
    const float* src = W + (size_t)(k0 + (lane >> 5)) * ldw + s0 + (lane & 31);
    float w[32];
#pragma unroll
    for (int i = 0; i < 32; ++i) w[i] = src[(size_t)(2 * i) * ldw];
    const int c = lane & 7;
    f32x4 g0 = (f32x4){1.f, 1.f, 1.f, 1.f}, g1 = g0;
    if (gs) { g0 = *(const f32x4*)(gs + k0 + 8 * c); g1 = *(const f32x4*)(gs + k0 + 8 * c + 4); }
#pragma unroll
    for (int i = 0; i < 32; ++i) scr[(2 * i + (lane >> 5)) * 33 + (lane & 31)] = w[i];
    LDS_WAIT(); asm volatile("" ::: "memory");
#pragma unroll
    for (int j = 0; j < 4; ++j) { const int n = (lane >> 3) + 8 * j; const LAS float* s = scr + (8 * c) * 33 + n;
        v4u o; o.x = pk2(s[0 * 33] * g0.x, s[1 * 33] * g0.y); o.y = pk2(s[2 * 33] * g0.z, s[3 * 33] * g0.w); o.z = pk2(s[4 * 33] * g1.x, s[5 * 33] * g1.y); o.w = pk2(s[6 * 33] * g1.z, s[7 * 33] * g1.w);
        *(GAS v4u*)(WT + (size_t)(n0 + n) * K + k0 + 8 * c) = o; }
    LDS_WAIT(); asm volatile("" ::: "memory");
}
struct Args { const float* in[16]; float* out; unsigned char* ws; };
constexpr int WF_OFF = 8 * 8704;

__global__ void __launch_bounds__(NWAVES * 64, 2) mk_fwd(Args args) {
    extern __shared__ __attribute__((aligned(16))) unsigned char lds[];
    cg::grid_group grid = cg::this_grid();
    Frame F;
    F.lds = (LAS unsigned char*)lds;
    F.wave = __builtin_amdgcn_readfirstlane((int)threadIdx.x >> 6);
    F.G = gridDim.x; { const int bx = blockIdx.x; F.vcu = (F.G % 8 == 0) ? (bx % 8) * (F.G / 8) + bx / 8 : bx; }
    unsigned char* ws = args.ws;
    const float* x = args.in[0]; const float* p_in = args.in[1]; const float* g_mix = args.in[2]; const float* w_in = args.in[3]; const float* b_forget = args.in[4];
    const float* sinks = args.in[5]; const float* w_br_swa = args.in[6]; const float* w_br_fox = args.in[7]; const float* w_mix = args.in[8]; const float* g_mlp = args.in[9];
    const float* w_ff1 = args.in[10]; const float* w_ff2 = args.in[11]; const float* g_ple = args.in[12]; const float* w_pg = args.in[13]; const float* w_pp = args.in[14]; const float* g_final = args.in[15];
    float* out = args.out;
    bf16 *WIN_t = (bf16*)(ws + WS_WIN), *WA_t = (bf16*)(ws + WS_WA), *WB_t = (bf16*)(ws + WS_WB), *WMIX_t = (bf16*)(ws + WS_WMIX), *W1_t = (bf16*)(ws + WS_W1), *W2_t = (bf16*)(ws + WS_W2), *WG_t = (bf16*)(ws + WS_WG), *WP_t = (bf16*)(ws + WS_WP);
    float *LF = (float*)(ws + WS_LF), *CB = (float*)(ws + WS_CB), *ST1 = (float*)(ws + WS_ST1), *ST2 = (float*)(ws + WS_ST2), *ST3 = (float*)(ws + WS_ST3);
    bf16 *PB = (bf16*)(ws + WS_PB), *XN = (bf16*)(ws + WS_XN), *HN = (bf16*)(ws + WS_HN), *Z = (bf16*)(ws + WS_Z), *HB = (bf16*)(ws + WS_Z); bf16* PP = (bf16*)(ws + WS_Z);
    unsigned* NM = (unsigned*)(ws + WS_NM);
    const int gw = F.vcu * NWAVES + F.wave, NGW = F.G * NWAVES;

    for (int u = threadIdx.x; u < 128; u += NWAVES * 64) ((LAS unsigned*)(F.lds + RING_BYTES))[u] = 0u;
    __syncthreads();
    XcdBarrier bar = xcd_barrier_post((unsigned*)(ws + WS_CTL), (volatile LAS unsigned*)(F.lds + MISC_OFF) + 8);
#define GRID_BAR() do { const int l_ = fresh_lane(); xcd_barrier(bar, (F.wave == 0) && (l_ == 0)); } while (0)
    {
        const int p0_tid = threadIdx.x, p0_lane = p0_tid & 63;
        for (int i = blockIdx.x * (NWAVES * 64) + p0_tid; i < 1024 + 32; i += F.G * NWAVES * 64) NM[i] = 0u;
        LAS float* wfT = (LAS float*)(F.lds + WF_OFF);
        for (int i = p0_tid; i < 8 * D; i += NWAVES * 64) { const int k = i >> 3, h = i & 7; wfT[h * 1024 + k] = g_mix[k] * w_in[(size_t)k * DIN_SRC + 2304 + h]; }
        __syncthreads();
        f32x4 gm4[4];
#pragma unroll
        for (int j = 0; j < 4; ++j) gm4[j] = ((const GAS f32x4*)g_mix)[64 * j + p0_lane];
        const float bfg = b_forget[p0_lane & 7];
        f32x4 v[4];
        if (gw < M) { const GAS f32x4* xr = (const GAS f32x4*)(x + (size_t)gw * D) + p0_lane;
#pragma unroll
            for (int j = 0; j < 4; ++j) v[j] = xr[64 * j]; }
        for (int m = gw; m < M; m += NGW) {
            f32x4 vn[4]; const int mn = (m + NGW < M) ? m + NGW : m;
            { const GAS f32x4* xr = (const GAS f32x4*)(x + (size_t)mn * D) + p0_lane;
#pragma unroll
              for (int j = 0; j < 4; ++j) vn[j] = xr[64 * j]; }
            float ss = 0.f;
#pragma unroll
            for (int j = 0; j < 4; ++j) ss += (v[j].x * v[j].x + v[j].y * v[j].y) + (v[j].z * v[j].z + v[j].w * v[j].w);
            float a8[8];
#pragma unroll
            for (int h = 0; h < 8; ++h) { float a = 0.f;
#pragma unroll
                for (int j = 0; j < 4; ++j) { const f32x4 w = ((const LAS f32x4*)wfT)[h * 256 + 64 * j + p0_lane]; a += (v[j].x * w.x + v[j].y * w.y) + (v[j].z * w.z + v[j].w * w.w); }
                a8[h] = a; }
#pragma unroll
            for (int o = 1; o < 64; o <<= 1) { ss += __shfl_xor(ss, o);
#pragma unroll
                for (int h = 0; h < 8; ++h) a8[h] += __shfl_xor(a8[h], o); }
            const float rstd = 1.f / sqrtf(ss * (1.f / D) + RMS_EPS);
            float fsel = a8[0];
#pragma unroll
            for (int h = 1; h < 8; ++h) fsel = (p0_lane == h) ? a8[h] : fsel;
            if (p0_lane < 8) { const float xf = fsel * rstd + bfg; const float ls = fminf(xf, 0.f) - log1pf(expf(-fabsf(xf)));
                LF[(size_t)((m >> 13) * 8 + p0_lane) * T + (m & (T - 1))] = ls; }
            GAS unsigned long long* o8 = (GAS unsigned long long*)(XN + (size_t)m * D) + p0_lane;
#pragma unroll
            for (int j = 0; j < 4; ++j) { const f32x4 y = v[j] * rstd * gm4[j];
                o8[64 * j] = (unsigned long long)pk2(y.x, y.y) | ((unsigned long long)pk2(y.z, y.w) << 32); }
#pragma unroll
            for (int j = 0; j < 4; ++j) v[j] = vn[j];
        }
        LAS float* scr = (LAS float*)(F.lds + F.wave * 8704);
        constexpr int I_IN = (D / 64) * (NZ / 32);
        for (int it = gw; it < I_IN; it += NGW) p0_transpose_item(w_in, DIN_SRC, D, NZ, 2304, 8, nullptr, WIN_t, scr, it, p0_lane);
    }
    grid.sync();

    for (int bh = (F.G >= 96) ? (int)blockIdx.x - 64 : (int)blockIdx.x; bh < 16; bh += (int)gridDim.x) {
        if (bh < 0) continue;
        const int c_lane = fresh_lane(), c_tid = F.wave * 64 + c_lane;
        const GAS f32x4* src = (const GAS f32x4*)(LF + (size_t)bh * T) + c_tid * 4;
        f32x4 v[4]; float run = 0.f;
#pragma unroll
        for (int j = 0; j < 4; ++j) { v[j] = src[j];
#pragma unroll
            for (int e = 0; e < 4; ++e) { run += v[j][e]; v[j][e] = run; } }
        float sc = run;
#pragma unroll
        for (int o = 1; o < 64; o <<= 1) { const float n = __shfl_up(sc, o); if (c_lane >= o) sc += n; }
        LAS float* wt = (LAS float*)F.lds;
        if (c_lane == 63) wt[F.wave] = sc;
        __syncthreads();
        float woff = 0.f;
        for (int w = 0; w < F.wave; ++w) woff += wt[w];
        const float off = woff + sc - run;
        GAS f32x4* dst = (GAS f32x4*)(CB + (size_t)bh * T) + c_tid * 4;
#pragma unroll
        for (int j = 0; j < 4; ++j) dst[j] = (v[j] + off) * (-LOG2E);
        __syncthreads();
    }
    {
        pg8::Gemm g{XN, WIN_t, M, NZ, D, D}; pg8::StaticOrder S; S.init(M, NZ, F.G, (int)blockIdx.x);
        pg8::EpiZ E{Z, NM, 0};
        pg8::gemm_phase<pg8::EpiZ, pg8::StaticOrder, PG8_ALIGN, PG8_SP2>(F.lds, g, S, E, F.wave);
    }
    {
        const int nfive = (M / 256) * (NZ / 256) - 4 * F.G;
        const int nconv = (nfive > 0 && nfive < F.G) ? F.G - nfive : F.G, cidx = (nfive > 0 && nfive < F.G) ? (int)blockIdx.x - nfive : (int)blockIdx.x;
        if (cidx >= 0) {
            const int w_lane = fresh_lane();
            LAS float* scr = (LAS float*)(F.lds + F.wave * 8704);
            for (int i = (cidx * NWAVES + F.wave) * 64 + w_lane; i < M * PLE / 32; i += nconv * NWAVES * 64) { f32x4 a[8];
#pragma unroll
            for (int q = 0; q < 4; ++q) { a[2 * q] = ((const GAS f32x4*)p_in)[2 * (i + q * (M * PLE / 32))]; a[2 * q + 1] = ((const GAS f32x4*)p_in)[2 * (i + q * (M * PLE / 32)) + 1]; }
#pragma unroll
            for (int q = 0; q < 4; ++q) { v4u o; o.x = pk2(a[2 * q].x, a[2 * q].y); o.y = pk2(a[2 * q].z, a[2 * q].w); o.z = pk2(a[2 * q + 1].x, a[2 * q + 1].y); o.w = pk2(a[2 * q + 1].z, a[2 * q + 1].w); ((GAS v4u*)PB)[i + q * (M * PLE / 32)] = o; } }
            constexpr int I_A = (512 / 64) * (D / 32), I_MIX = (D / 64) * (D / 32), I_1 = (D / 64) * (FF / 32), I_2 = (FF / 64) * (D / 32), I_P = (PLE / 64) * (D / 32);
            constexpr int NITEMS = 2 * I_A + I_MIX + I_1 + I_2 + I_MIX + I_P;
            for (int it = cidx * NWAVES + F.wave; it < NITEMS; it += nconv * NWAVES) {
                int r = it;
                if (r < I_A) { p0_transpose_item(w_br_swa, D, 512, D, 1 << 30, 0, nullptr, WA_t, scr, r, w_lane); continue; } r -= I_A;
                if (r < I_A) { p0_transpose_item(w_br_fox, D, 512, D, 1 << 30, 0, nullptr, WB_t, scr, r, w_lane); continue; } r -= I_A;
                if (r < I_MIX) { p0_transpose_item(w_mix, D, D, D, 1 << 30, 0, nullptr, WMIX_t, scr, r, w_lane); continue; } r -= I_MIX;
                if (r < I_1) { p0_transpose_item(w_ff1, FF, D, FF, 1 << 30, 0, g_mlp, W1_t, scr, r, w_lane); continue; } r -= I_1;
                if (r < I_2) { p0_transpose_item(w_ff2, D, FF, D, 1 << 30, 0, nullptr, W2_t, scr, r, w_lane); continue; } r -= I_2;
                if (r < I_MIX) { p0_transpose_item(w_pg, D, D, D, 1 << 30, 0, g_ple, WG_t, scr, r, w_lane); continue; } r -= I_MIX;
                p0_transpose_item(w_pp, D, PLE, D, 1 << 30, 0, nullptr, WP_t, scr, r, w_lane);
            }
        }
    }
    GRID_BAR();

    {
        unsigned* qctr = (unsigned*)(ws + WS_CTL) + 3584;
        volatile LAS unsigned* qslot = (volatile LAS unsigned*)(F.lds + RING_BYTES + 16);
        for (;;) {
            { const int l_ = fresh_lane(); if (F.wave == 0 && l_ == 0) qslot[0] = __hip_atomic_fetch_add(qctr, 1u, __ATOMIC_RELAXED, __HIP_MEMORY_SCOPE_AGENT); }
            __syncthreads();
            const int idx = __builtin_amdgcn_readfirstlane((int)qslot[0]);
            __syncthreads();
            if (idx >= 64 + 512 + 512) break;
            if (idx < 64) {
                continue;
            } else if (idx < 64 + 512) {
                const int j = idx - 64, qb = 31 - (j >> 4), bh = j & 15, b = bh >> 3, h = bh & 7;
                const attn_body::bf16* Zb = (const attn_body::bf16*)Z + (size_t)b * T * NZ;
                const attn_body::bf16* Qh = Zb + 768 + h * 64; const attn_body::bf16* Kh = Zb + 1280 + h * 64; const attn_body::bf16* Vh = Zb + 1792 + h * 64;
                const float* cb = CB + (size_t)bh * T;
                const float km = sqrtf(__uint_as_float(NM[1024 + bh * 2]) + __uint_as_float(NM[1024 + bh * 2 + 1]));
                const int pmA = b * 32 + qb;
                const float qkA = 2.04f * km * sqrtf(__uint_as_float(NM[(pmA * 8 + h) * 2]) + __uint_as_float(NM[(pmA * 8 + h) * 2 + 1]));
                attn_body::attn_unit<24>(F.wave, qb, Qh, Kh, Vh, (attn_body::bf16*)Qh, cb, qkA, (char*)lds);
            } else {
                const int j = idx - 64 - 512, bh = j >> 5, qb = j & 31, b = bh >> 3, h = bh & 7;
                const attn_body::bf16* Zb = (const attn_body::bf16*)Z + (size_t)b * T * NZ;
                const attn_body::bf16* Qh = Zb + h * 64; const attn_body::bf16* Kh = Zb + 512 + (h >> 2) * 64; const attn_body::bf16* Vh = Zb + 640 + (h >> 2) * 64;
                const float slope2 = exp2f(-(float)(h + 1)) * LOG2E, sink2 = sinks[h] * LOG2E;
                attn_body::swa_unit(F.wave, qb, Qh, Kh, Vh, (attn_body::bf16*)Qh, slope2, sink2, (char*)lds);
            }
        }
    }
    GRID_BAR();

    {
        pg8::PairOrder S; S.so.init(M, D, F.G, (int)blockIdx.x);
        pg8::Gemm g{Z, WA_t, M, D, 512, NZ}; pg8::EpiPair E{Z + 2304, Z + 3328, XN, (size_t)768 * 2, (size_t)(WS_WB - WS_WA)};
        pg8::gemm_phase<pg8::EpiPair, pg8::PairOrder, PG8_ALIGN, PG8_SP2>(F.lds, g, S, E, F.wave);
    }
    GRID_BAR();

    {
        pg8::Gemm g{XN, WMIX_t, M, D, D, D}; pg8::StaticOrder S; S.init(M, D, F.G, (int)blockIdx.x);
        pg8::EpiRes<false> E{x, HN, ST1};
        pg8::gemm_phase<pg8::EpiRes<false>, pg8::StaticOrder, PG8_ALIGN, PG8_SP2>(F.lds, g, S, E, F.wave);
    }
    GRID_BAR();

    {
        pg8::Gemm g{HN, W1_t, M, FF, D, D}; pg8::StaticOrder S; S.init(M, FF, F.G, (int)blockIdx.x);
        pg8::EpiRelu2 E{ST1, HB};
        pg8::gemm_phase<pg8::EpiRelu2, pg8::StaticOrder, PG8_ALIGN, PG8_SP2>(F.lds, g, S, E, F.wave);
    }
    GRID_BAR();

    {
        pg8::Gemm g{HB, W2_t, M, D, FF, FF}; pg8::StaticOrder S; S.init(M, D, F.G, (int)blockIdx.x);
        pg8::EpiRes<true> E{HN, XN, ST2};
        pg8::gemm_phase<pg8::EpiRes<true>, pg8::StaticOrder, PG8_ALIGN, PG8_SP2>(F.lds, g, S, E, F.wave);
    }
    GRID_BAR();

    {
        pg8::StaticOrder S; S.init(M, D, F.G, (int)blockIdx.x);
        { pg8::Gemm g{PB, WP_t, M, D, PLE, PLE}; pg8::EpiPP E{PP}; pg8::gemm_phase<pg8::EpiPP, pg8::StaticOrder, PG8_ALIGN, PG8_SP2>(F.lds, g, S, E, F.wave); }
        { pg8::Gemm g{XN, WG_t, M, D, D, D}; pg8::EpiPle E{ST2, PP, XN, HN, ST3}; pg8::gemm_phase<pg8::EpiPle, pg8::StaticOrder, PG8_ALIGN, PG8_SP2>(F.lds, g, S, E, F.wave); }
    }
    GRID_BAR();

    const int f_lane = fresh_lane();
    for (int m = gw; m < M; m += NGW) {
        float t = (f_lane < 16) ? ST3[(size_t)m * 16 + f_lane] : 0.f;
        const float rstd = 1.f / sqrtf(wave_sum(t) * (1.f / D) + RMS_EPS);
        const GAS v2u* hr = (const GAS v2u*)(HN + (size_t)m * D) + f_lane;
        GAS f32x4* xr = (GAS f32x4*)(out + (size_t)m * D) + f_lane;
#pragma unroll
        for (int j = 0; j < 4; ++j) { const v2u hv = hr[64 * j]; const f32x4 gm = ((const GAS f32x4*)g_final)[64 * j + f_lane];
            const f32x4 hf = (f32x4){__uint_as_float(hv.x << 16), __uint_as_float(hv.x & 0xffff0000u), __uint_as_float(hv.y << 16), __uint_as_float(hv.y & 0xffff0000u)};
            xr[64 * j] = hf * rstd * gm; }
    }
}

extern "C" void kernel_launch(void* const* d_in, const int* in_sizes, int n_in, void* d_out, int out_size, void* d_ws, size_t ws_size, hipStream_t stream) {
    static int grid = 0;
    if (grid == 0) {
        if (n_in != 16 || in_sizes[0] != M * D || out_size != M * D || ws_size < WS_END) { fprintf(stderr, "kernel_launch: unexpected shapes (n_in %d, in0 %d, out %d, ws %zu); nothing launched\n", n_in, n_in > 0 ? in_sizes[0] : -1, out_size, ws_size); grid = -1; return; }
        int dev = 0, cus = 0, per_cu = 0;
        if (hipGetDevice(&dev) != hipSuccess || hipDeviceGetAttribute(&cus, hipDeviceAttributeMultiprocessorCount, dev) != hipSuccess) { grid = -1; return; }
        if (hipFuncSetAttribute((const void*)mk_fwd, hipFuncAttributeMaxDynamicSharedMemorySize, LDS_BYTES) != hipSuccess) { fprintf(stderr, "kernel_launch: hipFuncSetAttribute failed\n"); grid = -1; return; }
        if (hipOccupancyMaxActiveBlocksPerMultiprocessor(&per_cu, (const void*)mk_fwd, NWAVES * 64, LDS_BYTES) != hipSuccess || per_cu < 1) { fprintf(stderr, "kernel_launch: occupancy query failed (%d)\n", per_cu); (void)hipGetLastError(); per_cu = 1; }
        if (per_cu > 1) per_cu = 1;
        grid = cus * per_cu;
    }
    if (grid < 0) return;
    if (hipMemsetAsync((char*)d_ws + WS_CTL, 0, CTL_ZERO_BYTES, stream) != hipSuccess) { fprintf(stderr, "kernel_launch: memset failed\n"); return; }
    Args a{};
    for (int i = 0; i < 16; ++i) a.in[i] = (const float*)d_in[i];
    a.out = (float*)d_out; a.ws = (unsigned char*)d_ws;
    void* kargs[] = {&a};
    hipError_t e = hipLaunchCooperativeKernel((const void*)mk_fwd, dim3(grid), dim3(NWAVES * 64), kargs, LDS_BYTES, stream);
    if (e != hipSuccess) fprintf(stderr, "kernel_launch: cooperative launch failed: %s (grid %d)\n", hipGetErrorString(e), grid);
}
```

```cpp
#include <hip/hip_runtime.h>
#include <hip/hip_cooperative_groups.h>
#include <cstdio>
#include <cstdint>
__device__ __forceinline__ int fresh_lane() { int l; asm volatile("v_mbcnt_lo_u32_b32 %0, -1, 0\n\tv_mbcnt_hi_u32_b32 %0, -1, %0" : "=v"(l)); return l; }

namespace pg8 {

#define PG8_LAS __attribute__((address_space(3)))
typedef unsigned short bf16_t;
typedef short bf16x8 __attribute__((ext_vector_type(8)));
typedef float f32x4 __attribute__((ext_vector_type(4)));
typedef unsigned u32x4 __attribute__((ext_vector_type(4)));
constexpr int BM = 256, BK = 64, HALF = 128, HTB = HALF * BK * 2  , STAGE_BYTES = 8 * HTB, NXCD = 8, WGM = 8;

__host__ __device__ __forceinline__ int lds_byte(int r, int c) { const int st = (r >> 4) * 2 + (c >> 5), rr = r & 15, cc = c & 31, ob = rr * 64 + cc * 2; return st * 1024 + (ob ^ (((ob >> 9) & 1) << 5)); }
__host__ __device__ __forceinline__ void stage_rc(int b, int& R, int& C) { const int st = b / 1024, sb = b % 1024, swz = sb ^ (((sb >> 9) & 1) << 5); R = (st >> 1) * 16 + swz / 64; C = (st & 1) * 32 + (swz % 64) / 2; }
__host__ __device__ __forceinline__ int perm32(int rho) { const int n = rho >> 4, i = rho & 15; return 8 * (i >> 2) + 4 * n + (i & 3); }

struct Unit { int pm, pn, part; };
struct Gemm { const bf16_t* A; const bf16_t* Bt; int M, N, K, lda; };

struct StaticOrder {
    int nM, nN, nwg, G, c;
    __host__ __device__ void init(int M, int N, int G_, int c_) { nM = M / BM; nN = N / BM; nwg = nM * nN; G = G_; c = c_; }
    __host__ __device__ bool next(int i, Unit& u) const {
        const long L = (long)i * G + c; if (L >= nwg) return false;
        int wgid = (int)L; { const int q = nwg / NXCD, r = nwg % NXCD, xcd = wgid % NXCD, off = wgid / NXCD; wgid = (xcd < r ? xcd * (q + 1) : r * (q + 1) + (xcd - r) * q) + off; }
        const int nig = WGM * nN, gid = wgid / nig, fm = gid * WGM, gsz = (nM - fm) < WGM ? (nM - fm) : WGM;
        u.pm = fm + ((wgid % nig) % gsz); u.pn = (wgid % nig) / gsz; return true;
    }
    __device__ __forceinline__ void a_ready(const Unit&) const {}
    __device__ __forceinline__ void done(const Unit&) const {}
};

__device__ __forceinline__ unsigned cvt_pk_bf16(float lo, float hi) { unsigned r; asm volatile("v_cvt_pk_bf16_f32 %0, %1, %2" : "=v"(r) : "v"(lo), "v"(hi)); return r; }
typedef float f32x2 __attribute__((ext_vector_type(2)));
struct OneUnit { int pm, pn; __device__ bool next(int i, Unit& u) const { if (i) return false; u.pm = pm; u.pn = pn; return true; } __device__ __forceinline__ void a_ready(const Unit&) const {} __device__ __forceinline__ void done(const Unit&) const {} };
constexpr int ZP = 4352;
constexpr float C2F = 0.125f * 1.4426950408889634f;
__device__ __forceinline__ float sigmoidf_fast(float x) { return __builtin_amdgcn_rcpf(1.0f + __builtin_amdgcn_exp2f(-1.4426950408889634f * x)); }
__device__ __forceinline__ f32x4 bf4_lo(unsigned a, unsigned b) { return (f32x4){__uint_as_float(a << 16), __uint_as_float(a & 0xffff0000u), __uint_as_float(b << 16), __uint_as_float(b & 0xffff0000u)}; }
__device__ __forceinline__ u32x4 pack8(f32x4 v0, f32x4 v1) { u32x4 w; w.x = cvt_pk_bf16(v0[0], v0[1]); w.y = cvt_pk_bf16(v0[2], v0[3]); w.z = cvt_pk_bf16(v1[0], v1[1]); w.w = cvt_pk_bf16(v1[2], v1[3]); return w; }
__device__ __forceinline__ float rstd_from_stats(const float* st, int row) { const f32x4* s = (const f32x4*)(st + (size_t)row * 16); const f32x4 a = s[0], b = s[1], c = s[2], d = s[3];
    const float t = ((a[0] + a[1]) + (a[2] + a[3])) + ((b[0] + b[1]) + (b[2] + b[3])) + ((c[0] + c[1]) + (c[2] + c[3])) + ((d[0] + d[1]) + (d[2] + d[3])); return 1.0f / sqrtf(t * (1.0f / 1024.0f) + 1e-6f); }
#define EPI_ROWS(...) _Pragma("unroll") for (int ai = 0; ai < 2; ++ai) _Pragma("unroll") for (int m = 0; m < 4; ++m) { const int row = u.pm * BM + ai * HALF + wr * 64 + m * 16 + fr; __VA_ARGS__ asm volatile("" ::: "memory"); }
#define EPI_COLS(...) _Pragma("unroll") for (int bj = 0; bj < 2; ++bj) { const int col = u.pn * BM + bj * HALF + wc * 32 + 8 * fq; const f32x4 a0 = acc[ai][bj][m][0], a1 = acc[ai][bj][m][1]; __VA_ARGS__ }
struct EpiZ { static constexpr bool PERM = true, AFTER_DRAIN = false, PAIRED = false; bf16_t* Z; unsigned* NM; int pn_off;
    __device__ __forceinline__ void operator()(const f32x4 (&acc)[2][2][4][2], const Unit& u, int wr, int wc, int fr, int fq) const {
        const int pn = u.pn + pn_off; const int mode = (pn >= 9) ? 2 : ((pn == 0 || pn == 1 || pn == 3 || pn == 4) ? 1 : 0);
        const bool nrm = (pn >= 3 && pn <= 6); float mx0 = 0.f, mx1 = 0.f;
        EPI_ROWS( bf16_t* rowp = Z + (size_t)row * ZP; EPI_COLS( f32x4 v0 = a0, v1 = a1;
            if (mode == 1) { v0 = v0 * C2F; v1 = v1 * C2F; }
            else if (mode == 2) { _Pragma("unroll") for (int e = 0; e < 4; ++e) { v0[e] = sigmoidf_fast(v0[e]); v1[e] = sigmoidf_fast(v1[e]); } }
            if (nrm) { float ss = ((v0[0] * v0[0] + v0[1] * v0[1]) + (v0[2] * v0[2] + v0[3] * v0[3])) + ((v1[0] * v1[0] + v1[1] * v1[1]) + (v1[2] * v1[2] + v1[3] * v1[3]));
                ss += __shfl_xor(ss, 16); ss += __shfl_xor(ss, 32); if (bj == 0) mx0 = fmaxf(mx0, ss); else mx1 = fmaxf(mx1, ss); }
            *(u32x4*)(rowp + col + pn_off * BM) = pack8(v0, v1); ) )
        if (nrm) {
#pragma unroll
            for (int o = 1; o < 16; o <<= 1) { mx0 = fmaxf(mx0, __shfl_xor(mx0, o)); mx1 = fmaxf(mx1, __shfl_xor(mx1, o)); }
            if (fr == 0 && fq == 0) {
                const int isk = (pn >= 5), cr = (pn - (isk ? 5 : 3)) * 4 + (wc >> 1), half = wc & 1;
                unsigned* b0 = isk ? NM + 1024 + ((u.pm >> 5) * 8 + cr) * 2 + half : NM + (u.pm * 8 + cr) * 2 + half;
                atomicMax(b0, __float_as_uint(mx0 * 1.0001f)); atomicMax(b0 + 4, __float_as_uint(mx1 * 1.0001f));
            } }
    } };
#define EPI_GROUP(NR, ...) _Pragma("unroll") for (int ai = 0; ai < 2; ++ai) _Pragma("unroll") for (int mg = 0; mg < 4; mg += NR) { __VA_ARGS__ asm volatile("" ::: "memory"); }
#define EPI_ROWOF(mm) (u.pm * BM + ai * HALF + wr * 64 + (mm) * 16 + fr)
#define EPI_COLOF(bj) (u.pn * BM + (bj) * HALF + wc * 32 + 8 * fq)
struct EpiT1 { static constexpr bool PERM = true, AFTER_DRAIN = false, PAIRED = false; const bf16_t* G; bf16_t* T;
    __device__ __forceinline__ void operator()(const f32x4 (&acc)[2][2][4][2], const Unit& u, int wr, int wc, int fr, int fq) const {
        EPI_GROUP(4, u32x4 g[4][2];
            _Pragma("unroll") for (int i = 0; i < 4; ++i) _Pragma("unroll") for (int bj = 0; bj < 2; ++bj) g[i][bj] = *(const u32x4*)(G + (size_t)EPI_ROWOF(mg + i) * ZP + EPI_COLOF(bj));
            _Pragma("unroll") for (int i = 0; i < 4; ++i) _Pragma("unroll") for (int bj = 0; bj < 2; ++bj)
                *(u32x4*)(T + (size_t)EPI_ROWOF(mg + i) * 1024 + EPI_COLOF(bj)) = pack8(acc[ai][bj][mg + i][0] * bf4_lo(g[i][bj].x, g[i][bj].y), acc[ai][bj][mg + i][1] * bf4_lo(g[i][bj].z, g[i][bj].w)); )
    } };
struct EpiMix { static constexpr bool PERM = true, AFTER_DRAIN = false, PAIRED = false; const bf16_t* G; const bf16_t* T; bf16_t* O;
    __device__ __forceinline__ void operator()(const f32x4 (&acc)[2][2][4][2], const Unit& u, int wr, int wc, int fr, int fq) const {
        EPI_GROUP(4, u32x4 g[4][2]; u32x4 t[4][2];
            _Pragma("unroll") for (int i = 0; i < 4; ++i) _Pragma("unroll") for (int bj = 0; bj < 2; ++bj) { g[i][bj] = *(const u32x4*)(G + (size_t)EPI_ROWOF(mg + i) * ZP + EPI_COLOF(bj));
                t[i][bj] = *(const u32x4*)(T + (size_t)EPI_ROWOF(mg + i) * 1024 + EPI_COLOF(bj)); }
            _Pragma("unroll") for (int i = 0; i < 4; ++i) _Pragma("unroll") for (int bj = 0; bj < 2; ++bj) {
                const f32x4 v0 = bf4_lo(t[i][bj].x, t[i][bj].y) + acc[ai][bj][mg + i][0] * bf4_lo(g[i][bj].x, g[i][bj].y), v1 = bf4_lo(t[i][bj].z, t[i][bj].w) + acc[ai][bj][mg + i][1] * bf4_lo(g[i][bj].z, g[i][bj].w);
                *(u32x4*)(O + (size_t)EPI_ROWOF(mg + i) * 1024 + EPI_COLOF(bj)) = pack8(v0, v1); } )
    } };
template <bool BASE_BF16> struct EpiRes { static constexpr bool PERM = true, AFTER_DRAIN = false, PAIRED = false; const void* base; bf16_t* hb; float* st;
    __device__ __forceinline__ void operator()(const f32x4 (&acc)[2][2][4][2], const Unit& u, int wr, int wc, int fr, int fq) const {
        EPI_GROUP(4, f32x4 b[4][2][2];
            _Pragma("unroll") for (int i = 0; i < 4; ++i) _Pragma("unroll") for (int bj = 0; bj < 2; ++bj) { const size_t off = (size_t)EPI_ROWOF(mg + i) * 1024 + EPI_COLOF(bj);
                if constexpr (BASE_BF16) { const u32x4 r = *(const u32x4*)((const bf16_t*)base + off); b[i][bj][0] = bf4_lo(r.x, r.y); b[i][bj][1] = bf4_lo(r.z, r.w); }
                else { const float* bp = (const float*)base + off; b[i][bj][0] = *(const f32x4*)bp; b[i][bj][1] = *(const f32x4*)(bp + 4); } }
            _Pragma("unroll") for (int i = 0; i < 4; ++i) { float ss = 0.f; const int row = EPI_ROWOF(mg + i);
                _Pragma("unroll") for (int bj = 0; bj < 2; ++bj) { const size_t off = (size_t)row * 1024 + EPI_COLOF(bj); const f32x4 h0 = b[i][bj][0] + acc[ai][bj][mg + i][0], h1 = b[i][bj][1] + acc[ai][bj][mg + i][1];
                    *(u32x4*)(hb + off) = pack8(h0, h1);
                    ss += ((h0[0] * h0[0] + h0[1] * h0[1]) + (h0[2] * h0[2] + h0[3] * h0[3])) + ((h1[0] * h1[0] + h1[1] * h1[1]) + (h1[2] * h1[2] + h1[3] * h1[3])); }
                ss += __shfl_xor(ss, 16); ss += __shfl_xor(ss, 32); if (fq == 0) st[(size_t)row * 16 + u.pn * 4 + wc] = ss; } )
    } };
struct EpiRelu2 { static constexpr bool PERM = true, AFTER_DRAIN = false, PAIRED = false; const float* st; bf16_t* O;
    __device__ __forceinline__ void operator()(const f32x4 (&acc)[2][2][4][2], const Unit& u, int wr, int wc, int fr, int fq) const {
        float rsv[2][4];
        _Pragma("unroll") for (int ai = 0; ai < 2; ++ai) { _Pragma("unroll") for (int m = 0; m < 4; ++m) rsv[ai][m] = rstd_from_stats(st, u.pm * BM + ai * HALF + wr * 64 + m * 16 + fr);
            asm volatile("" : "+v"(rsv[ai][0]), "+v"(rsv[ai][1]), "+v"(rsv[ai][2]), "+v"(rsv[ai][3]) :: "memory"); }
        EPI_ROWS( const float rs = rsv[ai][m]; EPI_COLS( f32x4 v0 = a0 * rs, v1 = a1 * rs;
            _Pragma("unroll") for (int e = 0; e < 4; ++e) { const float x0 = fmaxf(v0[e], 0.f), x1 = fmaxf(v1[e], 0.f); v0[e] = x0 * x0; v1[e] = x1 * x1; }
            *(u32x4*)(O + (size_t)row * 4096 + col) = pack8(v0, v1); ) )
    } };
struct EpiPP { static constexpr bool PERM = true, AFTER_DRAIN = false, PAIRED = false; bf16_t* T;
    __device__ __forceinline__ void operator()(const f32x4 (&acc)[2][2][4][2], const Unit& u, int wr, int wc, int fr, int fq) const {
        EPI_ROWS( EPI_COLS( *(u32x4*)(T + (size_t)row * 1024 + col) = pack8(a0, a1); ) )
    } };
struct EpiPle { static constexpr bool PERM = true, AFTER_DRAIN = false, PAIRED = false; const float* st_in; const bf16_t* T; const bf16_t* hsrc; bf16_t* out; float* st;
    __device__ __forceinline__ void operator()(const f32x4 (&acc)[2][2][4][2], const Unit& u, int wr, int wc, int fr, int fq) const {
        float rsv[2][4];
        _Pragma("unroll") for (int ai = 0; ai < 2; ++ai) { _Pragma("unroll") for (int m = 0; m < 4; ++m) rsv[ai][m] = rstd_from_stats(st_in, u.pm * BM + ai * HALF + wr * 64 + m * 16 + fr);
            asm volatile("" : "+v"(rsv[ai][0]), "+v"(rsv[ai][1]), "+v"(rsv[ai][2]), "+v"(rsv[ai][3]) :: "memory"); }
        EPI_GROUP(2, u32x4 hv[2][2]; u32x4 tv[2][2];
            _Pragma("unroll") for (int i = 0; i < 2; ++i) _Pragma("unroll") for (int bj = 0; bj < 2; ++bj) { const size_t off = (size_t)EPI_ROWOF(mg + i) * 1024 + EPI_COLOF(bj);
                    hv[i][bj] = *(const u32x4*)(hsrc + off); tv[i][bj] = *(const u32x4*)(T + off); }
            _Pragma("unroll") for (int i = 0; i < 2; ++i) { float ss = 0.f; const int row = EPI_ROWOF(mg + i); const float rs = rsv[ai][mg + i];
                _Pragma("unroll") for (int bj = 0; bj < 2; ++bj) { const size_t off = (size_t)row * 1024 + EPI_COLOF(bj);
                    f32x4 g0 = acc[ai][bj][mg + i][0] * rs, g1 = acc[ai][bj][mg + i][1] * rs; _Pragma("unroll") for (int e = 0; e < 4; ++e) { g0[e] = sigmoidf_fast(g0[e]); g1[e] = sigmoidf_fast(g1[e]); }
                    const f32x4 h0 = bf4_lo(hv[i][bj].x, hv[i][bj].y) + g0 * bf4_lo(tv[i][bj].x, tv[i][bj].y), h1 = bf4_lo(hv[i][bj].z, hv[i][bj].w) + g1 * bf4_lo(tv[i][bj].z, tv[i][bj].w);
                    *(u32x4*)(out + off) = pack8(h0, h1);
                    ss += ((h0[0] * h0[0] + h0[1] * h0[1]) + (h0[2] * h0[2] + h0[3] * h0[3])) + ((h1[0] * h1[0] + h1[1] * h1[1]) + (h1[2] * h1[2] + h1[3] * h1[3])); }
                ss += __shfl_xor(ss, 16); ss += __shfl_xor(ss, 32); if (fq == 0) st[(size_t)row * 16 + u.pn * 4 + wc] = ss; } )
    } };
struct EpiNone { static constexpr bool PERM = true, AFTER_DRAIN = false, PAIRED = false; float* sink;
    __device__ __forceinline__ void operator()(const f32x4 (&acc)[2][2][4][2], const Unit& u, int wr, int wc, int fr, int fq) const {
        if (acc[0][0][0][0][0] == 1.2345e33f) sink[0] = 1.f;
    } };

struct PairOrder { StaticOrder so; __device__ __forceinline__ bool next(int i, Unit& u) const { if (!so.next(i >> 1, u)) return false; u.part = i & 1; return true; }
    __device__ __forceinline__ void a_ready(const Unit&) const {} __device__ __forceinline__ void done(const Unit&) const {} };
struct EpiPair { static constexpr bool PERM = true, AFTER_DRAIN = false, PAIRED = true; const bf16_t* G0; const bf16_t* G1; bf16_t* O; size_t oA, oB;
    __device__ __forceinline__ size_t offA(const Unit& u) const { return u.part ? oA : 0; }
    __device__ __forceinline__ size_t offB(const Unit& u) const { return u.part ? oB : 0; }
    __device__ __forceinline__ static f32x4 clampg(f32x4 g) { return (f32x4){fmaxf(g[0], 1e-20f), fmaxf(g[1], 1e-20f), fmaxf(g[2], 1e-20f), fmaxf(g[3], 1e-20f)}; }
    __device__ __forceinline__ static f32x4 rcp4(f32x4 g) { return (f32x4){__builtin_amdgcn_rcpf(g[0]), __builtin_amdgcn_rcpf(g[1]), __builtin_amdgcn_rcpf(g[2]), __builtin_amdgcn_rcpf(g[3])}; }
    __device__ __forceinline__ void pair(f32x4 (&acc)[2][2][4][2], const Unit& u, int wr, int wc, int fr, int fq) const {
        if (u.part == 0) {
            EPI_GROUP(4, u32x4 g0[4][2]; u32x4 g1[4][2];
                _Pragma("unroll") for (int i = 0; i < 4; ++i) _Pragma("unroll") for (int bj = 0; bj < 2; ++bj) { const size_t off = (size_t)EPI_ROWOF(mg + i) * ZP + EPI_COLOF(bj); g0[i][bj] = *(const u32x4*)(G0 + off); g1[i][bj] = *(const u32x4*)(G1 + off); }
                _Pragma("unroll") for (int i = 0; i < 4; ++i) _Pragma("unroll") for (int bj = 0; bj < 2; ++bj) {
                    acc[ai][bj][mg + i][0] = acc[ai][bj][mg + i][0] * (bf4_lo(g0[i][bj].x, g0[i][bj].y) * rcp4(clampg(bf4_lo(g1[i][bj].x, g1[i][bj].y))));
                    acc[ai][bj][mg + i][1] = acc[ai][bj][mg + i][1] * (bf4_lo(g0[i][bj].z, g0[i][bj].w) * rcp4(clampg(bf4_lo(g1[i][bj].z, g1[i][bj].w)))); } )
        } else {
            EPI_GROUP(4, u32x4 g1[4][2];
                _Pragma("unroll") for (int i = 0; i < 4; ++i) _Pragma("unroll") for (int bj = 0; bj < 2; ++bj) g1[i][bj] = *(const u32x4*)(G1 + (size_t)EPI_ROWOF(mg + i) * ZP + EPI_COLOF(bj));
                _Pragma("unroll") for (int i = 0; i < 4; ++i) _Pragma("unroll") for (int bj = 0; bj < 2; ++bj)
                    *(u32x4*)(O + (size_t)EPI_ROWOF(mg + i) * 1024 + EPI_COLOF(bj)) = pack8(acc[ai][bj][mg + i][0] * clampg(bf4_lo(g1[i][bj].x, g1[i][bj].y)), acc[ai][bj][mg + i][1] * clampg(bf4_lo(g1[i][bj].z, g1[i][bj].w))); )
        }
    } };

template <class Epi, class Sched, bool ALIGN_EPI = false, bool SP2 = false>
__device__ __forceinline__ void gemm_phase(PG8_LAS unsigned char* lds, const Gemm g, const Sched& S, const Epi& E, const int wave_s) {
    const int tid = wave_s * 64 + fresh_lane(), wid = wave_s, lane = tid & 63, wr = wid >> 2, wc = wid & 3, fr = lane & 15, fq = lane >> 4;
    const int K = g.K, nt = K / BK;
    unsigned voffA[2], voffB[2];
#pragma unroll
    for (int i = 0; i < 2; ++i) { int R, C; stage_rc(tid * 16 + i * 8192, R, C); const int Rb = Epi::PERM ? ((R & ~31) + perm32(R & 31)) : R;
        voffA[i] = (unsigned)(R * g.lda + C) * 2u; voffB[i] = (unsigned)(Rb * K + C) * 2u; }
    const size_t kstep = (size_t)(BK * 2);
    const size_t hstepA = (size_t)HALF * g.lda * 2, hstepB = (size_t)HALF * K * 2;
    const size_t tstepA = 2 * hstepA, tstepB = 2 * hstepB;
    const unsigned ldsw = (unsigned)wid * 1024u;
    const int aoff = lds_byte(wr * 64 + fr, fq * 8), boff = lds_byte(wc * 32 + fr, fq * 8);
#define PG8_SA(b, h) (((b) * 2 + (h)) * HTB)
#define PG8_SB(b, h) ((4 + (b) * 2 + (h)) * HTB)
#define PG8_STAGE(bufoff, gbase, voff) do { _Pragma("unroll") for (int _i = 0; _i < 2; ++_i) \
        __builtin_amdgcn_global_load_lds((const unsigned*)((const char*)(gbase) + (voff)[_i]), (PG8_LAS unsigned*)(lds + (bufoff) + ldsw + _i * 8192), 16, 0, 0); } while (0)
#define PG8_LDA(dst, b, h) do { _Pragma("unroll") for (int m = 0; m < 4; ++m) _Pragma("unroll") for (int k = 0; k < 2; ++k) dst[m][k] = *(const PG8_LAS bf16x8*)(lds + PG8_SA(b, h) + aoff + m * 2048 + k * 1024); } while (0)
#define PG8_LDB(dst, b, h) do { _Pragma("unroll") for (int n = 0; n < 2; ++n) _Pragma("unroll") for (int k = 0; k < 2; ++k) dst[n][k] = *(const PG8_LAS bf16x8*)(lds + PG8_SB(b, h) + boff + n * 2048 + k * 1024); } while (0)
#define PG8_MMA(ai, bj, At, Bt) do { __builtin_amdgcn_s_setprio(1); _Pragma("unroll") for (int m = 0; m < 4; ++m) _Pragma("unroll") for (int n = 0; n < 2; ++n) _Pragma("unroll") for (int k = 0; k < 2; ++k) \
        acc[ai][bj][m][n] = __builtin_amdgcn_mfma_f32_16x16x32_bf16(Bt[n][k], At[m][k], acc[ai][bj][m][n], 0, 0, 0); __builtin_amdgcn_s_setprio(0); } while (0)
#define PG8_WAIT_V(n) asm volatile("s_waitcnt vmcnt(" #n ")" ::: "memory")
#define PG8_WAIT_L(n) asm volatile("s_waitcnt lgkmcnt(" #n ")" ::: "memory")
#define PG8_BAR __builtin_amdgcn_s_barrier()
#define PG8_SCHED __builtin_amdgcn_sched_barrier(0)
    Unit cur, nxt; int ui = 0;
    if (!S.next(0, cur)) return;
    f32x4 acc[2][2][4][2];
#pragma unroll
    for (int a = 0; a < 2; ++a)
#pragma unroll
        for (int b = 0; b < 2; ++b)
#pragma unroll
            for (int m = 0; m < 4; ++m)
#pragma unroll
                for (int n = 0; n < 2; ++n) acc[a][b][m][n] = (f32x4){0.f, 0.f, 0.f, 0.f};
    bf16x8 At[4][2], B0[2][2], B1[2][2];
    const char* cA = (const char*)g.A + (size_t)cur.pm * tstepA; const char* cB = (const char*)g.Bt + (size_t)cur.pn * tstepB;
    if constexpr (Epi::PAIRED) { cA += E.offA(cur); cB += E.offB(cur); }
    S.a_ready(cur);
    if constexpr (SP2) {
        PG8_STAGE(PG8_SB(0, 0), cB, voffB); PG8_STAGE(PG8_SB(0, 1), cB + hstepB, voffB); PG8_STAGE(PG8_SA(0, 0), cA, voffA); PG8_STAGE(PG8_SA(0, 1), cA + hstepA, voffA);
        if (wr == 1) PG8_BAR;
        PG8_WAIT_V(2); PG8_BAR;
        PG8_STAGE(PG8_SB(1, 0), cB + kstep, voffB); PG8_STAGE(PG8_SA(1, 0), cA + kstep, voffA); PG8_STAGE(PG8_SB(1, 1), cB + hstepB + kstep, voffB);
        PG8_WAIT_V(6); PG8_BAR;
    } else {
        PG8_STAGE(PG8_SB(0, 0), cB, voffB); PG8_STAGE(PG8_SA(0, 0), cA, voffA); PG8_STAGE(PG8_SB(0, 1), cB + hstepB, voffB); PG8_STAGE(PG8_SA(0, 1), cA + hstepA, voffA);
        if (wr == 1) PG8_BAR;
        PG8_WAIT_V(4); PG8_BAR;
        PG8_STAGE(PG8_SB(1, 0), cB + kstep, voffB); PG8_STAGE(PG8_SA(1, 0), cA + kstep, voffA); PG8_STAGE(PG8_SB(1, 1), cB + hstepB + kstep, voffB);
        PG8_WAIT_V(6); PG8_BAR;
    }
    for (;;) {
        const bool has_next = S.next(ui + 1, nxt);
        size_t oa_ = 0, ob_ = 0; if constexpr (Epi::PAIRED) { if (has_next) { oa_ = E.offA(nxt); ob_ = E.offB(nxt); } }
        const char* nA = has_next ? (const char*)g.A + (size_t)nxt.pm * tstepA + oa_ : cA; const char* nB = has_next ? (const char*)g.Bt + (size_t)nxt.pn * tstepB + ob_ : cB;
        for (int t = 0; t < nt; t += 2) {
            const bool last = (t == nt - 2);
            const char* a1 = cA + (size_t)(t + 1) * kstep;
            const char* a2 = last ? nA : cA + (size_t)(t + 2) * kstep; const char* b2 = last ? nB : cB + (size_t)(t + 2) * kstep;
            const char* a3 = a2 + kstep; const char* b3 = b2 + kstep;
            if (last && has_next) S.a_ready(nxt);
            if constexpr (SP2) {
            PG8_LDB(B0, 0, 0); PG8_LDB(B1, 0, 1); PG8_SCHED; PG8_LDA(At, 0, 0); PG8_STAGE(PG8_SA(1, 1), a1 + hstepA, voffA);
            PG8_WAIT_V(8); PG8_WAIT_L(0); PG8_BAR; PG8_MMA(0, 0, At, B0); PG8_MMA(0, 1, At, B1); PG8_BAR; PG8_SCHED;
            PG8_LDA(At, 0, 1); PG8_STAGE(PG8_SB(0, 0), b2, voffB); PG8_STAGE(PG8_SB(0, 1), b2 + hstepB, voffB); PG8_STAGE(PG8_SA(0, 0), a2, voffA);
            PG8_WAIT_V(8); PG8_WAIT_L(0); PG8_BAR; PG8_MMA(1, 0, At, B0); PG8_MMA(1, 1, At, B1); PG8_BAR; PG8_SCHED;
            PG8_LDB(B0, 1, 0); PG8_LDB(B1, 1, 1); PG8_SCHED; PG8_LDA(At, 1, 0); PG8_STAGE(PG8_SA(0, 1), a2 + hstepA, voffA);
            PG8_WAIT_V(8); PG8_WAIT_L(0); PG8_BAR; PG8_MMA(0, 0, At, B0); PG8_MMA(0, 1, At, B1); PG8_BAR; PG8_SCHED;
            PG8_LDA(At, 1, 1); PG8_STAGE(PG8_SB(1, 0), b3, voffB); PG8_STAGE(PG8_SB(1, 1), b3 + hstepB, voffB); PG8_STAGE(PG8_SA(1, 0), a3, voffA);
            PG8_WAIT_V(8); PG8_WAIT_L(0); PG8_BAR; PG8_MMA(1, 0, At, B0); PG8_MMA(1, 1, At, B1); PG8_BAR; PG8_SCHED;
            } else {
            PG8_LDB(B0, 0, 0); PG8_SCHED; PG8_LDA(At, 0, 0); PG8_STAGE(PG8_SA(1, 1), a1 + hstepA, voffA);
            PG8_WAIT_L(8); PG8_BAR; PG8_WAIT_L(0); PG8_MMA(0, 0, At, B0); PG8_BAR; PG8_SCHED;
            PG8_LDB(B1, 0, 1); PG8_STAGE(PG8_SB(0, 0), b2, voffB);
            PG8_BAR; PG8_WAIT_L(0); PG8_MMA(0, 1, At, B1); PG8_BAR;
            PG8_LDA(At, 0, 1); PG8_STAGE(PG8_SA(0, 0), a2, voffA);
            PG8_BAR; PG8_WAIT_L(0); PG8_MMA(1, 0, At, B0); PG8_BAR; PG8_SCHED;
            PG8_STAGE(PG8_SB(0, 1), b2 + hstepB, voffB);
            PG8_WAIT_V(6); PG8_BAR; PG8_MMA(1, 1, At, B1); PG8_BAR;
            PG8_LDB(B0, 1, 0); PG8_SCHED; PG8_LDA(At, 1, 0); PG8_STAGE(PG8_SA(0, 1), a2 + hstepA, voffA);
            PG8_WAIT_L(8); PG8_BAR; PG8_WAIT_L(0); PG8_MMA(0, 0, At, B0); PG8_BAR; PG8_SCHED;
            PG8_LDB(B1, 1, 1); PG8_STAGE(PG8_SB(1, 0), b3, voffB);
            PG8_BAR; PG8_WAIT_L(0); PG8_MMA(0, 1, At, B1); PG8_BAR;
            PG8_LDA(At, 1, 1); PG8_STAGE(PG8_SA(1, 0), a3, voffA);
            PG8_BAR; PG8_WAIT_L(0); PG8_MMA(1, 0, At, B0); PG8_BAR; PG8_SCHED;
            PG8_STAGE(PG8_SB(1, 1), b3 + hstepB, voffB);
            PG8_WAIT_V(6); PG8_BAR; PG8_MMA(1, 1, At, B1); PG8_BAR;
            }
        }
        if constexpr (ALIGN_EPI) { if (wr == 0) PG8_BAR; }
        if constexpr (Epi::PAIRED) { E.pair(acc, cur, wr, wc, fr, fq); } else if constexpr (!Epi::AFTER_DRAIN) { E(acc, cur, wr, wc, fr, fq); S.done(cur); }
        if (!has_next) break;
        if (!Epi::PAIRED || nxt.part == 0)
#pragma unroll
        for (int a = 0; a < 2; ++a)
#pragma unroll
            for (int b = 0; b < 2; ++b)
#pragma unroll
                for (int m = 0; m < 4; ++m)
#pragma unroll
                    for (int n = 0; n < 2; ++n) acc[a][b][m][n] = (f32x4){0.f, 0.f, 0.f, 0.f};
        cur = nxt; cA = nA; cB = nB; ++ui;
        if constexpr (ALIGN_EPI) { if (wr == 1) PG8_BAR; }
    }
    PG8_WAIT_V(0);
    if constexpr (!ALIGN_EPI) { if (wr == 0) PG8_BAR; }
    PG8_BAR;
    if constexpr (Epi::AFTER_DRAIN) { E.fused(acc, cur, wr, wc, fr, fq, lds, wid, lane); S.done(cur); }
#undef PG8_SA
#undef PG8_SB
#undef PG8_STAGE
#undef PG8_LDA
#undef PG8_LDB
#undef PG8_MMA
#undef PG8_WAIT_V
#undef PG8_WAIT_L
#undef PG8_BAR
#undef PG8_SCHED
}
}
#ifndef PG8_SP2
#define PG8_SP2 true
#endif
#ifndef PG8_ALIGN
#define PG8_ALIGN true
#endif
#include <hip/hip_bf16.h>
#include <cmath>
namespace attn_body {
using bf16=__hip_bfloat16;
using bf16x8=__attribute__((ext_vector_type(8)))short;
using s16x4=__attribute__((ext_vector_type(4)))short;
using f32x16=__attribute__((ext_vector_type(16)))float;
using u32x4=__attribute__((ext_vector_type(4)))unsigned;
constexpr int BATCH=2,SEQ=8192,D=64,DM=4352;
constexpr int NW=8,QBLK=32,QB=QBLK*NW,KVBLK=64,NQB=SEQ/QB;
constexpr int ATTN_PITCH=DM, ATTN_UNIT_ROWS=QB;
__device__ __forceinline__ int crow(int r,int hi){return (r&3)+8*(r>>2)+4*hi;}
#define SBAR() __builtin_amdgcn_sched_barrier(0)
__device__ __forceinline__ void cmask(f32x16&p0,f32x16&p1,int jb,int qrel,int hi){
  const float NEG=-INFINITY; int kb=64*jb+4*hi;
  #pragma unroll
  for(int r=0;r<16;++r){int kv=kb+(r&3)+8*(r>>2); if(kv>qrel)p0[r]=NEG; if(kv+32>qrel)p1[r]=NEG;}
}

constexpr int NSLOT=3, SLOTB=8192; typedef float f32x4v __attribute__((ext_vector_type(4))); constexpr int LDS_BIAS=86016;
constexpr int LDS_K=0, LDS_V=NSLOT*SLOTB, LDS_WS=2*NSLOT*SLOTB, LDS_OST=LDS_WS+NW*64*4, LDS_BYTES=LDS_OST+NW*4096;
constexpr float C2=0.125f*1.4426950408889634f;
__device__ __forceinline__ void glds16(const void*gsrc,unsigned lds_dst){unsigned keep;
  asm volatile("s_mov_b32 %0, m0\n\ts_mov_b32 m0, %2\n\ts_nop 0\n\tglobal_load_lds_dwordx4 %1, off\n\ts_mov_b32 m0, %0":"=&s"(keep):"v"(gsrc),"s"(lds_dst):"memory");}
__device__ __forceinline__ float max3f(float a,float b,float c){float r;asm("v_max3_f32 %0, %1, %2, %3":"=v"(r):"v"(a),"v"(b),"v"(c));return r;}
__device__ __forceinline__ float max2f(float a,float b){float r;asm("v_max_f32_e32 %0, %1, %2":"=v"(r):"v"(a),"v"(b));return r;}
__device__ __forceinline__ float fadd_s(float a,float b){float r;asm("v_add_f32_e32 %0, %1, %2":"=v"(r):"v"(a),"v"(b));return r;}
__device__ __forceinline__ float fsub_s(float a,float b){float r;asm("v_sub_f32_e32 %0, %1, %2":"=v"(r):"v"(a),"v"(b));return r;}
typedef float f32x2_t __attribute__((ext_vector_type(2))); typedef __bf16 bf16x2_t __attribute__((ext_vector_type(2)));
__device__ __forceinline__ unsigned cvtpk_s(float lo,float hi){f32x2_t v={lo,hi};bf16x2_t b=__builtin_convertvector(v,bf16x2_t);return __builtin_bit_cast(unsigned,b);}
#define WAIT_BAR(N) asm volatile("s_waitcnt vmcnt(" #N ") lgkmcnt(0)\n\ts_barrier":::"memory")

__device__ __forceinline__ void qkt(f32x16&p0,f32x16&p1,const char*Kslot,const bf16x8*qr,const f32x16&negm,int r32,int hi){
  const char*kb=Kslot+hi*1024+r32*16;
  #pragma unroll
  for(int d0=0;d0<4;++d0){
    const bf16x8 b0=*reinterpret_cast<const bf16x8*>(kb+d0*2048);
    const bf16x8 b1=*reinterpret_cast<const bf16x8*>(kb+d0*2048+512);
    if(d0==0){p0=__builtin_amdgcn_mfma_f32_32x32x16_bf16(b0,qr[0],negm,0,0,0);p1=__builtin_amdgcn_mfma_f32_32x32x16_bf16(b1,qr[0],negm,0,0,0);}
    else{p0=__builtin_amdgcn_mfma_f32_32x32x16_bf16(b0,qr[d0],p0,0,0,0);p1=__builtin_amdgcn_mfma_f32_32x32x16_bf16(b1,qr[d0],p1,0,0,0);}}
}
typedef __attribute__((address_space(3))) const char* lds_cptr;
typedef short v4i16_t __attribute__((ext_vector_type(4)));
__device__ __forceinline__ void kload8(bf16x8*kf,lds_cptr kp){
  kf[0]=*(const __attribute__((address_space(3))) bf16x8*)(kp);      kf[1]=*(const __attribute__((address_space(3))) bf16x8*)(kp+512);
  kf[2]=*(const __attribute__((address_space(3))) bf16x8*)(kp+2048); kf[3]=*(const __attribute__((address_space(3))) bf16x8*)(kp+2560);
  kf[4]=*(const __attribute__((address_space(3))) bf16x8*)(kp+4096); kf[5]=*(const __attribute__((address_space(3))) bf16x8*)(kp+4608);
  kf[6]=*(const __attribute__((address_space(3))) bf16x8*)(kp+6144); kf[7]=*(const __attribute__((address_space(3))) bf16x8*)(kp+6656);
}
__device__ __forceinline__ void kload2(bf16x8*kf,lds_cptr kp,int j){ kf[2*j]=*(const __attribute__((address_space(3))) bf16x8*)(kp+j*2048); kf[2*j+1]=*(const __attribute__((address_space(3))) bf16x8*)(kp+j*2048+512); }
__device__ __forceinline__ s16x4 vtr(lds_cptr p){ return __builtin_bit_cast(s16x4,__builtin_amdgcn_ds_read_tr16_b64_v4i16((__attribute__((address_space(3))) v4i16_t*)p)); }
__device__ __forceinline__ float rowmax(const f32x16&p0,const f32x16&p1){
  float a=max3f(p0[0],p0[1],p1[0]),b=max3f(p0[2],p0[3],p1[1]);a=max3f(a,p1[2],p1[3]);
  #pragma unroll
  for(int r=4;r<16;r+=4){a=max3f(a,p0[r],p0[r+1]);b=max3f(b,p0[r+2],p0[r+3]);a=max3f(a,p1[r],p1[r+1]);b=max3f(b,p1[r+2],p1[r+3]);}
  const float m=max2f(a,b);
  auto rr=__builtin_amdgcn_permlane32_swap(__float_as_uint(m),__float_as_uint(m),false,false);
  return max2f(__uint_as_float(rr[0]),__uint_as_float(rr[1]));
}
__device__ __forceinline__ void pv(f32x16*o,int vb,bf16x8 pa0,bf16x8 pa1,bf16x8 pa2,bf16x8 pa3){
  #pragma unroll
  for(int d0=0;d0<2;++d0){s16x4 lo[4],hi[4];
    #pragma unroll
    for(int ks=0;ks<4;++ks){
      asm volatile("ds_read_b64_tr_b16 %0,%1 offset:%c2":"=&v"(lo[ks]):"v"(vb),"i"(d0*4096+ks*1024):"memory");
      asm volatile("ds_read_b64_tr_b16 %0,%1 offset:%c2":"=&v"(hi[ks]):"v"(vb),"i"(d0*4096+ks*1024+512):"memory");}
    asm volatile("s_waitcnt lgkmcnt(0)":::"memory");SBAR();
    #define PK(k) (bf16x8){lo[k][0],lo[k][1],lo[k][2],lo[k][3],hi[k][0],hi[k][1],hi[k][2],hi[k][3]}
    o[d0]=__builtin_amdgcn_mfma_f32_32x32x16_bf16(pa0,PK(0),o[d0],0,0,0);
    o[d0]=__builtin_amdgcn_mfma_f32_32x32x16_bf16(pa1,PK(1),o[d0],0,0,0);
    o[d0]=__builtin_amdgcn_mfma_f32_32x32x16_bf16(pa2,PK(2),o[d0],0,0,0);
    o[d0]=__builtin_amdgcn_mfma_f32_32x32x16_bf16(pa3,PK(3),o[d0],0,0,0);
    #undef PK
  }
}

#ifndef ATTN_STORE16
#define ATTN_STORE16(p,v) (*(u32x4*)(p)=(v))
#endif
template<int THRL> __device__ __forceinline__ void attn_unit(const int wave_s,int qb,const bf16*Qh,const bf16*__restrict__ Kh,const bf16*__restrict__ Vh,bf16*Oh,const float*__restrict__ cbias,const float qk2,char*shm){
  const int wid=wave_s; const int tid=wave_s*64+fresh_lane(),lane=tid&63,r32=lane&31,hi=lane>>5;
  const int q0=qb*QB;
  const bf16*Qw=Qh+(long)(q0+wid*QBLK)*DM;
  int t0; { const int ntab=(q0+QB)/KVBLK; const float thr=cbias[q0]-(qk2+40.0f); const int l_=tid&63;
    const bool c0_=(l_<ntab-4)&&(cbias[l_*64+63]<thr), c1_=(l_+64<ntab-4)&&(cbias[(l_+64)*64+63]<thr);
    t0=(__builtin_popcountll(__ballot(c0_))+__builtin_popcountll(__ballot(c1_)))&~1; t0=__builtin_amdgcn_readfirstlane(t0); }
  Kh+=(long)t0*KVBLK*DM; Vh+=(long)t0*KVBLK*DM; cbias+=t0*KVBLK;
  const unsigned lds0=(unsigned)(uintptr_t)shm;
  float*wsf=(float*)(shm+LDS_WS)+wid*64;
  const bf16*ksrc=Kh+(long)lane*DM+wid*8;
  const bf16*vsrc=Vh+(long)(16*(wid&3)+(lane>>2))*DM+(wid>>2)*32+(lane&3)*8;
  const unsigned kdst=lds0+LDS_K+wid*1024, vdst=lds0+LDS_V+wid*1024;
  #define DMA_K(t,slot) glds16(ksrc+(long)(t)*KVBLK*DM,(unsigned)__builtin_amdgcn_readfirstlane(kdst+(slot)))
  #define DMA_V(t,slot) glds16(vsrc+(long)(t)*KVBLK*DM,(unsigned)__builtin_amdgcn_readfirstlane(vdst+(slot)))
  const int vb0=(int)(lds0+LDS_V)+((lane>>4)&1)*32+(lane&3)*8+(4*hi+((lane&15)>>2))*64;
  const char*Kbase=shm+LDS_K; bf16x8 kf[8];
  const lds_cptr shm3=(lds_cptr)shm; const lds_cptr kp0=shm3+LDS_K+hi*1024+r32*16; const lds_cptr vp0=shm3+LDS_V+((lane>>4)&1)*32+(lane&3)*8+(4*hi+((lane&15)>>2))*64;
  { const int nk4=((q0+QB)>>2)-t0*16; __attribute__((address_space(3))) f32x4v* bt=(__attribute__((address_space(3))) f32x4v*)((lds_cptr)shm+LDS_BIAS); for(int i=tid;i<nk4;i+=NW*64) bt[i]=((const f32x4v*)cbias)[i]; }
  const int NT=(q0+QB)/KVBLK-t0;
  DMA_K(0,0);DMA_V(0,0);DMA_K(1,SLOTB);
  bf16x8 qr[4];
  #pragma unroll
  for(int d0=0;d0<4;++d0)qr[d0]=*reinterpret_cast<const bf16x8*>(&Qw[(long)r32*DM+d0*16+hi*8]);
  float mhat=0.f,l_reg=0.f;float zf_=0.f;asm volatile("":"+v"(zf_));f32x16 o[2];f32x16 negm;
  _Pragma("unroll") for(int r=0;r<16;++r){o[0][r]=zf_;o[1][r]=zf_;negm[r]=zf_;} asm volatile("":"+v"(negm));
  const int qrel=wid*QBLK+r32;
  #define CMASK(P0,P1,t) do{int jb_=(t)-(NT-4); if(jb_>=0)cmask(P0,P1,jb_,qrel,hi);}while(0)
  #define BIAS(P0,P1,t) do{ const __attribute__((address_space(3))) f32x4v* bt_=(const __attribute__((address_space(3))) f32x4v*)(shm3+LDS_BIAS)+(t)*16+hi; \
    _Pragma("unroll") for(int i_=0;i_<4;++i_){ const f32x4v b0_=bt_[2*i_], b1_=bt_[8+2*i_]; \
      P0[4*i_]+=b0_[0];P0[4*i_+1]+=b0_[1];P0[4*i_+2]+=b0_[2];P0[4*i_+3]+=b0_[3]; P1[4*i_]+=b1_[0];P1[4*i_+1]+=b1_[1];P1[4*i_+2]+=b1_[2];P1[4*i_+3]+=b1_[3]; } }while(0)
  bool resc=false;
  #define START(P0,P1) do{ const float rm=rowmax(P0,P1); resc=false; \
    { const float dl=rm; mhat=fadd_s(mhat,dl); \
      _Pragma("unroll") for(int r=0;r<16;++r){P0[r]=fsub_s(P0[r],dl);P1[r]=fsub_s(P1[r],dl);} \
      _Pragma("unroll") for(int r=0;r<16;++r)negm[r]=-mhat; asm volatile("":"+v"(negm)); } \
    _Pragma("unroll") for(int r=0;r<16;++r)P0[r]=__builtin_amdgcn_exp2f(P0[r]); }while(0)
  #define RESC() do{ if(resc){ asm volatile("s_waitcnt lgkmcnt(0)":::"memory"); \
      _Pragma("unroll") for(int d_=0;d_<2;++d_) _Pragma("unroll") for(int r=0;r<16;++r)o[d_][r]*=wsf[crow(r,hi)]; } }while(0)
  f32x16 pA0,pA1,pB0,pB1;
  int sl_prev=0,sl_cur=0,sl_next=SLOTB;
  #define ROT() do{sl_prev=sl_cur;sl_cur=sl_next;sl_next=(sl_next==(NSLOT-1)*SLOTB)?0:sl_next+SLOTB;}while(0)
  DMA_K(2,2*SLOTB);
  WAIT_BAR(3);
  qkt(pA0,pA1,Kbase,qr,negm,r32,hi);asm volatile("s_nop 15\n\ts_nop 7":"+v"(pA0),"+v"(pA1));BIAS(pA0,pA1,0);CMASK(pA0,pA1,0);
  START(pA0,pA1);
  _Pragma("unroll") for(int r=0;r<16;++r)pA1[r]=__builtin_amdgcn_exp2f(pA1[r]);
  WAIT_BAR(0);
  DMA_K(3,0);DMA_V(1,SLOTB);
  ROT();
  kload8(kf,kp0+sl_cur);
  WAIT_BAR(2);
  s16x4 vlo[8],vhi[8]; u32x4 pw0,pw1,pw2,pw3;
  #define PKW(P,B) cvtpk_s(P[B],P[B+1])
  #define PAF(k) __builtin_bit_cast(bf16x8,pw##k)
  #define VFR(i) (bf16x8){vlo[i][0],vlo[i][1],vlo[i][2],vlo[i][3],vhi[i][0],vhi[i][1],vhi[i][2],vhi[i][3]}
  #define PIN(x) asm volatile("":"+v"(x))
  #define MX3(a,b,c) __builtin_fmaxf(__builtin_fmaxf((a),(b)),(c))
  #define GAPA(MF,A0,A1,A2,A3,W0,W1,PW) do{ MF; sacc+=A0; sacc+=A1; sacc+=A2; sacc+=A3; PIN(sacc); W0; W1; PIN(PW); SBAR(); }while(0)
  #define EX(v) __builtin_amdgcn_exp2f(v)
  #define GAPB(MF,X,B) do{ MF; X[B]=EX(X[B]); X[B+1]=EX(X[B+1]); X[B+2]=EX(X[B+2]); X[B+3]=EX(X[B+3]); PIN(X); SBAR(); }while(0)
  #define VRD(i) do{ vlo[i]=vtr(vp_+(((i)>>2)*4096+((i)&3)*1024)); vhi[i]=vtr(vp_+(((i)>>2)*4096+((i)&3)*1024+512)); }while(0)
  #define KRD(G,j) do{ if(G){ kload2(kf,kp0+sl_next,j); SBAR(); } }while(0)
  #define STEP(C0,C1,P0,P1,t,GK,GV,GL) do{ SBAR(); \
    const lds_cptr vp_=vp0+sl_prev; \
    VRD(0); SBAR(); float sacc=(P0[0]+P0[1]); \
    GAPA(C0=__builtin_amdgcn_mfma_f32_32x32x16_bf16(kf[0],qr[0],negm,0,0,0), P0[2],P0[3],P0[4],P0[5],     pw0[0]=PKW(P0,0), pw0[1]=PKW(P0,2), pw0); \
    VRD(4); SBAR(); GAPA(C1=__builtin_amdgcn_mfma_f32_32x32x16_bf16(kf[1],qr[0],negm,0,0,0), P0[6],P0[7],P0[8],P0[9],     pw0[2]=PKW(P0,4), pw0[3]=PKW(P0,6), pw0); \
    VRD(1); SBAR(); GAPA(C0=__builtin_amdgcn_mfma_f32_32x32x16_bf16(kf[2],qr[1],C0,0,0,0),   P0[10],P0[11],P0[12],P0[13], pw1[0]=PKW(P0,8), pw1[1]=PKW(P0,10), pw1); \
    VRD(5); SBAR(); GAPA(C1=__builtin_amdgcn_mfma_f32_32x32x16_bf16(kf[3],qr[1],C1,0,0,0),   P0[14],P0[15],P1[0],P1[1],   pw1[2]=PKW(P0,12),pw1[3]=PKW(P0,14), pw1); \
    VRD(2); SBAR(); GAPA(C0=__builtin_amdgcn_mfma_f32_32x32x16_bf16(kf[4],qr[2],C0,0,0,0),   P1[2],P1[3],P1[4],P1[5],     pw2[0]=PKW(P1,0), pw2[1]=PKW(P1,2), pw2); \
    VRD(6); SBAR(); GAPA(C1=__builtin_amdgcn_mfma_f32_32x32x16_bf16(kf[5],qr[2],C1,0,0,0),   P1[6],P1[7],P1[8],P1[9],     pw2[2]=PKW(P1,4), pw2[3]=PKW(P1,6), pw2); \
    VRD(3); SBAR(); GAPA(C0=__builtin_amdgcn_mfma_f32_32x32x16_bf16(kf[6],qr[3],C0,0,0,0),   P1[10],P1[11],P1[12],P1[13], pw3[0]=PKW(P1,8), pw3[1]=PKW(P1,10), pw3); \
    VRD(7); SBAR(); GAPA(C1=__builtin_amdgcn_mfma_f32_32x32x16_bf16(kf[7],qr[3],C1,0,0,0),   P1[14],P1[15],0.f,0.f,       pw3[2]=PKW(P1,12),pw3[3]=PKW(P1,14), pw3); \
    l_reg+=sacc; \
    if(GK){DMA_K((t)+3,sl_cur);} if(GV){DMA_V((t)+1,sl_next);} \
    BIAS(C0,C1,t); CMASK(C0,C1,t); \
    { float a=MX3(C0[0],C0[1],C1[0]),b=MX3(C0[2],C0[3],C1[1]); a=MX3(a,C1[2],C1[3]); \
      _Pragma("unroll") for(int r=4;r<16;r+=4){a=MX3(a,C0[r],C0[r+1]);b=MX3(b,C0[r+2],C0[r+3]);a=MX3(a,C1[r],C1[r+1]);b=MX3(b,C1[r+2],C1[r+3]);} \
      float rm=__builtin_fmaxf(a,b); { auto rr=__builtin_amdgcn_permlane32_swap(__float_as_uint(rm),__float_as_uint(rm),false,false); rm=__builtin_fmaxf(__uint_as_float(rr[0]),__uint_as_float(rr[1])); } \
      resc=false; \
      if(__builtin_expect(__any(rm>(float)THRL),0)){ const float dl=__builtin_fmaxf(rm,0.f); mhat+=dl; \
        _Pragma("unroll") for(int r=0;r<16;++r){C0[r]-=dl;C1[r]-=dl;} \
        _Pragma("unroll") for(int r=0;r<16;++r)negm[r]=-mhat; asm volatile("":"+v"(negm)); \
        const float f=__builtin_amdgcn_exp2f(-dl); l_reg*=f; if(hi==0)wsf[r32]=f; resc=true; } } \
    SBAR(); \
    GAPB(o[0]=__builtin_amdgcn_mfma_f32_32x32x16_bf16(PAF(0),VFR(0),o[0],0,0,0), C0,0); \
    GAPB(o[1]=__builtin_amdgcn_mfma_f32_32x32x16_bf16(PAF(0),VFR(4),o[1],0,0,0), C0,4); \
    KRD(GL,0); GAPB(o[0]=__builtin_amdgcn_mfma_f32_32x32x16_bf16(PAF(1),VFR(1),o[0],0,0,0), C0,8); \
    KRD(GL,1); GAPB(o[1]=__builtin_amdgcn_mfma_f32_32x32x16_bf16(PAF(1),VFR(5),o[1],0,0,0), C0,12); \
    KRD(GL,2); GAPB(o[0]=__builtin_amdgcn_mfma_f32_32x32x16_bf16(PAF(2),VFR(2),o[0],0,0,0), C1,0); \
    KRD(GL,3); GAPB(o[1]=__builtin_amdgcn_mfma_f32_32x32x16_bf16(PAF(2),VFR(6),o[1],0,0,0), C1,4); \
    GAPB(o[0]=__builtin_amdgcn_mfma_f32_32x32x16_bf16(PAF(3),VFR(3),o[0],0,0,0), C1,8); \
    GAPB(o[1]=__builtin_amdgcn_mfma_f32_32x32x16_bf16(PAF(3),VFR(7),o[1],0,0,0), C1,12); \
    }while(0)
  int t=1;
  #undef CMASK
  #define CMASK(P0,P1,t) do{}while(0)
  for(;t+5<NT;t+=2){
    STEP(pB0,pB1,pA0,pA1,t,true,true,true);     WAIT_BAR(2); RESC(); ROT();
    STEP(pA0,pA1,pB0,pB1,t+1,true,true,true);   WAIT_BAR(2); RESC(); ROT();
  }
  #undef CMASK
  #define CMASK(P0,P1,t) do{int jb_=(t)-(NT-4); if(jb_>=0)cmask(P0,P1,jb_,qrel,hi);}while(0)
  #define ENDW(tt) do{ if((tt)+3<NT){WAIT_BAR(2);} else if((tt)+2<NT){WAIT_BAR(1);} else {WAIT_BAR(0);} }while(0)
  for(;t+1<NT;t+=2){
    STEP(pB0,pB1,pA0,pA1,t,(t+3<NT),(t+1<NT),(t+1<NT));       ENDW(t);   RESC(); ROT();
    STEP(pA0,pA1,pB0,pB1,t+1,(t+4<NT),(t+2<NT),(t+2<NT));     ENDW(t+1); RESC(); ROT();
  }
  STEP(pB0,pB1,pA0,pA1,NT-1,false,false,false); RESC();
  { float sacc=pB0[0]+pB0[1]; _Pragma("unroll") for(int r=2;r<16;++r)sacc+=pB0[r]; _Pragma("unroll") for(int r=0;r<16;++r)sacc+=pB1[r]; l_reg+=sacc;
    pw0=(u32x4){PKW(pB0,0),PKW(pB0,2),PKW(pB0,4),PKW(pB0,6)};pw1=(u32x4){PKW(pB0,8),PKW(pB0,10),PKW(pB0,12),PKW(pB0,14)};pw2=(u32x4){PKW(pB1,0),PKW(pB1,2),PKW(pB1,4),PKW(pB1,6)};pw3=(u32x4){PKW(pB1,8),PKW(pB1,10),PKW(pB1,12),PKW(pB1,14)};
    SBAR(); pv(o,vb0+sl_cur,PAF(0),PAF(1),PAF(2),PAF(3)); }
  #undef PKW
  #undef PAF
  #undef VFR
  #undef PIN
  #undef MX3
  #undef GAPA
  #undef GAPB
  #undef EX
  #undef VRD
  #undef KRD
  #undef STEP
  #undef ENDW
  {auto rr=__builtin_amdgcn_permlane32_swap(__float_as_uint(l_reg),__float_as_uint(l_reg),false,false);l_reg=__uint_as_float(rr[0])+__uint_as_float(rr[1]);}
  if(hi==0)wsf[32+r32]=l_reg;asm volatile("s_waitcnt lgkmcnt(0)":::"memory");
  float rli[16];
  #pragma unroll
  for(int r=0;r<16;++r)rli[r]=__builtin_amdgcn_rcpf(wsf[32+crow(r,hi)]);
  bf16*Ow=Oh+(long)(q0+wid*QBLK)*DM;
  { bf16*stg=(bf16*)(shm+LDS_OST)+wid*2048;
    #pragma unroll
    for(int r=0;r<16;++r){const int orow=crow(r,hi);
      #pragma unroll
      for(int d0=0;d0<2;++d0)stg[orow*64+d0*32+r32]=__float2bfloat16(o[d0][r]*rli[r]);}
    asm volatile("s_waitcnt lgkmcnt(0)":::"memory");
    #pragma unroll
    for(int i=0;i<4;++i){const int row=i*8+(lane>>3),ch=lane&7; const u32x4 v=*(const u32x4*)(stg+row*64+ch*8); ATTN_STORE16(Ow+(long)row*DM+ch*8,v);} }
  asm volatile("s_waitcnt lgkmcnt(0)\n\ts_barrier":::"memory");
  #undef DMA_K
  #undef DMA_V
  #undef CMASK
  #undef START
  #undef RESC
  #undef ROT
  #undef BIAS
}
constexpr int ATTN_LDS_BYTES=LDS_BYTES;
constexpr int SWA_K=0, SWA_V=6*SLOTB, SWA_OST=12*SLOTB, SWA_WS=133120;
__device__ __forceinline__ void swa_unit(const int wave_s,int qb,const bf16*Qh,const bf16*__restrict__ Kh,const bf16*__restrict__ Vh,bf16*Oh,float slope2,float sink2,char*shm){
  const int wid=wave_s; const int tid=wave_s*64+fresh_lane(),lane=tid&63,r32=lane&31,hi=lane>>5;
  const int q0=qb*QB, c0=4*qb-2;
  const bf16*Qw=Qh+(long)(q0+wid*QBLK)*DM;
  const unsigned lds0=(unsigned)(uintptr_t)shm;
  float*wsf=(float*)(shm+SWA_WS)+wid*64;
  const bf16*ksrc=Kh+(long)lane*DM+wid*8;
  const bf16*vsrc=Vh+(long)(16*(wid&3)+(lane>>2))*DM+(wid>>2)*32+(lane&3)*8;
  const unsigned kdst=lds0+SWA_K+wid*1024, vdst=lds0+SWA_V+wid*1024;
  #pragma unroll
  for(int s=0;s<6;++s){ const int ch=c0+s; if(ch>=0){ glds16(ksrc+(long)ch*KVBLK*DM,(unsigned)__builtin_amdgcn_readfirstlane(kdst+s*SLOTB)); glds16(vsrc+(long)ch*KVBLK*DM,(unsigned)__builtin_amdgcn_readfirstlane(vdst+s*SLOTB)); } }
  bf16x8 qr[4];
  #pragma unroll
  for(int d0=0;d0<4;++d0)qr[d0]=*reinterpret_cast<const bf16x8*>(&Qw[(long)r32*DM+d0*16+hi*8]);
  WAIT_BAR(0);
  const int wc=wid>>1, qrel=(wid&1)*32+r32;
  f32x16 zero=f32x16{}; asm volatile("":"+v"(zero));
  f32x16 S[3][2];
  #pragma unroll
  for(int t=0;t<3;++t){
    if(c0+wc+t>=0){
      qkt(S[t][0],S[t][1],shm+SWA_K+(wc+t)*SLOTB,qr,zero,r32,hi);
      const float qf=(float)(64*(2-t)+qrel-4*hi);
      #pragma unroll
      for(int r=0;r<16;++r){ const float dd=qf-(float)((r&3)+8*(r>>2)); S[t][0][r]=__builtin_fmaf(-slope2,__builtin_fabsf(dd),S[t][0][r]); S[t][1][r]=__builtin_fmaf(-slope2,__builtin_fabsf(dd-32.f),S[t][1][r]); }
    } else {
      #pragma unroll
      for(int r=0;r<16;++r){ S[t][0][r]=-INFINITY; S[t][1][r]=-INFINITY; }
    }
  }
  float m=sink2;
  #pragma unroll
  for(int t=0;t<3;++t) m=__builtin_fmaxf(m,rowmax(S[t][0],S[t][1]));
  float l=0.f;
  #pragma unroll
  for(int t=0;t<3;++t){
    #pragma unroll
    for(int r=0;r<16;++r){ S[t][0][r]=__builtin_amdgcn_exp2f(S[t][0][r]-m); S[t][1][r]=__builtin_amdgcn_exp2f(S[t][1][r]-m); l+=S[t][0][r]+S[t][1][r]; }
  }
  {auto rr=__builtin_amdgcn_permlane32_swap(__float_as_uint(l),__float_as_uint(l),false,false);l=__uint_as_float(rr[0])+__uint_as_float(rr[1]);}
  l+=__builtin_amdgcn_exp2f(sink2-m);
  f32x16 o[2];o[0]=f32x16{};o[1]=f32x16{};
  const int vb0=(int)(lds0+SWA_V)+((lane>>4)&1)*32+(lane&3)*8+(4*hi+((lane&15)>>2))*64;
  #pragma unroll
  for(int t=0;t<3;++t){
    if(c0+wc+t>=0){
      #define PKW(P,B) cvtpk_s(P[B],P[B+1])
      const u32x4 pw0=(u32x4){PKW(S[t][0],0),PKW(S[t][0],2),PKW(S[t][0],4),PKW(S[t][0],6)},pw1=(u32x4){PKW(S[t][0],8),PKW(S[t][0],10),PKW(S[t][0],12),PKW(S[t][0],14)};
      const u32x4 pw2=(u32x4){PKW(S[t][1],0),PKW(S[t][1],2),PKW(S[t][1],4),PKW(S[t][1],6)},pw3=(u32x4){PKW(S[t][1],8),PKW(S[t][1],10),PKW(S[t][1],12),PKW(S[t][1],14)};
      #undef PKW
      SBAR(); pv(o,vb0+(wc+t)*SLOTB,__builtin_bit_cast(bf16x8,pw0),__builtin_bit_cast(bf16x8,pw1),__builtin_bit_cast(bf16x8,pw2),__builtin_bit_cast(bf16x8,pw3));
    }
  }
  if(hi==0)wsf[32+r32]=l;asm volatile("s_waitcnt lgkmcnt(0)":::"memory");
  float rli[16];
  #pragma unroll
  for(int r=0;r<16;++r)rli[r]=__builtin_amdgcn_rcpf(wsf[32+crow(r,hi)]);
  bf16*Ow=Oh+(long)(q0+wid*QBLK)*DM;
  { bf16*stg=(bf16*)(shm+SWA_OST)+wid*2048;
    #pragma unroll
    for(int r=0;r<16;++r){const int orow=crow(r,hi);
      #pragma unroll
      for(int d0=0;d0<2;++d0)stg[orow*64+d0*32+r32]=__float2bfloat16(o[d0][r]*rli[r]);}
    asm volatile("s_waitcnt lgkmcnt(0)":::"memory");
    #pragma unroll
    for(int i=0;i<4;++i){const int row=i*8+(lane>>3),ch=lane&7; const u32x4 v=*(const u32x4*)(stg+row*64+ch*8); ATTN_STORE16(Ow+(long)row*DM+ch*8,v);} }
  asm volatile("s_waitcnt lgkmcnt(0)\n\ts_barrier":::"memory");
}

#undef SBAR
#undef WAIT_BAR
}

namespace cg = cooperative_groups;
constexpr int NWAVES = 8;
constexpr int BATCH = 2, T = 8192, D = 1024, FF = 4096, PLE = 256, DIN_SRC = 4360, NZ = 4352, M = BATCH * T;
constexpr float RMS_EPS = 1e-6f, LOG2E = 1.4426950408889634f;
constexpr size_t MiB = 1u << 20;
constexpr size_t WS_WIN = 0, WS_WA = 9 * MiB, WS_WB = 10 * MiB, WS_WMIX = 11 * MiB, WS_W1 = 13 * MiB, WS_W2 = 21 * MiB, WS_WG = 29 * MiB, WS_WP = 31 * MiB;
constexpr size_t WS_LF = 31 * MiB + 512 * 1024, WS_CB = 32 * MiB;
constexpr size_t WS_NM = 32 * MiB + 512 * 1024;
constexpr size_t WS_ST1 = 33 * MiB, WS_ST2 = 34 * MiB, WS_ST3 = 35 * MiB;
constexpr size_t WS_PB = 36 * MiB;
constexpr size_t WS_XN = 44 * MiB;
constexpr size_t WS_HN = 76 * MiB;
constexpr size_t WS_Z = 108 * MiB;
constexpr size_t WS_CTL = 244 * MiB, CTL_ZERO_BYTES = 16384;
constexpr size_t WS_END = 245 * MiB;
constexpr int RING_BYTES = 131072, LDS_BYTES = 147456, MISC_OFF = RING_BYTES + 320;
#define GAS __attribute__((address_space(1)))
#define LAS __attribute__((address_space(3)))
typedef unsigned short bf16;
typedef unsigned v4u __attribute__((ext_vector_type(4)));
typedef unsigned v2u __attribute__((ext_vector_type(2)));
typedef float f32x4 __attribute__((ext_vector_type(4)));
#define LDS_WAIT() asm volatile("s_waitcnt lgkmcnt(0)" ::: "memory")
__device__ __forceinline__ unsigned f2bf(float f) { unsigned u = __builtin_bit_cast(unsigned, f); return (u + 0x7fffu + ((u >> 16) & 1u)) >> 16; }
__device__ __forceinline__ unsigned pk2(float lo, float hi) { return f2bf(lo) | (f2bf(hi) << 16); }
__device__ __forceinline__ float wave_sum(float v) {
#pragma unroll
    for (int o = 1; o < 64; o <<= 1) v += __shfl_xor(v, o);
    return v;
}
#define RLX_AGENT __ATOMIC_RELAXED, __HIP_MEMORY_SCOPE_AGENT
#define XB_TMO      128
#define XB_XCNT(j)  (256  + 64 * (j))
#define XB_XSUB(j)  (1280 + 64 * (j))
#define XB_XGEN(j)  (2304 + 64 * (j))
#define XB_TOP      3328
#define XB_TOPGEN   3392
#define XCD_BAR_WORDS 3456
#define XB_SPIN_CAP (1u << 18)

__device__ __forceinline__ unsigned xb_ld(unsigned* p)              { return __hip_atomic_load(p, __ATOMIC_RELAXED, __HIP_MEMORY_SCOPE_AGENT); }
__device__ __forceinline__ unsigned xb_add(unsigned* p, unsigned v) { return __hip_atomic_fetch_add(p, v, __ATOMIC_RELAXED, __HIP_MEMORY_SCOPE_AGENT); }
__device__ __forceinline__ unsigned xb_xcc_id() { return (unsigned)__builtin_amdgcn_s_getreg((3 << 11) | 20) & 0xFu; }
#define XB_SPIN(cond, bar) do { unsigned _sp = 0; while (cond) { __builtin_amdgcn_s_sleep(1); \
    if ((++_sp & 255u) == 0u) { if (xb_ld(&(bar)[XB_TMO])) break; if (_sp > XB_SPIN_CAP) { atomicAdd(&(bar)[XB_TMO], 1u); break; } } } } while (0)

struct XcdBarrier {
    unsigned* bar; unsigned x;
    volatile LAS unsigned* st;
};

__device__ __forceinline__ XcdBarrier xcd_barrier_post(unsigned* bar, volatile LAS unsigned* st) {
    XcdBarrier b; b.bar = bar; b.x = xb_xcc_id(); b.st = st;
    if (threadIdx.x == 0) (void)xb_add(&bar[XB_XCNT(b.x)], 1u);
    return b;
}
__device__ __forceinline__ void xcd_barrier_complete(unsigned* bar, unsigned x, unsigned& nloc, unsigned& nx) {
    const unsigned G = gridDim.x * gridDim.y * gridDim.z;
    unsigned sum, cnt, mine, sp = 0u;
    for (;;) {
        sum = 0u; cnt = 0u; mine = 0u;
#pragma unroll
        for (unsigned j = 0; j < 16; ++j) { const unsigned c = xb_ld(&bar[XB_XCNT(j)]); sum += c; cnt += (c > 0u) ? 1u : 0u; mine = (j == x) ? c : mine; }
        if (sum == G) break;
        __builtin_amdgcn_s_sleep(1);
        if ((++sp & 255u) == 0u) { if (xb_ld(&bar[XB_TMO])) break; if (sp > XB_SPIN_CAP) { atomicAdd(&bar[XB_TMO], 1u); break; } }
    }
    nloc = mine > 0u ? mine : 1u; nx = cnt > 0u ? cnt : 1u;
}

__device__ __forceinline__ void xcd_barrier(const XcdBarrier& b, const bool t0) {
    asm volatile("s_waitcnt vmcnt(0)" ::: "memory");
    __syncthreads();
    if (t0) {
        unsigned* bar = b.bar;
        __builtin_amdgcn_s_waitcnt(0);
        unsigned nloc = b.st[0], nx = b.st[1];
        if (nloc == 0u) { xcd_barrier_complete(bar, b.x, nloc, nx); b.st[0] = nloc; b.st[1] = nx; }
        const unsigned old = xb_add(&bar[XB_XSUB(b.x)], 1u);
        const unsigned gen = old / nloc;
        if (old + 1u == (gen + 1u) * nloc) {
            __builtin_amdgcn_fence(__ATOMIC_RELEASE, "agent");
            asm volatile("s_waitcnt vmcnt(0)" ::: "memory");
            const unsigned og = xb_add(&bar[XB_TOP], 1u);
            const unsigned tg = og / nx;
            if (og + 1u == (tg + 1u) * nx) xb_add(&bar[XB_TOPGEN], 1u);
            else XB_SPIN(xb_ld(&bar[XB_TOPGEN]) == tg, bar);
            __builtin_amdgcn_fence(__ATOMIC_ACQUIRE, "agent");
            xb_add(&bar[XB_XGEN(b.x)], 1u);
            asm volatile("s_waitcnt vmcnt(0)" ::: "memory");
        } else {
            XB_SPIN(xb_ld(&bar[XB_XGEN(b.x)]) == gen, bar);
            __builtin_amdgcn_fence(__ATOMIC_ACQUIRE, "agent");
            asm volatile("s_waitcnt vmcnt(0)" ::: "memory");
        }
    }
    __syncthreads();
}
struct Frame {
    LAS unsigned char* lds; int wave, vcu, G;
};
__device__ __forceinline__ void p0_transpose_item(const float* W, int ldw, int K, int N, int split, int extra, const float* gs, bf16* WT, LAS float* scr, int item, int lane) {
    const int nblk = N / 32, kb = item / nblk, nb = item % nblk, k0 = 64 * kb, n0 = 32 * nb, s0 = n0 + (n0 >= split ? extra : 0);
    const float* src = W + (size_t)(k0 + (lane >> 5)) * ldw + s0 + (lane & 31);
    float w[32];
#pragma unroll
    for (int i = 0; i < 32; ++i) w[i] = src[(size_t)(2 * i) * ldw];
    const int c = lane & 7;
    f32x4 g0 = (f32x4){1.f, 1.f, 1.f, 1.f}, g1 = g0;
    if (gs) { g0 = *(const f32x4*)(gs + k0 + 8 * c); g1 = *(const f32x4*)(gs + k0 + 8 * c + 4); }
#pragma unroll
    for (int i = 0; i < 32; ++i) scr[(2 * i + (lane >> 5)) * 33 + (lane & 31)] = w[i];
    LDS_WAIT(); asm volatile("" ::: "memory");
#pragma unroll
    for (int j = 0; j < 4; ++j) { const int n = (lane >> 3) + 8 * j; const LAS float* s = scr + (8 * c) * 33 + n;
        v4u o; o.x = pk2(s[0 * 33] * g0.x, s[1 * 33] * g0.y); o.y = pk2(s[2 * 33] * g0.z, s[3 * 33] * g0.w); o.z = pk2(s[4 * 33] * g1.x, s[5 * 33] * g1.y); o.w = pk2(s[6 * 33] * g1.z, s[7 * 33] * g1.w);
        *(GAS v4u*)(WT + (size_t)(n0 + n) * K + k0 + 8 * c) = o; }
    LDS_WAIT(); asm volatile("" ::: "memory");
}
struct Args { const float* in[16]; float* out; unsigned char* ws; };
constexpr int WF_OFF = 8 * 8704;

__global__ void __launch_bounds__(NWAVES * 64, 2) mk_fwd(Args args) {
    extern __shared__ __attribute__((aligned(16))) unsigned char lds[];
    cg::grid_group grid = cg::this_grid();
    Frame F;
    F.lds = (LAS unsigned char*)lds;
    F.wave = __builtin_amdgcn_readfirstlane((int)threadIdx.x >> 6);
    F.G = gridDim.x; { const int bx = blockIdx.x; F.vcu = (F.G % 8 == 0) ? (bx % 8) * (F.G / 8) + bx / 8 : bx; }
    unsigned char* ws = args.ws;
    const float* x = args.in[0]; const float* p_in = args.in[1]; const float* g_mix = args.in[2]; const float* w_in = args.in[3]; const float* b_forget = args.in[4];
    const float* sinks = args.in[5]; const float* w_br_swa = args.in[6]; const float* w_br_fox = args.in[7]; const float* w_mix = args.in[8]; const float* g_mlp = args.in[9];
    const float* w_ff1 = args.in[10]; const float* w_ff2 = args.in[11]; const float* g_ple = args.in[12]; const float* w_pg = args.in[13]; const float* w_pp = args.in[14]; const float* g_final = args.in[15];
    float* out = args.out;
    bf16 *WIN_t = (bf16*)(ws + WS_WIN), *WA_t = (bf16*)(ws + WS_WA), *WB_t = (bf16*)(ws + WS_WB), *WMIX_t = (bf16*)(ws + WS_WMIX), *W1_t = (bf16*)(ws + WS_W1), *W2_t = (bf16*)(ws + WS_W2), *WG_t = (bf16*)(ws + WS_WG), *WP_t = (bf16*)(ws + WS_WP);
    float *LF = (float*)(ws + WS_LF), *CB = (float*)(ws + WS_CB), *ST1 = (float*)(ws + WS_ST1), *ST2 = (float*)(ws + WS_ST2), *ST3 = (float*)(ws + WS_ST3);
    bf16 *PB = (bf16*)(ws + WS_PB), *XN = (bf16*)(ws + WS_XN), *HN = (bf16*)(ws + WS_HN), *Z = (bf16*)(ws + WS_Z), *HB = (bf16*)(ws + WS_Z); bf16* PP = (bf16*)(ws + WS_Z);
    unsigned* NM = (unsigned*)(ws + WS_NM);
    const int gw = F.vcu * NWAVES + F.wave, NGW = F.G * NWAVES;

    for (int u = threadIdx.x; u < 128; u += NWAVES * 64) ((LAS unsigned*)(F.lds + RING_BYTES))[u] = 0u;
    __syncthreads();
    XcdBarrier bar = xcd_barrier_post((unsigned*)(ws + WS_CTL), (volatile LAS unsigned*)(F.lds + MISC_OFF) + 8);
#define GRID_BAR() do { const int l_ = fresh_lane(); xcd_barrier(bar, (F.wave == 0) && (l_ == 0)); } while (0)
    {
        const int p0_tid = threadIdx.x, p0_lane = p0_tid & 63;
        for (int i = blockIdx.x * (NWAVES * 64) + p0_tid; i < 1024 + 32; i += F.G * NWAVES * 64) NM[i] = 0u;
        LAS float* wfT = (LAS float*)(F.lds + WF_OFF);
        for (int i = p0_tid; i < 8 * D; i += NWAVES * 64) { const int k = i >> 3, h = i & 7; wfT[h * 1024 + k] = g_mix[k] * w_in[(size_t)k * DIN_SRC + 2304 + h]; }
        __syncthreads();
        f32x4 gm4[4];
#pragma unroll
        for (int j = 0; j < 4; ++j) gm4[j] = ((const GAS f32x4*)g_mix)[64 * j + p0_lane];
        const float bfg = b_forget[p0_lane & 7];
        f32x4 v[4];
        if (gw < M) { const GAS f32x4* xr = (const GAS f32x4*)(x + (size_t)gw * D) + p0_lane;
#pragma unroll
            for (int j = 0; j < 4; ++j) v[j] = xr[64 * j]; }
        for (int m = gw; m < M; m += NGW) {
            f32x4 vn[4]; const int mn = (m + NGW < M) ? m + NGW : m;
            { const GAS f32x4* xr = (const GAS f32x4*)(x + (size_t)mn * D) + p0_lane;
#pragma unroll
              for (int j = 0; j < 4; ++j) vn[j] = xr[64 * j]; }
            float ss = 0.f;
#pragma unroll
            for (int j = 0; j < 4; ++j) ss += (v[j].x * v[j].x + v[j].y * v[j].y) + (v[j].z * v[j].z + v[j].w * v[j].w);
            float a8[8];
#pragma unroll
            for (int h = 0; h < 8; ++h) { float a = 0.f;
#pragma unroll
                for (int j = 0; j < 4; ++j) { const f32x4 w = ((const LAS f32x4*)wfT)[h * 256 + 64 * j + p0_lane]; a += (v[j].x * w.x + v[j].y * w.y) + (v[j].z * w.z + v[j].w * w.w); }
                a8[h] = a; }
#pragma unroll
            for (int o = 1; o < 64; o <<= 1) { ss += __shfl_xor(ss, o);
#pragma unroll
                for (int h = 0; h < 8; ++h) a8[h] += __shfl_xor(a8[h], o); }
            const float rstd = 1.f / sqrtf(ss * (1.f / D) + RMS_EPS);
            float fsel = a8[0];
#pragma unroll
            for (int h = 1; h < 8; ++h) fsel = (p0_lane == h) ? a8[h] : fsel;
            if (p0_lane < 8) { const float xf = fsel * rstd + bfg; const float ls = fminf(xf, 0.f) - log1pf(expf(-fabsf(xf)));
                LF[(size_t)((m >> 13) * 8 + p0_lane) * T + (m & (T - 1))] = ls; }
            GAS unsigned long long* o8 = (GAS unsigned long long*)(XN + (size_t)m * D) + p0_lane;
#pragma unroll
            for (int j = 0; j < 4; ++j) { const f32x4 y = v[j] * rstd * gm4[j];
                o8[64 * j] = (unsigned long long)pk2(y.x, y.y) | ((unsigned long long)pk2(y.z, y.w) << 32); }
#pragma unroll
            for (int j = 0; j < 4; ++j) v[j] = vn[j];
        }
        LAS float* scr = (LAS float*)(F.lds + F.wave * 8704);
        constexpr int I_IN = (D / 64) * (NZ / 32);
        for (int it = gw; it < I_IN; it += NGW) p0_transpose_item(w_in, DIN_SRC, D, NZ, 2304, 8, nullptr, WIN_t, scr, it, p0_lane);
    }
    grid.sync();

    for (int bh = (F.G >= 96) ? (int)blockIdx.x - 64 : (int)blockIdx.x; bh < 16; bh += (int)gridDim.x) {
        if (bh < 0) continue;
        const int c_lane = fresh_lane(), c_tid = F.wave * 64 + c_lane;
        const GAS f32x4* src = (const GAS f32x4*)(LF + (size_t)bh * T) + c_tid * 4;
        f32x4 v[4]; float run = 0.f;
#pragma unroll
        for (int j = 0; j < 4; ++j) { v[j] = src[j];
#pragma unroll
            for (int e = 0; e < 4; ++e) { run += v[j][e]; v[j][e] = run; } }
        float sc = run;
#pragma unroll
        for (int o = 1; o < 64; o <<= 1) { const float n = __shfl_up(sc, o); if (c_lane >= o) sc += n; }
        LAS float* wt = (LAS float*)F.lds;
        if (c_lane == 63) wt[F.wave] = sc;
        __syncthreads();
        float woff = 0.f;
        for (int w = 0; w < F.wave; ++w) woff += wt[w];
        const float off = woff + sc - run;
        GAS f32x4* dst = (GAS f32x4*)(CB + (size_t)bh * T) + c_tid * 4;
#pragma unroll
        for (int j = 0; j < 4; ++j) dst[j] = (v[j] + off) * (-LOG2E);
        __syncthreads();
    }
    {
        pg8::Gemm g{XN, WIN_t, M, NZ, D, D}; pg8::StaticOrder S; S.init(M, NZ, F.G, (int)blockIdx.x);
        pg8::EpiZ E{Z, NM, 0};
        pg8::gemm_phase<pg8::EpiZ, pg8::StaticOrder, PG8_ALIGN, PG8_SP2>(F.lds, g, S, E, F.wave);
    }
    {
        const int nfive = (M / 256) * (NZ / 256) - 4 * F.G;
        const int nconv = (nfive > 0 && nfive < F.G) ? F.G - nfive : F.G, cidx = (nfive > 0 && nfive < F.G) ? (int)blockIdx.x - nfive : (int)blockIdx.x;
        if (cidx >= 0) {
            const int w_lane = fresh_lane();
            LAS float* scr = (LAS float*)(F.lds + F.wave * 8704);
            for (int i = (cidx * NWAVES + F.wave) * 64 + w_lane; i < M * PLE / 32; i += nconv * NWAVES * 64) { f32x4 a[8];
#pragma unroll
            for (int q = 0; q < 4; ++q) { a[2 * q] = ((const GAS f32x4*)p_in)[2 * (i + q * (M * PLE / 32))]; a[2 * q + 1] = ((const GAS f32x4*)p_in)[2 * (i + q * (M * PLE / 32)) + 1]; }
#pragma unroll
            for (int q = 0; q < 4; ++q) { v4u o; o.x = pk2(a[2 * q].x, a[2 * q].y); o.y = pk2(a[2 * q].z, a[2 * q].w); o.z = pk2(a[2 * q + 1].x, a[2 * q + 1].y); o.w = pk2(a[2 * q + 1].z, a[2 * q + 1].w); ((GAS v4u*)PB)[i + q * (M * PLE / 32)] = o; } }
            constexpr int I_A = (512 / 64) * (D / 32), I_MIX = (D / 64) * (D / 32), I_1 = (D / 64) * (FF / 32), I_2 = (FF / 64) * (D / 32), I_P = (PLE / 64) * (D / 32);
            constexpr int NITEMS = 2 * I_A + I_MIX + I_1 + I_2 + I_MIX + I_P;
            for (int it = cidx * NWAVES + F.wave; it < NITEMS; it += nconv * NWAVES) {
                int r = it;
                if (r < I_A) { p0_transpose_item(w_br_swa, D, 512, D, 1 << 30, 0, nullptr, WA_t, scr, r, w_lane); continue; } r -= I_A;
                if (r < I_A) { p0_transpose_item(w_br_fox, D, 512, D, 1 << 30, 0, nullptr, WB_t, scr, r, w_lane); continue; } r -= I_A;
                if (r < I_MIX) { p0_transpose_item(w_mix, D, D, D, 1 << 30, 0, nullptr, WMIX_t, scr, r, w_lane); continue; } r -= I_MIX;
                if (r < I_1) { p0_transpose_item(w_ff1, FF, D, FF, 1 << 30, 0, g_mlp, W1_t, scr, r, w_lane); continue; } r -= I_1;
                if (r < I_2) { p0_transpose_item(w_ff2, D, FF, D, 1 << 30, 0, nullptr, W2_t, scr, r, w_lane); continue; } r -= I_2;
                if (r < I_MIX) { p0_transpose_item(w_pg, D, D, D, 1 << 30, 0, g_ple, WG_t, scr, r, w_lane); continue; } r -= I_MIX;
                p0_transpose_item(w_pp, D, PLE, D, 1 << 30, 0, nullptr, WP_t, scr, r, w_lane);
            }
        }
    }
    GRID_BAR();

    {
        unsigned* qctr = (unsigned*)(ws + WS_CTL) + 3584;
        volatile LAS unsigned* qslot = (volatile LAS unsigned*)(F.lds + RING_BYTES + 16);
        for (;;) {
            { const int l_ = fresh_lane(); if (F.wave == 0 && l_ == 0) qslot[0] = __hip_atomic_fetch_add(qctr, 1u, __ATOMIC_RELAXED, __HIP_MEMORY_SCOPE_AGENT); }
            __syncthreads();
            const int idx = __builtin_amdgcn_readfirstlane((int)qslot[0]);
            __syncthreads();
            if (idx >= 64 + 512 + 512) break;
            if (idx < 64) {
                continue;
            } else if (idx < 64 + 512) {
                const int j = idx - 64, qb = 31 - (j >> 4), bh = j & 15, b = bh >> 3, h = bh & 7;
                const attn_body::bf16* Zb = (const attn_body::bf16*)Z + (size_t)b * T * NZ;
                const attn_body::bf16* Qh = Zb + 768 + h * 64; const attn_body::bf16* Kh = Zb + 1280 + h * 64; const attn_body::bf16* Vh = Zb + 1792 + h * 64;
                const float* cb = CB + (size_t)bh * T;
                const float km = sqrtf(__uint_as_float(NM[1024 + bh * 2]) + __uint_as_float(NM[1024 + bh * 2 + 1]));
                const int pmA = b * 32 + qb;
                const float qkA = 2.04f * km * sqrtf(__uint_as_float(NM[(pmA * 8 + h) * 2]) + __uint_as_float(NM[(pmA * 8 + h) * 2 + 1]));
                attn_body::attn_unit<24>(F.wave, qb, Qh, Kh, Vh, (attn_body::bf16*)Qh, cb, qkA, (char*)lds);
            } else {
                const int j = idx - 64 - 512, bh = j >> 5, qb = j & 31, b = bh >> 3, h = bh & 7;
                const attn_body::bf16* Zb = (const attn_body::bf16*)Z + (size_t)b * T * NZ;
                const attn_body::bf16* Qh = Zb + h * 64; const attn_body::bf16* Kh = Zb + 512 + (h >> 2) * 64; const attn_body::bf16* Vh = Zb + 640 + (h >> 2) * 64;
                const float slope2 = exp2f(-(float)(h + 1)) * LOG2E, sink2 = sinks[h] * LOG2E;
                attn_body::swa_unit(F.wave, qb, Qh, Kh, Vh, (attn_body::bf16*)Qh, slope2, sink2, (char*)lds);
            }
        }
    }
    GRID_BAR();

    {
        pg8::PairOrder S; S.so.init(M, D, F.G, (int)blockIdx.x);
        pg8::Gemm g{Z, WA_t, M, D, 512, NZ}; pg8::EpiPair E{Z + 2304, Z + 3328, XN, (size_t)768 * 2, (size_t)(WS_WB - WS_WA)};
        pg8::gemm_phase<pg8::EpiPair, pg8::PairOrder, PG8_ALIGN, PG8_SP2>(F.lds, g, S, E, F.wave);
    }
    GRID_BAR();

    {
        pg8::Gemm g{XN, WMIX_t, M, D, D, D}; pg8::StaticOrder S; S.init(M, D, F.G, (int)blockIdx.x);
        pg8::EpiRes<false> E{x, HN, ST1};
        pg8::gemm_phase<pg8::EpiRes<false>, pg8::StaticOrder, PG8_ALIGN, PG8_SP2>(F.lds, g, S, E, F.wave);
    }
    GRID_BAR();

    {
        pg8::Gemm g{HN, W1_t, M, FF, D, D}; pg8::StaticOrder S; S.init(M, FF, F.G, (int)blockIdx.x);
        pg8::EpiRelu2 E{ST1, HB};
        pg8::gemm_phase<pg8::EpiRelu2, pg8::StaticOrder, PG8_ALIGN, PG8_SP2>(F.lds, g, S, E, F.wave);
    }
    GRID_BAR();

    {
        pg8::Gemm g{HB, W2_t, M, D, FF, FF}; pg8::StaticOrder S; S.init(M, D, F.G, (int)blockIdx.x);
        pg8::EpiRes<true> E{HN, XN, ST2};
        pg8::gemm_phase<pg8::EpiRes<true>, pg8::StaticOrder, PG8_ALIGN, PG8_SP2>(F.lds, g, S, E, F.wave);
    }
    GRID_BAR();

    {
        pg8::StaticOrder S; S.init(M, D, F.G, (int)blockIdx.x);
        { pg8::Gemm g{PB, WP_t, M, D, PLE, PLE}; pg8::EpiPP E{PP}; pg8::gemm_phase<pg8::EpiPP, pg8::StaticOrder, PG8_ALIGN, PG8_SP2>(F.lds, g, S, E, F.wave); }
        { pg8::Gemm g{XN, WG_t, M, D, D, D}; pg8::EpiPle E{ST2, PP, XN, HN, ST3}; pg8::gemm_phase<pg8::EpiPle, pg8::StaticOrder, PG8_ALIGN, PG8_SP2>(F.lds, g, S, E, F.wave); }
    }
    GRID_BAR();

    const int f_lane = fresh_lane();
    f32x4 gf4[4];
#pragma unroll
    for (int j = 0; j < 4; ++j) gf4[j] = ((const GAS f32x4*)g_final)[64 * j + f_lane];
    for (int m = gw; m < M; m += 2 * NGW) {
        const int m2 = (m + NGW < M) ? m + NGW : m;
        const float t0 = (f_lane < 16) ? ST3[(size_t)m * 16 + f_lane] : 0.f, t1 = (f_lane < 16) ? ST3[(size_t)m2 * 16 + f_lane] : 0.f;
        const GAS v2u* hr0 = (const GAS v2u*)(HN + (size_t)m * D) + f_lane; const GAS v2u* hr1 = (const GAS v2u*)(HN + (size_t)m2 * D) + f_lane;
        v2u h0[4], h1[4];
#pragma unroll
        for (int j = 0; j < 4; ++j) { h0[j] = hr0[64 * j]; h1[j] = hr1[64 * j]; }
        float s0 = t0, s1 = t1;
#pragma unroll
        for (int o = 1; o < 16; o <<= 1) { s0 += __shfl_xor(s0, o); s1 += __shfl_xor(s1, o); }
        s0 = __shfl(s0, 0); s1 = __shfl(s1, 0);
        const float r0 = 1.f / sqrtf(s0 * (1.f / D) + RMS_EPS), r1 = 1.f / sqrtf(s1 * (1.f / D) + RMS_EPS);
        GAS f32x4* x0 = (GAS f32x4*)(out + (size_t)m * D) + f_lane; GAS f32x4* x1 = (GAS f32x4*)(out + (size_t)m2 * D) + f_lane;
#pragma unroll
        for (int j = 0; j < 4; ++j) {
            const f32x4 a = (f32x4){__uint_as_float(h0[j].x << 16), __uint_as_float(h0[j].x & 0xffff0000u), __uint_as_float(h0[j].y << 16), __uint_as_float(h0[j].y & 0xffff0000u)};
            const f32x4 b = (f32x4){__uint_as_float(h1[j].x << 16), __uint_as_float(h1[j].x & 0xffff0000u), __uint_as_float(h1[j].y << 16), __uint_as_float(h1[j].y & 0xffff0000u)};
            x0[64 * j] = a * r0 * gf4[j]; x1[64 * j] = b * r1 * gf4[j]; }
    }
}

extern "C" void kernel_launch(void* const* d_in, const int* in_sizes, int n_in, void* d_out, int out_size, void* d_ws, size_t ws_size, hipStream_t stream) {
    static int grid = 0;
    if (grid == 0) {
        if (n_in != 16 || in_sizes[0] != M * D || out_size != M * D || ws_size < WS_END) { fprintf(stderr, "kernel_launch: unexpected shapes (n_in %d, in0 %d, out %d, ws %zu); nothing launched\n", n_in, n_in > 0 ? in_sizes[0] : -1, out_size, ws_size); grid = -1; return; }
        int dev = 0, cus = 0, per_cu = 0;
        if (hipGetDevice(&dev) != hipSuccess || hipDeviceGetAttribute(&cus, hipDeviceAttributeMultiprocessorCount, dev) != hipSuccess) { grid = -1; return; }
        if (hipFuncSetAttribute((const void*)mk_fwd, hipFuncAttributeMaxDynamicSharedMemorySize, LDS_BYTES) != hipSuccess) { fprintf(stderr, "kernel_launch: hipFuncSetAttribute failed\n"); grid = -1; return; }
        if (hipOccupancyMaxActiveBlocksPerMultiprocessor(&per_cu, (const void*)mk_fwd, NWAVES * 64, LDS_BYTES) != hipSuccess || per_cu < 1) { fprintf(stderr, "kernel_launch: occupancy query failed (%d)\n", per_cu); (void)hipGetLastError(); per_cu = 1; }
        if (per_cu > 1) per_cu = 1;
        grid = cus * per_cu;
    }
    if (grid < 0) return;
    if (hipMemsetAsync((char*)d_ws + WS_CTL, 0, CTL_ZERO_BYTES, stream) != hipSuccess) { fprintf(stderr, "kernel_launch: memset failed\n"); return; }
    Args a{};
    for (int i = 0; i < 16; ++i) a.in[i] = (const float*)d_in[i];
    a.out = (float*)d_out; a.ws = (unsigned char*)d_ws;
    void* kargs[] = {&a};
    hipError_t e = hipLaunchCooperativeKernel((const void*)mk_fwd, dim3(grid), dim3(NWAVES * 64), kargs, LDS_BYTES, stream);
    if (e != hipSuccess) fprintf(stderr, "kernel_launch: cooperative launch failed: %s (grid %d)\n", hipGetErrorString(e), grid);
}
```

```cpp
#include <hip/hip_runtime.h>
#include <hip/hip_cooperative_groups.h>
#include <cstdio>
#include <cstdint>
__device__ __forceinline__ int fresh_lane() { int l; asm volatile("v_mbcnt_lo_u32_b32 %0, -1, 0\n\tv_mbcnt_hi_u32_b32 %0, -1, %0" : "=v"(l)); return l; }

namespace pg8 {

#define PG8_LAS __attribute__((address_space(3)))
typedef unsigned short bf16_t;
typedef short bf16x8 __attribute__((ext_vector_type(8)));
typedef float f32x4 __attribute__((ext_vector_type(4)));
typedef unsigned u32x4 __attribute__((ext_vector_type(4)));
constexpr int BM = 256, BK = 64, HALF = 128, HTB = HALF * BK * 2  , STAGE_BYTES = 8 * HTB, NXCD = 8, WGM = 8;

__host__ __device__ __forceinline__ int lds_byte(int r, int c) { const int st = (r >> 4) * 2 + (c >> 5), rr = r & 15, cc = c & 31, ob = rr * 64 + cc * 2; return st * 1024 + (ob ^ (((ob >> 9) & 1) << 5)); }
__host__ __device__ __forceinline__ void stage_rc(int b, int& R, int& C) { const int st = b / 1024, sb = b % 1024, swz = sb ^ (((sb >> 9) & 1) << 5); R = (st >> 1) * 16 + swz / 64; C = (st & 1) * 32 + (swz % 64) / 2; }
__host__ __device__ __forceinline__ int perm32(int rho) { const int n = rho >> 4, i = rho & 15; return 8 * (i >> 2) + 4 * n + (i & 3); }

struct Unit { int pm, pn, part; };
struct Gemm { const bf16_t* A; const bf16_t* Bt; int M, N, K, lda; };

struct StaticOrder {
    int nM, nN, nwg, G, c;
    __host__ __device__ void init(int M, int N, int G_, int c_) { nM = M / BM; nN = N / BM; nwg = nM * nN; G = G_; c = c_; }
    __host__ __device__ bool next(int i, Unit& u) const {
        const long L = (long)i * G + c; if (L >= nwg) return false;
        int wgid = (int)L; { const int q = nwg / NXCD, r = nwg % NXCD, xcd = wgid % NXCD, off = wgid / NXCD; wgid = (xcd < r ? xcd * (q + 1) : r * (q + 1) + (xcd - r) * q) + off; }
        const int nig = WGM * nN, gid = wgid / nig, fm = gid * WGM, gsz = (nM - fm) < WGM ? (nM - fm) : WGM;
        u.pm = fm + ((wgid % nig) % gsz); u.pn = (wgid % nig) / gsz; return true;
    }
    __device__ __forceinline__ void a_ready(const Unit&) const {}
    __device__ __forceinline__ void done(const Unit&) const {}
};

__device__ __forceinline__ unsigned cvt_pk_bf16(float lo, float hi) { unsigned r; asm volatile("v_cvt_pk_bf16_f32 %0, %1, %2" : "=v"(r) : "v"(lo), "v"(hi)); return r; }
typedef float f32x2 __attribute__((ext_vector_type(2)));
struct OneUnit { int pm, pn; __device__ bool next(int i, Unit& u) const { if (i) return false; u.pm = pm; u.pn = pn; return true; } __device__ __forceinline__ void a_ready(const Unit&) const {} __device__ __forceinline__ void done(const Unit&) const {} };
constexpr int ZP = 4352;
constexpr float C2F = 0.125f * 1.4426950408889634f;
__device__ __forceinline__ float sigmoidf_fast(float x) { return __builtin_amdgcn_rcpf(1.0f + __builtin_amdgcn_exp2f(-1.4426950408889634f * x)); }
__device__ __forceinline__ f32x4 bf4_lo(unsigned a, unsigned b) { return (f32x4){__uint_as_float(a << 16), __uint_as_float(a & 0xffff0000u), __uint_as_float(b << 16), __uint_as_float(b & 0xffff0000u)}; }
__device__ __forceinline__ u32x4 pack8(f32x4 v0, f32x4 v1) { u32x4 w; w.x = cvt_pk_bf16(v0[0], v0[1]); w.y = cvt_pk_bf16(v0[2], v0[3]); w.z = cvt_pk_bf16(v1[0], v1[1]); w.w = cvt_pk_bf16(v1[2], v1[3]); return w; }
__device__ __forceinline__ float rstd_from_stats(const float* st, int row) { const f32x4* s = (const f32x4*)(st + (size_t)row * 16); const f32x4 a = s[0], b = s[1], c = s[2], d = s[3];
    const float t = ((a[0] + a[1]) + (a[2] + a[3])) + ((b[0] + b[1]) + (b[2] + b[3])) + ((c[0] + c[1]) + (c[2] + c[3])) + ((d[0] + d[1]) + (d[2] + d[3])); return 1.0f / sqrtf(t * (1.0f / 1024.0f) + 1e-6f); }
#define EPI_ROWS(...) _Pragma("unroll") for (int ai = 0; ai < 2; ++ai) _Pragma("unroll") for (int m = 0; m < 4; ++m) { const int row = u.pm * BM + ai * HALF + wr * 64 + m * 16 + fr; __VA_ARGS__ asm volatile("" ::: "memory"); }
#define EPI_COLS(...) _Pragma("unroll") for (int bj = 0; bj < 2; ++bj) { const int col = u.pn * BM + bj * HALF + wc * 32 + 8 * fq; const f32x4 a0 = acc[ai][bj][m][0], a1 = acc[ai][bj][m][1]; __VA_ARGS__ }
struct EpiZ { static constexpr bool PERM = true, AFTER_DRAIN = false, PAIRED = false; bf16_t* Z; unsigned* NM; int pn_off;
    __device__ __forceinline__ void operator()(const f32x4 (&acc)[2][2][4][2], const Unit& u, int wr, int wc, int fr, int fq) const {
        const int pn = u.pn + pn_off; const int mode = (pn >= 9) ? 2 : ((pn == 0 || pn == 1 || pn == 3 || pn == 4) ? 1 : 0);
        const bool nrm = (pn >= 3 && pn <= 6); float mx0 = 0.f, mx1 = 0.f;
        EPI_ROWS( bf16_t* rowp = Z + (size_t)row * ZP; EPI_COLS( f32x4 v0 = a0, v1 = a1;
            if (mode == 1) { v0 = v0 * C2F; v1 = v1 * C2F; }
            else if (mode == 2) { _Pragma("unroll") for (int e = 0; e < 4; ++e) { v0[e] = sigmoidf_fast(v0[e]); v1[e] = sigmoidf_fast(v1[e]); } }
            if (nrm) { float ss = ((v0[0] * v0[0] + v0[1] * v0[1]) + (v0[2] * v0[2] + v0[3] * v0[3])) + ((v1[0] * v1[0] + v1[1] * v1[1]) + (v1[2] * v1[2] + v1[3] * v1[3]));
                ss += __shfl_xor(ss, 16); ss += __shfl_xor(ss, 32); if (bj == 0) mx0 = fmaxf(mx0, ss); else mx1 = fmaxf(mx1, ss); }
            *(u32x4*)(rowp + col + pn_off * BM) = pack8(v0, v1); ) )
        if (nrm) {
#pragma unroll
            for (int o = 1; o < 16; o <<= 1) { mx0 = fmaxf(mx0, __shfl_xor(mx0, o)); mx1 = fmaxf(mx1, __shfl_xor(mx1, o)); }
            if (fr == 0 && fq == 0) {
                const int isk = (pn >= 5), cr = (pn - (isk ? 5 : 3)) * 4 + (wc >> 1), half = wc & 1;
                unsigned* b0 = isk ? NM + 1024 + ((u.pm >> 5) * 8 + cr) * 2 + half : NM + (u.pm * 8 + cr) * 2 + half;
                atomicMax(b0, __float_as_uint(mx0 * 1.0001f)); atomicMax(b0 + 4, __float_as_uint(mx1 * 1.0001f));
            } }
    } };
#define EPI_GROUP(NR, ...) _Pragma("unroll") for (int ai = 0; ai < 2; ++ai) _Pragma("unroll") for (int mg = 0; mg < 4; mg += NR) { __VA_ARGS__ asm volatile("" ::: "memory"); }
#define EPI_ROWOF(mm) (u.pm * BM + ai * HALF + wr * 64 + (mm) * 16 + fr)
#define EPI_COLOF(bj) (u.pn * BM + (bj) * HALF + wc * 32 + 8 * fq)
struct EpiT1 { static constexpr bool PERM = true, AFTER_DRAIN = false, PAIRED = false; const bf16_t* G; bf16_t* T;
    __device__ __forceinline__ void operator()(const f32x4 (&acc)[2][2][4][2], const Unit& u, int wr, int wc, int fr, int fq) const {
        EPI_GROUP(4, u32x4 g[4][2];
            _Pragma("unroll") for (int i = 0; i < 4; ++i) _Pragma("unroll") for (int bj = 0; bj < 2; ++bj) g[i][bj] = *(const u32x4*)(G + (size_t)EPI_ROWOF(mg + i) * ZP + EPI_COLOF(bj));
            _Pragma("unroll") for (int i = 0; i < 4; ++i) _Pragma("unroll") for (int bj = 0; bj < 2; ++bj)
                *(u32x4*)(T + (size_t)EPI_ROWOF(mg + i) * 1024 + EPI_COLOF(bj)) = pack8(acc[ai][bj][mg + i][0] * bf4_lo(g[i][bj].x, g[i][bj].y), acc[ai][bj][mg + i][1] * bf4_lo(g[i][bj].z, g[i][bj].w)); )
    } };
struct EpiMix { static constexpr bool PERM = true, AFTER_DRAIN = false, PAIRED = false; const bf16_t* G; const bf16_t* T; bf16_t* O;
    __device__ __forceinline__ void operator()(const f32x4 (&acc)[2][2][4][2], const Unit& u, int wr, int wc, int fr, int fq) const {
        EPI_GROUP(4, u32x4 g[4][2]; u32x4 t[4][2];
            _Pragma("unroll") for (int i = 0; i < 4; ++i) _Pragma("unroll") for (int bj = 0; bj < 2; ++bj) { g[i][bj] = *(const u32x4*)(G + (size_t)EPI_ROWOF(mg + i) * ZP + EPI_COLOF(bj));
                t[i][bj] = *(const u32x4*)(T + (size_t)EPI_ROWOF(mg + i) * 1024 + EPI_COLOF(bj)); }
            _Pragma("unroll") for (int i = 0; i < 4; ++i) _Pragma("unroll") for (int bj = 0; bj < 2; ++bj) {
                const f32x4 v0 = bf4_lo(t[i][bj].x, t[i][bj].y) + acc[ai][bj][mg + i][0] * bf4_lo(g[i][bj].x, g[i][bj].y), v1 = bf4_lo(t[i][bj].z, t[i][bj].w) + acc[ai][bj][mg + i][1] * bf4_lo(g[i][bj].z, g[i][bj].w);
                *(u32x4*)(O + (size_t)EPI_ROWOF(mg + i) * 1024 + EPI_COLOF(bj)) = pack8(v0, v1); } )
    } };
template <bool BASE_BF16> struct EpiRes { static constexpr bool PERM = true, AFTER_DRAIN = false, PAIRED = false; const void* base; bf16_t* hb; float* st;
    __device__ __forceinline__ void operator()(const f32x4 (&acc)[2][2][4][2], const Unit& u, int wr, int wc, int fr, int fq) const {
        EPI_GROUP(4, f32x4 b[4][2][2];
            _Pragma("unroll") for (int i = 0; i < 4; ++i) _Pragma("unroll") for (int bj = 0; bj < 2; ++bj) { const size_t off = (size_t)EPI_ROWOF(mg + i) * 1024 + EPI_COLOF(bj);
                if constexpr (BASE_BF16) { const u32x4 r = *(const u32x4*)((const bf16_t*)base + off); b[i][bj][0] = bf4_lo(r.x, r.y); b[i][bj][1] = bf4_lo(r.z, r.w); }
                else { const float* bp = (const float*)base + off; b[i][bj][0] = *(const f32x4*)bp; b[i][bj][1] = *(const f32x4*)(bp + 4); } }
            _Pragma("unroll") for (int i = 0; i < 4; ++i) { float ss = 0.f; const int row = EPI_ROWOF(mg + i);
                _Pragma("unroll") for (int bj = 0; bj < 2; ++bj) { const size_t off = (size_t)row * 1024 + EPI_COLOF(bj); const f32x4 h0 = b[i][bj][0] + acc[ai][bj][mg + i][0], h1 = b[i][bj][1] + acc[ai][bj][mg + i][1];
                    *(u32x4*)(hb + off) = pack8(h0, h1);
                    ss += ((h0[0] * h0[0] + h0[1] * h0[1]) + (h0[2] * h0[2] + h0[3] * h0[3])) + ((h1[0] * h1[0] + h1[1] * h1[1]) + (h1[2] * h1[2] + h1[3] * h1[3])); }
                ss += __shfl_xor(ss, 16); ss += __shfl_xor(ss, 32); if (fq == 0) st[(size_t)row * 16 + u.pn * 4 + wc] = ss; } )
    } };
struct EpiRelu2 { static constexpr bool PERM = true, AFTER_DRAIN = false, PAIRED = false; const float* st; bf16_t* O;
    __device__ __forceinline__ void operator()(const f32x4 (&acc)[2][2][4][2], const Unit& u, int wr, int wc, int fr, int fq) const {
        float rsv[2][4];
        _Pragma("unroll") for (int ai = 0; ai < 2; ++ai) { _Pragma("unroll") for (int m = 0; m < 4; ++m) rsv[ai][m] = rstd_from_stats(st, u.pm * BM + ai * HALF + wr * 64 + m * 16 + fr);
            asm volatile("" : "+v"(rsv[ai][0]), "+v"(rsv[ai][1]), "+v"(rsv[ai][2]), "+v"(rsv[ai][3]) :: "memory"); }
        EPI_ROWS( const float rs = rsv[ai][m]; EPI_COLS( f32x4 v0 = a0 * rs, v1 = a1 * rs;
            _Pragma("unroll") for (int e = 0; e < 4; ++e) { const float x0 = fmaxf(v0[e], 0.f), x1 = fmaxf(v1[e], 0.f); v0[e] = x0 * x0; v1[e] = x1 * x1; }
            *(u32x4*)(O + (size_t)row * 4096 + col) = pack8(v0, v1); ) )
    } };
struct EpiPP { static constexpr bool PERM = true, AFTER_DRAIN = false, PAIRED = false; bf16_t* T;
    __device__ __forceinline__ void operator()(const f32x4 (&acc)[2][2][4][2], const Unit& u, int wr, int wc, int fr, int fq) const {
        EPI_ROWS( EPI_COLS( *(u32x4*)(T + (size_t)row * 1024 + col) = pack8(a0, a1); ) )
    } };
struct EpiPle { static constexpr bool PERM = true, AFTER_DRAIN = false, PAIRED = false; const float* st_in; const bf16_t* T; const bf16_t* hsrc; bf16_t* out; float* st;
    __device__ __forceinline__ void operator()(const f32x4 (&acc)[2][2][4][2], const Unit& u, int wr, int wc, int fr, int fq) const {
        float rsv[2][4];
        _Pragma("unroll") for (int ai = 0; ai < 2; ++ai) { _Pragma("unroll") for (int m = 0; m < 4; ++m) rsv[ai][m] = rstd_from_stats(st_in, u.pm * BM + ai * HALF + wr * 64 + m * 16 + fr);
            asm volatile("" : "+v"(rsv[ai][0]), "+v"(rsv[ai][1]), "+v"(rsv[ai][2]), "+v"(rsv[ai][3]) :: "memory"); }
        EPI_GROUP(2, u32x4 hv[2][2]; u32x4 tv[2][2];
            _Pragma("unroll") for (int i = 0; i < 2; ++i) _Pragma("unroll") for (int bj = 0; bj < 2; ++bj) { const size_t off = (size_t)EPI_ROWOF(mg + i) * 1024 + EPI_COLOF(bj);
                    hv[i][bj] = *(const u32x4*)(hsrc + off); tv[i][bj] = *(const u32x4*)(T + off); }
            _Pragma("unroll") for (int i = 0; i < 2; ++i) { float ss = 0.f; const int row = EPI_ROWOF(mg + i); const float rs = rsv[ai][mg + i];
                _Pragma("unroll") for (int bj = 0; bj < 2; ++bj) { const size_t off = (size_t)row * 1024 + EPI_COLOF(bj);
                    f32x4 g0 = acc[ai][bj][mg + i][0] * rs, g1 = acc[ai][bj][mg + i][1] * rs; _Pragma("unroll") for (int e = 0; e < 4; ++e) { g0[e] = sigmoidf_fast(g0[e]); g1[e] = sigmoidf_fast(g1[e]); }
                    const f32x4 h0 = bf4_lo(hv[i][bj].x, hv[i][bj].y) + g0 * bf4_lo(tv[i][bj].x, tv[i][bj].y), h1 = bf4_lo(hv[i][bj].z, hv[i][bj].w) + g1 * bf4_lo(tv[i][bj].z, tv[i][bj].w);
                    *(u32x4*)(out + off) = pack8(h0, h1);
                    ss += ((h0[0] * h0[0] + h0[1] * h0[1]) + (h0[2] * h0[2] + h0[3] * h0[3])) + ((h1[0] * h1[0] + h1[1] * h1[1]) + (h1[2] * h1[2] + h1[3] * h1[3])); }
                ss += __shfl_xor(ss, 16); ss += __shfl_xor(ss, 32); if (fq == 0) st[(size_t)row * 16 + u.pn * 4 + wc] = ss; } )
    } };
struct EpiNone { static constexpr bool PERM = true, AFTER_DRAIN = false, PAIRED = false; float* sink;
    __device__ __forceinline__ void operator()(const f32x4 (&acc)[2][2][4][2], const Unit& u, int wr, int wc, int fr, int fq) const {
        if (acc[0][0][0][0][0] == 1.2345e33f) sink[0] = 1.f;
    } };

struct PairOrder { StaticOrder so; __device__ __forceinline__ bool next(int i, Unit& u) const { if (!so.next(i >> 1, u)) return false; u.part = i & 1; return true; }
    __device__ __forceinline__ void a_ready(const Unit&) const {} __device__ __forceinline__ void done(const Unit&) const {} };
struct EpiPair { static constexpr bool PERM = true, AFTER_DRAIN = false, PAIRED = true; const bf16_t* G0; const bf16_t* G1; bf16_t* O; size_t oA, oB;
    __device__ __forceinline__ size_t offA(const Unit& u) const { return u.part ? oA : 0; }
    __device__ __forceinline__ size_t offB(const Unit& u) const { return u.part ? oB : 0; }
    __device__ __forceinline__ static f32x4 clampg(f32x4 g) { return (f32x4){fmaxf(g[0], 1e-20f), fmaxf(g[1], 1e-20f), fmaxf(g[2], 1e-20f), fmaxf(g[3], 1e-20f)}; }
    __device__ __forceinline__ static f32x4 rcp4(f32x4 g) { return (f32x4){__builtin_amdgcn_rcpf(g[0]), __builtin_amdgcn_rcpf(g[1]), __builtin_amdgcn_rcpf(g[2]), __builtin_amdgcn_rcpf(g[3])}; }
    __device__ __forceinline__ void pair(f32x4 (&acc)[2][2][4][2], const Unit& u, int wr, int wc, int fr, int fq) const {
        if (u.part == 0) {
            EPI_GROUP(4, u32x4 g0[4][2]; u32x4 g1[4][2];
                _Pragma("unroll") for (int i = 0; i < 4; ++i) _Pragma("unroll") for (int bj = 0; bj < 2; ++bj) { const size_t off = (size_t)EPI_ROWOF(mg + i) * ZP + EPI_COLOF(bj); g0[i][bj] = *(const u32x4*)(G0 + off); g1[i][bj] = *(const u32x4*)(G1 + off); }
                _Pragma("unroll") for (int i = 0; i < 4; ++i) _Pragma("unroll") for (int bj = 0; bj < 2; ++bj) {
                    acc[ai][bj][mg + i][0] = acc[ai][bj][mg + i][0] * (bf4_lo(g0[i][bj].x, g0[i][bj].y) * rcp4(clampg(bf4_lo(g1[i][bj].x, g1[i][bj].y))));
                    acc[ai][bj][mg + i][1] = acc[ai][bj][mg + i][1] * (bf4_lo(g0[i][bj].z, g0[i][bj].w) * rcp4(clampg(bf4_lo(g1[i][bj].z, g1[i][bj].w)))); } )
        } else {
            EPI_GROUP(4, u32x4 g1[4][2];
                _Pragma("unroll") for (int i = 0; i < 4; ++i) _Pragma("unroll") for (int bj = 0; bj < 2; ++bj) g1[i][bj] = *(const u32x4*)(G1 + (size_t)EPI_ROWOF(mg + i) * ZP + EPI_COLOF(bj));
                _Pragma("unroll") for (int i = 0; i < 4; ++i) _Pragma("unroll") for (int bj = 0; bj < 2; ++bj)
                    *(u32x4*)(O + (size_t)EPI_ROWOF(mg + i) * 1024 + EPI_COLOF(bj)) = pack8(acc[ai][bj][mg + i][0] * clampg(bf4_lo(g1[i][bj].x, g1[i][bj].y)), acc[ai][bj][mg + i][1] * clampg(bf4_lo(g1[i][bj].z, g1[i][bj].w))); )
        }
    } };

template <class Epi, class Sched, bool ALIGN_EPI = false, bool SP2 = false>
__device__ __forceinline__ void gemm_phase(PG8_LAS unsigned char* lds, const Gemm g, const Sched& S, const Epi& E, const int wave_s) {
    const int tid = wave_s * 64 + fresh_lane(), wid = wave_s, lane = tid & 63, wr = wid >> 2, wc = wid & 3, fr = lane & 15, fq = lane >> 4;
    const int K = g.K, nt = K / BK;
    unsigned voffA[2], voffB[2];
#pragma unroll
    for (int i = 0; i < 2; ++i) { int R, C; stage_rc(tid * 16 + i * 8192, R, C); const int Rb = Epi::PERM ? ((R & ~31) + perm32(R & 31)) : R;
        voffA[i] = (unsigned)(R * g.lda + C) * 2u; voffB[i] = (unsigned)(Rb * K + C) * 2u; }
    const size_t kstep = (size_t)(BK * 2);
    const size_t hstepA = (size_t)HALF * g.lda * 2, hstepB = (size_t)HALF * K * 2;
    const size_t tstepA = 2 * hstepA, tstepB = 2 * hstepB;
    const unsigned ldsw = (unsigned)wid * 1024u;
    const int aoff = lds_byte(wr * 64 + fr, fq * 8), boff = lds_byte(wc * 32 + fr, fq * 8);
#define PG8_SA(b, h) (((b) * 2 + (h)) * HTB)
#define PG8_SB(b, h) ((4 + (b) * 2 + (h)) * HTB)
#define PG8_STAGE(bufoff, gbase, voff) do { _Pragma("unroll") for (int _i = 0; _i < 2; ++_i) \
        __builtin_amdgcn_global_load_lds((const unsigned*)((const char*)(gbase) + (voff)[_i]), (PG8_LAS unsigned*)(lds + (bufoff) + ldsw + _i * 8192), 16, 0, 0); } while (0)
#define PG8_LDA(dst, b, h) do { _Pragma("unroll") for (int m = 0; m < 4; ++m) _Pragma("unroll") for (int k = 0; k < 2; ++k) dst[m][k] = *(const PG8_LAS bf16x8*)(lds + PG8_SA(b, h) + aoff + m * 2048 + k * 1024); } while (0)
#define PG8_LDB(dst, b, h) do { _Pragma("unroll") for (int n = 0; n < 2; ++n) _Pragma("unroll") for (int k = 0; k < 2; ++k) dst[n][k] = *(const PG8_LAS bf16x8*)(lds + PG8_SB(b, h) + boff + n * 2048 + k * 1024); } while (0)
#define PG8_MMA(ai, bj, At, Bt) do { __builtin_amdgcn_s_setprio(1); _Pragma("unroll") for (int m = 0; m < 4; ++m) _Pragma("unroll") for (int n = 0; n < 2; ++n) _Pragma("unroll") for (int k = 0; k < 2; ++k) \
        acc[ai][bj][m][n] = __builtin_amdgcn_mfma_f32_16x16x32_bf16(Bt[n][k], At[m][k], acc[ai][bj][m][n], 0, 0, 0); __builtin_amdgcn_s_setprio(0); } while (0)
#define PG8_WAIT_V(n) asm volatile("s_waitcnt vmcnt(" #n ")" ::: "memory")
#define PG8_WAIT_L(n) asm volatile("s_waitcnt lgkmcnt(" #n ")" ::: "memory")
#define PG8_BAR __builtin_amdgcn_s_barrier()
#define PG8_SCHED __builtin_amdgcn_sched_barrier(0)
    Unit cur, nxt; int ui = 0;
    if (!S.next(0, cur)) return;
    f32x4 acc[2][2][4][2];
#pragma unroll
    for (int a = 0; a < 2; ++a)
#pragma unroll
        for (int b = 0; b < 2; ++b)
#pragma unroll
            for (int m = 0; m < 4; ++m)
#pragma unroll
                for (int n = 0; n < 2; ++n) acc[a][b][m][n] = (f32x4){0.f, 0.f, 0.f, 0.f};
    bf16x8 At[4][2], B0[2][2], B1[2][2];
    const char* cA = (const char*)g.A + (size_t)cur.pm * tstepA; const char* cB = (const char*)g.Bt + (size_t)cur.pn * tstepB;
    if constexpr (Epi::PAIRED) { cA += E.offA(cur); cB += E.offB(cur); }
    S.a_ready(cur);
    if constexpr (SP2) {
        PG8_STAGE(PG8_SB(0, 0), cB, voffB); PG8_STAGE(PG8_SB(0, 1), cB + hstepB, voffB); PG8_STAGE(PG8_SA(0, 0), cA, voffA); PG8_STAGE(PG8_SA(0, 1), cA + hstepA, voffA);
        if (wr == 1) PG8_BAR;
        PG8_WAIT_V(2); PG8_BAR;
        PG8_STAGE(PG8_SB(1, 0), cB + kstep, voffB); PG8_STAGE(PG8_SA(1, 0), cA + kstep, voffA); PG8_STAGE(PG8_SB(1, 1), cB + hstepB + kstep, voffB);
        PG8_WAIT_V(6); PG8_BAR;
    } else {
        PG8_STAGE(PG8_SB(0, 0), cB, voffB); PG8_STAGE(PG8_SA(0, 0), cA, voffA); PG8_STAGE(PG8_SB(0, 1), cB + hstepB, voffB); PG8_STAGE(PG8_SA(0, 1), cA + hstepA, voffA);
        if (wr == 1) PG8_BAR;
        PG8_WAIT_V(4); PG8_BAR;
        PG8_STAGE(PG8_SB(1, 0), cB + kstep, voffB); PG8_STAGE(PG8_SA(1, 0), cA + kstep, voffA); PG8_STAGE(PG8_SB(1, 1), cB + hstepB + kstep, voffB);
        PG8_WAIT_V(6); PG8_BAR;
    }
    for (;;) {
        const bool has_next = S.next(ui + 1, nxt);
        size_t oa_ = 0, ob_ = 0; if constexpr (Epi::PAIRED) { if (has_next) { oa_ = E.offA(nxt); ob_ = E.offB(nxt); } }
        const char* nA = has_next ? (const char*)g.A + (size_t)nxt.pm * tstepA + oa_ : cA; const char* nB = has_next ? (const char*)g.Bt + (size_t)nxt.pn * tstepB + ob_ : cB;
        for (int t = 0; t < nt; t += 2) {
            const bool last = (t == nt - 2);
            const char* a1 = cA + (size_t)(t + 1) * kstep;
            const char* a2 = last ? nA : cA + (size_t)(t + 2) * kstep; const char* b2 = last ? nB : cB + (size_t)(t + 2) * kstep;
            const char* a3 = a2 + kstep; const char* b3 = b2 + kstep;
            if (last && has_next) S.a_ready(nxt);
            if constexpr (SP2) {
            PG8_LDB(B0, 0, 0); PG8_LDB(B1, 0, 1); PG8_SCHED; PG8_LDA(At, 0, 0); PG8_STAGE(PG8_SA(1, 1), a1 + hstepA, voffA);
            PG8_WAIT_V(8); PG8_WAIT_L(0); PG8_BAR; PG8_MMA(0, 0, At, B0); PG8_MMA(0, 1, At, B1); PG8_BAR; PG8_SCHED;
            PG8_LDA(At, 0, 1); PG8_STAGE(PG8_SB(0, 0), b2, voffB); PG8_STAGE(PG8_SB(0, 1), b2 + hstepB, voffB); PG8_STAGE(PG8_SA(0, 0), a2, voffA);
            PG8_WAIT_V(8); PG8_WAIT_L(0); PG8_BAR; PG8_MMA(1, 0, At, B0); PG8_MMA(1, 1, At, B1); PG8_BAR; PG8_SCHED;
            PG8_LDB(B0, 1, 0); PG8_LDB(B1, 1, 1); PG8_SCHED; PG8_LDA(At, 1, 0); PG8_STAGE(PG8_SA(0, 1), a2 + hstepA, voffA);
            PG8_WAIT_V(8); PG8_WAIT_L(0); PG8_BAR; PG8_MMA(0, 0, At, B0); PG8_MMA(0, 1, At, B1); PG8_BAR; PG8_SCHED;
            PG8_LDA(At, 1, 1); PG8_STAGE(PG8_SB(1, 0), b3, voffB); PG8_STAGE(PG8_SB(1, 1), b3 + hstepB, voffB); PG8_STAGE(PG8_SA(1, 0), a3, voffA);
            PG8_WAIT_V(8); PG8_WAIT_L(0); PG8_BAR; PG8_MMA(1, 0, At, B0); PG8_MMA(1, 1, At, B1); PG8_BAR; PG8_SCHED;
            } else {
            PG8_LDB(B0, 0, 0); PG8_SCHED; PG8_LDA(At, 0, 0); PG8_STAGE(PG8_SA(1, 1), a1 + hstepA, voffA);
            PG8_WAIT_L(8); PG8_BAR; PG8_WAIT_L(0); PG8_MMA(0, 0, At, B0); PG8_BAR; PG8_SCHED;
            PG8_LDB(B1, 0, 1); PG8_STAGE(PG8_SB(0, 0), b2, voffB);
            PG8_BAR; PG8_WAIT_L(0); PG8_MMA(0, 1, At, B1); PG8_BAR;
            PG8_LDA(At, 0, 1); PG8_STAGE(PG8_SA(0, 0), a2, voffA);
            PG8_BAR; PG8_WAIT_L(0); PG8_MMA(1, 0, At, B0); PG8_BAR; PG8_SCHED;
            PG8_STAGE(PG8_SB(0, 1), b2 + hstepB, voffB);
            PG8_WAIT_V(6); PG8_BAR; PG8_MMA(1, 1, At, B1); PG8_BAR;
            PG8_LDB(B0, 1, 0); PG8_SCHED; PG8_LDA(At, 1, 0); PG8_STAGE(PG8_SA(0, 1), a2 + hstepA, voffA);
            PG8_WAIT_L(8); PG8_BAR; PG8_WAIT_L(0); PG8_MMA(0, 0, At, B0); PG8_BAR; PG8_SCHED;
            PG8_LDB(B1, 1, 1); PG8_STAGE(PG8_SB(1, 0), b3, voffB);
            PG8_BAR; PG8_WAIT_L(0); PG8_MMA(0, 1, At, B1); PG8_BAR;
            PG8_LDA(At, 1, 1); PG8_STAGE(PG8_SA(1, 0), a3, voffA);
            PG8_BAR; PG8_WAIT_L(0); PG8_MMA(1, 0, At, B0); PG8_BAR; PG8_SCHED;
            PG8_STAGE(PG8_SB(1, 1), b3 + hstepB, voffB);
            PG8_WAIT_V(6); PG8_BAR; PG8_MMA(1, 1, At, B1); PG8_BAR;
            }
        }
        if constexpr (ALIGN_EPI) { if (wr == 0) PG8_BAR; }
        if constexpr (Epi::PAIRED) { E.pair(acc, cur, wr, wc, fr, fq); } else if constexpr (!Epi::AFTER_DRAIN) { E(acc, cur, wr, wc, fr, fq); S.done(cur); }
        if (!has_next) break;
        if (!Epi::PAIRED || nxt.part == 0)
#pragma unroll
        for (int a = 0; a < 2; ++a)
#pragma unroll
            for (int b = 0; b < 2; ++b)
#pragma unroll
                for (int m = 0; m < 4; ++m)
#pragma unroll
                    for (int n = 0; n < 2; ++n) acc[a][b][m][n] = (f32x4){0.f, 0.f, 0.f, 0.f};
        cur = nxt; cA = nA; cB = nB; ++ui;
        if constexpr (ALIGN_EPI) { if (wr == 1) PG8_BAR; }
    }
    PG8_WAIT_V(0);
    if constexpr (!ALIGN_EPI) { if (wr == 0) PG8_BAR; }
    PG8_BAR;
    if constexpr (Epi::AFTER_DRAIN) { E.fused(acc, cur, wr, wc, fr, fq, lds, wid, lane); S.done(cur); }
#undef PG8_SA
#undef PG8_SB
#undef PG8_STAGE
#undef PG8_LDA
#undef PG8_LDB
#undef PG8_MMA
#undef PG8_WAIT_V
#undef PG8_WAIT_L
#undef PG8_BAR
#undef PG8_SCHED
}
}
#ifndef PG8_SP2
#define PG8_SP2 true
#endif
#ifndef PG8_ALIGN
#define PG8_ALIGN true
#endif
#include <hip/hip_bf16.h>
#include <cmath>
namespace attn_body {
using bf16=__hip_bfloat16;
using bf16x8=__attribute__((ext_vector_type(8)))short;
using s16x4=__attribute__((ext_vector_type(4)))short;
using f32x16=__attribute__((ext_vector_type(16)))float;
using u32x4=__attribute__((ext_vector_type(4)))unsigned;
constexpr int BATCH=2,SEQ=8192,D=64,DM=4352;
constexpr int NW=8,QBLK=32,QB=QBLK*NW,KVBLK=64,NQB=SEQ/QB;
constexpr int ATTN_PITCH=DM, ATTN_UNIT_ROWS=QB;
__device__ __forceinline__ int crow(int r,int hi){return (r&3)+8*(r>>2)+4*hi;}
#define SBAR() __builtin_amdgcn_sched_barrier(0)
__device__ __forceinline__ void cmask(f32x16&p0,f32x16&p1,int jb,int qrel,int hi){
  const float NEG=-INFINITY; int kb=64*jb+4*hi;
  #pragma unroll
  for(int r=0;r<16;++r){int kv=kb+(r&3)+8*(r>>2); if(kv>qrel)p0[r]=NEG; if(kv+32>qrel)p1[r]=NEG;}
}

constexpr int NSLOT=3, SLOTB=8192; typedef float f32x4v __attribute__((ext_vector_type(4))); constexpr int LDS_BIAS=86016;
constexpr int LDS_K=0, LDS_V=NSLOT*SLOTB, LDS_WS=2*NSLOT*SLOTB, LDS_OST=LDS_WS+NW*64*4, LDS_BYTES=LDS_OST+NW*4096;
constexpr float C2=0.125f*1.4426950408889634f;
__device__ __forceinline__ void glds16(const void*gsrc,unsigned lds_dst){unsigned keep;
  asm volatile("s_mov_b32 %0, m0\n\ts_mov_b32 m0, %2\n\ts_nop 0\n\tglobal_load_lds_dwordx4 %1, off\n\ts_mov_b32 m0, %0":"=&s"(keep):"v"(gsrc),"s"(lds_dst):"memory");}
__device__ __forceinline__ float max3f(float a,float b,float c){float r;asm("v_max3_f32 %0, %1, %2, %3":"=v"(r):"v"(a),"v"(b),"v"(c));return r;}
__device__ __forceinline__ float max2f(float a,float b){float r;asm("v_max_f32_e32 %0, %1, %2":"=v"(r):"v"(a),"v"(b));return r;}
__device__ __forceinline__ float fadd_s(float a,float b){float r;asm("v_add_f32_e32 %0, %1, %2":"=v"(r):"v"(a),"v"(b));return r;}
__device__ __forceinline__ float fsub_s(float a,float b){float r;asm("v_sub_f32_e32 %0, %1, %2":"=v"(r):"v"(a),"v"(b));return r;}
typedef float f32x2_t __attribute__((ext_vector_type(2))); typedef __bf16 bf16x2_t __attribute__((ext_vector_type(2)));
__device__ __forceinline__ unsigned cvtpk_s(float lo,float hi){f32x2_t v={lo,hi};bf16x2_t b=__builtin_convertvector(v,bf16x2_t);return __builtin_bit_cast(unsigned,b);}
#define WAIT_BAR(N) asm volatile("s_waitcnt vmcnt(" #N ") lgkmcnt(0)\n\ts_barrier":::"memory")

__device__ __forceinline__ void qkt(f32x16&p0,f32x16&p1,const char*Kslot,const bf16x8*qr,const f32x16&negm,int r32,int hi){
  const char*kb=Kslot+hi*1024+r32*16;
  #pragma unroll
  for(int d0=0;d0<4;++d0){
    const bf16x8 b0=*reinterpret_cast<const bf16x8*>(kb+d0*2048);
    const bf16x8 b1=*reinterpret_cast<const bf16x8*>(kb+d0*2048+512);
    if(d0==0){p0=__builtin_amdgcn_mfma_f32_32x32x16_bf16(b0,qr[0],negm,0,0,0);p1=__builtin_amdgcn_mfma_f32_32x32x16_bf16(b1,qr[0],negm,0,0,0);}
    else{p0=__builtin_amdgcn_mfma_f32_32x32x16_bf16(b0,qr[d0],p0,0,0,0);p1=__builtin_amdgcn_mfma_f32_32x32x16_bf16(b1,qr[d0],p1,0,0,0);}}
}
typedef __attribute__((address_space(3))) const char* lds_cptr;
typedef short v4i16_t __attribute__((ext_vector_type(4)));
__device__ __forceinline__ void kload8(bf16x8*kf,lds_cptr kp){
  kf[0]=*(const __attribute__((address_space(3))) bf16x8*)(kp);      kf[1]=*(const __attribute__((address_space(3))) bf16x8*)(kp+512);
  kf[2]=*(const __attribute__((address_space(3))) bf16x8*)(kp+2048); kf[3]=*(const __attribute__((address_space(3))) bf16x8*)(kp+2560);
  kf[4]=*(const __attribute__((address_space(3))) bf16x8*)(kp+4096); kf[5]=*(const __attribute__((address_space(3))) bf16x8*)(kp+4608);
  kf[6]=*(const __attribute__((address_space(3))) bf16x8*)(kp+6144); kf[7]=*(const __attribute__((address_space(3))) bf16x8*)(kp+6656);
}
__device__ __forceinline__ void kload2(bf16x8*kf,lds_cptr kp,int j){ kf[2*j]=*(const __attribute__((address_space(3))) bf16x8*)(kp+j*2048); kf[2*j+1]=*(const __attribute__((address_space(3))) bf16x8*)(kp+j*2048+512); }
__device__ __forceinline__ s16x4 vtr(lds_cptr p){ return __builtin_bit_cast(s16x4,__builtin_amdgcn_ds_read_tr16_b64_v4i16((__attribute__((address_space(3))) v4i16_t*)p)); }
__device__ __forceinline__ float rowmax(const f32x16&p0,const f32x16&p1){
  float a=max3f(p0[0],p0[1],p1[0]),b=max3f(p0[2],p0[3],p1[1]);a=max3f(a,p1[2],p1[3]);
  #pragma unroll
  for(int r=4;r<16;r+=4){a=max3f(a,p0[r],p0[r+1]);b=max3f(b,p0[r+2],p0[r+3]);a=max3f(a,p1[r],p1[r+1]);b=max3f(b,p1[r+2],p1[r+3]);}
  const float m=max2f(a,b);
  auto rr=__builtin_amdgcn_permlane32_swap(__float_as_uint(m),__float_as_uint(m),false,false);
  return max2f(__uint_as_float(rr[0]),__uint_as_float(rr[1]));
}
__device__ __forceinline__ void pv(f32x16*o,int vb,bf16x8 pa0,bf16x8 pa1,bf16x8 pa2,bf16x8 pa3){
  #pragma unroll
  for(int d0=0;d0<2;++d0){s16x4 lo[4],hi[4];
    #pragma unroll
    for(int ks=0;ks<4;++ks){
      asm volatile("ds_read_b64_tr_b16 %0,%1 offset:%c2":"=&v"(lo[ks]):"v"(vb),"i"(d0*4096+ks*1024):"memory");
      asm volatile("ds_read_b64_tr_b16 %0,%1 offset:%c2":"=&v"(hi[ks]):"v"(vb),"i"(d0*4096+ks*1024+512):"memory");}
    asm volatile("s_waitcnt lgkmcnt(0)":::"memory");SBAR();
    #define PK(k) (bf16x8){lo[k][0],lo[k][1],lo[k][2],lo[k][3],hi[k][0],hi[k][1],hi[k][2],hi[k][3]}
    o[d0]=__builtin_amdgcn_mfma_f32_32x32x16_bf16(pa0,PK(0),o[d0],0,0,0);
    o[d0]=__builtin_amdgcn_mfma_f32_32x32x16_bf16(pa1,PK(1),o[d0],0,0,0);
    o[d0]=__builtin_amdgcn_mfma_f32_32x32x16_bf16(pa2,PK(2),o[d0],0,0,0);
    o[d0]=__builtin_amdgcn_mfma_f32_32x32x16_bf16(pa3,PK(3),o[d0],0,0,0);
    #undef PK
  }
}

#ifndef ATTN_STORE16
#define ATTN_STORE16(p,v) (*(u32x4*)(p)=(v))
#endif
template<int THRL> __device__ __forceinline__ void attn_unit(const int wave_s,int qb,const bf16*Qh,const bf16*__restrict__ Kh,const bf16*__restrict__ Vh,bf16*Oh,const float*__restrict__ cbias,const float qk2,char*shm){
  const int wid=wave_s; const int tid=wave_s*64+fresh_lane(),lane=tid&63,r32=lane&31,hi=lane>>5;
  const int q0=qb*QB;
  const bf16*Qw=Qh+(long)(q0+wid*QBLK)*DM;
  int t0; { const int ntab=(q0+QB)/KVBLK; const float thr=cbias[q0]-(qk2+40.0f); const int l_=tid&63;
    const bool c0_=(l_<ntab-4)&&(cbias[l_*64+63]<thr), c1_=(l_+64<ntab-4)&&(cbias[(l_+64)*64+63]<thr);
    t0=(__builtin_popcountll(__ballot(c0_))+__builtin_popcountll(__ballot(c1_)))&~1; t0=__builtin_amdgcn_readfirstlane(t0); }
  Kh+=(long)t0*KVBLK*DM; Vh+=(long)t0*KVBLK*DM; cbias+=t0*KVBLK;
  const unsigned lds0=(unsigned)(uintptr_t)shm;
  float*wsf=(float*)(shm+LDS_WS)+wid*64;
  const bf16*ksrc=Kh+(long)lane*DM+wid*8;
  const bf16*vsrc=Vh+(long)(16*(wid&3)+(lane>>2))*DM+(wid>>2)*32+(lane&3)*8;
  const unsigned kdst=lds0+LDS_K+wid*1024, vdst=lds0+LDS_V+wid*1024;
  #define DMA_K(t,slot) glds16(ksrc+(long)(t)*KVBLK*DM,(unsigned)__builtin_amdgcn_readfirstlane(kdst+(slot)))
  #define DMA_V(t,slot) glds16(vsrc+(long)(t)*KVBLK*DM,(unsigned)__builtin_amdgcn_readfirstlane(vdst+(slot)))
  const int vb0=(int)(lds0+LDS_V)+((lane>>4)&1)*32+(lane&3)*8+(4*hi+((lane&15)>>2))*64;
  const char*Kbase=shm+LDS_K; bf16x8 kf[8];
  const lds_cptr shm3=(lds_cptr)shm; const lds_cptr kp0=shm3+LDS_K+hi*1024+r32*16; const lds_cptr vp0=shm3+LDS_V+((lane>>4)&1)*32+(lane&3)*8+(4*hi+((lane&15)>>2))*64;
  { const int nk4=((q0+QB)>>2)-t0*16; __attribute__((address_space(3))) f32x4v* bt=(__attribute__((address_space(3))) f32x4v*)((lds_cptr)shm+LDS_BIAS); for(int i=tid;i<nk4;i+=NW*64) bt[i]=((const f32x4v*)cbias)[i]; }
  const int NT=(q0+QB)/KVBLK-t0;
  DMA_K(0,0);DMA_V(0,0);DMA_K(1,SLOTB);
  bf16x8 qr[4];
  #pragma unroll
  for(int d0=0;d0<4;++d0)qr[d0]=*reinterpret_cast<const bf16x8*>(&Qw[(long)r32*DM+d0*16+hi*8]);
  float mhat=0.f,l_reg=0.f;float zf_=0.f;asm volatile("":"+v"(zf_));f32x16 o[2];f32x16 negm;
  _Pragma("unroll") for(int r=0;r<16;++r){o[0][r]=zf_;o[1][r]=zf_;negm[r]=zf_;} asm volatile("":"+v"(negm));
  const int qrel=wid*QBLK+r32;
  #define CMASK(P0,P1,t) do{int jb_=(t)-(NT-4); if(jb_>=0)cmask(P0,P1,jb_,qrel,hi);}while(0)
  #define BIAS(P0,P1,t) do{ const __attribute__((address_space(3))) f32x4v* bt_=(const __attribute__((address_space(3))) f32x4v*)(shm3+LDS_BIAS)+(t)*16+hi; \
    _Pragma("unroll") for(int i_=0;i_<4;++i_){ const f32x4v b0_=bt_[2*i_], b1_=bt_[8+2*i_]; \
      P0[4*i_]+=b0_[0];P0[4*i_+1]+=b0_[1];P0[4*i_+2]+=b0_[2];P0[4*i_+3]+=b0_[3]; P1[4*i_]+=b1_[0];P1[4*i_+1]+=b1_[1];P1[4*i_+2]+=b1_[2];P1[4*i_+3]+=b1_[3]; } }while(0)
  bool resc=false;
  #define START(P0,P1) do{ const float rm=rowmax(P0,P1); resc=false; \
    { const float dl=rm; mhat=fadd_s(mhat,dl); \
      _Pragma("unroll") for(int r=0;r<16;++r){P0[r]=fsub_s(P0[r],dl);P1[r]=fsub_s(P1[r],dl);} \
      _Pragma("unroll") for(int r=0;r<16;++r)negm[r]=-mhat; asm volatile("":"+v"(negm)); } \
    _Pragma("unroll") for(int r=0;r<16;++r)P0[r]=__builtin_amdgcn_exp2f(P0[r]); }while(0)
  #define RESC() do{ if(resc){ asm volatile("s_waitcnt lgkmcnt(0)":::"memory"); \
      _Pragma("unroll") for(int d_=0;d_<2;++d_) _Pragma("unroll") for(int r=0;r<16;++r)o[d_][r]*=wsf[crow(r,hi)]; } }while(0)
  f32x16 pA0,pA1,pB0,pB1;
  int sl_prev=0,sl_cur=0,sl_next=SLOTB;
  #define ROT() do{sl_prev=sl_cur;sl_cur=sl_next;sl_next=(sl_next==(NSLOT-1)*SLOTB)?0:sl_next+SLOTB;}while(0)
  DMA_K(2,2*SLOTB);
  WAIT_BAR(3);
  qkt(pA0,pA1,Kbase,qr,negm,r32,hi);asm volatile("s_nop 15\n\ts_nop 7":"+v"(pA0),"+v"(pA1));BIAS(pA0,pA1,0);CMASK(pA0,pA1,0);
  START(pA0,pA1);
  _Pragma("unroll") for(int r=0;r<16;++r)pA1[r]=__builtin_amdgcn_exp2f(pA1[r]);
  WAIT_BAR(0);
  DMA_K(3,0);DMA_V(1,SLOTB);
  ROT();
  kload8(kf,kp0+sl_cur);
  WAIT_BAR(2);
  s16x4 vlo[8],vhi[8]; u32x4 pw0,pw1,pw2,pw3;
  #define PKW(P,B) cvtpk_s(P[B],P[B+1])
  #define PAF(k) __builtin_bit_cast(bf16x8,pw##k)
  #define VFR(i) (bf16x8){vlo[i][0],vlo[i][1],vlo[i][2],vlo[i][3],vhi[i][0],vhi[i][1],vhi[i][2],vhi[i][3]}
  #define PIN(x) asm volatile("":"+v"(x))
  #define MX3(a,b,c) __builtin_fmaxf(__builtin_fmaxf((a),(b)),(c))
  #define GAPA(MF,A0,A1,A2,A3,W0,W1,PW) do{ MF; sacc+=A0; sacc+=A1; sacc+=A2; sacc+=A3; PIN(sacc); W0; W1; PIN(PW); SBAR(); }while(0)
  #define EX(v) __builtin_amdgcn_exp2f(v)
  #define GAPB(MF,X,B) do{ MF; X[B]=EX(X[B]); X[B+1]=EX(X[B+1]); X[B+2]=EX(X[B+2]); X[B+3]=EX(X[B+3]); PIN(X); SBAR(); }while(0)
  #define VRD(i) do{ vlo[i]=vtr(vp_+(((i)>>2)*4096+((i)&3)*1024)); vhi[i]=vtr(vp_+(((i)>>2)*4096+((i)&3)*1024+512)); }while(0)
  #define KRD(G,j) do{ if(G){ kload2(kf,kp0+sl_next,j); SBAR(); } }while(0)
  #define STEP(C0,C1,P0,P1,t,GK,GV,GL) do{ SBAR(); \
    const lds_cptr vp_=vp0+sl_prev; \
    VRD(0); SBAR(); float sacc=(P0[0]+P0[1]); \
    GAPA(C0=__builtin_amdgcn_mfma_f32_32x32x16_bf16(kf[0],qr[0],negm,0,0,0), P0[2],P0[3],P0[4],P0[5],     pw0[0]=PKW(P0,0), pw0[1]=PKW(P0,2), pw0); \
    VRD(4); SBAR(); GAPA(C1=__builtin_amdgcn_mfma_f32_32x32x16_bf16(kf[1],qr[0],negm,0,0,0), P0[6],P0[7],P0[8],P0[9],     pw0[2]=PKW(P0,4), pw0[3]=PKW(P0,6), pw0); \
    VRD(1); SBAR(); GAPA(C0=__builtin_amdgcn_mfma_f32_32x32x16_bf16(kf[2],qr[1],C0,0,0,0),   P0[10],P0[11],P0[12],P0[13], pw1[0]=PKW(P0,8), pw1[1]=PKW(P0,10), pw1); \
    VRD(5); SBAR(); GAPA(C1=__builtin_amdgcn_mfma_f32_32x32x16_bf16(kf[3],qr[1],C1,0,0,0),   P0[14],P0[15],P1[0],P1[1],   pw1[2]=PKW(P0,12),pw1[3]=PKW(P0,14), pw1); \
    VRD(2); SBAR(); GAPA(C0=__builtin_amdgcn_mfma_f32_32x32x16_bf16(kf[4],qr[2],C0,0,0,0),   P1[2],P1[3],P1[4],P1[5],     pw2[0]=PKW(P1,0), pw2[1]=PKW(P1,2), pw2); \
    VRD(6); SBAR(); GAPA(C1=__builtin_amdgcn_mfma_f32_32x32x16_bf16(kf[5],qr[2],C1,0,0,0),   P1[6],P1[7],P1[8],P1[9],     pw2[2]=PKW(P1,4), pw2[3]=PKW(P1,6), pw2); \
    VRD(3); SBAR(); GAPA(C0=__builtin_amdgcn_mfma_f32_32x32x16_bf16(kf[6],qr[3],C0,0,0,0),   P1[10],P1[11],P1[12],P1[13], pw3[0]=PKW(P1,8), pw3[1]=PKW(P1,10), pw3); \
    VRD(7); SBAR(); GAPA(C1=__builtin_amdgcn_mfma_f32_32x32x16_bf16(kf[7],qr[3],C1,0,0,0),   P1[14],P1[15],0.f,0.f,       pw3[2]=PKW(P1,12),pw3[3]=PKW(P1,14), pw3); \
    l_reg+=sacc; \
    if(GK){DMA_K((t)+3,sl_cur);} if(GV){DMA_V((t)+1,sl_next);} \
    BIAS(C0,C1,t); CMASK(C0,C1,t); \
    { float a=MX3(C0[0],C0[1],C1[0]),b=MX3(C0[2],C0[3],C1[1]); a=MX3(a,C1[2],C1[3]); \
      _Pragma("unroll") for(int r=4;r<16;r+=4){a=MX3(a,C0[r],C0[r+1]);b=MX3(b,C0[r+2],C0[r+3]);a=MX3(a,C1[r],C1[r+1]);b=MX3(b,C1[r+2],C1[r+3]);} \
      float rm=__builtin_fmaxf(a,b); { auto rr=__builtin_amdgcn_permlane32_swap(__float_as_uint(rm),__float_as_uint(rm),false,false); rm=__builtin_fmaxf(__uint_as_float(rr[0]),__uint_as_float(rr[1])); } \
      resc=false; \
      if(__builtin_expect(__any(rm>(float)THRL),0)){ const float dl=__builtin_fmaxf(rm,0.f); mhat+=dl; \
        _Pragma("unroll") for(int r=0;r<16;++r){C0[r]-=dl;C1[r]-=dl;} \
        _Pragma("unroll") for(int r=0;r<16;++r)negm[r]=-mhat; asm volatile("":"+v"(negm)); \
        const float f=__builtin_amdgcn_exp2f(-dl); l_reg*=f; if(hi==0)wsf[r32]=f; resc=true; } } \
    SBAR(); \
    GAPB(o[0]=__builtin_amdgcn_mfma_f32_32x32x16_bf16(PAF(0),VFR(0),o[0],0,0,0), C0,0); \
    GAPB(o[1]=__builtin_amdgcn_mfma_f32_32x32x16_bf16(PAF(0),VFR(4),o[1],0,0,0), C0,4); \
    KRD(GL,0); GAPB(o[0]=__builtin_amdgcn_mfma_f32_32x32x16_bf16(PAF(1),VFR(1),o[0],0,0,0), C0,8); \
    KRD(GL,1); GAPB(o[1]=__builtin_amdgcn_mfma_f32_32x32x16_bf16(PAF(1),VFR(5),o[1],0,0,0), C0,12); \
    KRD(GL,2); GAPB(o[0]=__builtin_amdgcn_mfma_f32_32x32x16_bf16(PAF(2),VFR(2),o[0],0,0,0), C1,0); \
    KRD(GL,3); GAPB(o[1]=__builtin_amdgcn_mfma_f32_32x32x16_bf16(PAF(2),VFR(6),o[1],0,0,0), C1,4); \
    GAPB(o[0]=__builtin_amdgcn_mfma_f32_32x32x16_bf16(PAF(3),VFR(3),o[0],0,0,0), C1,8); \
    GAPB(o[1]=__builtin_amdgcn_mfma_f32_32x32x16_bf16(PAF(3),VFR(7),o[1],0,0,0), C1,12); \
    }while(0)
  int t=1;
  #undef CMASK
  #define CMASK(P0,P1,t) do{}while(0)
  for(;t+5<NT;t+=2){
    STEP(pB0,pB1,pA0,pA1,t,true,true,true);     WAIT_BAR(2); RESC(); ROT();
    STEP(pA0,pA1,pB0,pB1,t+1,true,true,true);   WAIT_BAR(2); RESC(); ROT();
  }
  #undef CMASK
  #define CMASK(P0,P1,t) do{int jb_=(t)-(NT-4); if(jb_>=0)cmask(P0,P1,jb_,qrel,hi);}while(0)
  #define ENDW(tt) do{ if((tt)+3<NT){WAIT_BAR(2);} else if((tt)+2<NT){WAIT_BAR(1);} else {WAIT_BAR(0);} }while(0)
  for(;t+1<NT;t+=2){
    STEP(pB0,pB1,pA0,pA1,t,(t+3<NT),(t+1<NT),(t+1<NT));       ENDW(t);   RESC(); ROT();
    STEP(pA0,pA1,pB0,pB1,t+1,(t+4<NT),(t+2<NT),(t+2<NT));     ENDW(t+1); RESC(); ROT();
  }
  STEP(pB0,pB1,pA0,pA1,NT-1,false,false,false); RESC();
  { float sacc=pB0[0]+pB0[1]; _Pragma("unroll") for(int r=2;r<16;++r)sacc+=pB0[r]; _Pragma("unroll") for(int r=0;r<16;++r)sacc+=pB1[r]; l_reg+=sacc;
    pw0=(u32x4){PKW(pB0,0),PKW(pB0,2),PKW(pB0,4),PKW(pB0,6)};pw1=(u32x4){PKW(pB0,8),PKW(pB0,10),PKW(pB0,12),PKW(pB0,14)};pw2=(u32x4){PKW(pB1,0),PKW(pB1,2),PKW(pB1,4),PKW(pB1,6)};pw3=(u32x4){PKW(pB1,8),PKW(pB1,10),PKW(pB1,12),PKW(pB1,14)};
    SBAR(); pv(o,vb0+sl_cur,PAF(0),PAF(1),PAF(2),PAF(3)); }
  #undef PKW
  #undef PAF
  #undef VFR
  #undef PIN
  #undef MX3
  #undef GAPA
  #undef GAPB
  #undef EX
  #undef VRD
  #undef KRD
  #undef STEP
  #undef ENDW
  {auto rr=__builtin_amdgcn_permlane32_swap(__float_as_uint(l_reg),__float_as_uint(l_reg),false,false);l_reg=__uint_as_float(rr[0])+__uint_as_float(rr[1]);}
  if(hi==0)wsf[32+r32]=l_reg;asm volatile("s_waitcnt lgkmcnt(0)":::"memory");
  float rli[16];
  #pragma unroll
  for(int r=0;r<16;++r)rli[r]=__builtin_amdgcn_rcpf(wsf[32+crow(r,hi)]);
  bf16*Ow=Oh+(long)(q0+wid*QBLK)*DM;
  { bf16*stg=(bf16*)(shm+LDS_OST)+wid*2048;
    #pragma unroll
    for(int r=0;r<16;++r){const int orow=crow(r,hi);
      #pragma unroll
      for(int d0=0;d0<2;++d0)stg[orow*64+d0*32+r32]=__float2bfloat16(o[d0][r]*rli[r]);}
    asm volatile("s_waitcnt lgkmcnt(0)":::"memory");
    #pragma unroll
    for(int i=0;i<4;++i){const int row=i*8+(lane>>3),ch=lane&7; const u32x4 v=*(const u32x4*)(stg+row*64+ch*8); ATTN_STORE16(Ow+(long)row*DM+ch*8,v);} }
  asm volatile("s_waitcnt lgkmcnt(0)\n\ts_barrier":::"memory");
  #undef DMA_K
  #undef DMA_V
  #undef CMASK
  #undef START
  #undef RESC
  #undef ROT
  #undef BIAS
}
constexpr int ATTN_LDS_BYTES=LDS_BYTES;
constexpr int SWA_K=0, SWA_V=6*SLOTB, SWA_OST=12*SLOTB, SWA_WS=133120;
__device__ __forceinline__ void swa_unit(const int wave_s,int qb,const bf16*Qh,const bf16*__restrict__ Kh,const bf16*__restrict__ Vh,bf16*Oh,float slope2,float sink2,char*shm){
  const int wid=wave_s; const int tid=wave_s*64+fresh_lane(),lane=tid&63,r32=lane&31,hi=lane>>5;
  const int q0=qb*QB, c0=4*qb-2;
  const bf16*Qw=Qh+(long)(q0+wid*QBLK)*DM;
  const unsigned lds0=(unsigned)(uintptr_t)shm;
  float*wsf=(float*)(shm+SWA_WS)+wid*64;
  const bf16*ksrc=Kh+(long)lane*DM+wid*8;
  const bf16*vsrc=Vh+(long)(16*(wid&3)+(lane>>2))*DM+(wid>>2)*32+(lane&3)*8;
  const unsigned kdst=lds0+SWA_K+wid*1024, vdst=lds0+SWA_V+wid*1024;
  #pragma unroll
  for(int s=0;s<6;++s){ const int ch=c0+s; if(ch>=0){ glds16(ksrc+(long)ch*KVBLK*DM,(unsigned)__builtin_amdgcn_readfirstlane(kdst+s*SLOTB)); glds16(vsrc+(long)ch*KVBLK*DM,(unsigned)__builtin_amdgcn_readfirstlane(vdst+s*SLOTB)); } }
  bf16x8 qr[4];
  #pragma unroll
  for(int d0=0;d0<4;++d0)qr[d0]=*reinterpret_cast<const bf16x8*>(&Qw[(long)r32*DM+d0*16+hi*8]);
  WAIT_BAR(0);
  const int wc=wid>>1, qrel=(wid&1)*32+r32;
  f32x16 zero=f32x16{}; asm volatile("":"+v"(zero));
  f32x16 S[3][2];
  #pragma unroll
  for(int t=0;t<3;++t){
    if(c0+wc+t>=0){
      qkt(S[t][0],S[t][1],shm+SWA_K+(wc+t)*SLOTB,qr,zero,r32,hi);
      const float qf=(float)(64*(2-t)+qrel-4*hi);
      #pragma unroll
      for(int r=0;r<16;++r){ const float dd=qf-(float)((r&3)+8*(r>>2)); S[t][0][r]=__builtin_fmaf(-slope2,__builtin_fabsf(dd),S[t][0][r]); S[t][1][r]=__builtin_fmaf(-slope2,__builtin_fabsf(dd-32.f),S[t][1][r]); }
    } else {
      #pragma unroll
      for(int r=0;r<16;++r){ S[t][0][r]=-INFINITY; S[t][1][r]=-INFINITY; }
    }
  }
  float m=sink2;
  #pragma unroll
  for(int t=0;t<3;++t) m=__builtin_fmaxf(m,rowmax(S[t][0],S[t][1]));
  float l=0.f;
  #pragma unroll
  for(int t=0;t<3;++t){
    #pragma unroll
    for(int r=0;r<16;++r){ S[t][0][r]=__builtin_amdgcn_exp2f(S[t][0][r]-m); S[t][1][r]=__builtin_amdgcn_exp2f(S[t][1][r]-m); l+=S[t][0][r]+S[t][1][r]; }
  }
  {auto rr=__builtin_amdgcn_permlane32_swap(__float_as_uint(l),__float_as_uint(l),false,false);l=__uint_as_float(rr[0])+__uint_as_float(rr[1]);}
  l+=__builtin_amdgcn_exp2f(sink2-m);
  f32x16 o[2];o[0]=f32x16{};o[1]=f32x16{};
  const int vb0=(int)(lds0+SWA_V)+((lane>>4)&1)*32+(lane&3)*8+(4*hi+((lane&15)>>2))*64;
  #pragma unroll
  for(int t=0;t<3;++t){
    if(c0+wc+t>=0){
      #define PKW(P,B) cvtpk_s(P[B],P[B+1])
      const u32x4 pw0=(u32x4){PKW(S[t][0],0),PKW(S[t][0],2),PKW(S[t][0],4),PKW(S[t][0],6)},pw1=(u32x4){PKW(S[t][0],8),PKW(S[t][0],10),PKW(S[t][0],12),PKW(S[t][0],14)};
      const u32x4 pw2=(u32x4){PKW(S[t][1],0),PKW(S[t][1],2),PKW(S[t][1],4),PKW(S[t][1],6)},pw3=(u32x4){PKW(S[t][1],8),PKW(S[t][1],10),PKW(S[t][1],12),PKW(S[t][1],14)};
      #undef PKW
      SBAR(); pv(o,vb0+(wc+t)*SLOTB,__builtin_bit_cast(bf16x8,pw0),__builtin_bit_cast(bf16x8,pw1),__builtin_bit_cast(bf16x8,pw2),__builtin_bit_cast(bf16x8,pw3));
    }
  }
  if(hi==0)wsf[32+r32]=l;asm volatile("s_waitcnt lgkmcnt(0)":::"memory");
  float rli[16];
  #pragma unroll
  for(int r=0;r<16;++r)rli[r]=__builtin_amdgcn_rcpf(wsf[32+crow(r,hi)]);
  bf16*Ow=Oh+(long)(q0+wid*QBLK)*DM;
  { bf16*stg=(bf16*)(shm+SWA_OST)+wid*2048;
    #pragma unroll
    for(int r=0;r<16;++r){const int orow=crow(r,hi);
      #pragma unroll
      for(int d0=0;d0<2;++d0)stg[orow*64+d0*32+r32]=__float2bfloat16(o[d0][r]*rli[r]);}
    asm volatile("s_waitcnt lgkmcnt(0)":::"memory");
    #pragma unroll
    for(int i=0;i<4;++i){const int row=i*8+(lane>>3),ch=lane&7; const u32x4 v=*(const u32x4*)(stg+row*64+ch*8); ATTN_STORE16(Ow+(long)row*DM+ch*8,v);} }
  asm volatile("s_waitcnt lgkmcnt(0)\n\ts_barrier":::"memory");
}

#undef SBAR
#undef WAIT_BAR
}

namespace cg = cooperative_groups;
constexpr int NWAVES = 8;
constexpr int BATCH = 2, T = 8192, D = 1024, FF = 4096, PLE = 256, DIN_SRC = 4360, NZ = 4352, M = BATCH * T;
constexpr float RMS_EPS = 1e-6f, LOG2E = 1.4426950408889634f;
constexpr size_t MiB = 1u << 20;
constexpr size_t WS_WIN = 0, WS_WA = 9 * MiB, WS_WB = 10 * MiB, WS_WMIX = 11 * MiB, WS_W1 = 13 * MiB, WS_W2 = 21 * MiB, WS_WG = 29 * MiB, WS_WP = 31 * MiB;
constexpr size_t WS_LF = 31 * MiB + 512 * 1024, WS_CB = 32 * MiB;
constexpr size_t WS_NM = 32 * MiB + 512 * 1024;
constexpr size_t WS_ST1 = 33 * MiB, WS_ST2 = 34 * MiB, WS_ST3 = 35 * MiB;
constexpr size_t WS_PB = 36 * MiB;
constexpr size_t WS_XN = 44 * MiB;
constexpr size_t WS_HN = 76 * MiB;
constexpr size_t WS_Z = 108 * MiB;
constexpr size_t WS_CTL = 244 * MiB, CTL_ZERO_BYTES = 16384;
constexpr size_t WS_END = 245 * MiB;
constexpr int RING_BYTES = 131072, LDS_BYTES = 147456, MISC_OFF = RING_BYTES + 320;
#define GAS __attribute__((address_space(1)))
#define LAS __attribute__((address_space(3)))
typedef unsigned short bf16;
typedef unsigned v4u __attribute__((ext_vector_type(4)));
typedef unsigned v2u __attribute__((ext_vector_type(2)));
typedef float f32x4 __attribute__((ext_vector_type(4)));
#define LDS_WAIT() asm volatile("s_waitcnt lgkmcnt(0)" ::: "memory")
__device__ __forceinline__ unsigned f2bf(float f) { unsigned u = __builtin_bit_cast(unsigned, f); return (u + 0x7fffu + ((u >> 16) & 1u)) >> 16; }
__device__ __forceinline__ unsigned pk2(float lo, float hi) { return f2bf(lo) | (f2bf(hi) << 16); }
__device__ __forceinline__ float wave_sum(float v) {
#pragma unroll
    for (int o = 1; o < 64; o <<= 1) v += __shfl_xor(v, o);
    return v;
}
#define RLX_AGENT __ATOMIC_RELAXED, __HIP_MEMORY_SCOPE_AGENT
#define XB_TMO      128
#define XB_XCNT(j)  (256  + 64 * (j))
#define XB_XSUB(j)  (1280 + 64 * (j))
#define XB_XGEN(j)  (2304 + 64 * (j))
#define XB_TOP      3328
#define XB_TOPGEN   3392
#define XCD_BAR_WORDS 3456
#define XB_SPIN_CAP (1u << 18)

__device__ __forceinline__ unsigned xb_ld(unsigned* p)              { return __hip_atomic_load(p, __ATOMIC_RELAXED, __HIP_MEMORY_SCOPE_AGENT); }
__device__ __forceinline__ unsigned xb_add(unsigned* p, unsigned v) { return __hip_atomic_fetch_add(p, v, __ATOMIC_RELAXED, __HIP_MEMORY_SCOPE_AGENT); }
__device__ __forceinline__ unsigned xb_xcc_id() { return (unsigned)__builtin_amdgcn_s_getreg((3 << 11) | 20) & 0xFu; }
#define XB_SPIN(cond, bar) do { unsigned _sp = 0; while (cond) { __builtin_amdgcn_s_sleep(1); \
    if ((++_sp & 255u) == 0u) { if (xb_ld(&(bar)[XB_TMO])) break; if (_sp > XB_SPIN_CAP) { atomicAdd(&(bar)[XB_TMO], 1u); break; } } } } while (0)

struct XcdBarrier {
    unsigned* bar; unsigned x;
    volatile LAS unsigned* st;
};

__device__ __forceinline__ XcdBarrier xcd_barrier_post(unsigned* bar, volatile LAS unsigned* st) {
    XcdBarrier b; b.bar = bar; b.x = xb_xcc_id(); b.st = st;
    if (threadIdx.x == 0) (void)xb_add(&bar[XB_XCNT(b.x)], 1u);
    return b;
}
__device__ __forceinline__ void xcd_barrier_complete(unsigned* bar, unsigned x, unsigned& nloc, unsigned& nx) {
    const unsigned G = gridDim.x * gridDim.y * gridDim.z;
    unsigned sum, cnt, mine, sp = 0u;
    for (;;) {
        sum = 0u; cnt = 0u; mine = 0u;
#pragma unroll
        for (unsigned j = 0; j < 16; ++j) { const unsigned c = xb_ld(&bar[XB_XCNT(j)]); sum += c; cnt += (c > 0u) ? 1u : 0u; mine = (j == x) ? c : mine; }
        if (sum == G) break;
        __builtin_amdgcn_s_sleep(1);
        if ((++sp & 255u) == 0u) { if (xb_ld(&bar[XB_TMO])) break; if (sp > XB_SPIN_CAP) { atomicAdd(&bar[XB_TMO], 1u); break; } }
    }
    nloc = mine > 0u ? mine : 1u; nx = cnt > 0u ? cnt : 1u;
}

__device__ __forceinline__ void xcd_barrier(const XcdBarrier& b, const bool t0) {
    asm volatile("s_waitcnt vmcnt(0)" ::: "memory");
    __syncthreads();
    if (t0) {
        unsigned* bar = b.bar;
        __builtin_amdgcn_s_waitcnt(0);
        unsigned nloc = b.st[0], nx = b.st[1];
        if (nloc == 0u) { xcd_barrier_complete(bar, b.x, nloc, nx); b.st[0] = nloc; b.st[1] = nx; }
        const unsigned old = xb_add(&bar[XB_XSUB(b.x)], 1u);
        const unsigned gen = old / nloc;
        if (old + 1u == (gen + 1u) * nloc) {
            __builtin_amdgcn_fence(__ATOMIC_RELEASE, "agent");
            asm volatile("s_waitcnt vmcnt(0)" ::: "memory");
            const unsigned og = xb_add(&bar[XB_TOP], 1u);
            const unsigned tg = og / nx;
            if (og + 1u == (tg + 1u) * nx) xb_add(&bar[XB_TOPGEN], 1u);
            else XB_SPIN(xb_ld(&bar[XB_TOPGEN]) == tg, bar);
            __builtin_amdgcn_fence(__ATOMIC_ACQUIRE, "agent");
            xb_add(&bar[XB_XGEN(b.x)], 1u);
            asm volatile("s_waitcnt vmcnt(0)" ::: "memory");
        } else {
            XB_SPIN(xb_ld(&bar[XB_XGEN(b.x)]) == gen, bar);
            __builtin_amdgcn_fence(__ATOMIC_ACQUIRE, "agent");
            asm volatile("s_waitcnt vmcnt(0)" ::: "memory");
        }
    }
    __syncthreads();
}
struct Frame {
    LAS unsigned char* lds; int wave, vcu, G;
};
__device__ __forceinline__ void p0_transpose_item(const float* W, int ldw, int K, int N, int split, int extra, const float* gs, bf16* WT, LAS float* scr, int item, int lane) {
    const int nblk = N / 32, kb = item / nblk, nb = item % nblk, k0 = 64 * kb, n0 = 32 * nb, s0 = n0 + (n0 >= split ? extra : 0);
    const float* src = W + (size_t)(k0 + (lane >> 5)) * ldw + s0 + (lane & 31);
    float w[32];
#pragma unroll
    for (int i = 0; i < 32; ++i) w[i] = src[(size_t)(2 * i) * ldw];
    const int c = lane & 7;
    f32x4 g0 = (f32x4){1.f, 1.f, 1.f, 1.f}, g1 = g0;
    if (gs) { g0 = *(const f32x4*)(gs + k0 + 8 * c); g1 = *(const f32x4*)(gs + k0 + 8 * c + 4); }
#pragma unroll
    for (int i = 0; i < 32; ++i) scr[(2 * i + (lane >> 5)) * 33 + (lane & 31)] = w[i];
    LDS_WAIT(); asm volatile("" ::: "memory");
#pragma unroll
    for (int j = 0; j < 4; ++j) { const int n = (lane >> 3) + 8 * j; const LAS float* s = scr + (8 * c) * 33 + n;
        v4u o; o.x = pk2(s[0 * 33] * g0.x, s[1 * 33] * g0.y); o.y = pk2(s[2 * 33] * g0.z, s[3 * 33] * g0.w); o.z = pk2(s[4 * 33] * g1.x, s[5 * 33] * g1.y); o.w = pk2(s[6 * 33] * g1.z, s[7 * 33] * g1.w);
        *(GAS v4u*)(WT + (size_t)(n0 + n) * K + k0 + 8 * c) = o; }
    LDS_WAIT(); asm volatile("" ::: "memory");
}
struct Args { const float* in[16]; float* out; unsigned char* ws; };
constexpr int WF_OFF = 8 * 8704;

__global__ void __launch_bounds__(NWAVES * 64, 2) mk_fwd(Args args) {
    extern __shared__ __attribute__((aligned(16))) unsigned char lds[];
    cg::grid_group grid = cg::this_grid();
    Frame F;
    F.lds = (LAS unsigned char*)lds;
    F.wave = __builtin_amdgcn_readfirstlane((int)threadIdx.x >> 6);
    F.G = gridDim.x; { const int bx = blockIdx.x; F.vcu = (F.G % 8 == 0) ? (bx % 8) * (F.G / 8) + bx / 8 : bx; }
    unsigned char* ws = args.ws;
    const float* x = args.in[0]; const float* p_in = args.in[1]; const float* g_mix = args.in[2]; const float* w_in = args.in[3]; const float* b_forget = args.in[4];
    const float* sinks = args.in[5]; const float* w_br_swa = args.in[6]; const float* w_br_fox = args.in[7]; const float* w_mix = args.in[8]; const float* g_mlp = args.in[9];
    const float* w_ff1 = args.in[10]; const float* w_ff2 = args.in[11]; const float* g_ple = args.in[12]; const float* w_pg = args.in[13]; const float* w_pp = args.in[14]; const float* g_final = args.in[15];
    float* out = args.out;
    bf16 *WIN_t = (bf16*)(ws + WS_WIN), *WA_t = (bf16*)(ws + WS_WA), *WB_t = (bf16*)(ws + WS_WB), *WMIX_t = (bf16*)(ws + WS_WMIX), *W1_t = (bf16*)(ws + WS_W1), *W2_t = (bf16*)(ws + WS_W2), *WG_t = (bf16*)(ws + WS_WG), *WP_t = (bf16*)(ws + WS_WP);
    float *LF = (float*)(ws + WS_LF), *CB = (float*)(ws + WS_CB), *ST1 = (float*)(ws + WS_ST1), *ST2 = (float*)(ws + WS_ST2), *ST3 = (float*)(ws + WS_ST3);
    bf16 *PB = (bf16*)(ws + WS_PB), *XN = (bf16*)(ws + WS_XN), *HN = (bf16*)(ws + WS_HN), *Z = (bf16*)(ws + WS_Z), *HB = (bf16*)(ws + WS_Z); bf16* PP = (bf16*)(ws + WS_Z);
    unsigned* NM = (unsigned*)(ws + WS_NM);
    const int gw = F.vcu * NWAVES + F.wave, NGW = F.G * NWAVES;

    for (int u = threadIdx.x; u < 128; u += NWAVES * 64) ((LAS unsigned*)(F.lds + RING_BYTES))[u] = 0u;
    __syncthreads();
    XcdBarrier bar = xcd_barrier_post((unsigned*)(ws + WS_CTL), (volatile LAS unsigned*)(F.lds + MISC_OFF) + 8);
#define GRID_BAR() do { const int l_ = fresh_lane(); xcd_barrier(bar, (F.wave == 0) && (l_ == 0)); } while (0)
    {
        const int p0_tid = threadIdx.x, p0_lane = p0_tid & 63;
        for (int i = blockIdx.x * (NWAVES * 64) + p0_tid; i < 1024 + 32; i += F.G * NWAVES * 64) NM[i] = 0u;
        LAS float* wfT = (LAS float*)(F.lds + WF_OFF);
        for (int i = p0_tid; i < 8 * D; i += NWAVES * 64) { const int k = i >> 3, h = i & 7; wfT[h * 1024 + k] = g_mix[k] * w_in[(size_t)k * DIN_SRC + 2304 + h]; }
        __syncthreads();
        f32x4 gm4[4];
#pragma unroll
        for (int j = 0; j < 4; ++j) gm4[j] = ((const GAS f32x4*)g_mix)[64 * j + p0_lane];
        const float bfg = b_forget[p0_lane & 7];
        f32x4 v[4];
        if (gw < M) { const GAS f32x4* xr = (const GAS f32x4*)(x + (size_t)gw * D) + p0_lane;
#pragma unroll
            for (int j = 0; j < 4; ++j) v[j] = xr[64 * j]; }
        for (int m = gw; m < M; m += NGW) {
            f32x4 vn[4]; const int mn = (m + NGW < M) ? m + NGW : m;
            { const GAS f32x4* xr = (const GAS f32x4*)(x + (size_t)mn * D) + p0_lane;
#pragma unroll
              for (int j = 0; j < 4; ++j) vn[j] = xr[64 * j]; }
            float ss = 0.f;
#pragma unroll
            for (int j = 0; j < 4; ++j) ss += (v[j].x * v[j].x + v[j].y * v[j].y) + (v[j].z * v[j].z + v[j].w * v[j].w);
            float a8[8];
#pragma unroll
            for (int h = 0; h < 8; ++h) { float a = 0.f;
#pragma unroll
                for (int j = 0; j < 4; ++j) { const f32x4 w = ((const LAS f32x4*)wfT)[h * 256 + 64 * j + p0_lane]; a += (v[j].x * w.x + v[j].y * w.y) + (v[j].z * w.z + v[j].w * w.w); }
                a8[h] = a; }
#pragma unroll
            for (int o = 1; o < 64; o <<= 1) { ss += __shfl_xor(ss, o);
#pragma unroll
                for (int h = 0; h < 8; ++h) a8[h] += __shfl_xor(a8[h], o); }
            const float rstd = 1.f / sqrtf(ss * (1.f / D) + RMS_EPS);
            float fsel = a8[0];
#pragma unroll
            for (int h = 1; h < 8; ++h) fsel = (p0_lane == h) ? a8[h] : fsel;
            if (p0_lane < 8) { const float xf = fsel * rstd + bfg; const float ls = fminf(xf, 0.f) - log1pf(expf(-fabsf(xf)));
                LF[(size_t)((m >> 13) * 8 + p0_lane) * T + (m & (T - 1))] = ls; }
            GAS unsigned long long* o8 = (GAS unsigned long long*)(XN + (size_t)m * D) + p0_lane;
#pragma unroll
            for (int j = 0; j < 4; ++j) { const f32x4 y = v[j] * rstd * gm4[j];
                o8[64 * j] = (unsigned long long)pk2(y.x, y.y) | ((unsigned long long)pk2(y.z, y.w) << 32); }
#pragma unroll
            for (int j = 0; j < 4; ++j) v[j] = vn[j];
        }
        LAS float* scr = (LAS float*)(F.lds + F.wave * 8704);
        constexpr int I_IN = (D / 64) * (NZ / 32);
        for (int it = gw; it < I_IN; it += NGW) p0_transpose_item(w_in, DIN_SRC, D, NZ, 2304, 8, nullptr, WIN_t, scr, it, p0_lane);
    }
    grid.sync();

    for (int bh = (F.G >= 96) ? (int)blockIdx.x - 64 : (int)blockIdx.x; bh < 16; bh += (int)gridDim.x) {
        if (bh < 0) continue;
        const int c_lane = fresh_lane(), c_tid = F.wave * 64 + c_lane;
        const GAS f32x4* src = (const GAS f32x4*)(LF + (size_t)bh * T) + c_tid * 4;
        f32x4 v[4]; float run = 0.f;
#pragma unroll
        for (int j = 0; j < 4; ++j) { v[j] = src[j];
#pragma unroll
            for (int e = 0; e < 4; ++e) { run += v[j][e]; v[j][e] = run; } }
        float sc = run;
#pragma unroll
        for (int o = 1; o < 64; o <<= 1) { const float n = __shfl_up(sc, o); if (c_lane >= o) sc += n; }
        LAS float* wt = (LAS float*)F.lds;
        if (c_lane == 63) wt[F.wave] = sc;
        __syncthreads();
        float woff = 0.f;
        for (int w = 0; w < F.wave; ++w) woff += wt[w];
        const float off = woff + sc - run;
        GAS f32x4* dst = (GAS f32x4*)(CB + (size_t)bh * T) + c_tid * 4;
#pragma unroll
        for (int j = 0; j < 4; ++j) dst[j] = (v[j] + off) * (-LOG2E);
        __syncthreads();
    }
    {
        pg8::Gemm g{XN, WIN_t, M, NZ, D, D}; pg8::StaticOrder S; S.init(M, NZ, F.G, (int)blockIdx.x);
        pg8::EpiZ E{Z, NM, 0};
        pg8::gemm_phase<pg8::EpiZ, pg8::StaticOrder, PG8_ALIGN, PG8_SP2>(F.lds, g, S, E, F.wave);
    }
    {
        const int nfive = (M / 256) * (NZ / 256) - 4 * F.G;
        const int nconv = (nfive > 0 && nfive < F.G) ? F.G - nfive : F.G, cidx = (nfive > 0 && nfive < F.G) ? (int)blockIdx.x - nfive : (int)blockIdx.x;
        if (cidx >= 0) {
            const int w_lane = fresh_lane();
            LAS float* scr = (LAS float*)(F.lds + F.wave * 8704);
            for (int i = (cidx * NWAVES + F.wave) * 64 + w_lane; i < M * PLE / 32; i += nconv * NWAVES * 64) { f32x4 a[8];
#pragma unroll
            for (int q = 0; q < 4; ++q) { a[2 * q] = ((const GAS f32x4*)p_in)[2 * (i + q * (M * PLE / 32))]; a[2 * q + 1] = ((const GAS f32x4*)p_in)[2 * (i + q * (M * PLE / 32)) + 1]; }
#pragma unroll
            for (int q = 0; q < 4; ++q) { v4u o; o.x = pk2(a[2 * q].x, a[2 * q].y); o.y = pk2(a[2 * q].z, a[2 * q].w); o.z = pk2(a[2 * q + 1].x, a[2 * q + 1].y); o.w = pk2(a[2 * q + 1].z, a[2 * q + 1].w); ((GAS v4u*)PB)[i + q * (M * PLE / 32)] = o; } }
            constexpr int I_A = (512 / 64) * (D / 32), I_MIX = (D / 64) * (D / 32), I_1 = (D / 64) * (FF / 32), I_2 = (FF / 64) * (D / 32), I_P = (PLE / 64) * (D / 32);
            constexpr int NITEMS = 2 * I_A + I_MIX + I_1 + I_2 + I_MIX + I_P;
            for (int it = cidx * NWAVES + F.wave; it < NITEMS; it += nconv * NWAVES) {
                int r = it;
                if (r < I_A) { p0_transpose_item(w_br_swa, D, 512, D, 1 << 30, 0, nullptr, WA_t, scr, r, w_lane); continue; } r -= I_A;
                if (r < I_A) { p0_transpose_item(w_br_fox, D, 512, D, 1 << 30, 0, nullptr, WB_t, scr, r, w_lane); continue; } r -= I_A;
                if (r < I_MIX) { p0_transpose_item(w_mix, D, D, D, 1 << 30, 0, nullptr, WMIX_t, scr, r, w_lane); continue; } r -= I_MIX;
                if (r < I_1) { p0_transpose_item(w_ff1, FF, D, FF, 1 << 30, 0, g_mlp, W1_t, scr, r, w_lane); continue; } r -= I_1;
                if (r < I_2) { p0_transpose_item(w_ff2, D, FF, D, 1 << 30, 0, nullptr, W2_t, scr, r, w_lane); continue; } r -= I_2;
                if (r < I_MIX) { p0_transpose_item(w_pg, D, D, D, 1 << 30, 0, g_ple, WG_t, scr, r, w_lane); continue; } r -= I_MIX;
                p0_transpose_item(w_pp, D, PLE, D, 1 << 30, 0, nullptr, WP_t, scr, r, w_lane);
            }
        }
    }
    GRID_BAR();

    {
        unsigned* qctr = (unsigned*)(ws + WS_CTL) + 3584;
        volatile LAS unsigned* qslot = (volatile LAS unsigned*)(F.lds + RING_BYTES + 16);
        for (;;) {
            { const int l_ = fresh_lane(); if (F.wave == 0 && l_ == 0) qslot[0] = __hip_atomic_fetch_add(qctr, 1u, __ATOMIC_RELAXED, __HIP_MEMORY_SCOPE_AGENT); }
            __syncthreads();
            const int idx = __builtin_amdgcn_readfirstlane((int)qslot[0]);
            __syncthreads();
            if (idx >= 512 + 512) break;
            if (idx < 512) {
                const int j = idx, qb = 31 - (j >> 4), bh = j & 15, b = bh >> 3, h = bh & 7;
                const attn_body::bf16* Zb = (const attn_body::bf16*)Z + (size_t)b * T * NZ;
                const attn_body::bf16* Qh = Zb + 768 + h * 64; const attn_body::bf16* Kh = Zb + 1280 + h * 64; const attn_body::bf16* Vh = Zb + 1792 + h * 64;
                const float* cb = CB + (size_t)bh * T;
                const float km = sqrtf(__uint_as_float(NM[1024 + bh * 2]) + __uint_as_float(NM[1024 + bh * 2 + 1]));
                const int pmA = b * 32 + qb;
                const float qkA = 2.04f * km * sqrtf(__uint_as_float(NM[(pmA * 8 + h) * 2]) + __uint_as_float(NM[(pmA * 8 + h) * 2 + 1]));
                attn_body::attn_unit<24>(F.wave, qb, Qh, Kh, Vh, (attn_body::bf16*)Qh, cb, qkA, (char*)lds);
            } else {
                const int j = idx - 512, bh = j >> 5, qb = j & 31, b = bh >> 3, h = bh & 7;
                const attn_body::bf16* Zb = (const attn_body::bf16*)Z + (size_t)b * T * NZ;
                const attn_body::bf16* Qh = Zb + h * 64; const attn_body::bf16* Kh = Zb + 512 + (h >> 2) * 64; const attn_body::bf16* Vh = Zb + 640 + (h >> 2) * 64;
                const float slope2 = exp2f(-(float)(h + 1)) * LOG2E, sink2 = sinks[h] * LOG2E;
                attn_body::swa_unit(F.wave, qb, Qh, Kh, Vh, (attn_body::bf16*)Qh, slope2, sink2, (char*)lds);
            }
        }
    }
    GRID_BAR();

    {
        pg8::PairOrder S; S.so.init(M, D, F.G, (int)blockIdx.x);
        pg8::Gemm g{Z, WA_t, M, D, 512, NZ}; pg8::EpiPair E{Z + 2304, Z + 3328, XN, (size_t)768 * 2, (size_t)(WS_WB - WS_WA)};
        pg8::gemm_phase<pg8::EpiPair, pg8::PairOrder, PG8_ALIGN, PG8_SP2>(F.lds, g, S, E, F.wave);
    }
    GRID_BAR();

    {
        pg8::Gemm g{XN, WMIX_t, M, D, D, D}; pg8::StaticOrder S; S.init(M, D, F.G, (int)blockIdx.x);
        pg8::EpiRes<false> E{x, HN, ST1};
        pg8::gemm_phase<pg8::EpiRes<false>, pg8::StaticOrder, PG8_ALIGN, PG8_SP2>(F.lds, g, S, E, F.wave);
    }
    GRID_BAR();

    {
        pg8::Gemm g{HN, W1_t, M, FF, D, D}; pg8::StaticOrder S; S.init(M, FF, F.G, (int)blockIdx.x);
        pg8::EpiRelu2 E{ST1, HB};
        pg8::gemm_phase<pg8::EpiRelu2, pg8::StaticOrder, PG8_ALIGN, PG8_SP2>(F.lds, g, S, E, F.wave);
    }
    GRID_BAR();

    {
        pg8::Gemm g{HB, W2_t, M, D, FF, FF}; pg8::StaticOrder S; S.init(M, D, F.G, (int)blockIdx.x);
        pg8::EpiRes<true> E{HN, XN, ST2};
        pg8::gemm_phase<pg8::EpiRes<true>, pg8::StaticOrder, PG8_ALIGN, PG8_SP2>(F.lds, g, S, E, F.wave);
    }
    GRID_BAR();

    {
        pg8::StaticOrder S; S.init(M, D, F.G, (int)blockIdx.x);
        { pg8::Gemm g{PB, WP_t, M, D, PLE, PLE}; pg8::EpiPP E{PP}; pg8::gemm_phase<pg8::EpiPP, pg8::StaticOrder, PG8_ALIGN, PG8_SP2>(F.lds, g, S, E, F.wave); }
        { pg8::Gemm g{XN, WG_t, M, D, D, D}; pg8::EpiPle E{ST2, PP, XN, HN, ST3}; pg8::gemm_phase<pg8::EpiPle, pg8::StaticOrder, PG8_ALIGN, PG8_SP2>(F.lds, g, S, E, F.wave); }
    }
    GRID_BAR();

    const int f_lane = fresh_lane();
    f32x4 gf4[4];
#pragma unroll
    for (int j = 0; j < 4; ++j) gf4[j] = ((const GAS f32x4*)g_final)[64 * j + f_lane];
    for (int m = gw; m < M; m += 2 * NGW) {
        const int m2 = (m + NGW < M) ? m + NGW : m;
        const float t0 = (f_lane < 16) ? ST3[(size_t)m * 16 + f_lane] : 0.f, t1 = (f_lane < 16) ? ST3[(size_t)m2 * 16 + f_lane] : 0.f;
        const GAS v2u* hr0 = (const GAS v2u*)(HN + (size_t)m * D) + f_lane; const GAS v2u* hr1 = (const GAS v2u*)(HN + (size_t)m2 * D) + f_lane;
        v2u h0[4], h1[4];
#pragma unroll
        for (int j = 0; j < 4; ++j) { h0[j] = hr0[64 * j]; h1[j] = hr1[64 * j]; }
        float s0 = t0, s1 = t1;
#pragma unroll
        for (int o = 1; o < 16; o <<= 1) { s0 += __shfl_xor(s0, o); s1 += __shfl_xor(s1, o); }
        s0 = __shfl(s0, 0); s1 = __shfl(s1, 0);
        const float r0 = 1.f / sqrtf(s0 * (1.f / D) + RMS_EPS), r1 = 1.f / sqrtf(s1 * (1.f / D) + RMS_EPS);
        GAS f32x4* x0 = (GAS f32x4*)(out + (size_t)m * D) + f_lane; GAS f32x4* x1 = (GAS f32x4*)(out + (size_t)m2 * D) + f_lane;
#pragma unroll
        for (int j = 0; j < 4; ++j) {
            const f32x4 a = (f32x4){__uint_as_float(h0[j].x << 16), __uint_as_float(h0[j].x & 0xffff0000u), __uint_as_float(h0[j].y << 16), __uint_as_float(h0[j].y & 0xffff0000u)};
            const f32x4 b = (f32x4){__uint_as_float(h1[j].x << 16), __uint_as_float(h1[j].x & 0xffff0000u), __uint_as_float(h1[j].y << 16), __uint_as_float(h1[j].y & 0xffff0000u)};
            x0[64 * j] = a * r0 * gf4[j]; x1[64 * j] = b * r1 * gf4[j]; }
    }
}

extern "C" void kernel_launch(void* const* d_in, const int* in_sizes, int n_in, void* d_out, int out_size, void* d_ws, size_t ws_size, hipStream_t stream) {
    static int grid = 0;
    if (grid == 0) {
        if (n_in != 16 || in_sizes[0] != M * D || out_size != M * D || ws_size < WS_END) { fprintf(stderr, "kernel_launch: unexpected shapes (n_in %d, in0 %d, out %d, ws %zu); nothing launched\n", n_in, n_in > 0 ? in_sizes[0] : -1, out_size, ws_size); grid = -1; return; }
        int dev = 0, cus = 0, per_cu = 0;
        if (hipGetDevice(&dev) != hipSuccess || hipDeviceGetAttribute(&cus, hipDeviceAttributeMultiprocessorCount, dev) != hipSuccess) { grid = -1; return; }
        if (hipFuncSetAttribute((const void*)mk_fwd, hipFuncAttributeMaxDynamicSharedMemorySize, LDS_BYTES) != hipSuccess) { fprintf(stderr, "kernel_launch: hipFuncSetAttribute failed\n"); grid = -1; return; }
        if (hipOccupancyMaxActiveBlocksPerMultiprocessor(&per_cu, (const void*)mk_fwd, NWAVES * 64, LDS_BYTES) != hipSuccess || per_cu < 1) { fprintf(stderr, "kernel_launch: occupancy query failed (%d)\n", per_cu); (void)hipGetLastError(); per_cu = 1; }
        if (per_cu > 1) per_cu = 1;
        grid = cus * per_cu;
    }
    if (grid < 0) return;
    if (hipMemsetAsync((char*)d_ws + WS_CTL, 0, CTL_ZERO_BYTES, stream) != hipSuccess) { fprintf(stderr, "kernel_launch: memset failed\n"); return; }
    Args a{};
    for (int i = 0; i < 16; ++i) a.in[i] = (const float*)d_in[i];
    a.out = (float*)d_out; a.ws = (unsigned char*)d_ws;
    void* kargs[] = {&a};
    hipError_t e = hipLaunchCooperativeKernel((const void*)mk_fwd, dim3(grid), dim3(NWAVES * 64), kargs, LDS_BYTES, stream);
    if (e != hipSuccess) fprintf(stderr, "kernel_launch: cooperative launch failed: %s (grid %d)\n", hipGetErrorString(e), grid);
}
```
